# Optimizing an MI355X kernel written in HIP

```python
import jax
import jax.numpy as jnp
from jax import lax
import numpy as np

D_MODEL = 1024
BATCH = 8
SEQ = 2048
DEPTH = 2

GRID_W = 64
CTX_LEN = 256
HEAD_DIM = 64
ROPE_BASE = 10000.0
NORM_EPS = 1e-6
QBLOCK = 128
WINDOW = 128
N_MOD = 6

RG_WIDTH = D_MODEL // 2
RG_HEADS = RG_WIDTH // HEAD_DIM
RG_BLOCK = RG_WIDTH // RG_HEADS
RG_CONV = 4
RG_C = 8.0
ATT_HEADS = (D_MODEL // 2) // HEAD_DIM
ATT_KV_HEADS = ATT_HEADS // 4

S5_WIDTH = D_MODEL // 2
S5_GROUP = 16
S5_GROUPS = S5_WIDTH // S5_GROUP
S5_STATE = 64
WIN_HEADS = (D_MODEL // 2) // HEAD_DIM
WIN_KV_HEADS = WIN_HEADS // 4

FFN_HIDDEN = ((8 * D_MODEL // 3 + 127) // 128) * 128
FFN_CONV = 3

EVEN_IN = 2 * RG_WIDTH + (ATT_HEADS + 2 * ATT_KV_HEADS) * HEAD_DIM
EVEN_MIX = RG_WIDTH + ATT_HEADS * HEAD_DIM
ODD_IN = S5_WIDTH + (WIN_HEADS + 2 * WIN_KV_HEADS) * HEAD_DIM
ODD_MIX = S5_WIDTH + WIN_HEADS * HEAD_DIM

kernel_name = "hybrid_rglru_gqa_s5_swa_dit_trunk"


def _split_cols(t, sizes):
    idx = [int(v) for v in np.cumsum(sizes)]
    return jnp.split(t, idx, axis=-1)


def _flip(t, rev):
    return jnp.flip(t, axis=1) if rev else t


def rms_norm(x, g):
    xf = x.astype(jnp.float32)
    y = xf * lax.rsqrt(jnp.mean(xf * xf, axis=-1, keepdims=True) + NORM_EPS)
    return (y * g.astype(jnp.float32)).astype(x.dtype)


def adaln_norm(x, g, shift, scale):
    return rms_norm(x, g) * (1.0 + scale) + shift


def depthwise_conv(x, w, b):
    k = w.shape[0]
    left = (k - 1) // 2
    n = x.shape[1]
    xp = jnp.pad(x, ((0, 0), (left, k - 1 - left), (0, 0)))
    out = b
    for j in range(k):
        out = out + xp[:, j:j + n] * w[j]
    return out


def axial_rope_tables(n_tokens):
    rows = n_tokens // GRID_W
    row = jnp.repeat(jnp.arange(rows, dtype=jnp.float32), GRID_W)
    col = jnp.tile(jnp.arange(GRID_W, dtype=jnp.float32), rows)
    quarter = HEAD_DIM // 4
    inv_freq = ROPE_BASE ** (-jnp.arange(quarter, dtype=jnp.float32) / quarter)
    ang = jnp.concatenate([row[:, None] * inv_freq, col[:, None] * inv_freq], axis=-1)
    return jnp.cos(ang), jnp.sin(ang)


def apply_axial_rope(x, cos, sin):
    quarter = HEAD_DIM // 4
    xs = x.astype(jnp.float32).reshape(x.shape[:-1] + (2, 2, quarter))
    x1, x2 = xs[..., 0, :], xs[..., 1, :]
    cs = cos.reshape(cos.shape[0], 1, 2, quarter)
    sn = sin.reshape(sin.shape[0], 1, 2, quarter)
    out = jnp.stack([x1 * cs - x2 * sn, x2 * cs + x1 * sn], axis=-2)
    return out.reshape(x.shape).astype(x.dtype)


def head_norm(t, n_heads, g):
    return rms_norm(t.reshape(t.shape[:-1] + (n_heads, HEAD_DIM)), g)


def split_heads(t, n_heads):
    return t.reshape(t.shape[:-1] + (n_heads, HEAD_DIM))


def ctx_attention(qc, kc, vc, sink):
    bsz, n_ctx, n_heads, _ = qc.shape
    n_kv = kc.shape[2]
    grp = n_heads // n_kv
    qg = qc.reshape(bsz, n_ctx, n_kv, grp, HEAD_DIM)
    s = jnp.einsum('bqkgd,bskd->bkgqs', qg, kc).astype(jnp.float32) * (HEAD_DIM ** -0.5)
    if sink is None:
        p = jax.nn.softmax(s, axis=-1)
    else:
        sink_col = jnp.broadcast_to(sink.astype(jnp.float32).reshape(1, n_kv, grp, 1, 1), s.shape[:-1] + (1,))
        p = jax.nn.softmax(jnp.concatenate([s, sink_col], axis=-1), axis=-1)[..., :-1]
    o = jnp.einsum('bkgqs,bskd->bqkgd', p.astype(vc.dtype), vc)
    return o.reshape(bsz, n_ctx, n_heads * HEAD_DIM)


def global_gqa(q, k, v, qc, kc, vc, cos, sin):
    bsz, n, n_heads, _ = q.shape
    n_kv = k.shape[2]
    grp = n_heads // n_kv
    scale = HEAD_DIM ** -0.5
    q = apply_axial_rope(q, cos, sin)
    k = apply_axial_rope(k, cos, sin)
    k_all = jnp.concatenate([kc, k], axis=1)
    v_all = jnp.concatenate([vc, v], axis=1)
    nb = n // QBLOCK
    q_blocks = q.reshape(bsz, nb, QBLOCK, n_kv, grp, HEAD_DIM).transpose(1, 0, 2, 3, 4, 5)

    def one_block(qb):
        s = jnp.einsum('bqkgd,bskd->bkgqs', qb, k_all).astype(jnp.float32) * scale
        p = jax.nn.softmax(s, axis=-1).astype(v_all.dtype)
        return jnp.einsum('bkgqs,bskd->bqkgd', p, v_all)

    o = lax.map(one_block, q_blocks)
    o = o.transpose(1, 0, 2, 3, 4, 5).reshape(bsz, n, n_heads * HEAD_DIM)
    o_c = ctx_attention(qc, kc, vc, None) if qc is not None else None
    return o, o_c


def window_gqa_sink(q, k, v, qc, kc, vc, sink, cos, sin):
    bsz, n, n_heads, _ = q.shape
    n_kv = k.shape[2]
    grp = n_heads // n_kv
    n_ctx = kc.shape[1]
    scale = HEAD_DIM ** -0.5
    q = apply_axial_rope(q, cos, sin)
    k = apply_axial_rope(k, cos, sin)
    nb = n // QBLOCK
    qb = q.reshape(bsz, nb, QBLOCK, n_kv, grp, HEAD_DIM)
    pad = ((0, 0), (WINDOW, WINDOW), (0, 0), (0, 0))
    kb = jnp.pad(k, pad).reshape(bsz, nb + 2, QBLOCK, n_kv, HEAD_DIM)
    vb = jnp.pad(v, pad).reshape(bsz, nb + 2, QBLOCK, n_kv, HEAD_DIM)
    k_win = jnp.concatenate([kb[:, :-2], kb[:, 1:-1], kb[:, 2:]], axis=2)
    v_win = jnp.concatenate([vb[:, :-2], vb[:, 1:-1], vb[:, 2:]], axis=2)
    starts = jnp.arange(nb) * QBLOCK
    q_pos = starts[:, None] + jnp.arange(QBLOCK)[None, :]
    k_pos = starts[:, None] - WINDOW + jnp.arange(3 * QBLOCK)[None, :]
    valid = ((jnp.abs(q_pos[:, :, None] - k_pos[:, None, :]) <= WINDOW)
             & (k_pos[:, None, :] >= 0) & (k_pos[:, None, :] < n))
    s_loc = jnp.einsum('bnqkgd,bnskd->bnkgqs', qb, k_win).astype(jnp.float32) * scale
    s_loc = jnp.where(valid[None, :, None, None], s_loc, -jnp.inf)
    s_ctx = jnp.einsum('bnqkgd,bskd->bnkgqs', qb, kc).astype(jnp.float32) * scale
    sink_col = jnp.broadcast_to(sink.astype(jnp.float32).reshape(1, 1, n_kv, grp, 1, 1), s_ctx.shape[:-1] + (1,))
    p = jax.nn.softmax(jnp.concatenate([s_ctx, s_loc, sink_col], axis=-1), axis=-1).astype(v.dtype)
    o = (jnp.einsum('bnkgqs,bskd->bnqkgd', p[..., :n_ctx], vc)
         + jnp.einsum('bnkgqs,bnskd->bnqkgd', p[..., n_ctx:n_ctx + 3 * QBLOCK], v_win))
    o = o.reshape(bsz, n, n_heads * HEAD_DIM)
    o_c = ctx_attention(qc, kc, vc, sink) if qc is not None else None
    return o, o_c


def linear_scan(a, b, h0):
    b = b.at[:, 0].add(a[:, 0] * h0)

    def combine(left, right):
        return (left[0] * right[0], right[0] * left[1] + right[1])

    _, h = lax.associative_scan(combine, (a, b), axis=1)
    return h


def rglru_coeffs(x, wa, ba, wx, bx, lam):
    bsz, n, width = x.shape
    xh = x.astype(jnp.float32).reshape(bsz, n, RG_HEADS, RG_BLOCK)
    r = jax.nn.sigmoid(jnp.einsum('blhi,hij->blhj', xh, wa.astype(jnp.float32)) + ba.astype(jnp.float32).reshape(RG_HEADS, RG_BLOCK))
    i = jax.nn.sigmoid(jnp.einsum('blhi,hij->blhj', xh, wx.astype(jnp.float32)) + bx.astype(jnp.float32).reshape(RG_HEADS, RG_BLOCK))
    log_a = -RG_C * r * jax.nn.softplus(-lam.astype(jnp.float32).reshape(RG_HEADS, RG_BLOCK))
    a = jnp.exp(log_a)
    b = jnp.sqrt(-jnp.expm1(2.0 * log_a)) * (i * xh)
    return a.reshape(bsz, n, width), b.reshape(bsz, n, width)


def rglru_mixer(u, gate, uc, gate_c, conv_w, conv_b, wa, ba, wx, bx, lam, emit_ctx):
    u = depthwise_conv(u, conv_w, conv_b)
    uc = depthwise_conv(uc, conv_w, conv_b)
    y = jnp.zeros(u.shape, jnp.float32)
    yc = jnp.zeros(uc.shape, jnp.float32)
    for d in range(2):
        rev = d == 1
        ac, bc = rglru_coeffs(_flip(uc, rev), wa[d], ba[d], wx[d], bx[d], lam[d])
        hc = linear_scan(ac, bc, jnp.zeros_like(bc[:, 0]))
        al, bl = rglru_coeffs(_flip(u, rev), wa[d], ba[d], wx[d], bx[d], lam[d])
        hl = linear_scan(al, bl, hc[:, -1])
        y = y + _flip(hl, rev)
        if emit_ctx:
            yc = yc + _flip(hc, rev)
    out = y.astype(u.dtype) * jax.nn.gelu(gate)
    out_c = yc.astype(uc.dtype) * jax.nn.gelu(gate_c) if emit_ctx else None
    return out, out_c


def s5_discretize(lam_re, lam_im, log_step, b_re, b_im):
    dt = jnp.exp(log_step.astype(jnp.float32))[:, None]
    lr = lam_re.astype(jnp.float32)
    li = lam_im.astype(jnp.float32)
    mag = jnp.exp(lr * dt)
    ang = li * dt
    abr, abi = mag * jnp.cos(ang), mag * jnp.sin(ang)
    den = lr * lr + li * li
    nr, ni = abr - 1.0, abi
    kr = (nr * lr + ni * li) / den
    ki = (ni * lr - nr * li) / den
    br = b_re.astype(jnp.float32)
    bi = b_im.astype(jnp.float32)
    bbr = kr[..., None] * br - ki[..., None] * bi
    bbi = kr[..., None] * bi + ki[..., None] * br
    return abr, abi, bbr, bbi


def complex_diag_scan(a_re, a_im, b_re, b_im, h_re, h_im):
    b_re = b_re.at[:, 0].add(a_re * h_re - a_im * h_im)
    b_im = b_im.at[:, 0].add(a_re * h_im + a_im * h_re)
    n = b_re.shape[1]
    ar = jnp.broadcast_to(a_re, (1, n) + a_re.shape)
    ai = jnp.broadcast_to(a_im, (1, n) + a_im.shape)

    def combine(left, right):
        lar, lai, lbr, lbi = left
        rar, rai, rbr, rbi = right
        return (rar * lar - rai * lai, rar * lai + rai * lar,
                rar * lbr - rai * lbi + rbr, rar * lbi + rai * lbr + rbi)

    _, _, sr, si = lax.associative_scan(combine, (ar, ai, b_re, b_im), axis=1)
    return sr, si


def s5_mixer(u, uc, lam_re, lam_im, log_step, b_re, b_im, c_re, c_im, d_skip, glu_w, glu_b, emit_ctx):
    bsz, n, width = u.shape
    ug = u.astype(jnp.float32).reshape(bsz, n, S5_GROUPS, S5_GROUP)
    ucg = uc.astype(jnp.float32).reshape(bsz, uc.shape[1], S5_GROUPS, S5_GROUP)
    dg = d_skip.astype(jnp.float32).reshape(S5_GROUPS, S5_GROUP)
    y = ug * dg
    yc = ucg * dg
    for d in range(2):
        rev = d == 1
        abr, abi, bbr, bbi = s5_discretize(lam_re[d], lam_im[d], log_step[d], b_re[d], b_im[d])
        cr = c_re[d].astype(jnp.float32)
        ci = c_im[d].astype(jnp.float32)

        def drive(t):
            return jnp.einsum('blgh,gph->blgp', t, bbr), jnp.einsum('blgh,gph->blgp', t, bbi)

        def readout(sr, si):
            return jnp.einsum('blgp,ghp->blgh', sr, cr) - jnp.einsum('blgp,ghp->blgh', si, ci)

        pc_r, pc_i = drive(_flip(ucg, rev))
        zeros = jnp.zeros_like(pc_r[:, 0])
        sc_r, sc_i = complex_diag_scan(abr, abi, pc_r, pc_i, zeros, zeros)
        pl_r, pl_i = drive(_flip(ug, rev))
        sl_r, sl_i = complex_diag_scan(abr, abi, pl_r, pl_i, sc_r[:, -1], sc_i[:, -1])
        y = y + _flip(readout(sl_r, sl_i), rev)
        if emit_ctx:
            yc = yc + _flip(readout(sc_r, sc_i), rev)

    def glu(t):
        z = jax.nn.gelu(t.reshape(t.shape[0], t.shape[1], width)).astype(u.dtype)
        return z * jax.nn.sigmoid(z @ glu_w + glu_b)

    return glu(y), (glu(yc) if emit_ctx else None)


def conv_ffn(x, w_up, conv_w, conv_b, w_down):
    hid = depthwise_conv(x @ w_up, conv_w, conv_b)
    val, gate = jnp.split(hid, 2, axis=-1)
    return (val * jax.nn.silu(gate)) @ w_down


def even_mixers(xn, xnc, w_in, conv_w, conv_b, wa, ba, wx, bx, lam, qn, kn, cos, sin, emit_ctx):
    sizes = [RG_WIDTH, RG_WIDTH, ATT_HEADS * HEAD_DIM, ATT_KV_HEADS * HEAD_DIM]
    u, gate, q, k, v = _split_cols(xn @ w_in, sizes)
    uc, gate_c, qc, kc, vc = _split_cols(xnc @ w_in, sizes)
    a_out, a_out_c = rglru_mixer(u, gate, uc, gate_c, conv_w, conv_b, wa, ba, wx, bx, lam, emit_ctx)
    qc_n = head_norm(qc, ATT_HEADS, qn) if emit_ctx else None
    b_out, b_out_c = global_gqa(head_norm(q, ATT_HEADS, qn), head_norm(k, ATT_KV_HEADS, kn), split_heads(v, ATT_KV_HEADS),
                                qc_n, head_norm(kc, ATT_KV_HEADS, kn), split_heads(vc, ATT_KV_HEADS), cos, sin)
    mix = jnp.concatenate([a_out, b_out], axis=-1)
    mix_c = jnp.concatenate([a_out_c, b_out_c], axis=-1) if emit_ctx else None
    return mix, mix_c


def odd_mixers(xn, xnc, w_in, lam_re, lam_im, log_step, b_re, b_im, c_re, c_im, d_skip, glu_w, glu_b,
               qn, kn, sink, cos, sin, emit_ctx):
    sizes = [S5_WIDTH, WIN_HEADS * HEAD_DIM, WIN_KV_HEADS * HEAD_DIM]
    u, q, k, v = _split_cols(xn @ w_in, sizes)
    uc, qc, kc, vc = _split_cols(xnc @ w_in, sizes)
    c_out, c_out_c = s5_mixer(u, uc, lam_re, lam_im, log_step, b_re, b_im, c_re, c_im, d_skip, glu_w, glu_b, emit_ctx)
    qc_n = head_norm(qc, WIN_HEADS, qn) if emit_ctx else None
    d_out, d_out_c = window_gqa_sink(head_norm(q, WIN_HEADS, qn), head_norm(k, WIN_KV_HEADS, kn), split_heads(v, WIN_KV_HEADS),
                                     qc_n, head_norm(kc, WIN_KV_HEADS, kn), split_heads(vc, WIN_KV_HEADS), sink, cos, sin)
    mix = jnp.concatenate([c_out, d_out], axis=-1)
    mix_c = jnp.concatenate([c_out_c, d_out_c], axis=-1) if emit_ctx else None
    return mix, mix_c


def setup_inputs(seed: int = 0) -> dict:
    key = jax.random.key(seed)
    keys = iter(jax.random.split(key, 64))
    f32 = jnp.float32

    def nrm(shape, std):
        return jax.random.normal(next(keys), shape, f32) * std

    d = D_MODEL
    n_even = (DEPTH + 1) // 2
    n_odd = DEPTH // 2
    x = nrm((BATCH, SEQ, d), 1.0)
    c = nrm((BATCH, d), 1.0)
    ctx = nrm((BATCH, CTX_LEN, d), 1.0)
    c_ctx = nrm((d,), 1.0)
    mod_w = nrm((DEPTH, d, N_MOD * d), 0.5 * d ** -0.5)
    mod_b = nrm((DEPTH, N_MOD * d), 0.02)
    norm_g = 1.0 + nrm((DEPTH, 2, d), 0.02)
    ffn_up = nrm((DEPTH, d, 2 * FFN_HIDDEN), d ** -0.5)
    ffn_conv_w = nrm((DEPTH, FFN_CONV, 2 * FFN_HIDDEN), FFN_CONV ** -0.5)
    ffn_conv_b = nrm((DEPTH, 2 * FFN_HIDDEN), 0.01)
    ffn_down = nrm((DEPTH, FFN_HIDDEN, d), FFN_HIDDEN ** -0.5)
    ev_w_in = nrm((n_even, d, EVEN_IN), d ** -0.5)
    ev_w_out = nrm((n_even, EVEN_MIX, d), EVEN_MIX ** -0.5)
    rg_conv_w = nrm((n_even, RG_CONV, RG_WIDTH), RG_CONV ** -0.5)
    rg_conv_b = nrm((n_even, RG_WIDTH), 0.01)
    rg_wa = nrm((n_even, 2, RG_HEADS, RG_BLOCK, RG_BLOCK), RG_BLOCK ** -0.5)
    rg_ba = nrm((n_even, 2, RG_WIDTH), 0.01)
    rg_wx = nrm((n_even, 2, RG_HEADS, RG_BLOCK, RG_BLOCK), RG_BLOCK ** -0.5)
    rg_bx = nrm((n_even, 2, RG_WIDTH), 0.01)
    a_pow = jax.random.uniform(next(keys), (n_even, 2, RG_WIDTH), f32, 0.9, 0.999)
    a_base = a_pow ** (1.0 / RG_C)
    rg_lam = jnp.log(a_base) - jnp.log1p(-a_base)
    ga_qn = 1.0 + nrm((n_even, HEAD_DIM), 0.02)
    ga_kn = 1.0 + nrm((n_even, HEAD_DIM), 0.02)
    od_w_in = nrm((n_odd, d, ODD_IN), d ** -0.5)
    od_w_out = nrm((n_odd, ODD_MIX, d), ODD_MIX ** -0.5)
    s5_lam_re = -0.5 + nrm((n_odd, 2, S5_GROUPS, S5_STATE), 0.01)
    s5_lam_im = jnp.pi * jnp.arange(S5_STATE, dtype=f32) + nrm((n_odd, 2, S5_GROUPS, S5_STATE), 0.01)
    s5_log_step = jax.random.uniform(next(keys), (n_odd, 2, S5_GROUPS), f32, float(np.log(1e-3)), float(np.log(1e-1)))
    s5_b_re = nrm((n_odd, 2, S5_GROUPS, S5_STATE, S5_GROUP), (2 * S5_GROUP) ** -0.5)
    s5_b_im = nrm((n_odd, 2, S5_GROUPS, S5_STATE, S5_GROUP), (2 * S5_GROUP) ** -0.5)
    s5_c_re = nrm((n_odd, 2, S5_GROUPS, S5_GROUP, S5_STATE), S5_STATE ** -0.5)
    s5_c_im = nrm((n_odd, 2, S5_GROUPS, S5_GROUP, S5_STATE), S5_STATE ** -0.5)
    s5_d = nrm((n_odd, S5_WIDTH), 1.0)
    s5_glu_w = nrm((n_odd, S5_WIDTH, S5_WIDTH), S5_WIDTH ** -0.5)
    s5_glu_b = nrm((n_odd, S5_WIDTH), 0.01)
    wa_qn = 1.0 + nrm((n_odd, HEAD_DIM), 0.02)
    wa_kn = 1.0 + nrm((n_odd, HEAD_DIM), 0.02)
    wa_sink = nrm((n_odd, WIN_HEADS), 1.0)
    return {"x": x, "c": c, "ctx": ctx, "c_ctx": c_ctx,
            "mod_w": mod_w, "mod_b": mod_b, "norm_g": norm_g,
            "ffn_up": ffn_up, "ffn_conv_w": ffn_conv_w, "ffn_conv_b": ffn_conv_b, "ffn_down": ffn_down,
            "ev_w_in": ev_w_in, "ev_w_out": ev_w_out, "rg_conv_w": rg_conv_w, "rg_conv_b": rg_conv_b,
            "rg_wa": rg_wa, "rg_ba": rg_ba, "rg_wx": rg_wx, "rg_bx": rg_bx, "rg_lam": rg_lam,
            "ga_qn": ga_qn, "ga_kn": ga_kn,
            "od_w_in": od_w_in, "od_w_out": od_w_out, "s5_lam_re": s5_lam_re, "s5_lam_im": s5_lam_im,
            "s5_log_step": s5_log_step, "s5_b_re": s5_b_re, "s5_b_im": s5_b_im, "s5_c_re": s5_c_re,
            "s5_c_im": s5_c_im, "s5_d": s5_d, "s5_glu_w": s5_glu_w, "s5_glu_b": s5_glu_b,
            "wa_qn": wa_qn, "wa_kn": wa_kn, "wa_sink": wa_sink}


def reference(x, c, ctx, c_ctx, mod_w, mod_b, norm_g, ffn_up, ffn_conv_w, ffn_conv_b, ffn_down,
              ev_w_in, ev_w_out, rg_conv_w, rg_conv_b, rg_wa, rg_ba, rg_wx, rg_bx, rg_lam, ga_qn, ga_kn,
              od_w_in, od_w_out, s5_lam_re, s5_lam_im, s5_log_step, s5_b_re, s5_b_im, s5_c_re, s5_c_im,
              s5_d, s5_glu_w, s5_glu_b, wa_qn, wa_kn, wa_sink):
    n = x.shape[1]
    cos, sin = axial_rope_tables(n)
    cond = jax.nn.silu(c)
    cond_c = jax.nn.silu(c_ctx)
    h, hc = x, ctx
    for layer in range(DEPTH):
        emit_ctx = layer < DEPTH - 1
        mod = jnp.split((cond @ mod_w[layer] + mod_b[layer])[:, None, :], N_MOD, axis=-1)
        mod_c = jnp.split(cond_c @ mod_w[layer] + mod_b[layer], N_MOD, axis=-1)
        xn = adaln_norm(h, norm_g[layer, 0], mod[0], mod[1])
        xnc = adaln_norm(hc, norm_g[layer, 0], mod_c[0], mod_c[1])
        j = layer // 2
        if layer % 2 == 0:
            mix, mix_c = even_mixers(xn, xnc, ev_w_in[j], rg_conv_w[j], rg_conv_b[j], rg_wa[j], rg_ba[j],
                                     rg_wx[j], rg_bx[j], rg_lam[j], ga_qn[j], ga_kn[j], cos, sin, emit_ctx)
            w_out = ev_w_out[j]
        else:
            mix, mix_c = odd_mixers(xn, xnc, od_w_in[j], s5_lam_re[j], s5_lam_im[j], s5_log_step[j],
                                    s5_b_re[j], s5_b_im[j], s5_c_re[j], s5_c_im[j], s5_d[j], s5_glu_w[j],
                                    s5_glu_b[j], wa_qn[j], wa_kn[j], wa_sink[j], cos, sin, emit_ctx)
            w_out = od_w_out[j]
        h = h + mod[2] * (mix @ w_out)
        xn = adaln_norm(h, norm_g[layer, 1], mod[3], mod[4])
        h = h + mod[5] * conv_ffn(xn, ffn_up[layer], ffn_conv_w[layer], ffn_conv_b[layer], ffn_down[layer])
        if emit_ctx:
            hc = hc + mod_c[2] * (mix_c @ w_out)
            xnc = adaln_norm(hc, norm_g[layer, 1], mod_c[3], mod_c[4])
            hc = hc + mod_c[5] * conv_ffn(xnc, ffn_up[layer], ffn_conv_w[layer], ffn_conv_b[layer], ffn_down[layer])
    return h
```

```cpp
#include <hip/hip_runtime.h>
#include <hip/hip_cooperative_groups.h>
#include <hip/hip_bf16.h>
#include <cstdio>
#include <cstdint>
#include <cmath>
namespace cg = cooperative_groups;
namespace pg8 {
#define PG8_LAS __attribute__((address_space(3)))
typedef unsigned short bf16_t;
typedef short bf16x8 __attribute__((ext_vector_type(8)));
typedef float f32x4 __attribute__((ext_vector_type(4)));
typedef unsigned u32x4 __attribute__((ext_vector_type(4)));
constexpr int BM = 256, BK = 64, HALF = 128, HTB = HALF * BK * 2  , STAGE_BYTES = 8 * HTB, NXCD = 8, WGM = 8;

__host__ __device__ __forceinline__ int lds_byte(int r, int c) { const int st = (r >> 4) * 2 + (c >> 5), rr = r & 15, cc = c & 31, ob = rr * 64 + cc * 2; return st * 1024 + (ob ^ (((ob >> 9) & 1) << 5)); }
__host__ __device__ __forceinline__ void stage_rc(int b, int& R, int& C) { const int st = b / 1024, sb = b % 1024, swz = sb ^ (((sb >> 9) & 1) << 5); R = (st >> 1) * 16 + swz / 64; C = (st & 1) * 32 + (swz % 64) / 2; }
__host__ __device__ __forceinline__ int perm32(int rho) { const int n = rho >> 4, i = rho & 15; return 8 * (i >> 2) + 4 * n + (i & 3); }

struct Unit { int pm, pn; };
struct Gemm { const bf16_t* A; const bf16_t* Bt; int M, N, K; };

struct StaticOrder {
    int nM, nN, nwg, G, c;
    __host__ __device__ void init(int M, int N, int G_, int c_) { nM = M / BM; nN = N / BM; nwg = nM * nN; G = G_; c = c_; }
    __host__ __device__ bool next(int i, Unit& u) const {
        const long L = (long)i * G + c; if (L >= nwg) return false;
        int wgid = (int)L; { const int q = nwg / NXCD, r = nwg % NXCD, xcd = wgid % NXCD, off = wgid / NXCD; wgid = (xcd < r ? xcd * (q + 1) : r * (q + 1) + (xcd - r) * q) + off; }
        const int nig = WGM * nN, gid = wgid / nig, fm = gid * WGM, gsz = (nM - fm) < WGM ? (nM - fm) : WGM;
        u.pm = fm + ((wgid % nig) % gsz); u.pn = (wgid % nig) / gsz; return true;
    }
    __device__ __forceinline__ void a_ready(const Unit&) const {}
    __device__ __forceinline__ void done(const Unit&) const {}
};

__device__ __forceinline__ unsigned cvt_pk_bf16(float lo, float hi) { unsigned r; asm volatile("v_cvt_pk_bf16_f32 %0, %1, %2" : "=v"(r) : "v"(lo), "v"(hi)); return r; }
typedef float f32x2 __attribute__((ext_vector_type(2)));
__device__ __forceinline__ f32x2 gelu_pk(f32x2 v) {
    const f32x2 av = __builtin_elementwise_abs(v), d = av * 0.2316418882f + 1.0f;
    f32x2 t; t.x = __builtin_amdgcn_rcpf(d.x); t.y = __builtin_amdgcn_rcpf(d.y);
    f32x2 q = t * 0.5307027145f + (-0.7265760135f); q = q * t + 0.7107068705f; q = q * t + (-0.142248368f); q = q * t + 0.127414796f; q = q * t;
    const f32x2 s = (v * v) * (-0.72134752044f);
    f32x2 e; e.x = __builtin_amdgcn_exp2f(s.x); e.y = __builtin_amdgcn_exp2f(s.y);
    const f32x2 m = v * (q * e), r = v - m;
    f32x2 o; o.x = v.x < 0.f ? m.x : r.x; o.y = v.y < 0.f ? m.y : r.y; return o;
}
template <int ACT  > struct EpiBf16 {
    static constexpr bool PERM = true, AFTER_DRAIN = false; static_assert(ACT == 0 || ACT == 1, "EpiBf16: ACT is 0 (none) or 1 (gelu_pk)");
    bf16_t* O; int ldc; const float* bias; int split_cols; size_t split_stride; float scale0;
    __device__ __forceinline__ void operator()(const f32x4 (&acc)[2][2][4][2], const Unit& u, int wr, int wc, int fr, int fq) const {
        const int row0 = u.pm * BM + wr * 64 + fr; int colt = u.pn * BM; bf16_t* base = O;
        float sc = 1.f; if (split_cols) { const int t = colt / split_cols; base += (size_t)t * split_stride; colt -= t * split_cols; if (t == 0) sc = scale0; }
        const int col0 = colt + wc * 32 + 8 * fq, bcol0 = u.pn * BM + wc * 32 + 8 * fq;
        f32x4 bv[2][2];
#pragma unroll
        for (int bj = 0; bj < 2; ++bj)
#pragma unroll
            for (int n = 0; n < 2; ++n) bv[bj][n] = bias ? *(const f32x4*)(bias + bcol0 + bj * HALF + 4 * n) : (f32x4){0.f, 0.f, 0.f, 0.f};
#pragma unroll
        for (int ai = 0; ai < 2; ++ai)
#pragma unroll
            for (int m = 0; m < 4; ++m) { bf16_t* rowp = base + (size_t)(row0 + ai * HALF + m * 16) * ldc + col0;
#pragma unroll
                for (int bj = 0; bj < 2; ++bj) { f32x4 v0 = acc[ai][bj][m][0] + bv[bj][0], v1 = acc[ai][bj][m][1] + bv[bj][1];
                    if (ACT == 1) { f32x2 a = gelu_pk((f32x2){v0[0], v0[1]}), b = gelu_pk((f32x2){v0[2], v0[3]}), c = gelu_pk((f32x2){v1[0], v1[1]}), d = gelu_pk((f32x2){v1[2], v1[3]});
                        v0 = (f32x4){a.x, a.y, b.x, b.y}; v1 = (f32x4){c.x, c.y, d.x, d.y}; }
                    v0 = v0 * sc; v1 = v1 * sc; u32x4 w; w.x = cvt_pk_bf16(v0[0], v0[1]); w.y = cvt_pk_bf16(v0[2], v0[3]); w.z = cvt_pk_bf16(v1[0], v1[1]); w.w = cvt_pk_bf16(v1[2], v1[3]);
                    *(u32x4*)(rowp + bj * HALF) = w; } }
    }
};
template <class Epi, class Sched, bool ALIGN_EPI = false, bool SP2 = false>
__device__ __forceinline__ void gemm_phase(PG8_LAS unsigned char* lds, const Gemm g, const Sched& S, const Epi& E) {
    const int tid = threadIdx.x, wid = __builtin_amdgcn_readfirstlane(tid >> 6), lane = tid & 63, wr = wid >> 2, wc = wid & 3, fr = lane & 15, fq = lane >> 4;
    const int K = g.K, nt = K / BK;
    unsigned voffA[2], voffB[2];
#pragma unroll
    for (int i = 0; i < 2; ++i) { int R, C; stage_rc(tid * 16 + i * 8192, R, C); const int Rb = Epi::PERM ? ((R & ~31) + perm32(R & 31)) : R;
        voffA[i] = (unsigned)(R * K + C) * 2u; voffB[i] = (unsigned)(Rb * K + C) * 2u; }
    const size_t kstep = (size_t)(BK * 2);
    const size_t hstep = (size_t)HALF * K * 2;
    const size_t tstep = 2 * hstep;
    const unsigned ldsw = (unsigned)wid * 1024u;
    const int aoff = lds_byte(wr * 64 + fr, fq * 8), boff = lds_byte(wc * 32 + fr, fq * 8);
#define PG8_SA(b, h) (((b) * 2 + (h)) * HTB)
#define PG8_SB(b, h) ((4 + (b) * 2 + (h)) * HTB)
#define PG8_STAGE(bufoff, gbase, voff) do { _Pragma("unroll") for (int _i = 0; _i < 2; ++_i) \
        __builtin_amdgcn_global_load_lds((const unsigned*)((const char*)(gbase) + (voff)[_i]), (PG8_LAS unsigned*)(lds + (bufoff) + ldsw + _i * 8192), 16, 0, 0); } while (0)
#define PG8_LDA(dst, b, h) do { _Pragma("unroll") for (int m = 0; m < 4; ++m) _Pragma("unroll") for (int k = 0; k < 2; ++k) dst[m][k] = *(const PG8_LAS bf16x8*)(lds + PG8_SA(b, h) + aoff + m * 2048 + k * 1024); } while (0)
#define PG8_LDB(dst, b, h) do { _Pragma("unroll") for (int n = 0; n < 2; ++n) _Pragma("unroll") for (int k = 0; k < 2; ++k) dst[n][k] = *(const PG8_LAS bf16x8*)(lds + PG8_SB(b, h) + boff + n * 2048 + k * 1024); } while (0)
#define PG8_MMA(ai, bj, At, Bt) do { __builtin_amdgcn_s_setprio(1); _Pragma("unroll") for (int m = 0; m < 4; ++m) _Pragma("unroll") for (int n = 0; n < 2; ++n) _Pragma("unroll") for (int k = 0; k < 2; ++k) \
        acc[ai][bj][m][n] = __builtin_amdgcn_mfma_f32_16x16x32_bf16(Bt[n][k], At[m][k], acc[ai][bj][m][n], 0, 0, 0); __builtin_amdgcn_s_setprio(0); } while (0)
#define PG8_WAIT_V(n) asm volatile("s_waitcnt vmcnt(" #n ")" ::: "memory")
#define PG8_WAIT_L(n) asm volatile("s_waitcnt lgkmcnt(" #n ")" ::: "memory")
#define PG8_BAR __builtin_amdgcn_s_barrier()
#define PG8_SCHED __builtin_amdgcn_sched_barrier(0)
    Unit cur, nxt; int ui = 0;
    if (!S.next(0, cur)) return;
    f32x4 acc[2][2][4][2];
#pragma unroll
    for (int a = 0; a < 2; ++a)
#pragma unroll
        for (int b = 0; b < 2; ++b)
#pragma unroll
            for (int m = 0; m < 4; ++m)
#pragma unroll
                for (int n = 0; n < 2; ++n) acc[a][b][m][n] = (f32x4){0.f, 0.f, 0.f, 0.f};
    bf16x8 At[4][2], B0[2][2], B1[2][2];
    const char* cA = (const char*)g.A + (size_t)cur.pm * tstep; const char* cB = (const char*)g.Bt + (size_t)cur.pn * tstep;
    S.a_ready(cur);
    if constexpr (SP2) {
        PG8_STAGE(PG8_SB(0, 0), cB, voffB); PG8_STAGE(PG8_SB(0, 1), cB + hstep, voffB); PG8_STAGE(PG8_SA(0, 0), cA, voffA); PG8_STAGE(PG8_SA(0, 1), cA + hstep, voffA);
        if (wr == 1) PG8_BAR;
        PG8_WAIT_V(2); PG8_BAR;
        PG8_STAGE(PG8_SB(1, 0), cB + kstep, voffB); PG8_STAGE(PG8_SA(1, 0), cA + kstep, voffA); PG8_STAGE(PG8_SB(1, 1), cB + hstep + kstep, voffB);
        PG8_WAIT_V(6); PG8_BAR;
    } else {
        PG8_STAGE(PG8_SB(0, 0), cB, voffB); PG8_STAGE(PG8_SA(0, 0), cA, voffA); PG8_STAGE(PG8_SB(0, 1), cB + hstep, voffB); PG8_STAGE(PG8_SA(0, 1), cA + hstep, voffA);
        if (wr == 1) PG8_BAR;
        PG8_WAIT_V(4); PG8_BAR;
        PG8_STAGE(PG8_SB(1, 0), cB + kstep, voffB); PG8_STAGE(PG8_SA(1, 0), cA + kstep, voffA); PG8_STAGE(PG8_SB(1, 1), cB + hstep + kstep, voffB);
        PG8_WAIT_V(6); PG8_BAR;
    }
    for (;;) {
        const bool has_next = S.next(ui + 1, nxt);
        const char* nA = has_next ? (const char*)g.A + (size_t)nxt.pm * tstep : cA; const char* nB = has_next ? (const char*)g.Bt + (size_t)nxt.pn * tstep : cB;
        for (int t = 0; t < nt; t += 2) {
            const bool last = (t == nt - 2);
            const char* a1 = cA + (size_t)(t + 1) * kstep;
            const char* a2 = last ? nA : cA + (size_t)(t + 2) * kstep; const char* b2 = last ? nB : cB + (size_t)(t + 2) * kstep;
            const char* a3 = a2 + kstep; const char* b3 = b2 + kstep;
            if (last && has_next) S.a_ready(nxt);
            if constexpr (SP2) {
            PG8_LDB(B0, 0, 0); PG8_LDB(B1, 0, 1); PG8_SCHED; PG8_LDA(At, 0, 0); PG8_STAGE(PG8_SA(1, 1), a1 + hstep, voffA);
            PG8_WAIT_V(8); PG8_WAIT_L(0); PG8_BAR; PG8_MMA(0, 0, At, B0); PG8_MMA(0, 1, At, B1); PG8_BAR; PG8_SCHED;
            PG8_LDA(At, 0, 1); PG8_STAGE(PG8_SB(0, 0), b2, voffB); PG8_STAGE(PG8_SB(0, 1), b2 + hstep, voffB); PG8_STAGE(PG8_SA(0, 0), a2, voffA);
            PG8_WAIT_V(8); PG8_WAIT_L(0); PG8_BAR; PG8_MMA(1, 0, At, B0); PG8_MMA(1, 1, At, B1); PG8_BAR; PG8_SCHED;
            PG8_LDB(B0, 1, 0); PG8_LDB(B1, 1, 1); PG8_SCHED; PG8_LDA(At, 1, 0); PG8_STAGE(PG8_SA(0, 1), a2 + hstep, voffA);
            PG8_WAIT_V(8); PG8_WAIT_L(0); PG8_BAR; PG8_MMA(0, 0, At, B0); PG8_MMA(0, 1, At, B1); PG8_BAR; PG8_SCHED;
            PG8_LDA(At, 1, 1); PG8_STAGE(PG8_SB(1, 0), b3, voffB); PG8_STAGE(PG8_SB(1, 1), b3 + hstep, voffB); PG8_STAGE(PG8_SA(1, 0), a3, voffA);
            PG8_WAIT_V(8); PG8_WAIT_L(0); PG8_BAR; PG8_MMA(1, 0, At, B0); PG8_MMA(1, 1, At, B1); PG8_BAR; PG8_SCHED;
            } else {
            PG8_LDB(B0, 0, 0); PG8_SCHED; PG8_LDA(At, 0, 0); PG8_STAGE(PG8_SA(1, 1), a1 + hstep, voffA);
            PG8_WAIT_L(8); PG8_BAR; PG8_WAIT_L(0); PG8_MMA(0, 0, At, B0); PG8_BAR; PG8_SCHED;
            PG8_LDB(B1, 0, 1); PG8_STAGE(PG8_SB(0, 0), b2, voffB);
            PG8_BAR; PG8_WAIT_L(0); PG8_MMA(0, 1, At, B1); PG8_BAR;
            PG8_LDA(At, 0, 1); PG8_STAGE(PG8_SA(0, 0), a2, voffA);
            PG8_BAR; PG8_WAIT_L(0); PG8_MMA(1, 0, At, B0); PG8_BAR; PG8_SCHED;
            PG8_STAGE(PG8_SB(0, 1), b2 + hstep, voffB);
            PG8_WAIT_V(6); PG8_BAR; PG8_MMA(1, 1, At, B1); PG8_BAR;
            PG8_LDB(B0, 1, 0); PG8_SCHED; PG8_LDA(At, 1, 0); PG8_STAGE(PG8_SA(0, 1), a2 + hstep, voffA);
            PG8_WAIT_L(8); PG8_BAR; PG8_WAIT_L(0); PG8_MMA(0, 0, At, B0); PG8_BAR; PG8_SCHED;
            PG8_LDB(B1, 1, 1); PG8_STAGE(PG8_SB(1, 0), b3, voffB);
            PG8_BAR; PG8_WAIT_L(0); PG8_MMA(0, 1, At, B1); PG8_BAR;
            PG8_LDA(At, 1, 1); PG8_STAGE(PG8_SA(1, 0), a3, voffA);
            PG8_BAR; PG8_WAIT_L(0); PG8_MMA(1, 0, At, B0); PG8_BAR; PG8_SCHED;
            PG8_STAGE(PG8_SB(1, 1), b3 + hstep, voffB);
            PG8_WAIT_V(6); PG8_BAR; PG8_MMA(1, 1, At, B1); PG8_BAR;
            }
        }
        if constexpr (ALIGN_EPI) { if (wr == 0) PG8_BAR; }
        if constexpr (!Epi::AFTER_DRAIN) { E(acc, cur, wr, wc, fr, fq); S.done(cur); }
        if (!has_next) break;
#pragma unroll
        for (int a = 0; a < 2; ++a)
#pragma unroll
            for (int b = 0; b < 2; ++b)
#pragma unroll
                for (int m = 0; m < 4; ++m)
#pragma unroll
                    for (int n = 0; n < 2; ++n) acc[a][b][m][n] = (f32x4){0.f, 0.f, 0.f, 0.f};
        cur = nxt; cA = nA; cB = nB; ++ui;
        if constexpr (ALIGN_EPI) { if (wr == 1) PG8_BAR; }
    }
    PG8_WAIT_V(0);
    if constexpr (!ALIGN_EPI) { if (wr == 0) PG8_BAR; }
    PG8_BAR;
    if constexpr (Epi::AFTER_DRAIN) { E.fused(acc, cur, wr, wc, fr, fq, lds, wid, lane); S.done(cur); }
#undef PG8_SA
#undef PG8_SB
#undef PG8_STAGE
#undef PG8_LDA
#undef PG8_LDB
#undef PG8_MMA
#undef PG8_WAIT_V
#undef PG8_WAIT_L
#undef PG8_BAR
#undef PG8_SCHED
}
}

#define DI __device__ __forceinline__
typedef pg8::bf16_t bf16_t;
typedef short bf16x8 __attribute__((ext_vector_type(8)));
typedef short s16x4 __attribute__((ext_vector_type(4)));
typedef float f32x4 __attribute__((ext_vector_type(4)));
typedef float f32x16 __attribute__((ext_vector_type(16)));
typedef unsigned u32x4 __attribute__((ext_vector_type(4)));
typedef unsigned u32x2 __attribute__((ext_vector_type(2)));
#define LAS __attribute__((address_space(3)))
typedef float f32x2_t __attribute__((ext_vector_type(2)));

constexpr int DM = 1024, NB = 8, SEQ = 2048, CTXL = 256;
constexpr int NLAT = NB * SEQ, NCTX = NB * CTXL, MALL = NLAT + NCTX;
constexpr int FH = 2816, FH2 = 5632, EIN = 1792, OIN = 1280;
constexpr float NORM_EPS = 1e-6f;
constexpr float C2 = 0.125f * 1.4426950408889634f;
constexpr int NTHREADS = 512, NWAVES = 8;
constexpr int LDS_BYTES = 147456;
constexpr int NBND_LAT = NB * 31, NBND_CTX = NB * 3;
constexpr int XNE_ROW_L0 = MALL, XNE_ROW_L1 = NLAT;
constexpr int XN_ROWS = MALL + 1280;

constexpr size_t MiB = 1u << 20;
constexpr size_t WS_CTL = 0, CTL_ZERO_BYTES = 1 * MiB;
constexpr size_t WS_MOD = 1 * MiB;
constexpr size_t WS_ROPE = 2 * MiB;
constexpr size_t WS_RGW = 3 * MiB;
constexpr size_t WS_S5AT = 3 * MiB + 512 * 1024;
constexpr size_t WS_RGTOT = 4 * MiB;
constexpr size_t WS_S5M = 7 * MiB, WS_S5E = 23 * MiB, WS_S5F = 31 * MiB;
constexpr size_t WS_WIN0 = 39 * MiB, WS_WOUT0 = 43 * MiB, WS_WUP0 = 45 * MiB, WS_WDN0 = 56 * MiB;
constexpr size_t WS_WIN1 = 62 * MiB, WS_WOUT1 = 65 * MiB, WS_WUP1 = 67 * MiB, WS_WDN1 = 78 * MiB, WS_WGLU = 84 * MiB;
constexpr size_t WS_HC = 85 * MiB;
constexpr size_t WS_XN = 93 * MiB;
constexpr size_t WS_PROJ = 132 * MiB;
constexpr size_t WS_S5L = 177 * MiB;
constexpr size_t WS_MIX = 195 * MiB;
constexpr size_t WS_HID = 132 * MiB;
constexpr size_t WS_S5S = 231 * MiB;
constexpr size_t WS_Z = WS_XN;
constexpr size_t WS_END = 240 * MiB;
static_assert(WS_XN + (size_t)XN_ROWS * DM * 2 <= WS_PROJ, "xn");
static_assert(WS_PROJ + (size_t)MALL * OIN * 2 <= WS_S5L && WS_S5L + (size_t)576 * 32 * 256 * 4 <= WS_MIX, "s5l");
static_assert(WS_HID + (size_t)MALL * FH * 2 <= WS_S5S, "hid");

DI float bf2f(bf16_t v) { return __uint_as_float((unsigned)v << 16); }
DI unsigned f2bf(float f) { unsigned u = __float_as_uint(f); return (u + 0x7fffu + ((u >> 16) & 1u)) >> 16; }
DI unsigned pk2(float lo, float hi) { return f2bf(lo) | (f2bf(hi) << 16); }
DI float wave_sum(float v) {
#pragma unroll
    for (int o = 1; o < 64; o <<= 1) v += __shfl_xor(v, o);
    return v;
}
DI float sigmoidf_(float x) { return 1.f / (1.f + __expf(-x)); }
DI float gelu_tanh(float x) { const float z = 1.5957691216057308f * (x + 0.044715f * x * x * x); return x * sigmoidf_(z); }
DI float siluf_(float x) { return x * sigmoidf_(x); }

struct EpiRes {
    static constexpr bool PERM = false, AFTER_DRAIN = false;
    const float* baseL; const float* baseC; float* outL; float* outC; const float* gate;
    __device__ __forceinline__ void operator()(const f32x4 (&acc)[2][2][4][2], const pg8::Unit& u, int wr, int wc, int fr, int fq) const {
        const bool isc = u.pm >= 64; const int bb = isc ? 8 : (u.pm >> 3);
        const float* base = isc ? baseC + (size_t)(u.pm - 64) * 256 * DM : baseL + (size_t)u.pm * 256 * DM;
        float* out = isc ? outC + (size_t)(u.pm - 64) * 256 * DM : outL + (size_t)u.pm * 256 * DM;
        const float* g = gate + (size_t)bb * 6144;
        const int col0 = u.pn * 256 + wc * 32 + 4 * fq;
#pragma unroll
        for (int bj = 0; bj < 2; ++bj)
#pragma unroll
            for (int n = 0; n < 2; ++n) {
                const int c = col0 + bj * 128 + n * 16; const f32x4 gv = *(const f32x4*)(g + c);
#pragma unroll
                for (int ai = 0; ai < 2; ++ai)
#pragma unroll
                    for (int m = 0; m < 4; ++m) {
                        const size_t off = (size_t)(ai * 128 + wr * 64 + m * 16 + fr) * DM + c;
                        const f32x4 bs = *(const f32x4*)(base + off);
                        *(f32x4*)(out + off) = bs + gv * acc[ai][bj][m][n];
                    }
            }
    }
};

struct EpiConvAct {
    static constexpr bool PERM = true, AFTER_DRAIN = false;
    bf16_t* H; const float* cw; const float* cb; int pm_edge; int nbnd_lat; int nbnd; char* xlds;
    __device__ __forceinline__ void operator()(const f32x4 (&acc)[2][2][4][2], const pg8::Unit& u, int wr_, int wc_, int fr_, int fq_) const {
        int tl = threadIdx.x; asm volatile("" : "+v"(tl));
        const int lane = tl & 63, wid_ = tl >> 6, fr = lane & 15, fq = lane >> 4, wr = wid_ >> 2, wc = wid_ & 3; (void)wr_; (void)wc_; (void)fr_; (void)fq_;
        const bool edge = u.pm >= pm_edge;
        const int hc0 = u.pn * 128 + wc * 32 + 8 * fq;
        f32x2_t* sc = (f32x2_t*)(xlds + wid_ * 2048);
#pragma unroll
        for (int n = 0; n < 2; ++n) {
#pragma unroll
            for (int ai = 0; ai < 2; ++ai) {
                unsigned wd[4][2];
#pragma unroll
                for (int jp = 0; jp < 2; ++jp) {
                    float hvv[2][4][2];
#pragma unroll
                    for (int bj = 0; bj < 2; ++bj) {
                        int oc = bj * FH + hc0 + 4 * n + 2 * jp; asm volatile("" : "+v"(oc) :: "memory");
                        const f32x2_t w0 = *(const f32x2_t*)(cw + oc), w1 = *(const f32x2_t*)(cw + FH2 + oc), w2 = *(const f32x2_t*)(cw + 2 * FH2 + oc), bb = *(const f32x2_t*)(cb + oc);
#pragma unroll
                        for (int m = 0; m < 4; ++m) sc[(16 * m + fr) * 4 + fq] = (f32x2_t){acc[ai][bj][m][n][2 * jp], acc[ai][bj][m][n][2 * jp + 1]};
                        asm volatile("" ::: "memory");
#pragma unroll
                        for (int m = 0; m < 4; ++m) {
                            const int row = 16 * m + fr; const int ru = row > 0 ? row - 1 : 0, rd = row < 63 ? row + 1 : 63;
                            f32x2_t up = sc[ru * 4 + fq], dn = sc[rd * 4 + fq];
                            if (row == 0) up = (f32x2_t){0.f, 0.f}; if (row == 63) dn = (f32x2_t){0.f, 0.f};
                            const f32x2_t ce = (f32x2_t){acc[ai][bj][m][n][2 * jp], acc[ai][bj][m][n][2 * jp + 1]};
                            const f32x2_t hv = bb + w0 * up + w1 * ce + w2 * dn;
                            hvv[bj][m][0] = hv.x; hvv[bj][m][1] = hv.y;
                        }
                        asm volatile("" : "+v"(hvv[bj][0][0]), "+v"(hvv[bj][0][1]), "+v"(hvv[bj][1][0]), "+v"(hvv[bj][1][1]), "+v"(hvv[bj][2][0]), "+v"(hvv[bj][2][1]), "+v"(hvv[bj][3][0]), "+v"(hvv[bj][3][1]) :: "memory");
                    }
#pragma unroll
                    for (int m = 0; m < 4; ++m) wd[m][jp] = pk2(hvv[0][m][0] * siluf_(hvv[1][m][0]), hvv[0][m][1] * siluf_(hvv[1][m][1]));
                    __builtin_amdgcn_sched_barrier(0);
                }
#pragma unroll
                for (int m = 0; m < 4; ++m) {
                    const int R = ai * 128 + wr * 64 + m * 16 + fr;
                    long grow; bool st;
                    if (!edge) {
                        grow = (long)u.pm * 256 + R; st = true;
                        const int r64 = R & 63;
                        if (r64 == 0) st = (R == 0) && (u.pm >= 64 || (u.pm & 7) == 0);
                        if (r64 == 63) st = (R == 255) && (u.pm >= 64 || (u.pm & 7) == 7);
                    } else {
                        const int slot = (u.pm - pm_edge) * 256 + R, q = slot >> 2, pos = slot & 3;
                        st = (pos == 1 || pos == 2) && q < nbnd;
                        int row0;
                        if (q < nbnd_lat) { const int s = q / 31, k = q - s * 31 + 1; row0 = s * SEQ + 64 * k; }
                        else { const int q2 = q - nbnd_lat, s = q2 / 3, k = q2 - s * 3 + 1; row0 = NLAT + s * CTXL + 64 * k; }
                        grow = (long)row0 - 2 + pos;
                    }
                    if (st) { u32x2 w; w.x = wd[m][0]; w.y = wd[m][1]; *(u32x2*)(H + (size_t)grow * FH + hc0 + 4 * n) = w; }
                }
                asm volatile("" ::: "memory"); __builtin_amdgcn_sched_barrier(0);
            }
        }
    }
};

struct EpiGlu {
    static constexpr bool PERM = true, AFTER_DRAIN = false;
    const bf16_t* Z; bf16_t* O; const float* bias;
    __device__ __forceinline__ void operator()(const f32x4 (&acc)[2][2][4][2], const pg8::Unit& u, int wr, int wc, int fr, int fq) const {
        const int row0 = u.pm * 256 + wr * 64 + fr; const int col0 = u.pn * 256 + wc * 32 + 8 * fq;
#pragma unroll
        for (int bj = 0; bj < 2; ++bj) {
            const f32x4 b0 = *(const f32x4*)(bias + col0 + bj * 128), b1 = *(const f32x4*)(bias + col0 + bj * 128 + 4);
#pragma unroll
            for (int ai = 0; ai < 2; ++ai)
#pragma unroll
                for (int m = 0; m < 4; ++m) {
                    const size_t r = (size_t)(row0 + ai * 128 + m * 16);
                    const u32x4 zz = *(const u32x4*)(Z + r * 512 + col0 + bj * 128);
                    const f32x4 v0 = acc[ai][bj][m][0] + b0, v1 = acc[ai][bj][m][1] + b1;
                    float o[8];
#pragma unroll
                    for (int j = 0; j < 4; ++j) {
                        const float z0 = __uint_as_float((j & 1) ? (zz[j >> 1] & 0xffff0000u) : (zz[j >> 1] << 16));
                        const float z1 = __uint_as_float((j & 1) ? (zz[2 + (j >> 1)] & 0xffff0000u) : (zz[2 + (j >> 1)] << 16));
                        o[j] = z0 * sigmoidf_(v0[j]); o[4 + j] = z1 * sigmoidf_(v1[j]);
                    }
                    u32x4 w; w.x = pk2(o[0], o[1]); w.y = pk2(o[2], o[3]); w.z = pk2(o[4], o[5]); w.w = pk2(o[6], o[7]);
                    *(u32x4*)(O + r * DM + col0 + bj * 128) = w;
                }
        }
    }
};

DI s16x4 vtr(const char* p) { typedef short v4i16_t __attribute__((ext_vector_type(4))); return __builtin_bit_cast(s16x4, __builtin_amdgcn_ds_read_tr16_b64_v4i16((LAS v4i16_t*)p)); }
typedef __bf16 bf16x2_t __attribute__((ext_vector_type(2)));
DI unsigned cvtpk(float lo, float hi) { f32x2_t v = {lo, hi}; bf16x2_t b = __builtin_convertvector(v, bf16x2_t); return __builtin_bit_cast(unsigned, b); }
DI int crow(int r, int h) { return (r & 3) + 8 * (r >> 2) + 4 * h; }
#define MFMA32(a, b, c) __builtin_amdgcn_mfma_f32_32x32x16_bf16((a), (b), (c), 0, 0, 0)
constexpr int ATT_BUF = 17408, ATT_KB = 9216;

template <int MODE>
DI void attn_unit(const bf16_t* __restrict__ P, int ld, int qoff, int koff, int voff, bf16_t* __restrict__ O, char* lds, int b, int head, int q0, float sink_l2) {
    const int tid = threadIdx.x, lane = tid & 63, wid = tid >> 6, r32 = lane & 31, hi = lane >> 5;
    const int kvh = head >> 2;
    const int qrow0 = (MODE == 1) ? (NLAT + b * CTXL) : (b * SEQ + q0);
    int lat0 = 0, nlat = 0;
    if (MODE == 0) { lat0 = 0; nlat = SEQ / 64; }
    if (MODE == 2) { const int lo = q0 - 128 < 0 ? 0 : q0 - 128; const int hi_ = q0 + 384 > SEQ ? SEQ : q0 + 384; lat0 = lo; nlat = (hi_ - lo) / 64; }
    const int NT = 4 + nlat;
#define KROW(t) ((t) < 4 ? (NLAT + b * CTXL + 64 * (t)) : (b * SEQ + lat0 + 64 * ((t) - 4)))
    const bf16_t* Qp = P + (size_t)(qrow0 + wid * 32 + r32) * ld + qoff + head * 64 + 8 * hi;
    bf16x8 qr[4];
#pragma unroll
    for (int ks = 0; ks < 4; ++ks) qr[ks] = *(const bf16x8*)(Qp + 16 * ks);
    const int srow = tid >> 3, sch = tid & 7;
    const bf16_t* kg = P + koff + kvh * 64 + sch * 8; const bf16_t* vg = P + voff + kvh * 64 + sch * 8;
    const int kw = srow * 144 + sch * 16, vw = ATT_KB + (sch >> 2) * 4096 + srow * 64 + (sch & 3) * 16;
    const int kr_off = r32 * 144 + 16 * hi;
    const int vr_off = ATT_KB + ((lane >> 4) & 1) * 32 + (lane & 3) * 8 + (4 * hi + ((lane & 15) >> 2)) * 64;
    u32x4 kreg, vreg;
    { const size_t r = (size_t)(KROW(0) + srow) * ld; kreg = *(const u32x4*)(kg + r); vreg = *(const u32x4*)(vg + r); }
    *(u32x4*)(lds + kw) = kreg; *(u32x4*)(lds + vw) = vreg;
    if (NT > 1) { const size_t r = (size_t)(KROW(1) + srow) * ld; kreg = *(const u32x4*)(kg + r); vreg = *(const u32x4*)(vg + r); }
    float m = -1e30f, l = 0.f; f32x16 o0 = {}, o1 = {};
    const int qpos = q0 + wid * 32 + r32;
    __syncthreads();
    for (int t = 0; t < NT; ++t) {
        const char* buf = lds + (t & 1) * ATT_BUF;
        bool need = true; int kpos0 = 0;
        if (MODE == 2 && t >= 4) { kpos0 = lat0 + 64 * (t - 4); const int ql = q0 + wid * 32; need = (kpos0 <= ql + 31 + 128) && (kpos0 + 63 >= ql - 128); }
        if (need) {
            f32x16 p0 = {}, p1 = {};
#pragma unroll
            for (int ks = 0; ks < 4; ++ks) {
                const bf16x8 k0 = *(const bf16x8*)(buf + kr_off + ks * 32), k1 = *(const bf16x8*)(buf + kr_off + 32 * 144 + ks * 32);
                p0 = MFMA32(k0, qr[ks], p0); p1 = MFMA32(k1, qr[ks], p1);
            }
            if (MODE == 2 && t >= 4) {
#pragma unroll
                for (int i = 0; i < 16; ++i) { const int kp = kpos0 + crow(i, hi); int d0 = qpos - kp; d0 = d0 < 0 ? -d0 : d0; int d1 = qpos - kp - 32; d1 = d1 < 0 ? -d1 : d1;
                    if (d0 > 128) p0[i] = -1e30f; if (d1 > 128) p1[i] = -1e30f; }
            }
            float mx = p0[0];
#pragma unroll
            for (int i = 1; i < 16; ++i) mx = fmaxf(mx, p0[i]);
#pragma unroll
            for (int i = 0; i < 16; ++i) mx = fmaxf(mx, p1[i]);
            mx = fmaxf(mx, __shfl_xor(mx, 32));
            const float mnew = fmaxf(m, mx); const float alpha = __builtin_amdgcn_exp2f(m - mnew); m = mnew;
            float rs = 0.f;
#pragma unroll
            for (int i = 0; i < 16; ++i) { p0[i] = __builtin_amdgcn_exp2f(p0[i] - m); rs += p0[i]; }
#pragma unroll
            for (int i = 0; i < 16; ++i) { p1[i] = __builtin_amdgcn_exp2f(p1[i] - m); rs += p1[i]; }
            l = l * alpha + rs;
#pragma unroll
            for (int i = 0; i < 16; ++i) { o0[i] *= alpha; o1[i] *= alpha; }
#pragma unroll
            for (int s = 0; s < 4; ++s) {
                u32x4 pw;
                if (s < 2) { pw[0] = cvtpk(p0[8 * (s & 1)], p0[8 * (s & 1) + 1]); pw[1] = cvtpk(p0[8 * (s & 1) + 2], p0[8 * (s & 1) + 3]); pw[2] = cvtpk(p0[8 * (s & 1) + 4], p0[8 * (s & 1) + 5]); pw[3] = cvtpk(p0[8 * (s & 1) + 6], p0[8 * (s & 1) + 7]); }
                else { pw[0] = cvtpk(p1[8 * (s & 1)], p1[8 * (s & 1) + 1]); pw[1] = cvtpk(p1[8 * (s & 1) + 2], p1[8 * (s & 1) + 3]); pw[2] = cvtpk(p1[8 * (s & 1) + 4], p1[8 * (s & 1) + 5]); pw[3] = cvtpk(p1[8 * (s & 1) + 6], p1[8 * (s & 1) + 7]); }
                const bf16x8 pb = __builtin_bit_cast(bf16x8, pw);
                const char* vb = buf + vr_off + s * 1024;
                const s16x4 a0 = vtr(vb), a1 = vtr(vb + 512), c0 = vtr(vb + 4096), c1 = vtr(vb + 4096 + 512);
                const bf16x8 va0 = (bf16x8){a0[0], a0[1], a0[2], a0[3], a1[0], a1[1], a1[2], a1[3]};
                const bf16x8 va1 = (bf16x8){c0[0], c0[1], c0[2], c0[3], c1[0], c1[1], c1[2], c1[3]};
                o0 = MFMA32(va0, pb, o0); o1 = MFMA32(va1, pb, o1);
            }
        }
        if (t + 1 < NT) {
            char* nb = lds + ((t + 1) & 1) * ATT_BUF;
            *(u32x4*)(nb + kw) = kreg; *(u32x4*)(nb + vw) = vreg;
            if (t + 2 < NT) { const size_t r = (size_t)(KROW(t + 2) + srow) * ld; kreg = *(const u32x4*)(kg + r); vreg = *(const u32x4*)(vg + r); }
        }
        __syncthreads();
    }
#undef KROW
    l += __shfl_xor(l, 32);
    if (MODE == 2) l += __builtin_amdgcn_exp2f(sink_l2 - m);
    const float inv = 1.f / l;
    bf16_t* Op = O + (size_t)(qrow0 + wid * 32 + r32) * DM + 512 + head * 64 + 4 * hi;
#pragma unroll
    for (int k = 0; k < 4; ++k) {
        u32x2 w0, w1;
        w0.x = pk2(o0[4 * k] * inv, o0[4 * k + 1] * inv); w0.y = pk2(o0[4 * k + 2] * inv, o0[4 * k + 3] * inv);
        w1.x = pk2(o1[4 * k] * inv, o1[4 * k + 1] * inv); w1.y = pk2(o1[4 * k + 2] * inv, o1[4 * k + 3] * inv);
        *(u32x2*)(Op + 8 * k) = w0; *(u32x2*)(Op + 32 + 8 * k) = w1;
    }
}

constexpr int RG_XA = 0, RG_XF = 9216, RG_GT = RG_XF + 64 * 65 * 4  , RG_SEG = RG_GT + 4 * 64 * 65 * 4  , RG_CAR = RG_SEG + 2 * 64 * 4 * 8  ;
template <int PASS>
DI void rg_item(const float* const* in, unsigned char* ws, char* lds, int item) {
    const int tid = threadIdx.x, lane = tid & 63, wid = tid >> 6;
    const int ci = item % 36, bh = item / 36, head = bh & 7, b = bh >> 3;
    const bf16_t* PROJ = (const bf16_t*)(ws + WS_PROJ);
    const int seqbase = ci < 4 ? NLAT + b * CTXL : b * SEQ, t0 = ci < 4 ? ci * 64 : (ci - 4) * 64, slen = ci < 4 ? CTXL : SEQ;
    bf16_t* XA = (bf16_t*)(lds + RG_XA); float* XF = (float*)(lds + RG_XF); float* GT = (float*)(lds + RG_GT); float* SEGL = (float*)(lds + RG_SEG); float* CAR = (float*)(lds + RG_CAR);
    float* TOT = (float*)(ws + WS_RGTOT);
    const int sdir = tid >> 8, sch = (tid >> 2) & 63, sseg = tid & 3;
    if (PASS == 2) {
        const int pos = sdir == 0 ? ci : (ci < 4 ? 3 - ci : 4 + (35 - ci));
        float pp[9], hh[9];
#pragma unroll
        for (int i = 0; i < 9; ++i) {
            const int k = sseg * 9 + i;
            const int ck = sdir == 0 ? k : (k < 4 ? 3 - k : 35 - (k - 4));
            if (k < pos) { const float* tp = TOT + ((size_t)((sdir * NB + b) * 36 + ck) * 2) * 512 + head * 64 + sch; pp[i] = tp[0]; hh[i] = tp[512]; }
            else { pp[i] = 1.f; hh[i] = 0.f; }
        }
        float Pc = 1.f, Hc = 0.f;
#pragma unroll
        for (int i = 0; i < 9; ++i) { Hc = pp[i] * Hc + hh[i]; Pc *= pp[i]; }
        SEGL[((sdir * 64 + sch) * 4 + sseg) * 2] = Pc; SEGL[((sdir * 64 + sch) * 4 + sseg) * 2 + 1] = Hc;
    }
    {
        const int tok = tid >> 3, cg8 = tid & 7, ch0 = head * 64 + cg8 * 8;
        const float* cw = in[13]; const float* cb = in[14];
        float x[8];
#pragma unroll
        for (int c = 0; c < 8; ++c) x[c] = cb[ch0 + c];
#pragma unroll
        for (int j = 0; j < 4; ++j) {
            const int tt = t0 + tok + j - 1;
            if (tt >= 0 && tt < slen) {
                const u32x4 uu = *(const u32x4*)(PROJ + (size_t)(seqbase + tt) * EIN + ch0);
#pragma unroll
                for (int c = 0; c < 8; ++c) { const float uv = __uint_as_float((c & 1) ? (uu[c >> 1] & 0xffff0000u) : (uu[c >> 1] << 16)); x[c] += cw[j * 512 + ch0 + c] * uv; }
            }
        }
        u32x4 w; w.x = pk2(x[0], x[1]); w.y = pk2(x[2], x[3]); w.z = pk2(x[4], x[5]); w.w = pk2(x[6], x[7]);
        *(u32x4*)(XA + tok * 72 + cg8 * 8) = w;
#pragma unroll
        for (int c = 0; c < 8; ++c) XF[tok * 65 + cg8 * 8 + c] = x[c];
    }
    __syncthreads();
    if (PASS == 2) {
        if (tid < 128) { const int d = tid >> 6, ch = tid & 63; float Hc = 0.f;
#pragma unroll
            for (int s = 0; s < 4; ++s) { const float p = SEGL[((d * 64 + ch) * 4 + s) * 2], h = SEGL[((d * 64 + ch) * 4 + s) * 2 + 1]; Hc = p * Hc + h; }
            CAR[d * 64 + ch] = Hc; }
    }
    {
        const int mi = wid & 3, th = wid >> 2, r32 = lane & 31, hi = lane >> 5;
        const bf16_t* W = (const bf16_t*)(ws + WS_RGW) + (size_t)(mi * 8 + head) * 4096;
        const float* bias = (mi & 1) ? in[18] : in[16]; const int dirm = mi >> 1;
#pragma unroll
        for (int nt = 0; nt < 2; ++nt) {
            f32x16 acc = {};
#pragma unroll
            for (int ks = 0; ks < 4; ++ks) {
                const bf16x8 a = *(const bf16x8*)(XA + (32 * th + r32) * 72 + 16 * ks + 8 * hi);
                const bf16x8 bfr = *(const bf16x8*)(W + (32 * nt + r32) * 64 + 16 * ks + 8 * hi);
                acc = MFMA32(a, bfr, acc);
            }
            const float bv = bias[dirm * 512 + head * 64 + 32 * nt + r32];
#pragma unroll
            for (int i = 0; i < 16; ++i) GT[(mi * 64 + 32 * th + crow(i, hi)) * 65 + 32 * nt + r32] = sigmoidf_(acc[i] + bv);
        }
    }
    __syncthreads();
    float av[16], bvv[16];
    {
        const float lam = in[19][sdir * 512 + head * 64 + sch];
        const float nl = -lam; const float sp = nl > 20.f ? nl : log1pf(__expf(nl));
        float hh = 0.f, PP = 1.f;
#pragma unroll
        for (int s = 0; s < 16; ++s) {
            const int k = 16 * sseg + s, tok = sdir == 0 ? k : 63 - k;
            const float r = GT[((2 * sdir) * 64 + tok) * 65 + sch], ig = GT[((2 * sdir + 1) * 64 + tok) * 65 + sch], x = XF[tok * 65 + sch];
            const float la = -8.f * r * sp; const float a = __expf(la); const float bb = sqrtf(-expm1f(2.f * la)) * (ig * x);
            av[s] = a; bvv[s] = bb; hh = a * hh + bb; PP *= a;
        }
        __syncthreads();
        SEGL[((sdir * 64 + sch) * 4 + sseg) * 2] = PP; SEGL[((sdir * 64 + sch) * 4 + sseg) * 2 + 1] = hh;
    }
    __syncthreads();
    {
        float c = (PASS == 2) ? CAR[sdir * 64 + sch] : 0.f; float Pt = 1.f;
        for (int s = 0; s < 4; ++s) { const float p = SEGL[((sdir * 64 + sch) * 4 + s) * 2], h = SEGL[((sdir * 64 + sch) * 4 + s) * 2 + 1];
            if (s < sseg) c = p * c + h;
            if (PASS == 1) { Pt *= p; if (s >= sseg && sseg == 0) {   } } }
        if (PASS == 1) {
            if (sseg == 3) {
                const float p3 = SEGL[((sdir * 64 + sch) * 4 + 3) * 2], h3 = SEGL[((sdir * 64 + sch) * 4 + 3) * 2 + 1];
                float* tp = TOT + ((size_t)((sdir * NB + b) * 36 + ci) * 2) * 512 + head * 64 + sch;
                tp[0] = Pt; tp[512] = p3 * c + h3;
            }
        } else {
            float h = c;
#pragma unroll
            for (int s = 0; s < 16; ++s) { const int k = 16 * sseg + s, tok = sdir == 0 ? k : 63 - k; h = av[s] * h + bvv[s]; GT[(sdir * 64 + tok) * 65 + sch] = h; }
        }
    }
    if (PASS == 2) {
        __syncthreads();
        const int tok = tid >> 3, cg8 = tid & 7, ch0 = head * 64 + cg8 * 8;
        const size_t row = (size_t)(seqbase + t0 + tok);
        const u32x4 gg = *(const u32x4*)(PROJ + row * EIN + 512 + ch0);
        float o[8];
#pragma unroll
        for (int c = 0; c < 8; ++c) { const float gt = __uint_as_float((c & 1) ? (gg[c >> 1] & 0xffff0000u) : (gg[c >> 1] << 16));
            const float y = GT[tok * 65 + cg8 * 8 + c] + GT[(64 + tok) * 65 + cg8 * 8 + c]; o[c] = y * gelu_tanh(gt); }
        u32x4 w; w.x = pk2(o[0], o[1]); w.y = pk2(o[2], o[3]); w.z = pk2(o[4], o[5]); w.w = pk2(o[6], o[7]);
        *(u32x4*)((bf16_t*)(ws + WS_MIX) + row * DM + ch0) = w;
    }
    __syncthreads();
}

DI void s5_pre_item(const float* const* in, unsigned char* ws, char* lds, int item) {
    const int tid = threadIdx.x; const int g = item >> 2, qq = item & 3;
    float* AP = (float*)lds;
    float* BB = AP + 2 * 33 * 64 * 2;
    float* CC = BB + 2 * 64 * 16 * 2;
    float* KT = CC + 2 * 16 * 64 * 2;
    const float* lam_re = in[24]; const float* lam_im = in[25]; const float* lstep = in[26];
    for (int e = tid; e < 2 * 33 * 64; e += NTHREADS) { const int p = e & 63, j = (e >> 6) % 33, d = e / (64 * 33);
        const float dt = __expf(lstep[d * 32 + g]); const float lr = lam_re[(d * 32 + g) * 64 + p], li = lam_im[(d * 32 + g) * 64 + p];
        const float mag = expf((float)j * lr * dt), ang = (float)j * li * dt; AP[e * 2] = mag * cosf(ang); AP[e * 2 + 1] = mag * sinf(ang); }
    for (int e = tid; e < 2 * 64 * 16; e += NTHREADS) { const int h = e & 15, p = (e >> 4) & 63, d = e >> 10;
        const float dt = __expf(lstep[d * 32 + g]); const float lr = lam_re[(d * 32 + g) * 64 + p], li = lam_im[(d * 32 + g) * 64 + p];
        const float mag = expf(lr * dt), ang = li * dt; const float abr = mag * cosf(ang), abi = mag * sinf(ang);
        const float den = lr * lr + li * li, nr = abr - 1.f, ni = abi; const float kr = (nr * lr + ni * li) / den, ki = (ni * lr - nr * li) / den;
        const float br = in[27][((size_t)(d * 32 + g) * 64 + p) * 16 + h], bi = in[28][((size_t)(d * 32 + g) * 64 + p) * 16 + h];
        BB[e * 2] = kr * br - ki * bi; BB[e * 2 + 1] = kr * bi + ki * br; }
    for (int e = tid; e < 2 * 16 * 64; e += NTHREADS) { const int p = e & 63, h = (e >> 6) & 15, d = e >> 10;
        CC[e * 2] = in[29][((size_t)(d * 32 + g) * 16 + h) * 64 + p]; CC[e * 2 + 1] = in[30][((size_t)(d * 32 + g) * 16 + h) * 64 + p]; }
    __syncthreads();
    for (int e = tid; e < 2 * 32 * 256; e += NTHREADS) { const int hi = e & 15, ho = (e >> 4) & 15, j = (e >> 8) & 31, d = e >> 13; float s = 0.f;
        for (int p = 0; p < 64; ++p) { const float ar = AP[((d * 33 + j) * 64 + p) * 2], ai = AP[((d * 33 + j) * 64 + p) * 2 + 1];
            const float cr = CC[((d * 16 + ho) * 64 + p) * 2], ci = CC[((d * 16 + ho) * 64 + p) * 2 + 1];
            const float br = BB[((d * 64 + p) * 16 + hi) * 2], bi = BB[((d * 64 + p) * 16 + hi) * 2 + 1];
            const float xr = cr * ar - ci * ai, xi = cr * ai + ci * ar; s += xr * br - xi * bi; }
        KT[e] = s; }
    __syncthreads();
    bf16_t* Mg = (bf16_t*)(ws + WS_S5M) + (size_t)g * 512 * 512; bf16_t* Eg = (bf16_t*)(ws + WS_S5E) + (size_t)g * 256 * 512; bf16_t* Fg = (bf16_t*)(ws + WS_S5F) + (size_t)g * 512 * 256;
    const float* dsk = in[31];
    for (int e = tid; e < 128 * 512; e += NTHREADS) { const int k = e & 511, mr = e >> 9, m = qq * 128 + mr; const int t = m >> 4, ho = m & 15, tau = k >> 4, hi = k & 15;
        float v = 0.f; if (tau <= t) v += KT[(0 * 32 + (t - tau)) * 256 + ho * 16 + hi]; if (tau >= t) v += KT[(1 * 32 + (tau - t)) * 256 + ho * 16 + hi];
        if (tau == t && ho == hi) v += dsk[g * 16 + ho];
        Mg[(size_t)m * 512 + k] = (bf16_t)f2bf(v); }
    { const int d = qq >> 1, c = qq & 1;
      for (int e = tid; e < 64 * 512; e += NTHREADS) { const int k = e & 511, p = e >> 9, tau = k >> 4, hi = k & 15; const int j = d == 0 ? 31 - tau : tau;
          const float ar = AP[((d * 33 + j) * 64 + p) * 2], ai = AP[((d * 33 + j) * 64 + p) * 2 + 1]; const float br = BB[((d * 64 + p) * 16 + hi) * 2], bi = BB[((d * 64 + p) * 16 + hi) * 2 + 1];
          const float v = c ? (ar * bi + ai * br) : (ar * br - ai * bi);
          Eg[(size_t)(qq * 64 + p) * 512 + k] = (bf16_t)f2bf(v); } }
    for (int e = tid; e < 128 * 256; e += NTHREADS) { const int k = e & 255, mr = e >> 8, m = qq * 128 + mr, t = m >> 4, ho = m & 15; const int d = k >> 7, c = (k >> 6) & 1, p = k & 63;
        const int j = d == 0 ? t + 1 : 32 - t;
        const float ar = AP[((d * 33 + j) * 64 + p) * 2], ai = AP[((d * 33 + j) * 64 + p) * 2 + 1]; const float cr = CC[((d * 16 + ho) * 64 + p) * 2], ci = CC[((d * 16 + ho) * 64 + p) * 2 + 1];
        const float v = c ? -(cr * ai + ci * ar) : (cr * ar - ci * ai);
        Fg[(size_t)m * 256 + k] = (bf16_t)f2bf(v); }
    if (qq == 0) for (int e = tid; e < 2 * 64; e += NTHREADS) { const int p = e & 63, d = e >> 6; float* at = (float*)(ws + WS_S5AT) + ((size_t)(d * 32 + g) * 64 + p) * 2;
        at[0] = AP[((d * 33 + 32) * 64 + p) * 2]; at[1] = AP[((d * 33 + 32) * 64 + p) * 2 + 1]; }
    __syncthreads();
}
DI int s5_chunk_row(int n72) { const int b = n72 / 72, cc = n72 - b * 72; return cc < 8 ? NLAT + b * CTXL + 32 * cc : b * SEQ + 32 * (cc - 8); }
DI void s5_L_item(unsigned char* ws, int witem) {
    const int lane = threadIdx.x & 63, r32 = lane & 31, hi = lane >> 5;
    const int mq = witem & 1, nt = (witem >> 1) % 18, g = witem / 36;
    const bf16_t* PROJ = (const bf16_t*)(ws + WS_PROJ); const bf16_t* Eg = (const bf16_t*)(ws + WS_S5E) + (size_t)g * 256 * 512;
    const int n = nt * 32 + r32; const bf16_t* up = PROJ + (size_t)s5_chunk_row(n) * OIN + g * 16 + 8 * hi;
    const bf16_t* ap = Eg + (size_t)(mq * 128 + r32) * 512 + 8 * hi;
    f32x16 acc[4] = {};
#pragma unroll 4
    for (int ks = 0; ks < 32; ++ks) {
        const bf16x8 bfr = *(const bf16x8*)(up + (size_t)ks * OIN);
#pragma unroll
        for (int mt = 0; mt < 4; ++mt) { const bf16x8 a = *(const bf16x8*)(ap + (size_t)mt * 32 * 512 + 16 * ks); acc[mt] = MFMA32(a, bfr, acc[mt]); }
    }
    float* L = (float*)(ws + WS_S5L) + ((size_t)n * 32 + g) * 256 + mq * 128;
#pragma unroll
    for (int mt = 0; mt < 4; ++mt)
#pragma unroll
        for (int k = 0; k < 4; ++k) *(f32x4*)(L + mt * 32 + 8 * k + 4 * hi) = (f32x4){acc[mt][4 * k], acc[mt][4 * k + 1], acc[mt][4 * k + 2], acc[mt][4 * k + 3]};
}
DI void s5_scan_thread(unsigned char* ws, int gid) {
    const int p = gid & 63, d = (gid >> 6) & 1, g = (gid >> 7) & 31, b = gid >> 12;
    const float* at = (const float*)(ws + WS_S5AT) + ((size_t)(d * 32 + g) * 64 + p) * 2; const float ar = at[0], ai = at[1];
    const float* L = (const float*)(ws + WS_S5L); bf16_t* S = (bf16_t*)(ws + WS_S5S);
    float sr = 0.f, si = 0.f;
#pragma unroll 8
    for (int k = 0; k < 72; ++k) {
        const int cc = d == 0 ? k : (k < 8 ? 7 - k : 71 - (k - 8));
        const size_t lo = ((size_t)(b * 72 + cc) * 32 + g) * 256 + d * 128 + p;
        const float lr = L[lo], li = L[lo + 64];
        if (cc >= 8) { const size_t so = ((size_t)(b * 64 + cc - 8) * 32 + g) * 256 + d * 128 + p; S[so] = (bf16_t)f2bf(sr); S[so + 64] = (bf16_t)f2bf(si); }
        const float nr = ar * sr - ai * si + lr, ni = ar * si + ai * sr + li; sr = nr; si = ni;
    }
}
DI void s5_Y_item(unsigned char* ws, int witem) {
    const int lane = threadIdx.x & 63, r32 = lane & 31, hi = lane >> 5;
    const int mq = witem & 3, nt = (witem >> 2) & 15, g = witem >> 6;
    const bf16_t* PROJ = (const bf16_t*)(ws + WS_PROJ);
    const bf16_t* Mg = (const bf16_t*)(ws + WS_S5M) + (size_t)g * 512 * 512; const bf16_t* Fg = (const bf16_t*)(ws + WS_S5F) + (size_t)g * 512 * 256;
    const int n = nt * 32 + r32; const int row0 = (n >> 6) * SEQ + (n & 63) * 32;
    const bf16_t* up = PROJ + (size_t)row0 * OIN + g * 16 + 8 * hi;
    const bf16_t* sp = (const bf16_t*)(ws + WS_S5S) + ((size_t)n * 32 + g) * 256 + 8 * hi;
    const bf16_t* ap = Mg + (size_t)(mq * 128 + r32) * 512 + 8 * hi; const bf16_t* fp = Fg + (size_t)(mq * 128 + r32) * 256 + 8 * hi;
    f32x16 acc[4] = {};
#pragma unroll 4
    for (int ks = 0; ks < 32; ++ks) {
        const bf16x8 bfr = *(const bf16x8*)(up + (size_t)ks * OIN);
#pragma unroll
        for (int mt = 0; mt < 4; ++mt) { const bf16x8 a = *(const bf16x8*)(ap + (size_t)mt * 32 * 512 + 16 * ks); acc[mt] = MFMA32(a, bfr, acc[mt]); }
    }
#pragma unroll 4
    for (int ks = 0; ks < 16; ++ks) {
        const bf16x8 bfr = *(const bf16x8*)(sp + 16 * ks);
#pragma unroll
        for (int mt = 0; mt < 4; ++mt) { const bf16x8 a = *(const bf16x8*)(fp + (size_t)mt * 32 * 256 + 16 * ks); acc[mt] = MFMA32(a, bfr, acc[mt]); }
    }
    bf16_t* Z = (bf16_t*)(ws + WS_Z);
#pragma unroll
    for (int mt = 0; mt < 4; ++mt)
#pragma unroll
        for (int k = 0; k < 4; ++k) { const int m = mq * 128 + mt * 32 + 8 * k + 4 * hi, t = m >> 4, ho = m & 15;
            u32x2 w; w.x = pk2(gelu_tanh(acc[mt][4 * k]), gelu_tanh(acc[mt][4 * k + 1])); w.y = pk2(gelu_tanh(acc[mt][4 * k + 2]), gelu_tanh(acc[mt][4 * k + 3]));
            *(u32x2*)(Z + (size_t)(row0 + t) * 512 + g * 16 + ho) = w; }
}

DI int up_row_map(int n) { return n < FH ? (n >> 7) * 256 + (n & 127) : ((n - FH) >> 7) * 256 + 128 + ((n - FH) & 127); }
DI void p0_transpose_item(const float* W, int K, int N, bf16_t* WT, bool upmap, float* scr, int item, int lane) {
    const int nblk = N / 32, kb = item / nblk, nb = item % nblk, k0 = 64 * kb, n0 = 32 * nb;
#pragma unroll 8
    for (int i = 0; i < 32; ++i) { const int kk = 2 * i + (lane >> 5); scr[kk * 33 + (lane & 31)] = W[(size_t)(k0 + kk) * N + n0 + (lane & 31)]; }
    asm volatile("s_waitcnt lgkmcnt(0)" ::: "memory");
    const int c = lane & 7;
#pragma unroll
    for (int j = 0; j < 4; ++j) { const int n = (lane >> 3) + 8 * j; const float* s = scr + (8 * c) * 33 + n;
        u32x4 o; o.x = pk2(s[0 * 33], s[1 * 33]); o.y = pk2(s[2 * 33], s[3 * 33]); o.z = pk2(s[4 * 33], s[5 * 33]); o.w = pk2(s[6 * 33], s[7 * 33]);
        const int nr = upmap ? up_row_map(n0 + n) : n0 + n;
        *(u32x4*)(WT + (size_t)nr * K + k0 + 8 * c) = o; }
    asm volatile("s_waitcnt lgkmcnt(0)" ::: "memory");
}
DI void norm_row(const float* xrow, const float* g, const float* shift, const float* scale, bf16_t* o1, bf16_t* o2, int lane) {
    f32x4 v[4]; float s = 0.f;
#pragma unroll
    for (int j = 0; j < 4; ++j) { v[j] = *((const f32x4*)xrow + lane + 64 * j); s += (v[j].x * v[j].x + v[j].y * v[j].y) + (v[j].z * v[j].z + v[j].w * v[j].w); }
    const float rstd = rsqrtf(wave_sum(s) * (1.f / DM) + NORM_EPS);
#pragma unroll
    for (int j = 0; j < 4; ++j) {
        const f32x4 gg = *((const f32x4*)g + lane + 64 * j), sh = *((const f32x4*)shift + lane + 64 * j), sc = *((const f32x4*)scale + lane + 64 * j);
        const f32x4 y = (v[j] * rstd) * gg * (sc + 1.0f) + sh;
        u32x2 w; w.x = pk2(y.x, y.y); w.y = pk2(y.z, y.w);
        *((u32x2*)o1 + lane + 64 * j) = w; if (o2) *((u32x2*)o2 + lane + 64 * j) = w;
    }
}
DI void norm_phase(const float* hL, const float* hC, const float* g, const float* mod, int ish, int isc, bf16_t* XN, int nrows, int xne_row, int gw, int NGW, int lane) {
    for (int r = gw; r < nrows; r += NGW) {
        const bool isctx = r >= NLAT; const int bb = isctx ? 8 : r >> 11;
        const float* x = isctx ? hC + (size_t)(r - NLAT) * DM : hL + (size_t)r * DM;
        bf16_t* o2 = nullptr;
        if (xne_row >= 0) {
            const int t = isctx ? (r - NLAT) & 255 : r & 2047, slen = isctx ? CTXL : SEQ, s = isctx ? (r - NLAT) >> 8 : r >> 11;
            const int k = (t + 2) >> 6, pos = (t + 2) & 63;
            if (pos < 4 && k >= 1 && k <= slen / 64 - 1) { const int q = isctx ? NBND_LAT + s * 3 + (k - 1) : s * 31 + (k - 1); o2 = XN + (size_t)(xne_row + 4 * q + pos) * DM; }
        }
        norm_row(x, g, mod + (size_t)bb * 6144 + ish * 1024, mod + (size_t)bb * 6144 + isc * 1024, XN + (size_t)r * DM, o2, lane);
    }
}
DI void qknorm_phase(bf16_t* PROJ, int ld, int qoff, const float* qn, const float* kn, const float* rope, int gw, int NGW, int lane) {
    const float gq = qn[lane], gk = kn[lane];
    const int ridx = (lane >> 5) * 16 + (lane & 15); const bool second = (lane >> 4) & 1;
    for (int r = gw; r < MALL; r += NGW) {
        bf16_t* p = PROJ + (size_t)r * ld + qoff + lane;
        const bool lat = r < NLAT; float cs = 1.f, sn = 0.f;
        if (lat) { const int t = r & 2047; cs = rope[t * 32 + ridx]; sn = rope[SEQ * 32 + t * 32 + ridx]; }
        float v[10];
#pragma unroll
        for (int h = 0; h < 10; ++h) v[h] = bf2f(p[h * 64]);
#pragma unroll
        for (int h = 0; h < 10; ++h) {
            const float ss = wave_sum(v[h] * v[h]); float y = v[h] * rsqrtf(ss * (1.f / 64.f) + NORM_EPS) * (h < 8 ? gq : gk);
            const float yp = __shfl_xor(y, 16);
            if (lat) y = second ? (y * cs + yp * sn) : (y * cs - yp * sn);
            if (h < 8) y *= C2;
            p[h * 64] = (bf16_t)f2bf(y);
        }
    }
}

struct Args { const float* in[37]; float* out; unsigned char* ws; int ph_lo, ph_hi; };
constexpr int NPHASE = 19;

DI void p0_prologue(const Args& a, char* lds, int G) {
    const int tid = threadIdx.x, lane = tid & 63, wid = tid >> 6;
    unsigned char* ws = a.ws;
    const int gw = blockIdx.x * NWAVES + wid, NGW = G * NWAVES;
    {
        float* scr = (float*)(lds + wid * 16384);
        constexpr int I_IN0 = 16 * (EIN / 32), I_OUT = 16 * 32, I_UP = 16 * (FH2 / 32), I_DN = (FH / 64) * 32, I_IN1 = 16 * (OIN / 32), I_GLU = 8 * 16;
        constexpr int NIT = I_IN0 + I_OUT + I_UP + I_DN + I_IN1 + I_OUT + I_UP + I_DN + I_GLU;
        for (int it = gw; it < NIT; it += NGW) {
            int r = it;
            if (r < I_UP) { p0_transpose_item(a.in[7], DM, FH2, (bf16_t*)(ws + WS_WUP0), true, scr, r, lane); continue; } r -= I_UP;
            if (r < I_UP) { p0_transpose_item(a.in[7] + (size_t)DM * FH2, DM, FH2, (bf16_t*)(ws + WS_WUP1), true, scr, r, lane); continue; } r -= I_UP;
            if (r < I_DN) { p0_transpose_item(a.in[10], FH, DM, (bf16_t*)(ws + WS_WDN0), false, scr, r, lane); continue; } r -= I_DN;
            if (r < I_DN) { p0_transpose_item(a.in[10] + (size_t)FH * DM, FH, DM, (bf16_t*)(ws + WS_WDN1), false, scr, r, lane); continue; } r -= I_DN;
            if (r < I_IN0) { p0_transpose_item(a.in[11], DM, EIN, (bf16_t*)(ws + WS_WIN0), false, scr, r, lane); continue; } r -= I_IN0;
            if (r < I_IN1) { p0_transpose_item(a.in[22], DM, OIN, (bf16_t*)(ws + WS_WIN1), false, scr, r, lane); continue; } r -= I_IN1;
            if (r < I_OUT) { p0_transpose_item(a.in[12], DM, DM, (bf16_t*)(ws + WS_WOUT0), false, scr, r, lane); continue; } r -= I_OUT;
            if (r < I_OUT) { p0_transpose_item(a.in[23], DM, DM, (bf16_t*)(ws + WS_WOUT1), false, scr, r, lane); continue; } r -= I_OUT;
            p0_transpose_item(a.in[32], 512, 512, (bf16_t*)(ws + WS_WGLU), false, scr, r, lane);
        }
    }
    {
        const int gt = blockIdx.x * NTHREADS + tid, NGT = G * NTHREADS;
        float* rope = (float*)(ws + WS_ROPE);
        for (int e = gt; e < SEQ * 32; e += NGT) { const int t = e >> 5, idx = e & 31, i = idx & 15; const float pos = (float)((idx < 16) ? (t >> 6) : (t & 63));
            const float invf = powf(10000.0f, -(float)i / 16.0f); const float ang = pos * invf; rope[e] = cosf(ang); rope[SEQ * 32 + e] = sinf(ang); }
        bf16_t* rgw = (bf16_t*)(ws + WS_RGW);
        for (int e = gt; e < 4 * 8 * 4096; e += NGT) { const int k = e & 63, n = (e >> 6) & 63, hd = (e >> 12) & 7, mi = e >> 15; const int d = mi >> 1;
            const float* w = (mi & 1) ? a.in[17] : a.in[15]; rgw[e] = (bf16_t)f2bf(w[((size_t)(d * 8 + hd) * 64 + k) * 64 + n]); }
    }
    __syncthreads();
    {
        float* cond = (float*)lds;
        float* red = (float*)(lds + 1024 * 12 * 4);
        for (int e = tid; e < 9 * 1024; e += NTHREADS) { const int k = e & 1023, bb = e >> 10; const float cv = bb < 8 ? a.in[1][bb * 1024 + k] : a.in[3][k]; cond[k * 12 + bb] = siluf_(cv); }
        __syncthreads();
        float* MOD = (float*)(ws + WS_MOD);
        for (int it = blockIdx.x; it < 2 * 96; it += G) {
            const int layer = it / 96, cb = it % 96, col = cb * 64 + lane;
            const float* w = a.in[4] + (size_t)layer * DM * 6144 + col;
            float acc[9];
#pragma unroll
            for (int bb = 0; bb < 9; ++bb) acc[bb] = 0.f;
#pragma unroll 4
            for (int kk = 0; kk < 128; ++kk) { const int k = wid * 128 + kk; const float wv = w[(size_t)k * 6144];
                const f32x4 c0 = *(const f32x4*)(cond + k * 12), c1 = *(const f32x4*)(cond + k * 12 + 4); const float c8 = cond[k * 12 + 8];
                acc[0] += c0.x * wv; acc[1] += c0.y * wv; acc[2] += c0.z * wv; acc[3] += c0.w * wv; acc[4] += c1.x * wv; acc[5] += c1.y * wv; acc[6] += c1.z * wv; acc[7] += c1.w * wv; acc[8] += c8 * wv; }
#pragma unroll
            for (int bb = 0; bb < 9; ++bb) red[(wid * 9 + bb) * 64 + lane] = acc[bb];
            __syncthreads();
            for (int e = tid; e < 9 * 64; e += NTHREADS) { const int bb = e >> 6, ln = e & 63; float s = a.in[5][layer * 6144 + cb * 64 + ln];
#pragma unroll
                for (int w8 = 0; w8 < 8; ++w8) s += red[(w8 * 9 + bb) * 64 + ln];
                MOD[((size_t)layer * 9 + bb) * 6144 + cb * 64 + ln] = s; }
            __syncthreads();
        }
    }
    __syncthreads();
    for (int it = blockIdx.x; it < 128; it += G) s5_pre_item(a.in, ws, lds, (it + 64) & 127);
}

__global__ void __launch_bounds__(NTHREADS, 2) trunk_fwd(Args a) {
    extern __shared__ __attribute__((aligned(16))) unsigned char lds_raw[];
    char* lds = (char*)lds_raw;
    PG8_LAS unsigned char* ldsl = (PG8_LAS unsigned char*)lds_raw;
    cg::grid_group grid = cg::this_grid();
    const int tid = threadIdx.x, lane = tid & 63, wid = tid >> 6, G = gridDim.x;
    const int gw = blockIdx.x * NWAVES + wid, NGW = G * NWAVES;
    unsigned char* ws = a.ws;
    const int lo = a.ph_lo, hi = a.ph_hi;
    float* MOD = (float*)(ws + WS_MOD); float* HC = (float*)(ws + WS_HC);
    bf16_t* XN = (bf16_t*)(ws + WS_XN); bf16_t* PROJ = (bf16_t*)(ws + WS_PROJ); bf16_t* MIX = (bf16_t*)(ws + WS_MIX); bf16_t* HID = (bf16_t*)(ws + WS_HID);
    const float* rope = (const float*)(ws + WS_ROPE);
#ifndef PHASE_MASK
#define PHASE_MASK 0x7ffff
#endif
#define IN(k) (((PHASE_MASK >> (k)) & 1) && lo <= (k) && (k) < hi)
#define SEAM(k) do { if (IN(k) && IN((k) + 1)) grid.sync(); } while (0)

    if (IN(0)) { p0_prologue(a, lds, G); } SEAM(0);
    if (IN(1)) norm_phase(a.in[0], a.in[2], a.in[6], MOD, 0, 1, XN, MALL, -1, gw, NGW, lane);
    SEAM(1);
    if (IN(2)) { pg8::Gemm g{XN, (const bf16_t*)(ws + WS_WIN0), MALL, EIN, DM}; pg8::StaticOrder S; S.init(MALL, EIN, G, (int)blockIdx.x);
        pg8::EpiBf16<0> E{PROJ, EIN, nullptr, 0, 0, 1.f}; pg8::gemm_phase<pg8::EpiBf16<0>, pg8::StaticOrder, true, true>(ldsl, g, S, E); }
    SEAM(2);
    if (IN(3)) { qknorm_phase(PROJ, EIN, 1024, a.in[20], a.in[21], rope, gw, NGW, lane); __syncthreads();
        for (int it = blockIdx.x; it < NB * 8 * 36; it += G) rg_item<1>(a.in, ws, lds, it); }
    SEAM(3);
    if (IN(4)) {
#ifndef P4_NO_ATTN
        for (int it = blockIdx.x; it < 512 + 64; it += G) {
            if (it < 512) { const int qb = it & 7, head = (it >> 3) & 7, b = it >> 6; attn_unit<0>(PROJ, EIN, 1024, 1536, 1664, MIX, lds, b, head, qb * 256, 0.f); }
            else { const int u = it - 512, head = u & 7, b = u >> 3; attn_unit<1>(PROJ, EIN, 1024, 1536, 1664, MIX, lds, b, head, 0, 0.f); }
        }
#endif
#ifndef P4_NO_RG
        for (int it = (blockIdx.x + G - 64) % G; it < NB * 8 * 36; it += G) rg_item<2>(a.in, ws, lds, it);
#endif
    }
    SEAM(4);
    if (IN(5)) { pg8::Gemm g{MIX, (const bf16_t*)(ws + WS_WOUT0), MALL, DM, DM}; pg8::StaticOrder S; S.init(MALL, DM, G, (int)blockIdx.x);
        EpiRes E{a.in[0], a.in[2], a.out, HC, MOD + 2 * 1024}; pg8::gemm_phase<EpiRes, pg8::StaticOrder, true, true>(ldsl, g, S, E); }
    SEAM(5);
    if (IN(6)) norm_phase(a.out, HC, a.in[6] + DM, MOD, 3, 4, XN, MALL, XNE_ROW_L0, gw, NGW, lane);
    SEAM(6);
    if (IN(7)) { constexpr int MT = MALL + 1280; pg8::Gemm g{XN, (const bf16_t*)(ws + WS_WUP0), MT, FH2, DM}; pg8::StaticOrder S; S.init(MT, FH2, G, (int)blockIdx.x);
        EpiConvAct E{HID, a.in[8], a.in[9], MALL / 256, NBND_LAT, NBND_LAT + NBND_CTX, lds + 131072}; pg8::gemm_phase<EpiConvAct, pg8::StaticOrder, true, true>(ldsl, g, S, E); }
    SEAM(7);
    if (IN(8)) { pg8::Gemm g{HID, (const bf16_t*)(ws + WS_WDN0), MALL, DM, FH}; pg8::StaticOrder S; S.init(MALL, DM, G, (int)blockIdx.x);
        EpiRes E{a.out, HC, a.out, HC, MOD + 5 * 1024}; pg8::gemm_phase<EpiRes, pg8::StaticOrder, true, true>(ldsl, g, S, E); }
    SEAM(8);
    const float* MOD1 = MOD + 9 * 6144;
    if (IN(9)) norm_phase(a.out, HC, a.in[6] + 2 * DM, MOD1, 0, 1, XN, MALL, -1, gw, NGW, lane);
    SEAM(9);
    if (IN(10)) { pg8::Gemm g{XN, (const bf16_t*)(ws + WS_WIN1), MALL, OIN, DM}; pg8::StaticOrder S; S.init(MALL, OIN, G, (int)blockIdx.x);
        pg8::EpiBf16<0> E{PROJ, OIN, nullptr, 0, 0, 1.f}; pg8::gemm_phase<pg8::EpiBf16<0>, pg8::StaticOrder, true, true>(ldsl, g, S, E); }
    SEAM(10);
    if (IN(11)) { qknorm_phase(PROJ, OIN, 512, a.in[34], a.in[35], rope, gw, NGW, lane);
        for (int it = gw; it < 32 * 36; it += NGW) s5_L_item(ws, it); }
    SEAM(11);
    if (IN(12)) {
        { const int gt = blockIdx.x * NTHREADS + tid; if (gt < NB * 32 * 2 * 64) s5_scan_thread(ws, gt); }
        __syncthreads();
        const int nskip = (NB * 32 * 2 * 64) / NTHREADS;
        for (int it = (blockIdx.x + G - nskip) % G; it < 512; it += G) { const int qb = it & 7, head = (it >> 3) & 7, b = it >> 6;
            attn_unit<2>(PROJ, OIN, 512, 1024, 1152, MIX, lds, b, head, qb * 256, a.in[36][head] * 1.4426950408889634f); }
    }
    SEAM(12);
    if (IN(13)) { for (int it = gw; it < 32 * 64; it += NGW) s5_Y_item(ws, it); }
    SEAM(13);
    if (IN(14)) { pg8::Gemm g{(const bf16_t*)(ws + WS_Z), (const bf16_t*)(ws + WS_WGLU), NLAT, 512, 512}; pg8::StaticOrder S; S.init(NLAT, 512, G, (int)blockIdx.x);
        EpiGlu E{(const bf16_t*)(ws + WS_Z), MIX, a.in[33]}; pg8::gemm_phase<EpiGlu, pg8::StaticOrder, true, true>(ldsl, g, S, E); }
    SEAM(14);
    if (IN(15)) { pg8::Gemm g{MIX, (const bf16_t*)(ws + WS_WOUT1), NLAT, DM, DM}; pg8::StaticOrder S; S.init(NLAT, DM, G, (int)blockIdx.x);
        EpiRes E{a.out, HC, a.out, HC, MOD1 + 2 * 1024}; pg8::gemm_phase<EpiRes, pg8::StaticOrder, true, true>(ldsl, g, S, E); }
    SEAM(15);
    if (IN(16)) norm_phase(a.out, HC, a.in[6] + 3 * DM, MOD1, 3, 4, XN, NLAT, XNE_ROW_L1, gw, NGW, lane);
    SEAM(16);
    if (IN(17)) { constexpr int MT = NLAT + 1024; pg8::Gemm g{XN, (const bf16_t*)(ws + WS_WUP1), MT, FH2, DM}; pg8::StaticOrder S; S.init(MT, FH2, G, (int)blockIdx.x);
        EpiConvAct E{HID, a.in[8] + 3 * FH2, a.in[9] + FH2, NLAT / 256, NBND_LAT, NBND_LAT, lds + 131072}; pg8::gemm_phase<EpiConvAct, pg8::StaticOrder, true, true>(ldsl, g, S, E); }
    SEAM(17);
    if (IN(18)) { pg8::Gemm g{HID, (const bf16_t*)(ws + WS_WDN1), NLAT, DM, FH}; pg8::StaticOrder S; S.init(NLAT, DM, G, (int)blockIdx.x);
        EpiRes E{a.out, HC, a.out, HC, MOD1 + 5 * 1024}; pg8::gemm_phase<EpiRes, pg8::StaticOrder, true, true>(ldsl, g, S, E); }
#undef IN
#undef SEAM
}

#ifndef N_LAUNCH_MODE
#define N_LAUNCH_MODE 1
#endif
extern "C" void kernel_launch(void* const* d_in, const int* in_sizes, int n_in, void* d_out, int out_size, void* d_ws, size_t ws_size, hipStream_t stream) {
    static int grid = 0;
    if (grid == 0) {
        if (n_in != 37 || out_size != NLAT * DM || ws_size < WS_END) { fprintf(stderr, "kernel_launch: unexpected problem (n_in %d out %d ws %zu)\n", n_in, out_size, ws_size); grid = -1; return; }
        int dev = 0, cus = 0, per_cu = 0;
        hipGetDevice(&dev); hipDeviceGetAttribute(&cus, hipDeviceAttributeMultiprocessorCount, dev);
        if (hipFuncSetAttribute((const void*)trunk_fwd, hipFuncAttributeMaxDynamicSharedMemorySize, LDS_BYTES) != hipSuccess) { fprintf(stderr, "kernel_launch: hipFuncSetAttribute failed\n"); grid = -1; return; }
        if (hipOccupancyMaxActiveBlocksPerMultiprocessor(&per_cu, (const void*)trunk_fwd, NTHREADS, LDS_BYTES) != hipSuccess || per_cu < 1) { fprintf(stderr, "kernel_launch: occupancy query says %d\n", per_cu); per_cu = 1; }
        (void)hipGetLastError();
        grid = cus;
        fprintf(stderr, "kernel_launch: grid %d (cus %d, per_cu %d)\n", grid, cus, per_cu);
    }
    if (grid < 0) return;
    Args a{};
    for (int i = 0; i < 37; ++i) a.in[i] = (const float*)d_in[i];
    a.out = (float*)d_out; a.ws = (unsigned char*)d_ws;
#if N_LAUNCH_MODE == 1
    a.ph_lo = 0; a.ph_hi = NPHASE;
    void* args[] = {&a};
    hipError_t e = hipLaunchCooperativeKernel((const void*)trunk_fwd, dim3(grid), dim3(NTHREADS), args, LDS_BYTES, stream);
    if (e != hipSuccess) fprintf(stderr, "cooperative launch failed: %s (grid %d)\n", hipGetErrorString(e), grid);
#else
#ifdef DBG_CHECK
    (void)hipMemsetAsync((char*)d_ws + WS_CTL, 0, CTL_ZERO_BYTES, stream);
#endif
    for (int p = 0; p < NPHASE; ++p) { a.ph_lo = p; a.ph_hi = p + 1; hipLaunchKernelGGL(trunk_fwd, dim3(grid), dim3(NTHREADS), LDS_BYTES, stream, a);
#ifdef DBG_CHECK
        Args d = a; d.ph_lo = 0; d.ph_hi = 0;
        static const int chk[NPHASE][2] = {{1,0},{0,0},{2,0},{3,0},{4,5},{6,0},{0,0},{7,8},{0,0},{0,0},{9,0},{10,0},{11,0},{12,0},{15,0},{0,0},{0,0},{14,0},{0,0}};
        for (int q = 0; q < 2; ++q) { const int st = chk[p][q]; if (!st) continue; const bool heavy = (st == 5 || st == 12); hipLaunchKernelGGL(dbg_check, dim3(heavy ? 1 : 4), dim3(heavy ? 64 : 256), 0, stream, d, st); }
        if (p == NPHASE - 1) hipLaunchKernelGGL(dbg_report, dim3(1), dim3(64), 0, stream, d);
#endif
    }
#endif
}
```

```cpp
#include <hip/hip_runtime.h>
#include <hip/hip_cooperative_groups.h>
#include <hip/hip_bf16.h>
#include <cstdio>
#include <cstdint>
#include <cmath>
namespace cg = cooperative_groups;
namespace pg8 {
#define PG8_LAS __attribute__((address_space(3)))
typedef unsigned short bf16_t;
typedef short bf16x8 __attribute__((ext_vector_type(8)));
typedef float f32x4 __attribute__((ext_vector_type(4)));
typedef unsigned u32x4 __attribute__((ext_vector_type(4)));
constexpr int BM = 256, BK = 64, HALF = 128, HTB = HALF * BK * 2  , STAGE_BYTES = 8 * HTB, NXCD = 8, WGM = 8;

__host__ __device__ __forceinline__ int lds_byte(int r, int c) { const int st = (r >> 4) * 2 + (c >> 5), rr = r & 15, cc = c & 31, ob = rr * 64 + cc * 2; return st * 1024 + (ob ^ (((ob >> 9) & 1) << 5)); }
__host__ __device__ __forceinline__ void stage_rc(int b, int& R, int& C) { const int st = b / 1024, sb = b % 1024, swz = sb ^ (((sb >> 9) & 1) << 5); R = (st >> 1) * 16 + swz / 64; C = (st & 1) * 32 + (swz % 64) / 2; }
__host__ __device__ __forceinline__ int perm32(int rho) { const int n = rho >> 4, i = rho & 15; return 8 * (i >> 2) + 4 * n + (i & 3); }

struct Unit { int pm, pn; };
struct Gemm { const bf16_t* A; const bf16_t* Bt; int M, N, K; };

struct StaticOrder {
    int nM, nN, nwg, G, c;
    __host__ __device__ void init(int M, int N, int G_, int c_) { nM = M / BM; nN = N / BM; nwg = nM * nN; G = G_; c = c_; }
    __host__ __device__ bool next(int i, Unit& u) const {
        const long L = (long)i * G + c; if (L >= nwg) return false;
        int wgid = (int)L; { const int q = nwg / NXCD, r = nwg % NXCD, xcd = wgid % NXCD, off = wgid / NXCD; wgid = (xcd < r ? xcd * (q + 1) : r * (q + 1) + (xcd - r) * q) + off; }
        const int nig = WGM * nN, gid = wgid / nig, fm = gid * WGM, gsz = (nM - fm) < WGM ? (nM - fm) : WGM;
        u.pm = fm + ((wgid % nig) % gsz); u.pn = (wgid % nig) / gsz; return true;
    }
    __device__ __forceinline__ void a_ready(const Unit&) const {}
    __device__ __forceinline__ void done(const Unit&) const {}
};

__device__ __forceinline__ unsigned cvt_pk_bf16(float lo, float hi) { unsigned r; asm volatile("v_cvt_pk_bf16_f32 %0, %1, %2" : "=v"(r) : "v"(lo), "v"(hi)); return r; }
typedef float f32x2 __attribute__((ext_vector_type(2)));
__device__ __forceinline__ f32x2 gelu_pk(f32x2 v) {
    const f32x2 av = __builtin_elementwise_abs(v), d = av * 0.2316418882f + 1.0f;
    f32x2 t; t.x = __builtin_amdgcn_rcpf(d.x); t.y = __builtin_amdgcn_rcpf(d.y);
    f32x2 q = t * 0.5307027145f + (-0.7265760135f); q = q * t + 0.7107068705f; q = q * t + (-0.142248368f); q = q * t + 0.127414796f; q = q * t;
    const f32x2 s = (v * v) * (-0.72134752044f);
    f32x2 e; e.x = __builtin_amdgcn_exp2f(s.x); e.y = __builtin_amdgcn_exp2f(s.y);
    const f32x2 m = v * (q * e), r = v - m;
    f32x2 o; o.x = v.x < 0.f ? m.x : r.x; o.y = v.y < 0.f ? m.y : r.y; return o;
}
template <int ACT  > struct EpiBf16 {
    static constexpr bool PERM = true, AFTER_DRAIN = false; static_assert(ACT == 0 || ACT == 1, "EpiBf16: ACT is 0 (none) or 1 (gelu_pk)");
    bf16_t* O; int ldc; const float* bias; int split_cols; size_t split_stride; float scale0;
    __device__ __forceinline__ void operator()(const f32x4 (&acc)[2][2][4][2], const Unit& u, int wr, int wc, int fr, int fq) const {
        const int row0 = u.pm * BM + wr * 64 + fr; int colt = u.pn * BM; bf16_t* base = O;
        float sc = 1.f; if (split_cols) { const int t = colt / split_cols; base += (size_t)t * split_stride; colt -= t * split_cols; if (t == 0) sc = scale0; }
        const int col0 = colt + wc * 32 + 8 * fq, bcol0 = u.pn * BM + wc * 32 + 8 * fq;
        f32x4 bv[2][2];
#pragma unroll
        for (int bj = 0; bj < 2; ++bj)
#pragma unroll
            for (int n = 0; n < 2; ++n) bv[bj][n] = bias ? *(const f32x4*)(bias + bcol0 + bj * HALF + 4 * n) : (f32x4){0.f, 0.f, 0.f, 0.f};
#pragma unroll
        for (int ai = 0; ai < 2; ++ai)
#pragma unroll
            for (int m = 0; m < 4; ++m) { bf16_t* rowp = base + (size_t)(row0 + ai * HALF + m * 16) * ldc + col0;
#pragma unroll
                for (int bj = 0; bj < 2; ++bj) { f32x4 v0 = acc[ai][bj][m][0] + bv[bj][0], v1 = acc[ai][bj][m][1] + bv[bj][1];
                    if (ACT == 1) { f32x2 a = gelu_pk((f32x2){v0[0], v0[1]}), b = gelu_pk((f32x2){v0[2], v0[3]}), c = gelu_pk((f32x2){v1[0], v1[1]}), d = gelu_pk((f32x2){v1[2], v1[3]});
                        v0 = (f32x4){a.x, a.y, b.x, b.y}; v1 = (f32x4){c.x, c.y, d.x, d.y}; }
                    v0 = v0 * sc; v1 = v1 * sc; u32x4 w; w.x = cvt_pk_bf16(v0[0], v0[1]); w.y = cvt_pk_bf16(v0[2], v0[3]); w.z = cvt_pk_bf16(v1[0], v1[1]); w.w = cvt_pk_bf16(v1[2], v1[3]);
                    *(u32x4*)(rowp + bj * HALF) = w; } }
    }
};
template <class Epi, class Sched, bool ALIGN_EPI = false, bool SP2 = false>
__device__ __forceinline__ void gemm_phase(PG8_LAS unsigned char* lds, const Gemm g, const Sched& S, const Epi& E) {
    const int tid = threadIdx.x, wid = __builtin_amdgcn_readfirstlane(tid >> 6), lane = tid & 63, wr = wid >> 2, wc = wid & 3, fr = lane & 15, fq = lane >> 4;
    const int K = g.K, nt = K / BK;
    unsigned voffA[2], voffB[2];
#pragma unroll
    for (int i = 0; i < 2; ++i) { int R, C; stage_rc(tid * 16 + i * 8192, R, C); const int Rb = Epi::PERM ? ((R & ~31) + perm32(R & 31)) : R;
        voffA[i] = (unsigned)(R * K + C) * 2u; voffB[i] = (unsigned)(Rb * K + C) * 2u; }
    const size_t kstep = (size_t)(BK * 2);
    const size_t hstep = (size_t)HALF * K * 2;
    const size_t tstep = 2 * hstep;
    const unsigned ldsw = (unsigned)wid * 1024u;
    const int aoff = lds_byte(wr * 64 + fr, fq * 8), boff = lds_byte(wc * 32 + fr, fq * 8);
#define PG8_SA(b, h) (((b) * 2 + (h)) * HTB)
#define PG8_SB(b, h) ((4 + (b) * 2 + (h)) * HTB)
#define PG8_STAGE(bufoff, gbase, voff) do { _Pragma("unroll") for (int _i = 0; _i < 2; ++_i) \
        __builtin_amdgcn_global_load_lds((const unsigned*)((const char*)(gbase) + (voff)[_i]), (PG8_LAS unsigned*)(lds + (bufoff) + ldsw + _i * 8192), 16, 0, 0); } while (0)
#define PG8_LDA(dst, b, h) do { _Pragma("unroll") for (int m = 0; m < 4; ++m) _Pragma("unroll") for (int k = 0; k < 2; ++k) dst[m][k] = *(const PG8_LAS bf16x8*)(lds + PG8_SA(b, h) + aoff + m * 2048 + k * 1024); } while (0)
#define PG8_LDB(dst, b, h) do { _Pragma("unroll") for (int n = 0; n < 2; ++n) _Pragma("unroll") for (int k = 0; k < 2; ++k) dst[n][k] = *(const PG8_LAS bf16x8*)(lds + PG8_SB(b, h) + boff + n * 2048 + k * 1024); } while (0)
#define PG8_MMA(ai, bj, At, Bt) do { __builtin_amdgcn_s_setprio(1); _Pragma("unroll") for (int m = 0; m < 4; ++m) _Pragma("unroll") for (int n = 0; n < 2; ++n) _Pragma("unroll") for (int k = 0; k < 2; ++k) \
        acc[ai][bj][m][n] = __builtin_amdgcn_mfma_f32_16x16x32_bf16(Bt[n][k], At[m][k], acc[ai][bj][m][n], 0, 0, 0); __builtin_amdgcn_s_setprio(0); } while (0)
#define PG8_WAIT_V(n) asm volatile("s_waitcnt vmcnt(" #n ")" ::: "memory")
#define PG8_WAIT_L(n) asm volatile("s_waitcnt lgkmcnt(" #n ")" ::: "memory")
#define PG8_BAR __builtin_amdgcn_s_barrier()
#define PG8_SCHED __builtin_amdgcn_sched_barrier(0)
    Unit cur, nxt; int ui = 0;
    if (!S.next(0, cur)) return;
    f32x4 acc[2][2][4][2];
#pragma unroll
    for (int a = 0; a < 2; ++a)
#pragma unroll
        for (int b = 0; b < 2; ++b)
#pragma unroll
            for (int m = 0; m < 4; ++m)
#pragma unroll
                for (int n = 0; n < 2; ++n) acc[a][b][m][n] = (f32x4){0.f, 0.f, 0.f, 0.f};
    bf16x8 At[4][2], B0[2][2], B1[2][2];
    const char* cA = (const char*)g.A + (size_t)cur.pm * tstep; const char* cB = (const char*)g.Bt + (size_t)cur.pn * tstep;
    S.a_ready(cur);
    if constexpr (SP2) {
        PG8_STAGE(PG8_SB(0, 0), cB, voffB); PG8_STAGE(PG8_SB(0, 1), cB + hstep, voffB); PG8_STAGE(PG8_SA(0, 0), cA, voffA); PG8_STAGE(PG8_SA(0, 1), cA + hstep, voffA);
        if (wr == 1) PG8_BAR;
        PG8_WAIT_V(2); PG8_BAR;
        PG8_STAGE(PG8_SB(1, 0), cB + kstep, voffB); PG8_STAGE(PG8_SA(1, 0), cA + kstep, voffA); PG8_STAGE(PG8_SB(1, 1), cB + hstep + kstep, voffB);
        PG8_WAIT_V(6); PG8_BAR;
    } else {
        PG8_STAGE(PG8_SB(0, 0), cB, voffB); PG8_STAGE(PG8_SA(0, 0), cA, voffA); PG8_STAGE(PG8_SB(0, 1), cB + hstep, voffB); PG8_STAGE(PG8_SA(0, 1), cA + hstep, voffA);
        if (wr == 1) PG8_BAR;
        PG8_WAIT_V(4); PG8_BAR;
        PG8_STAGE(PG8_SB(1, 0), cB + kstep, voffB); PG8_STAGE(PG8_SA(1, 0), cA + kstep, voffA); PG8_STAGE(PG8_SB(1, 1), cB + hstep + kstep, voffB);
        PG8_WAIT_V(6); PG8_BAR;
    }
    for (;;) {
        const bool has_next = S.next(ui + 1, nxt);
        const char* nA = has_next ? (const char*)g.A + (size_t)nxt.pm * tstep : cA; const char* nB = has_next ? (const char*)g.Bt + (size_t)nxt.pn * tstep : cB;
        for (int t = 0; t < nt; t += 2) {
            const bool last = (t == nt - 2);
            const char* a1 = cA + (size_t)(t + 1) * kstep;
            const char* a2 = last ? nA : cA + (size_t)(t + 2) * kstep; const char* b2 = last ? nB : cB + (size_t)(t + 2) * kstep;
            const char* a3 = a2 + kstep; const char* b3 = b2 + kstep;
            if (last && has_next) S.a_ready(nxt);
            if constexpr (SP2) {
            PG8_LDB(B0, 0, 0); PG8_LDB(B1, 0, 1); PG8_SCHED; PG8_LDA(At, 0, 0); PG8_STAGE(PG8_SA(1, 1), a1 + hstep, voffA);
            PG8_WAIT_V(8); PG8_WAIT_L(0); PG8_BAR; PG8_MMA(0, 0, At, B0); PG8_MMA(0, 1, At, B1); PG8_BAR; PG8_SCHED;
            PG8_LDA(At, 0, 1); PG8_STAGE(PG8_SB(0, 0), b2, voffB); PG8_STAGE(PG8_SB(0, 1), b2 + hstep, voffB); PG8_STAGE(PG8_SA(0, 0), a2, voffA);
            PG8_WAIT_V(8); PG8_WAIT_L(0); PG8_BAR; PG8_MMA(1, 0, At, B0); PG8_MMA(1, 1, At, B1); PG8_BAR; PG8_SCHED;
            PG8_LDB(B0, 1, 0); PG8_LDB(B1, 1, 1); PG8_SCHED; PG8_LDA(At, 1, 0); PG8_STAGE(PG8_SA(0, 1), a2 + hstep, voffA);
            PG8_WAIT_V(8); PG8_WAIT_L(0); PG8_BAR; PG8_MMA(0, 0, At, B0); PG8_MMA(0, 1, At, B1); PG8_BAR; PG8_SCHED;
            PG8_LDA(At, 1, 1); PG8_STAGE(PG8_SB(1, 0), b3, voffB); PG8_STAGE(PG8_SB(1, 1), b3 + hstep, voffB); PG8_STAGE(PG8_SA(1, 0), a3, voffA);
            PG8_WAIT_V(8); PG8_WAIT_L(0); PG8_BAR; PG8_MMA(1, 0, At, B0); PG8_MMA(1, 1, At, B1); PG8_BAR; PG8_SCHED;
            } else {
            PG8_LDB(B0, 0, 0); PG8_SCHED; PG8_LDA(At, 0, 0); PG8_STAGE(PG8_SA(1, 1), a1 + hstep, voffA);
            PG8_WAIT_L(8); PG8_BAR; PG8_WAIT_L(0); PG8_MMA(0, 0, At, B0); PG8_BAR; PG8_SCHED;
            PG8_LDB(B1, 0, 1); PG8_STAGE(PG8_SB(0, 0), b2, voffB);
            PG8_BAR; PG8_WAIT_L(0); PG8_MMA(0, 1, At, B1); PG8_BAR;
            PG8_LDA(At, 0, 1); PG8_STAGE(PG8_SA(0, 0), a2, voffA);
            PG8_BAR; PG8_WAIT_L(0); PG8_MMA(1, 0, At, B0); PG8_BAR; PG8_SCHED;
            PG8_STAGE(PG8_SB(0, 1), b2 + hstep, voffB);
            PG8_WAIT_V(6); PG8_BAR; PG8_MMA(1, 1, At, B1); PG8_BAR;
            PG8_LDB(B0, 1, 0); PG8_SCHED; PG8_LDA(At, 1, 0); PG8_STAGE(PG8_SA(0, 1), a2 + hstep, voffA);
            PG8_WAIT_L(8); PG8_BAR; PG8_WAIT_L(0); PG8_MMA(0, 0, At, B0); PG8_BAR; PG8_SCHED;
            PG8_LDB(B1, 1, 1); PG8_STAGE(PG8_SB(1, 0), b3, voffB);
            PG8_BAR; PG8_WAIT_L(0); PG8_MMA(0, 1, At, B1); PG8_BAR;
            PG8_LDA(At, 1, 1); PG8_STAGE(PG8_SA(1, 0), a3, voffA);
            PG8_BAR; PG8_WAIT_L(0); PG8_MMA(1, 0, At, B0); PG8_BAR; PG8_SCHED;
            PG8_STAGE(PG8_SB(1, 1), b3 + hstep, voffB);
            PG8_WAIT_V(6); PG8_BAR; PG8_MMA(1, 1, At, B1); PG8_BAR;
            }
        }
        if constexpr (ALIGN_EPI) { if (wr == 0) PG8_BAR; }
        if constexpr (!Epi::AFTER_DRAIN) { E(acc, cur, wr, wc, fr, fq); S.done(cur); }
        if (!has_next) break;
#pragma unroll
        for (int a = 0; a < 2; ++a)
#pragma unroll
            for (int b = 0; b < 2; ++b)
#pragma unroll
                for (int m = 0; m < 4; ++m)
#pragma unroll
                    for (int n = 0; n < 2; ++n) acc[a][b][m][n] = (f32x4){0.f, 0.f, 0.f, 0.f};
        cur = nxt; cA = nA; cB = nB; ++ui;
        if constexpr (ALIGN_EPI) { if (wr == 1) PG8_BAR; }
    }
    PG8_WAIT_V(0);
    if constexpr (!ALIGN_EPI) { if (wr == 0) PG8_BAR; }
    PG8_BAR;
    if constexpr (Epi::AFTER_DRAIN) { E.fused(acc, cur, wr, wc, fr, fq, lds, wid, lane); S.done(cur); }
#undef PG8_SA
#undef PG8_SB
#undef PG8_STAGE
#undef PG8_LDA
#undef PG8_LDB
#undef PG8_MMA
#undef PG8_WAIT_V
#undef PG8_WAIT_L
#undef PG8_BAR
#undef PG8_SCHED
}
}

#define DI __device__ __forceinline__
typedef pg8::bf16_t bf16_t;
typedef short bf16x8 __attribute__((ext_vector_type(8)));
typedef short s16x4 __attribute__((ext_vector_type(4)));
typedef float f32x4 __attribute__((ext_vector_type(4)));
typedef float f32x16 __attribute__((ext_vector_type(16)));
typedef unsigned u32x4 __attribute__((ext_vector_type(4)));
typedef unsigned u32x2 __attribute__((ext_vector_type(2)));
#define LAS __attribute__((address_space(3)))
typedef float f32x2_t __attribute__((ext_vector_type(2)));

constexpr int DM = 1024, NB = 8, SEQ = 2048, CTXL = 256;
constexpr int NLAT = NB * SEQ, NCTX = NB * CTXL, MALL = NLAT + NCTX;
constexpr int FH = 2816, FH2 = 5632, EIN = 1792, OIN = 1280;
constexpr float NORM_EPS = 1e-6f;
constexpr float C2 = 0.125f * 1.4426950408889634f;
constexpr int NTHREADS = 512, NWAVES = 8;
constexpr int LDS_BYTES = 147456 + 256, LDS_MISC = 147456;
constexpr int NBND_LAT = NB * 31, NBND_CTX = NB * 3;
constexpr int XNE_ROW_L0 = MALL, XNE_ROW_L1 = NLAT;
constexpr int XN_ROWS = MALL + 1280;

constexpr size_t MiB = 1u << 20;
constexpr size_t WS_CTL = 0, CTL_ZERO_BYTES = 64 * 1024;
constexpr size_t WS_MOD = 1 * MiB;
constexpr size_t WS_ROPE = 2 * MiB;
constexpr size_t WS_RGW = 3 * MiB;
constexpr size_t WS_S5AT = 3 * MiB + 512 * 1024;
constexpr size_t WS_RGTOT = 4 * MiB;
constexpr size_t WS_S5M = 7 * MiB, WS_S5E = 23 * MiB, WS_S5F = 31 * MiB;
constexpr size_t WS_WIN0 = 39 * MiB, WS_WOUT0 = 43 * MiB, WS_WUP0 = 45 * MiB, WS_WDN0 = 56 * MiB;
constexpr size_t WS_WIN1 = 62 * MiB, WS_WOUT1 = 65 * MiB, WS_WUP1 = 67 * MiB, WS_WDN1 = 78 * MiB, WS_WGLU = 84 * MiB;
constexpr size_t WS_HC = 85 * MiB;
constexpr size_t WS_XN = 93 * MiB;
constexpr size_t WS_PROJ = 132 * MiB;
constexpr size_t WS_S5L = 177 * MiB;
constexpr size_t WS_MIX = 195 * MiB;
constexpr size_t WS_HID = 132 * MiB;
constexpr size_t WS_S5S = 231 * MiB;
constexpr size_t WS_Z = WS_XN;
constexpr size_t WS_END = 240 * MiB;
static_assert(WS_XN + (size_t)XN_ROWS * DM * 2 <= WS_PROJ, "xn");
static_assert(WS_PROJ + (size_t)MALL * OIN * 2 <= WS_S5L && WS_S5L + (size_t)576 * 32 * 256 * 4 <= WS_MIX, "s5l");
static_assert(WS_HID + (size_t)MALL * FH * 2 <= WS_S5S, "hid");

DI float bf2f(bf16_t v) { return __uint_as_float((unsigned)v << 16); }
DI unsigned f2bf(float f) { unsigned u = __float_as_uint(f); return (u + 0x7fffu + ((u >> 16) & 1u)) >> 16; }
DI unsigned pk2(float lo, float hi) { return f2bf(lo) | (f2bf(hi) << 16); }
DI float wave_sum(float v) {
#pragma unroll
    for (int o = 1; o < 64; o <<= 1) v += __shfl_xor(v, o);
    return v;
}
DI float sigmoidf_(float x) { return 1.f / (1.f + __expf(-x)); }
DI float gelu_tanh(float x) { const float z = 1.5957691216057308f * (x + 0.044715f * x * x * x); return x * sigmoidf_(z); }
DI float siluf_(float x) { return x * sigmoidf_(x); }

struct EpiRes {
    static constexpr bool PERM = false, AFTER_DRAIN = false;
    const float* baseL; const float* baseC; float* outL; float* outC; const float* gate;
    __device__ __forceinline__ void operator()(const f32x4 (&acc)[2][2][4][2], const pg8::Unit& u, int wr, int wc, int fr, int fq) const {
        const bool isc = u.pm >= 64; const int bb = isc ? 8 : (u.pm >> 3);
        const float* base = isc ? baseC + (size_t)(u.pm - 64) * 256 * DM : baseL + (size_t)u.pm * 256 * DM;
        float* out = isc ? outC + (size_t)(u.pm - 64) * 256 * DM : outL + (size_t)u.pm * 256 * DM;
        const float* g = gate + (size_t)bb * 6144;
        const int col0 = u.pn * 256 + wc * 32 + 4 * fq;
#pragma unroll
        for (int bj = 0; bj < 2; ++bj)
#pragma unroll
            for (int n = 0; n < 2; ++n) {
                const int c = col0 + bj * 128 + n * 16; const f32x4 gv = *(const f32x4*)(g + c);
#pragma unroll
                for (int ai = 0; ai < 2; ++ai)
#pragma unroll
                    for (int m = 0; m < 4; ++m) {
                        const size_t off = (size_t)(ai * 128 + wr * 64 + m * 16 + fr) * DM + c;
                        const f32x4 bs = *(const f32x4*)(base + off);
                        *(f32x4*)(out + off) = bs + gv * acc[ai][bj][m][n];
                    }
            }
    }
};

struct EpiConvAct {
    static constexpr bool PERM = true, AFTER_DRAIN = false;
    bf16_t* H; const float* cw; const float* cb; int pm_edge; int nbnd_lat; int nbnd; char* xlds;
    __device__ __forceinline__ void operator()(const f32x4 (&acc)[2][2][4][2], const pg8::Unit& u, int wr_, int wc_, int fr_, int fq_) const {
        int tl = threadIdx.x; asm volatile("" : "+v"(tl));
        const int lane = tl & 63, wid_ = tl >> 6, fr = lane & 15, fq = lane >> 4, wr = wid_ >> 2, wc = wid_ & 3; (void)wr_; (void)wc_; (void)fr_; (void)fq_;
        const bool edge = u.pm >= pm_edge;
        const int hc0 = u.pn * 128 + wc * 32 + 8 * fq;
        f32x2_t* sc = (f32x2_t*)(xlds + wid_ * 2048);
#pragma unroll
        for (int n = 0; n < 2; ++n) {
#pragma unroll
            for (int ai = 0; ai < 2; ++ai) {
                unsigned wd[4][2];
#pragma unroll
                for (int jp = 0; jp < 2; ++jp) {
                    float hvv[2][4][2];
#pragma unroll
                    for (int bj = 0; bj < 2; ++bj) {
                        int oc = bj * FH + hc0 + 4 * n + 2 * jp; asm volatile("" : "+v"(oc) :: "memory");
                        const f32x2_t w0 = *(const f32x2_t*)(cw + oc), w1 = *(const f32x2_t*)(cw + FH2 + oc), w2 = *(const f32x2_t*)(cw + 2 * FH2 + oc), bb = *(const f32x2_t*)(cb + oc);
#pragma unroll
                        for (int m = 0; m < 4; ++m) sc[(16 * m + fr) * 4 + fq] = (f32x2_t){acc[ai][bj][m][n][2 * jp], acc[ai][bj][m][n][2 * jp + 1]};
                        asm volatile("" ::: "memory");
#pragma unroll
                        for (int m = 0; m < 4; ++m) {
                            const int row = 16 * m + fr; const int ru = row > 0 ? row - 1 : 0, rd = row < 63 ? row + 1 : 63;
                            f32x2_t up = sc[ru * 4 + fq], dn = sc[rd * 4 + fq];
                            if (row == 0) up = (f32x2_t){0.f, 0.f}; if (row == 63) dn = (f32x2_t){0.f, 0.f};
                            const f32x2_t ce = (f32x2_t){acc[ai][bj][m][n][2 * jp], acc[ai][bj][m][n][2 * jp + 1]};
                            const f32x2_t hv = bb + w0 * up + w1 * ce + w2 * dn;
                            hvv[bj][m][0] = hv.x; hvv[bj][m][1] = hv.y;
                        }
                        asm volatile("" : "+v"(hvv[bj][0][0]), "+v"(hvv[bj][0][1]), "+v"(hvv[bj][1][0]), "+v"(hvv[bj][1][1]), "+v"(hvv[bj][2][0]), "+v"(hvv[bj][2][1]), "+v"(hvv[bj][3][0]), "+v"(hvv[bj][3][1]) :: "memory");
                    }
#pragma unroll
                    for (int m = 0; m < 4; ++m) wd[m][jp] = pk2(hvv[0][m][0] * siluf_(hvv[1][m][0]), hvv[0][m][1] * siluf_(hvv[1][m][1]));
                    __builtin_amdgcn_sched_barrier(0);
                }
#pragma unroll
                for (int m = 0; m < 4; ++m) {
                    const int R = ai * 128 + wr * 64 + m * 16 + fr;
                    long grow; bool st;
                    if (!edge) {
                        grow = (long)u.pm * 256 + R; st = true;
                        const int r64 = R & 63;
                        if (r64 == 0) st = (R == 0) && (u.pm >= 64 || (u.pm & 7) == 0);
                        if (r64 == 63) st = (R == 255) && (u.pm >= 64 || (u.pm & 7) == 7);
                    } else {
                        const int slot = (u.pm - pm_edge) * 256 + R, q = slot >> 2, pos = slot & 3;
                        st = (pos == 1 || pos == 2) && q < nbnd;
                        int row0;
                        if (q < nbnd_lat) { const int s = q / 31, k = q - s * 31 + 1; row0 = s * SEQ + 64 * k; }
                        else { const int q2 = q - nbnd_lat, s = q2 / 3, k = q2 - s * 3 + 1; row0 = NLAT + s * CTXL + 64 * k; }
                        grow = (long)row0 - 2 + pos;
                    }
                    if (st) { u32x2 w; w.x = wd[m][0]; w.y = wd[m][1]; *(u32x2*)(H + (size_t)grow * FH + hc0 + 4 * n) = w; }
                }
                asm volatile("" ::: "memory"); __builtin_amdgcn_sched_barrier(0);
            }
        }
    }
};

struct EpiGlu {
    static constexpr bool PERM = true, AFTER_DRAIN = false;
    const bf16_t* Z; bf16_t* O; const float* bias;
    __device__ __forceinline__ void operator()(const f32x4 (&acc)[2][2][4][2], const pg8::Unit& u, int wr, int wc, int fr, int fq) const {
        const int row0 = u.pm * 256 + wr * 64 + fr; const int col0 = u.pn * 256 + wc * 32 + 8 * fq;
#pragma unroll
        for (int bj = 0; bj < 2; ++bj) {
            const f32x4 b0 = *(const f32x4*)(bias + col0 + bj * 128), b1 = *(const f32x4*)(bias + col0 + bj * 128 + 4);
#pragma unroll
            for (int ai = 0; ai < 2; ++ai)
#pragma unroll
                for (int m = 0; m < 4; ++m) {
                    const size_t r = (size_t)(row0 + ai * 128 + m * 16);
                    const u32x4 zz = *(const u32x4*)(Z + r * 512 + col0 + bj * 128);
                    const f32x4 v0 = acc[ai][bj][m][0] + b0, v1 = acc[ai][bj][m][1] + b1;
                    float o[8];
#pragma unroll
                    for (int j = 0; j < 4; ++j) {
                        const float z0 = __uint_as_float((j & 1) ? (zz[j >> 1] & 0xffff0000u) : (zz[j >> 1] << 16));
                        const float z1 = __uint_as_float((j & 1) ? (zz[2 + (j >> 1)] & 0xffff0000u) : (zz[2 + (j >> 1)] << 16));
                        o[j] = z0 * sigmoidf_(v0[j]); o[4 + j] = z1 * sigmoidf_(v1[j]);
                    }
                    u32x4 w; w.x = pk2(o[0], o[1]); w.y = pk2(o[2], o[3]); w.z = pk2(o[4], o[5]); w.w = pk2(o[6], o[7]);
                    *(u32x4*)(O + r * DM + col0 + bj * 128) = w;
                }
        }
    }
};
#define GAS __attribute__((address_space(1)))
typedef GAS unsigned gu32;
typedef GAS unsigned long long gu64;
#define RLX_AGENT __ATOMIC_RELAXED, __HIP_MEMORY_SCOPE_AGENT
#define LDS_WAIT() asm volatile("s_waitcnt lgkmcnt(0)" ::: "memory")
#define VM_WAIT() asm volatile("s_waitcnt vmcnt(0)" ::: "memory")
__device__ __forceinline__ unsigned long long rt() { return __builtin_amdgcn_s_memrealtime(); }
#define XB_TMO      128
#define XB_XCNT(j)  (256  + 64 * (j))
#define XB_XSUB(j)  (1280 + 64 * (j))
#define XB_XGEN(j)  (2304 + 64 * (j))
#define XB_TOP      3328
#define XB_TOPGEN   3392
#define XCD_BAR_WORDS 3456
#define XB_SPIN_CAP (1u << 18)

__device__ __forceinline__ unsigned xb_ld(unsigned* p)              { return __hip_atomic_load(p, __ATOMIC_RELAXED, __HIP_MEMORY_SCOPE_AGENT); }
__device__ __forceinline__ unsigned xb_add(unsigned* p, unsigned v) { return __hip_atomic_fetch_add(p, v, __ATOMIC_RELAXED, __HIP_MEMORY_SCOPE_AGENT); }
__device__ __forceinline__ unsigned xb_xcc_id() { return (unsigned)__builtin_amdgcn_s_getreg((3 << 11) | 20) & 0xFu; }
#define XB_SPIN(cond, bar) do { unsigned _sp = 0; while (cond) { __builtin_amdgcn_s_sleep(1); \
    if ((++_sp & 255u) == 0u) { if (xb_ld(&(bar)[XB_TMO])) break; if (_sp > XB_SPIN_CAP) { atomicAdd(&(bar)[XB_TMO], 1u); break; } } } } while (0)

struct XcdBarrier {
    unsigned* bar; unsigned x;
    volatile LAS unsigned* st;
};

__device__ __forceinline__ XcdBarrier xcd_barrier_post(unsigned* bar, volatile LAS unsigned* st) {
    XcdBarrier b; b.bar = bar; b.x = xb_xcc_id(); b.st = st;
    if (threadIdx.x == 0) (void)xb_add(&bar[XB_XCNT(b.x)], 1u);
    return b;
}
__device__ __forceinline__ void xcd_barrier_complete(unsigned* bar, unsigned x, unsigned& nloc, unsigned& nx) {
    const unsigned G = gridDim.x * gridDim.y * gridDim.z;
    unsigned sum, cnt, mine, sp = 0u;
    for (;;) {
        sum = 0u; cnt = 0u; mine = 0u;
#pragma unroll
        for (unsigned j = 0; j < 16; ++j) { const unsigned c = xb_ld(&bar[XB_XCNT(j)]); sum += c; cnt += (c > 0u) ? 1u : 0u; mine = (j == x) ? c : mine; }
        if (sum == G) break;
        __builtin_amdgcn_s_sleep(1);
        if ((++sp & 255u) == 0u) { if (xb_ld(&bar[XB_TMO])) break; if (sp > XB_SPIN_CAP) { atomicAdd(&bar[XB_TMO], 1u); break; } }
    }
    nloc = mine > 0u ? mine : 1u; nx = cnt > 0u ? cnt : 1u;
}

__device__ __forceinline__ void xcd_barrier(const XcdBarrier& b) {
    asm volatile("s_waitcnt vmcnt(0)" ::: "memory");
    __syncthreads();
    if (threadIdx.x == 0) {
        unsigned* bar = b.bar;
        __builtin_amdgcn_s_waitcnt(0);
        unsigned nloc = b.st[0], nx = b.st[1];
        if (nloc == 0u) { xcd_barrier_complete(bar, b.x, nloc, nx); b.st[0] = nloc; b.st[1] = nx; }
        const unsigned old = xb_add(&bar[XB_XSUB(b.x)], 1u);
        const unsigned gen = old / nloc;
        if (old + 1u == (gen + 1u) * nloc) {
            __builtin_amdgcn_fence(__ATOMIC_RELEASE, "agent");
            asm volatile("s_waitcnt vmcnt(0)" ::: "memory");
            const unsigned og = xb_add(&bar[XB_TOP], 1u);
            const unsigned tg = og / nx;
            if (og + 1u == (tg + 1u) * nx) xb_add(&bar[XB_TOPGEN], 1u);
            else XB_SPIN(xb_ld(&bar[XB_TOPGEN]) == tg, bar);
            __builtin_amdgcn_fence(__ATOMIC_ACQUIRE, "agent");
            xb_add(&bar[XB_XGEN(b.x)], 1u);
            asm volatile("s_waitcnt vmcnt(0)" ::: "memory");
        } else {
            XB_SPIN(xb_ld(&bar[XB_XGEN(b.x)]) == gen, bar);
            __builtin_amdgcn_fence(__ATOMIC_ACQUIRE, "agent");
            asm volatile("s_waitcnt vmcnt(0)" ::: "memory");
        }
    }
    __syncthreads();
}

DI s16x4 vtr(const char* p) { typedef short v4i16_t __attribute__((ext_vector_type(4))); return __builtin_bit_cast(s16x4, __builtin_amdgcn_ds_read_tr16_b64_v4i16((LAS v4i16_t*)p)); }
typedef __bf16 bf16x2_t __attribute__((ext_vector_type(2)));
DI unsigned cvtpk(float lo, float hi) { f32x2_t v = {lo, hi}; bf16x2_t b = __builtin_convertvector(v, bf16x2_t); return __builtin_bit_cast(unsigned, b); }
DI int crow(int r, int h) { return (r & 3) + 8 * (r >> 2) + 4 * h; }
#define MFMA32(a, b, c) __builtin_amdgcn_mfma_f32_32x32x16_bf16((a), (b), (c), 0, 0, 0)
constexpr int ATT_BUF = 17408, ATT_KB = 9216;

template <int MODE>
DI void attn_unit(const bf16_t* __restrict__ P, int ld, int qoff, int koff, int voff, bf16_t* __restrict__ O, char* lds, int b, int head, int q0, float sink_l2) {
    const int tid = threadIdx.x, lane = tid & 63, wid = tid >> 6, r32 = lane & 31, hi = lane >> 5;
    const int kvh = head >> 2;
    const int qrow0 = (MODE == 1) ? (NLAT + b * CTXL) : (b * SEQ + q0);
    int lat0 = 0, nlat = 0;
    if (MODE == 0) { lat0 = 0; nlat = SEQ / 64; }
    if (MODE == 2) { const int lo = q0 - 128 < 0 ? 0 : q0 - 128; const int hi_ = q0 + 384 > SEQ ? SEQ : q0 + 384; lat0 = lo; nlat = (hi_ - lo) / 64; }
    const int NT = 4 + nlat;
#define KROW(t) ((t) < 4 ? (NLAT + b * CTXL + 64 * (t)) : (b * SEQ + lat0 + 64 * ((t) - 4)))
    const bf16_t* Qp = P + (size_t)(qrow0 + wid * 32 + r32) * ld + qoff + head * 64 + 8 * hi;
    bf16x8 qr[4];
#pragma unroll
    for (int ks = 0; ks < 4; ++ks) qr[ks] = *(const bf16x8*)(Qp + 16 * ks);
    const int srow = tid >> 3, sch = tid & 7;
    const bf16_t* kg = P + koff + kvh * 64 + sch * 8; const bf16_t* vg = P + voff + kvh * 64 + sch * 8;
    const int kw = srow * 144 + sch * 16, vw = ATT_KB + (sch >> 2) * 4096 + srow * 64 + (sch & 3) * 16;
    const int kr_off = r32 * 144 + 16 * hi;
    const int vr_off = ATT_KB + ((lane >> 4) & 1) * 32 + (lane & 3) * 8 + (4 * hi + ((lane & 15) >> 2)) * 64;
    u32x4 kreg, vreg;
    { const size_t r = (size_t)(KROW(0) + srow) * ld; kreg = *(const u32x4*)(kg + r); vreg = *(const u32x4*)(vg + r); }
    *(u32x4*)(lds + kw) = kreg; *(u32x4*)(lds + vw) = vreg;
    if (NT > 1) { const size_t r = (size_t)(KROW(1) + srow) * ld; kreg = *(const u32x4*)(kg + r); vreg = *(const u32x4*)(vg + r); }
    float m = -1e30f, l = 0.f; f32x16 o0 = {}, o1 = {};
    const int qpos = q0 + wid * 32 + r32;
    __syncthreads();
    for (int t = 0; t < NT; ++t) {
        const char* buf = lds + (t & 1) * ATT_BUF;
        bool need = true; int kpos0 = 0;
        if (MODE == 2 && t >= 4) { kpos0 = lat0 + 64 * (t - 4); const int ql = q0 + wid * 32; need = (kpos0 <= ql + 31 + 128) && (kpos0 + 63 >= ql - 128); }
        if (need) {
            f32x16 p0 = {}, p1 = {};
#pragma unroll
            for (int ks = 0; ks < 4; ++ks) {
                const bf16x8 k0 = *(const bf16x8*)(buf + kr_off + ks * 32), k1 = *(const bf16x8*)(buf + kr_off + 32 * 144 + ks * 32);
                p0 = MFMA32(k0, qr[ks], p0); p1 = MFMA32(k1, qr[ks], p1);
            }
            if (MODE == 2 && t >= 4) {
#pragma unroll
                for (int i = 0; i < 16; ++i) { const int kp = kpos0 + crow(i, hi); int d0 = qpos - kp; d0 = d0 < 0 ? -d0 : d0; int d1 = qpos - kp - 32; d1 = d1 < 0 ? -d1 : d1;
                    if (d0 > 128) p0[i] = -1e30f; if (d1 > 128) p1[i] = -1e30f; }
            }
            float mx = p0[0];
#pragma unroll
            for (int i = 1; i < 16; ++i) mx = fmaxf(mx, p0[i]);
#pragma unroll
            for (int i = 0; i < 16; ++i) mx = fmaxf(mx, p1[i]);
            mx = fmaxf(mx, __shfl_xor(mx, 32));
            const float mnew = fmaxf(m, mx); const float alpha = __builtin_amdgcn_exp2f(m - mnew); m = mnew;
            float rs = 0.f;
#pragma unroll
            for (int i = 0; i < 16; ++i) { p0[i] = __builtin_amdgcn_exp2f(p0[i] - m); rs += p0[i]; }
#pragma unroll
            for (int i = 0; i < 16; ++i) { p1[i] = __builtin_amdgcn_exp2f(p1[i] - m); rs += p1[i]; }
            l = l * alpha + rs;
#pragma unroll
            for (int i = 0; i < 16; ++i) { o0[i] *= alpha; o1[i] *= alpha; }
#pragma unroll
            for (int s = 0; s < 4; ++s) {
                u32x4 pw;
                if (s < 2) { pw[0] = cvtpk(p0[8 * (s & 1)], p0[8 * (s & 1) + 1]); pw[1] = cvtpk(p0[8 * (s & 1) + 2], p0[8 * (s & 1) + 3]); pw[2] = cvtpk(p0[8 * (s & 1) + 4], p0[8 * (s & 1) + 5]); pw[3] = cvtpk(p0[8 * (s & 1) + 6], p0[8 * (s & 1) + 7]); }
                else { pw[0] = cvtpk(p1[8 * (s & 1)], p1[8 * (s & 1) + 1]); pw[1] = cvtpk(p1[8 * (s & 1) + 2], p1[8 * (s & 1) + 3]); pw[2] = cvtpk(p1[8 * (s & 1) + 4], p1[8 * (s & 1) + 5]); pw[3] = cvtpk(p1[8 * (s & 1) + 6], p1[8 * (s & 1) + 7]); }
                const bf16x8 pb = __builtin_bit_cast(bf16x8, pw);
                const char* vb = buf + vr_off + s * 1024;
                const s16x4 a0 = vtr(vb), a1 = vtr(vb + 512), c0 = vtr(vb + 4096), c1 = vtr(vb + 4096 + 512);
                const bf16x8 va0 = (bf16x8){a0[0], a0[1], a0[2], a0[3], a1[0], a1[1], a1[2], a1[3]};
                const bf16x8 va1 = (bf16x8){c0[0], c0[1], c0[2], c0[3], c1[0], c1[1], c1[2], c1[3]};
                o0 = MFMA32(va0, pb, o0); o1 = MFMA32(va1, pb, o1);
            }
        }
        if (t + 1 < NT) {
            char* nb = lds + ((t + 1) & 1) * ATT_BUF;
            *(u32x4*)(nb + kw) = kreg; *(u32x4*)(nb + vw) = vreg;
            if (t + 2 < NT) { const size_t r = (size_t)(KROW(t + 2) + srow) * ld; kreg = *(const u32x4*)(kg + r); vreg = *(const u32x4*)(vg + r); }
        }
        __syncthreads();
    }
#undef KROW
    l += __shfl_xor(l, 32);
    if (MODE == 2) l += __builtin_amdgcn_exp2f(sink_l2 - m);
    const float inv = 1.f / l;
    bf16_t* Op = O + (size_t)(qrow0 + wid * 32 + r32) * DM + 512 + head * 64 + 4 * hi;
#pragma unroll
    for (int k = 0; k < 4; ++k) {
        u32x2 w0, w1;
        w0.x = pk2(o0[4 * k] * inv, o0[4 * k + 1] * inv); w0.y = pk2(o0[4 * k + 2] * inv, o0[4 * k + 3] * inv);
        w1.x = pk2(o1[4 * k] * inv, o1[4 * k + 1] * inv); w1.y = pk2(o1[4 * k + 2] * inv, o1[4 * k + 3] * inv);
        *(u32x2*)(Op + 8 * k) = w0; *(u32x2*)(Op + 32 + 8 * k) = w1;
    }
}

constexpr int RG_XA = 0, RG_XF = 9216, RG_GT = RG_XF + 64 * 65 * 4  , RG_SEG = RG_GT + 4 * 64 * 65 * 4  , RG_CAR = RG_SEG + 2 * 64 * 4 * 8  ;
template <int PASS>
DI void rg_item(const float* const* in, unsigned char* ws, char* lds, int item) {
    const int tid = threadIdx.x, lane = tid & 63, wid = tid >> 6;
    const int ci = item % 36, bh = item / 36, head = bh & 7, b = bh >> 3;
    const bf16_t* PROJ = (const bf16_t*)(ws + WS_PROJ);
    const int seqbase = ci < 4 ? NLAT + b * CTXL : b * SEQ, t0 = ci < 4 ? ci * 64 : (ci - 4) * 64, slen = ci < 4 ? CTXL : SEQ;
    bf16_t* XA = (bf16_t*)(lds + RG_XA); float* XF = (float*)(lds + RG_XF); float* GT = (float*)(lds + RG_GT); float* SEGL = (float*)(lds + RG_SEG); float* CAR = (float*)(lds + RG_CAR);
    float* TOT = (float*)(ws + WS_RGTOT);
    const int sdir = tid >> 8, sch = (tid >> 2) & 63, sseg = tid & 3;
    if (PASS == 2) {
        const int pos = sdir == 0 ? ci : (ci < 4 ? 3 - ci : 4 + (35 - ci));
        float pp[9], hh[9];
#pragma unroll
        for (int i = 0; i < 9; ++i) {
            const int k = sseg * 9 + i;
            const int ck = sdir == 0 ? k : (k < 4 ? 3 - k : 35 - (k - 4));
            if (k < pos) { const float* tp = TOT + ((size_t)((sdir * NB + b) * 36 + ck) * 2) * 512 + head * 64 + sch; pp[i] = tp[0]; hh[i] = tp[512]; }
            else { pp[i] = 1.f; hh[i] = 0.f; }
        }
        float Pc = 1.f, Hc = 0.f;
#pragma unroll
        for (int i = 0; i < 9; ++i) { Hc = pp[i] * Hc + hh[i]; Pc *= pp[i]; }
        SEGL[((sdir * 64 + sch) * 4 + sseg) * 2] = Pc; SEGL[((sdir * 64 + sch) * 4 + sseg) * 2 + 1] = Hc;
    }
    {
        const int tok = tid >> 3, cg8 = tid & 7, ch0 = head * 64 + cg8 * 8;
        const float* cw = in[13]; const float* cb = in[14];
        float x[8];
#pragma unroll
        for (int c = 0; c < 8; ++c) x[c] = cb[ch0 + c];
#pragma unroll
        for (int j = 0; j < 4; ++j) {
            const int tt = t0 + tok + j - 1;
            if (tt >= 0 && tt < slen) {
                const u32x4 uu = *(const u32x4*)(PROJ + (size_t)(seqbase + tt) * EIN + ch0);
#pragma unroll
                for (int c = 0; c < 8; ++c) { const float uv = __uint_as_float((c & 1) ? (uu[c >> 1] & 0xffff0000u) : (uu[c >> 1] << 16)); x[c] += cw[j * 512 + ch0 + c] * uv; }
            }
        }
        u32x4 w; w.x = pk2(x[0], x[1]); w.y = pk2(x[2], x[3]); w.z = pk2(x[4], x[5]); w.w = pk2(x[6], x[7]);
        *(u32x4*)(XA + tok * 72 + cg8 * 8) = w;
#pragma unroll
        for (int c = 0; c < 8; ++c) XF[tok * 65 + cg8 * 8 + c] = x[c];
    }
    __syncthreads();
    if (PASS == 2) {
        if (tid < 128) { const int d = tid >> 6, ch = tid & 63; float Hc = 0.f;
#pragma unroll
            for (int s = 0; s < 4; ++s) { const float p = SEGL[((d * 64 + ch) * 4 + s) * 2], h = SEGL[((d * 64 + ch) * 4 + s) * 2 + 1]; Hc = p * Hc + h; }
            CAR[d * 64 + ch] = Hc; }
    }
    {
        const int mi = wid & 3, th = wid >> 2, r32 = lane & 31, hi = lane >> 5;
        const bf16_t* W = (const bf16_t*)(ws + WS_RGW) + (size_t)(mi * 8 + head) * 4096;
        const float* bias = (mi & 1) ? in[18] : in[16]; const int dirm = mi >> 1;
#pragma unroll
        for (int nt = 0; nt < 2; ++nt) {
            f32x16 acc = {};
#pragma unroll
            for (int ks = 0; ks < 4; ++ks) {
                const bf16x8 a = *(const bf16x8*)(XA + (32 * th + r32) * 72 + 16 * ks + 8 * hi);
                const bf16x8 bfr = *(const bf16x8*)(W + (32 * nt + r32) * 64 + 16 * ks + 8 * hi);
                acc = MFMA32(a, bfr, acc);
            }
            const float bv = bias[dirm * 512 + head * 64 + 32 * nt + r32];
#pragma unroll
            for (int i = 0; i < 16; ++i) GT[(mi * 64 + 32 * th + crow(i, hi)) * 65 + 32 * nt + r32] = sigmoidf_(acc[i] + bv);
        }
    }
    __syncthreads();
    float av[16], bvv[16];
    {
        const float lam = in[19][sdir * 512 + head * 64 + sch];
        const float nl = -lam; const float sp = nl > 20.f ? nl : log1pf(__expf(nl));
        float hh = 0.f, PP = 1.f;
#pragma unroll
        for (int s = 0; s < 16; ++s) {
            const int k = 16 * sseg + s, tok = sdir == 0 ? k : 63 - k;
            const float r = GT[((2 * sdir) * 64 + tok) * 65 + sch], ig = GT[((2 * sdir + 1) * 64 + tok) * 65 + sch], x = XF[tok * 65 + sch];
            const float la = -8.f * r * sp; const float a = __expf(la); const float bb = __builtin_amdgcn_sqrtf(fmaxf(1.f - a * a, 0.f)) * (ig * x);
            av[s] = a; bvv[s] = bb; hh = a * hh + bb; PP *= a;
        }
        __syncthreads();
        SEGL[((sdir * 64 + sch) * 4 + sseg) * 2] = PP; SEGL[((sdir * 64 + sch) * 4 + sseg) * 2 + 1] = hh;
    }
    __syncthreads();
    {
        float c = (PASS == 2) ? CAR[sdir * 64 + sch] : 0.f; float Pt = 1.f;
        for (int s = 0; s < 4; ++s) { const float p = SEGL[((sdir * 64 + sch) * 4 + s) * 2], h = SEGL[((sdir * 64 + sch) * 4 + s) * 2 + 1];
            if (s < sseg) c = p * c + h;
            if (PASS == 1) { Pt *= p; if (s >= sseg && sseg == 0) {   } } }
        if (PASS == 1) {
            if (sseg == 3) {
                const float p3 = SEGL[((sdir * 64 + sch) * 4 + 3) * 2], h3 = SEGL[((sdir * 64 + sch) * 4 + 3) * 2 + 1];
                float* tp = TOT + ((size_t)((sdir * NB + b) * 36 + ci) * 2) * 512 + head * 64 + sch;
                tp[0] = Pt; tp[512] = p3 * c + h3;
            }
        } else {
            float h = c;
#pragma unroll
            for (int s = 0; s < 16; ++s) { const int k = 16 * sseg + s, tok = sdir == 0 ? k : 63 - k; h = av[s] * h + bvv[s]; GT[(sdir * 64 + tok) * 65 + sch] = h; }
        }
    }
    if (PASS == 2) {
        __syncthreads();
        const int tok = tid >> 3, cg8 = tid & 7, ch0 = head * 64 + cg8 * 8;
        const size_t row = (size_t)(seqbase + t0 + tok);
        const u32x4 gg = *(const u32x4*)(PROJ + row * EIN + 512 + ch0);
        float o[8];
#pragma unroll
        for (int c = 0; c < 8; ++c) { const float gt = __uint_as_float((c & 1) ? (gg[c >> 1] & 0xffff0000u) : (gg[c >> 1] << 16));
            const float y = GT[tok * 65 + cg8 * 8 + c] + GT[(64 + tok) * 65 + cg8 * 8 + c]; o[c] = y * gelu_tanh(gt); }
        u32x4 w; w.x = pk2(o[0], o[1]); w.y = pk2(o[2], o[3]); w.z = pk2(o[4], o[5]); w.w = pk2(o[6], o[7]);
        *(u32x4*)((bf16_t*)(ws + WS_MIX) + row * DM + ch0) = w;
    }
    __syncthreads();
}

DI void s5_pre_item(const float* const* in, unsigned char* ws, char* lds, int item) {
    const int tid = threadIdx.x; const int g = item >> 2, qq = item & 3;
    float* AP = (float*)lds;
    float* BB = AP + 2 * 33 * 64 * 2;
    float* CC = BB + 2 * 64 * 16 * 2;
    float* KT = CC + 2 * 16 * 64 * 2;
    const float* lam_re = in[24]; const float* lam_im = in[25]; const float* lstep = in[26];
    for (int e = tid; e < 2 * 33 * 64; e += NTHREADS) { const int p = e & 63, j = (e >> 6) % 33, d = e / (64 * 33);
        const float dt = __expf(lstep[d * 32 + g]); const float lr = lam_re[(d * 32 + g) * 64 + p], li = lam_im[(d * 32 + g) * 64 + p];
        const float mag = expf((float)j * lr * dt), ang = (float)j * li * dt; AP[e * 2] = mag * cosf(ang); AP[e * 2 + 1] = mag * sinf(ang); }
    for (int e = tid; e < 2 * 64 * 16; e += NTHREADS) { const int h = e & 15, p = (e >> 4) & 63, d = e >> 10;
        const float dt = __expf(lstep[d * 32 + g]); const float lr = lam_re[(d * 32 + g) * 64 + p], li = lam_im[(d * 32 + g) * 64 + p];
        const float mag = expf(lr * dt), ang = li * dt; const float abr = mag * cosf(ang), abi = mag * sinf(ang);
        const float den = lr * lr + li * li, nr = abr - 1.f, ni = abi; const float kr = (nr * lr + ni * li) / den, ki = (ni * lr - nr * li) / den;
        const float br = in[27][((size_t)(d * 32 + g) * 64 + p) * 16 + h], bi = in[28][((size_t)(d * 32 + g) * 64 + p) * 16 + h];
        BB[e * 2] = kr * br - ki * bi; BB[e * 2 + 1] = kr * bi + ki * br; }
    for (int e = tid; e < 2 * 16 * 64; e += NTHREADS) { const int p = e & 63, h = (e >> 6) & 15, d = e >> 10;
        CC[e * 2] = in[29][((size_t)(d * 32 + g) * 16 + h) * 64 + p]; CC[e * 2 + 1] = in[30][((size_t)(d * 32 + g) * 16 + h) * 64 + p]; }
    __syncthreads();
    for (int e = tid; e < 2 * 32 * 256; e += NTHREADS) { const int hi = e & 15, ho = (e >> 4) & 15, j = (e >> 8) & 31, d = e >> 13; float s = 0.f;
        for (int p = 0; p < 64; ++p) { const float ar = AP[((d * 33 + j) * 64 + p) * 2], ai = AP[((d * 33 + j) * 64 + p) * 2 + 1];
            const float cr = CC[((d * 16 + ho) * 64 + p) * 2], ci = CC[((d * 16 + ho) * 64 + p) * 2 + 1];
            const float br = BB[((d * 64 + p) * 16 + hi) * 2], bi = BB[((d * 64 + p) * 16 + hi) * 2 + 1];
            const float xr = cr * ar - ci * ai, xi = cr * ai + ci * ar; s += xr * br - xi * bi; }
        KT[e] = s; }
    __syncthreads();
    bf16_t* Mg = (bf16_t*)(ws + WS_S5M) + (size_t)g * 512 * 512; bf16_t* Eg = (bf16_t*)(ws + WS_S5E) + (size_t)g * 256 * 512; bf16_t* Fg = (bf16_t*)(ws + WS_S5F) + (size_t)g * 512 * 256;
    const float* dsk = in[31];
    for (int e = tid; e < 128 * 512; e += NTHREADS) { const int k = e & 511, mr = e >> 9, m = qq * 128 + mr; const int t = m >> 4, ho = m & 15, tau = k >> 4, hi = k & 15;
        float v = 0.f; if (tau <= t) v += KT[(0 * 32 + (t - tau)) * 256 + ho * 16 + hi]; if (tau >= t) v += KT[(1 * 32 + (tau - t)) * 256 + ho * 16 + hi];
        if (tau == t && ho == hi) v += dsk[g * 16 + ho];
        Mg[(size_t)m * 512 + k] = (bf16_t)f2bf(v); }
    { const int d = qq >> 1, c = qq & 1;
      for (int e = tid; e < 64 * 512; e += NTHREADS) { const int k = e & 511, p = e >> 9, tau = k >> 4, hi = k & 15; const int j = d == 0 ? 31 - tau : tau;
          const float ar = AP[((d * 33 + j) * 64 + p) * 2], ai = AP[((d * 33 + j) * 64 + p) * 2 + 1]; const float br = BB[((d * 64 + p) * 16 + hi) * 2], bi = BB[((d * 64 + p) * 16 + hi) * 2 + 1];
          const float v = c ? (ar * bi + ai * br) : (ar * br - ai * bi);
          Eg[(size_t)(qq * 64 + p) * 512 + k] = (bf16_t)f2bf(v); } }
    for (int e = tid; e < 128 * 256; e += NTHREADS) { const int k = e & 255, mr = e >> 8, m = qq * 128 + mr, t = m >> 4, ho = m & 15; const int d = k >> 7, c = (k >> 6) & 1, p = k & 63;
        const int j = d == 0 ? t + 1 : 32 - t;
        const float ar = AP[((d * 33 + j) * 64 + p) * 2], ai = AP[((d * 33 + j) * 64 + p) * 2 + 1]; const float cr = CC[((d * 16 + ho) * 64 + p) * 2], ci = CC[((d * 16 + ho) * 64 + p) * 2 + 1];
        const float v = c ? -(cr * ai + ci * ar) : (cr * ar - ci * ai);
        Fg[(size_t)m * 256 + k] = (bf16_t)f2bf(v); }
    if (qq == 0) for (int e = tid; e < 2 * 64; e += NTHREADS) { const int p = e & 63, d = e >> 6; float* at = (float*)(ws + WS_S5AT) + ((size_t)(d * 32 + g) * 64 + p) * 2;
        at[0] = AP[((d * 33 + 32) * 64 + p) * 2]; at[1] = AP[((d * 33 + 32) * 64 + p) * 2 + 1]; }
    __syncthreads();
}
DI int s5_chunk_row(int n72) { const int b = n72 / 72, cc = n72 - b * 72; return cc < 8 ? NLAT + b * CTXL + 32 * cc : b * SEQ + 32 * (cc - 8); }
DI void s5_L_item(unsigned char* ws, int witem) {
    const int lane = threadIdx.x & 63, r32 = lane & 31, hi = lane >> 5;
    const int mq = witem & 1, nt = (witem >> 1) % 18, g = witem / 36;
    const bf16_t* PROJ = (const bf16_t*)(ws + WS_PROJ); const bf16_t* Eg = (const bf16_t*)(ws + WS_S5E) + (size_t)g * 256 * 512;
    const int n = nt * 32 + r32; const bf16_t* up = PROJ + (size_t)s5_chunk_row(n) * OIN + g * 16 + 8 * hi;
    const bf16_t* ap = Eg + (size_t)(mq * 128 + r32) * 512 + 8 * hi;
    f32x16 acc[4] = {};
#pragma unroll 4
    for (int ks = 0; ks < 32; ++ks) {
        const bf16x8 bfr = *(const bf16x8*)(up + (size_t)ks * OIN);
#pragma unroll
        for (int mt = 0; mt < 4; ++mt) { const bf16x8 a = *(const bf16x8*)(ap + (size_t)mt * 32 * 512 + 16 * ks); acc[mt] = MFMA32(a, bfr, acc[mt]); }
    }
    float* L = (float*)(ws + WS_S5L) + ((size_t)n * 32 + g) * 256 + mq * 128;
#pragma unroll
    for (int mt = 0; mt < 4; ++mt)
#pragma unroll
        for (int k = 0; k < 4; ++k) *(f32x4*)(L + mt * 32 + 8 * k + 4 * hi) = (f32x4){acc[mt][4 * k], acc[mt][4 * k + 1], acc[mt][4 * k + 2], acc[mt][4 * k + 3]};
}
DI void s5_scan_thread(unsigned char* ws, int gid) {
    const int p = gid & 63, d = (gid >> 6) & 1, g = (gid >> 7) & 31, b = gid >> 12;
    const float* at = (const float*)(ws + WS_S5AT) + ((size_t)(d * 32 + g) * 64 + p) * 2; const float ar = at[0], ai = at[1];
    const float* L = (const float*)(ws + WS_S5L); bf16_t* S = (bf16_t*)(ws + WS_S5S);
    float sr = 0.f, si = 0.f;
#pragma unroll 8
    for (int k = 0; k < 72; ++k) {
        const int cc = d == 0 ? k : (k < 8 ? 7 - k : 71 - (k - 8));
        const size_t lo = ((size_t)(b * 72 + cc) * 32 + g) * 256 + d * 128 + p;
        const float lr = L[lo], li = L[lo + 64];
        if (cc >= 8) { const size_t so = ((size_t)(b * 64 + cc - 8) * 32 + g) * 256 + d * 128 + p; S[so] = (bf16_t)f2bf(sr); S[so + 64] = (bf16_t)f2bf(si); }
        const float nr = ar * sr - ai * si + lr, ni = ar * si + ai * sr + li; sr = nr; si = ni;
    }
}
DI void s5_Y_item(unsigned char* ws, int witem) {
    const int lane = threadIdx.x & 63, r32 = lane & 31, hi = lane >> 5;
    const int mq = witem & 3, nt = (witem >> 2) & 15, g = witem >> 6;
    const bf16_t* PROJ = (const bf16_t*)(ws + WS_PROJ);
    const bf16_t* Mg = (const bf16_t*)(ws + WS_S5M) + (size_t)g * 512 * 512; const bf16_t* Fg = (const bf16_t*)(ws + WS_S5F) + (size_t)g * 512 * 256;
    const int n = nt * 32 + r32; const int row0 = (n >> 6) * SEQ + (n & 63) * 32;
    const bf16_t* up = PROJ + (size_t)row0 * OIN + g * 16 + 8 * hi;
    const bf16_t* sp = (const bf16_t*)(ws + WS_S5S) + ((size_t)n * 32 + g) * 256 + 8 * hi;
    const bf16_t* ap = Mg + (size_t)(mq * 128 + r32) * 512 + 8 * hi; const bf16_t* fp = Fg + (size_t)(mq * 128 + r32) * 256 + 8 * hi;
    f32x16 acc[4] = {};
#pragma unroll 4
    for (int ks = 0; ks < 32; ++ks) {
        const bf16x8 bfr = *(const bf16x8*)(up + (size_t)ks * OIN);
#pragma unroll
        for (int mt = 0; mt < 4; ++mt) { const bf16x8 a = *(const bf16x8*)(ap + (size_t)mt * 32 * 512 + 16 * ks); acc[mt] = MFMA32(a, bfr, acc[mt]); }
    }
#pragma unroll 4
    for (int ks = 0; ks < 16; ++ks) {
        const bf16x8 bfr = *(const bf16x8*)(sp + 16 * ks);
#pragma unroll
        for (int mt = 0; mt < 4; ++mt) { const bf16x8 a = *(const bf16x8*)(fp + (size_t)mt * 32 * 256 + 16 * ks); acc[mt] = MFMA32(a, bfr, acc[mt]); }
    }
    bf16_t* Z = (bf16_t*)(ws + WS_Z);
#pragma unroll
    for (int mt = 0; mt < 4; ++mt)
#pragma unroll
        for (int k = 0; k < 4; ++k) { const int m = mq * 128 + mt * 32 + 8 * k + 4 * hi, t = m >> 4, ho = m & 15;
            u32x2 w; w.x = pk2(gelu_tanh(acc[mt][4 * k]), gelu_tanh(acc[mt][4 * k + 1])); w.y = pk2(gelu_tanh(acc[mt][4 * k + 2]), gelu_tanh(acc[mt][4 * k + 3]));
            *(u32x2*)(Z + (size_t)(row0 + t) * 512 + g * 16 + ho) = w; }
}

DI int up_row_map(int n) { return n < FH ? (n >> 7) * 256 + (n & 127) : ((n - FH) >> 7) * 256 + 128 + ((n - FH) & 127); }
DI void p0_transpose_item(const float* W, int K, int N, bf16_t* WT, bool upmap, float* scr, int item, int lane) {
    const int nblk = N / 32, kb = item / nblk, nb = item % nblk, k0 = 64 * kb, n0 = 32 * nb;
#pragma unroll 8
    for (int i = 0; i < 32; ++i) { const int kk = 2 * i + (lane >> 5); scr[kk * 33 + (lane & 31)] = W[(size_t)(k0 + kk) * N + n0 + (lane & 31)]; }
    asm volatile("s_waitcnt lgkmcnt(0)" ::: "memory");
    const int c = lane & 7;
#pragma unroll
    for (int j = 0; j < 4; ++j) { const int n = (lane >> 3) + 8 * j; const float* s = scr + (8 * c) * 33 + n;
        u32x4 o; o.x = pk2(s[0 * 33], s[1 * 33]); o.y = pk2(s[2 * 33], s[3 * 33]); o.z = pk2(s[4 * 33], s[5 * 33]); o.w = pk2(s[6 * 33], s[7 * 33]);
        const int nr = upmap ? up_row_map(n0 + n) : n0 + n;
        *(u32x4*)(WT + (size_t)nr * K + k0 + 8 * c) = o; }
    asm volatile("s_waitcnt lgkmcnt(0)" ::: "memory");
}
DI void norm_row(const float* xrow, const float* g, const float* shift, const float* scale, bf16_t* o1, bf16_t* o2, int lane) {
    f32x4 v[4]; float s = 0.f;
#pragma unroll
    for (int j = 0; j < 4; ++j) { v[j] = *((const f32x4*)xrow + lane + 64 * j); s += (v[j].x * v[j].x + v[j].y * v[j].y) + (v[j].z * v[j].z + v[j].w * v[j].w); }
    const float rstd = rsqrtf(wave_sum(s) * (1.f / DM) + NORM_EPS);
#pragma unroll
    for (int j = 0; j < 4; ++j) {
        const f32x4 gg = *((const f32x4*)g + lane + 64 * j), sh = *((const f32x4*)shift + lane + 64 * j), sc = *((const f32x4*)scale + lane + 64 * j);
        const f32x4 y = (v[j] * rstd) * gg * (sc + 1.0f) + sh;
        u32x2 w; w.x = pk2(y.x, y.y); w.y = pk2(y.z, y.w);
        *((u32x2*)o1 + lane + 64 * j) = w; if (o2) *((u32x2*)o2 + lane + 64 * j) = w;
    }
}
DI void norm_phase(const float* hL, const float* hC, const float* g, const float* mod, int ish, int isc, bf16_t* XN, int nrows, int xne_row, int gw, int NGW, int lane) {
    for (int r = gw; r < nrows; r += NGW) {
        const bool isctx = r >= NLAT; const int bb = isctx ? 8 : r >> 11;
        const float* x = isctx ? hC + (size_t)(r - NLAT) * DM : hL + (size_t)r * DM;
        bf16_t* o2 = nullptr;
        if (xne_row >= 0) {
            const int t = isctx ? (r - NLAT) & 255 : r & 2047, slen = isctx ? CTXL : SEQ, s = isctx ? (r - NLAT) >> 8 : r >> 11;
            const int k = (t + 2) >> 6, pos = (t + 2) & 63;
            if (pos < 4 && k >= 1 && k <= slen / 64 - 1) { const int q = isctx ? NBND_LAT + s * 3 + (k - 1) : s * 31 + (k - 1); o2 = XN + (size_t)(xne_row + 4 * q + pos) * DM; }
        }
        norm_row(x, g, mod + (size_t)bb * 6144 + ish * 1024, mod + (size_t)bb * 6144 + isc * 1024, XN + (size_t)r * DM, o2, lane);
    }
}
DI void qknorm_phase(bf16_t* PROJ, int ld, int qoff, const float* qn, const float* kn, const float* rope, int gw, int NGW, int lane) {
    const float gq = qn[lane], gk = kn[lane];
    const int ridx = (lane >> 5) * 16 + (lane & 15); const bool second = (lane >> 4) & 1;
    for (int r = gw; r < MALL; r += NGW) {
        bf16_t* p = PROJ + (size_t)r * ld + qoff + lane;
        const bool lat = r < NLAT; float cs = 1.f, sn = 0.f;
        if (lat) { const int t = r & 2047; cs = rope[t * 32 + ridx]; sn = rope[SEQ * 32 + t * 32 + ridx]; }
        float v[10];
#pragma unroll
        for (int h = 0; h < 10; ++h) v[h] = bf2f(p[h * 64]);
#pragma unroll
        for (int h = 0; h < 10; ++h) {
            const float ss = wave_sum(v[h] * v[h]); float y = v[h] * rsqrtf(ss * (1.f / 64.f) + NORM_EPS) * (h < 8 ? gq : gk);
            const float yp = __shfl_xor(y, 16);
            if (lat) y = second ? (y * cs + yp * sn) : (y * cs - yp * sn);
            if (h < 8) y *= C2;
            p[h * 64] = (bf16_t)f2bf(y);
        }
    }
}

struct Args { const float* in[37]; float* out; unsigned char* ws; int ph_lo, ph_hi; };
constexpr int NPHASE = 19;

DI void p0_prologue(const Args& a, char* lds, int G) {
    const int tid = threadIdx.x, lane = tid & 63, wid = tid >> 6;
    unsigned char* ws = a.ws;
    const int gw = blockIdx.x * NWAVES + wid, NGW = G * NWAVES;
    {
        const int gt = blockIdx.x * NTHREADS + tid, NGT = G * NTHREADS;
        float* rope = (float*)(ws + WS_ROPE);
        for (int e = gt; e < SEQ * 32; e += NGT) { const int t = e >> 5, idx = e & 31, i = idx & 15; const float pos = (float)((idx < 16) ? (t >> 6) : (t & 63));
            const float invf = powf(10000.0f, -(float)i / 16.0f); const float ang = pos * invf; rope[e] = cosf(ang); rope[SEQ * 32 + e] = sinf(ang); }
        bf16_t* rgw = (bf16_t*)(ws + WS_RGW);
        for (int e = gt; e < 4 * 8 * 4096; e += NGT) { const int k = e & 63, n = (e >> 6) & 63, hd = (e >> 12) & 7, mi = e >> 15; const int d = mi >> 1;
            const float* w = (mi & 1) ? a.in[17] : a.in[15]; rgw[e] = (bf16_t)f2bf(w[((size_t)(d * 8 + hd) * 64 + k) * 64 + n]); }
    }
    __syncthreads();
    {
        float* cond = (float*)lds;
        float* red = (float*)(lds + 1024 * 12 * 4);
        if (G < 256 || blockIdx.x >= 128) for (int e = tid; e < 9 * 1024; e += NTHREADS) { const int k = e & 1023, bb = e >> 10; const float cv = bb < 8 ? a.in[1][bb * 1024 + k] : a.in[3][k]; cond[k * 12 + bb] = siluf_(cv); }
        __syncthreads();
        float* MOD = (float*)(ws + WS_MOD);
        for (int it = (G >= 256 ? (int)blockIdx.x - 128 : (int)blockIdx.x); it < 2 * 96; it += (G >= 256 ? 128 : G)) { if (it < 0) break;
            const int layer = it / 96, cb = it % 96, col = cb * 64 + lane;
            const float* w = a.in[4] + (size_t)layer * DM * 6144 + col;
            float acc[9];
#pragma unroll
            for (int bb = 0; bb < 9; ++bb) acc[bb] = 0.f;
#pragma unroll 4
            for (int kk = 0; kk < 128; ++kk) { const int k = wid * 128 + kk; const float wv = w[(size_t)k * 6144];
                const f32x4 c0 = *(const f32x4*)(cond + k * 12), c1 = *(const f32x4*)(cond + k * 12 + 4); const float c8 = cond[k * 12 + 8];
                acc[0] += c0.x * wv; acc[1] += c0.y * wv; acc[2] += c0.z * wv; acc[3] += c0.w * wv; acc[4] += c1.x * wv; acc[5] += c1.y * wv; acc[6] += c1.z * wv; acc[7] += c1.w * wv; acc[8] += c8 * wv; }
#pragma unroll
            for (int bb = 0; bb < 9; ++bb) red[(wid * 9 + bb) * 64 + lane] = acc[bb];
            __syncthreads();
            for (int e = tid; e < 9 * 64; e += NTHREADS) { const int bb = e >> 6, ln = e & 63; float s = a.in[5][layer * 6144 + cb * 64 + ln];
#pragma unroll
                for (int w8 = 0; w8 < 8; ++w8) s += red[(w8 * 9 + bb) * 64 + ln];
                MOD[((size_t)layer * 9 + bb) * 6144 + cb * 64 + ln] = s; }
            __syncthreads();
        }
    }
    __syncthreads();
    for (int it = blockIdx.x; it < 128; it += G) s5_pre_item(a.in, ws, lds, it);
    __syncthreads();
    {
        float* scr = (float*)(lds + wid * 16384);
        constexpr int I_IN0 = 16 * (EIN / 32), I_OUT = 16 * 32, I_UP = 16 * (FH2 / 32), I_DN = (FH / 64) * 32, I_IN1 = 16 * (OIN / 32), I_GLU = 8 * 16;
        constexpr int NIT = I_IN0 + I_OUT + I_UP + I_DN + I_IN1 + I_OUT + I_UP + I_DN + I_GLU;
        unsigned* wctr = (unsigned*)(ws + WS_CTL);
        for (;;) {
            int it = 0; if (lane == 0) it = (int)atomicAdd(wctr, 1u); it = __builtin_amdgcn_readfirstlane(it); if (it >= NIT) break;
            int r = it;
            if (r < I_UP) { p0_transpose_item(a.in[7], DM, FH2, (bf16_t*)(ws + WS_WUP0), true, scr, r, lane); continue; } r -= I_UP;
            if (r < I_UP) { p0_transpose_item(a.in[7] + (size_t)DM * FH2, DM, FH2, (bf16_t*)(ws + WS_WUP1), true, scr, r, lane); continue; } r -= I_UP;
            if (r < I_DN) { p0_transpose_item(a.in[10], FH, DM, (bf16_t*)(ws + WS_WDN0), false, scr, r, lane); continue; } r -= I_DN;
            if (r < I_DN) { p0_transpose_item(a.in[10] + (size_t)FH * DM, FH, DM, (bf16_t*)(ws + WS_WDN1), false, scr, r, lane); continue; } r -= I_DN;
            if (r < I_IN0) { p0_transpose_item(a.in[11], DM, EIN, (bf16_t*)(ws + WS_WIN0), false, scr, r, lane); continue; } r -= I_IN0;
            if (r < I_IN1) { p0_transpose_item(a.in[22], DM, OIN, (bf16_t*)(ws + WS_WIN1), false, scr, r, lane); continue; } r -= I_IN1;
            if (r < I_OUT) { p0_transpose_item(a.in[12], DM, DM, (bf16_t*)(ws + WS_WOUT0), false, scr, r, lane); continue; } r -= I_OUT;
            if (r < I_OUT) { p0_transpose_item(a.in[23], DM, DM, (bf16_t*)(ws + WS_WOUT1), false, scr, r, lane); continue; } r -= I_OUT;
            p0_transpose_item(a.in[32], 512, 512, (bf16_t*)(ws + WS_WGLU), false, scr, r, lane);
        }
    }
}

__global__ void __launch_bounds__(NTHREADS, 2) trunk_fwd(Args a) {
    extern __shared__ __attribute__((aligned(16))) unsigned char lds_raw[];
    char* lds = (char*)lds_raw;
    PG8_LAS unsigned char* ldsl = (PG8_LAS unsigned char*)lds_raw;
    cg::grid_group grid = cg::this_grid();
    const int tid = threadIdx.x, lane = tid & 63, wid = tid >> 6, G = gridDim.x;
    const int gw = blockIdx.x * NWAVES + wid, NGW = G * NWAVES;
    unsigned char* ws = a.ws;
    const int lo = a.ph_lo, hi = a.ph_hi;
    float* MOD = (float*)(ws + WS_MOD); float* HC = (float*)(ws + WS_HC);
    bf16_t* XN = (bf16_t*)(ws + WS_XN); bf16_t* PROJ = (bf16_t*)(ws + WS_PROJ); bf16_t* MIX = (bf16_t*)(ws + WS_MIX); bf16_t* HID = (bf16_t*)(ws + WS_HID);
    const float* rope = (const float*)(ws + WS_ROPE);
    volatile LAS unsigned* MISC = (volatile LAS unsigned*)((LAS unsigned char*)lds_raw + LDS_MISC);
    if (tid < 64) MISC[tid] = 0u;
    __syncthreads();
    XcdBarrier xbar; xbar.bar = (unsigned*)(ws + WS_CTL) + 4096; xbar.x = 0; xbar.st = nullptr;
    if (hi - lo > 1) xbar = xcd_barrier_post((unsigned*)(ws + WS_CTL) + 4096, MISC + 8);
#ifndef PHASE_MASK
#define PHASE_MASK 0x7ffff
#endif
#define IN(k) (((PHASE_MASK >> (k)) & 1) && lo <= (k) && (k) < hi)
#define SEAM(k) do { if (IN(k) && IN((k) + 1)) { if ((k) == 0) grid.sync(); else xcd_barrier(xbar); } } while (0)

    if (IN(0)) { p0_prologue(a, lds, G); } SEAM(0);
    if (IN(1)) norm_phase(a.in[0], a.in[2], a.in[6], MOD, 0, 1, XN, MALL, -1, gw, NGW, lane);
    SEAM(1);
    if (IN(2)) { pg8::Gemm g{XN, (const bf16_t*)(ws + WS_WIN0), MALL, EIN, DM}; pg8::StaticOrder S; S.init(MALL, EIN, G, (int)blockIdx.x);
        pg8::EpiBf16<0> E{PROJ, EIN, nullptr, 0, 0, 1.f}; pg8::gemm_phase<pg8::EpiBf16<0>, pg8::StaticOrder, true, true>(ldsl, g, S, E); }
    SEAM(2);
    if (IN(3)) { qknorm_phase(PROJ, EIN, 1024, a.in[20], a.in[21], rope, gw, NGW, lane); __syncthreads();
        for (int it = blockIdx.x; it < NB * 8 * 36; it += G) rg_item<1>(a.in, ws, lds, it); }
    SEAM(3);
    if (IN(4)) {
#ifndef P4_NO_ATTN
        for (int it = blockIdx.x; it < 512 + 64; it += G) {
            if (it < 512) { const int qb = it & 7, head = (it >> 3) & 7, b = it >> 6; attn_unit<0>(PROJ, EIN, 1024, 1536, 1664, MIX, lds, b, head, qb * 256, 0.f); }
            else { const int u = it - 512, head = u & 7, b = u >> 3; attn_unit<1>(PROJ, EIN, 1024, 1536, 1664, MIX, lds, b, head, 0, 0.f); }
        }
#endif
#ifndef P4_NO_RG
        for (int it = (blockIdx.x + G - 64) % G; it < NB * 8 * 36; it += G) rg_item<2>(a.in, ws, lds, it);
#endif
    }
    SEAM(4);
    if (IN(5)) { pg8::Gemm g{MIX, (const bf16_t*)(ws + WS_WOUT0), MALL, DM, DM}; pg8::StaticOrder S; S.init(MALL, DM, G, (int)blockIdx.x);
        EpiRes E{a.in[0], a.in[2], a.out, HC, MOD + 2 * 1024}; pg8::gemm_phase<EpiRes, pg8::StaticOrder, true, true>(ldsl, g, S, E); }
    SEAM(5);
    if (IN(6)) norm_phase(a.out, HC, a.in[6] + DM, MOD, 3, 4, XN, MALL, XNE_ROW_L0, gw, NGW, lane);
    SEAM(6);
    if (IN(7)) { constexpr int MT = MALL + 1280; pg8::Gemm g{XN, (const bf16_t*)(ws + WS_WUP0), MT, FH2, DM}; pg8::StaticOrder S; S.init(MT, FH2, G, (int)blockIdx.x);
        EpiConvAct E{HID, a.in[8], a.in[9], MALL / 256, NBND_LAT, NBND_LAT + NBND_CTX, lds + 131072}; pg8::gemm_phase<EpiConvAct, pg8::StaticOrder, true, true>(ldsl, g, S, E); }
    SEAM(7);
    if (IN(8)) { pg8::Gemm g{HID, (const bf16_t*)(ws + WS_WDN0), MALL, DM, FH}; pg8::StaticOrder S; S.init(MALL, DM, G, (int)blockIdx.x);
        EpiRes E{a.out, HC, a.out, HC, MOD + 5 * 1024}; pg8::gemm_phase<EpiRes, pg8::StaticOrder, true, true>(ldsl, g, S, E); }
    SEAM(8);
    const float* MOD1 = MOD + 9 * 6144;
    if (IN(9)) norm_phase(a.out, HC, a.in[6] + 2 * DM, MOD1, 0, 1, XN, MALL, -1, gw, NGW, lane);
    SEAM(9);
    if (IN(10)) { pg8::Gemm g{XN, (const bf16_t*)(ws + WS_WIN1), MALL, OIN, DM}; pg8::StaticOrder S; S.init(MALL, OIN, G, (int)blockIdx.x);
        pg8::EpiBf16<0> E{PROJ, OIN, nullptr, 0, 0, 1.f}; pg8::gemm_phase<pg8::EpiBf16<0>, pg8::StaticOrder, true, true>(ldsl, g, S, E); }
    SEAM(10);
    if (IN(11)) { qknorm_phase(PROJ, OIN, 512, a.in[34], a.in[35], rope, gw, NGW, lane);
        for (int it = gw; it < 32 * 36; it += NGW) s5_L_item(ws, it); }
    SEAM(11);
    if (IN(12)) {
        { const int gt = blockIdx.x * NTHREADS + tid; if (gt < NB * 32 * 2 * 64) s5_scan_thread(ws, gt); }
        __syncthreads();
        const int nskip = (NB * 32 * 2 * 64) / NTHREADS;
        for (int it = (blockIdx.x + G - nskip) % G; it < 512; it += G) { const int qb = it & 7, head = (it >> 3) & 7, b = it >> 6;
            attn_unit<2>(PROJ, OIN, 512, 1024, 1152, MIX, lds, b, head, qb * 256, a.in[36][head] * 1.4426950408889634f); }
    }
    SEAM(12);
    if (IN(13)) { for (int it = gw; it < 32 * 64; it += NGW) s5_Y_item(ws, it); }
    SEAM(13);
    if (IN(14)) { pg8::Gemm g{(const bf16_t*)(ws + WS_Z), (const bf16_t*)(ws + WS_WGLU), NLAT, 512, 512}; pg8::StaticOrder S; S.init(NLAT, 512, G, (int)blockIdx.x);
        EpiGlu E{(const bf16_t*)(ws + WS_Z), MIX, a.in[33]}; pg8::gemm_phase<EpiGlu, pg8::StaticOrder, true, true>(ldsl, g, S, E); }
    SEAM(14);
    if (IN(15)) { pg8::Gemm g{MIX, (const bf16_t*)(ws + WS_WOUT1), NLAT, DM, DM}; pg8::StaticOrder S; S.init(NLAT, DM, G, (int)blockIdx.x);
        EpiRes E{a.out, HC, a.out, HC, MOD1 + 2 * 1024}; pg8::gemm_phase<EpiRes, pg8::StaticOrder, true, true>(ldsl, g, S, E); }
    SEAM(15);
    if (IN(16)) norm_phase(a.out, HC, a.in[6] + 3 * DM, MOD1, 3, 4, XN, NLAT, XNE_ROW_L1, gw, NGW, lane);
    SEAM(16);
    if (IN(17)) { constexpr int MT = NLAT + 1024; pg8::Gemm g{XN, (const bf16_t*)(ws + WS_WUP1), MT, FH2, DM}; pg8::StaticOrder S; S.init(MT, FH2, G, (int)blockIdx.x);
        EpiConvAct E{HID, a.in[8] + 3 * FH2, a.in[9] + FH2, NLAT / 256, NBND_LAT, NBND_LAT, lds + 131072}; pg8::gemm_phase<EpiConvAct, pg8::StaticOrder, true, true>(ldsl, g, S, E); }
    SEAM(17);
    if (IN(18)) { pg8::Gemm g{HID, (const bf16_t*)(ws + WS_WDN1), NLAT, DM, FH}; pg8::StaticOrder S; S.init(NLAT, DM, G, (int)blockIdx.x);
        EpiRes E{a.out, HC, a.out, HC, MOD1 + 5 * 1024}; pg8::gemm_phase<EpiRes, pg8::StaticOrder, true, true>(ldsl, g, S, E); }
#undef IN
#undef SEAM
}

#ifndef N_LAUNCH_MODE
#define N_LAUNCH_MODE 1
#endif
extern "C" void kernel_launch(void* const* d_in, const int* in_sizes, int n_in, void* d_out, int out_size, void* d_ws, size_t ws_size, hipStream_t stream) {
    static int grid = 0;
    if (grid == 0) {
        if (n_in != 37 || out_size != NLAT * DM || ws_size < WS_END) { fprintf(stderr, "kernel_launch: unexpected problem (n_in %d out %d ws %zu)\n", n_in, out_size, ws_size); grid = -1; return; }
        int dev = 0, cus = 0, per_cu = 0;
        hipGetDevice(&dev); hipDeviceGetAttribute(&cus, hipDeviceAttributeMultiprocessorCount, dev);
        if (hipFuncSetAttribute((const void*)trunk_fwd, hipFuncAttributeMaxDynamicSharedMemorySize, LDS_BYTES) != hipSuccess) { fprintf(stderr, "kernel_launch: hipFuncSetAttribute failed\n"); grid = -1; return; }
        if (hipOccupancyMaxActiveBlocksPerMultiprocessor(&per_cu, (const void*)trunk_fwd, NTHREADS, LDS_BYTES) != hipSuccess || per_cu < 1) { fprintf(stderr, "kernel_launch: occupancy query says %d\n", per_cu); per_cu = 1; }
        (void)hipGetLastError();
        grid = cus;
        fprintf(stderr, "kernel_launch: grid %d (cus %d, per_cu %d)\n", grid, cus, per_cu);
    }
    if (grid < 0) return;
    (void)hipMemsetAsync((char*)d_ws + WS_CTL, 0, CTL_ZERO_BYTES, stream);
    Args a{};
    for (int i = 0; i < 37; ++i) a.in[i] = (const float*)d_in[i];
    a.out = (float*)d_out; a.ws = (unsigned char*)d_ws;
#if N_LAUNCH_MODE == 1
    a.ph_lo = 0; a.ph_hi = NPHASE;
    void* args[] = {&a};
    hipError_t e = hipLaunchCooperativeKernel((const void*)trunk_fwd, dim3(grid), dim3(NTHREADS), args, LDS_BYTES, stream);
    if (e != hipSuccess) fprintf(stderr, "cooperative launch failed: %s (grid %d)\n", hipGetErrorString(e), grid);
#else
    for (int p = 0; p < NPHASE; ++p) { a.ph_lo = p; a.ph_hi = p + 1; hipLaunchKernelGGL(trunk_fwd, dim3(grid), dim3(NTHREADS), LDS_BYTES, stream, a);
#ifdef DBG_CHECK
        Args d = a; d.ph_lo = 0; d.ph_hi = 0;
        static const int chk[NPHASE][2] = {{1,0},{0,0},{2,0},{3,0},{4,5},{6,0},{0,0},{7,8},{0,0},{0,0},{9,0},{10,0},{11,0},{12,0},{15,0},{0,0},{0,0},{14,0},{0,0}};
        for (int q = 0; q < 2; ++q) { const int st = chk[p][q]; if (!st) continue; const bool heavy = (st == 5 || st == 12); hipLaunchKernelGGL(dbg_check, dim3(heavy ? 1 : 4), dim3(heavy ? 64 : 256), 0, stream, d, st); }
        if (p == NPHASE - 1) hipLaunchKernelGGL(dbg_report, dim3(1), dim3(64), 0, stream, d);
#endif
    }
#endif
}
```

```cpp
#include <hip/hip_runtime.h>
#include <hip/hip_cooperative_groups.h>
#include <hip/hip_bf16.h>
#include <cstdio>
#include <cstdint>
#include <cmath>
namespace cg = cooperative_groups;
namespace pg8 {
#define PG8_LAS __attribute__((address_space(3)))
typedef unsigned short bf16_t;
typedef short bf16x8 __attribute__((ext_vector_type(8)));
typedef float f32x4 __attribute__((ext_vector_type(4)));
typedef unsigned u32x4 __attribute__((ext_vector_type(4)));
constexpr int BM = 256, BK = 64, HALF = 128, HTB = HALF * BK * 2  , STAGE_BYTES = 8 * HTB, NXCD = 8, WGM = 8;

__host__ __device__ __forceinline__ int lds_byte(int r, int c) { const int st = (r >> 4) * 2 + (c >> 5), rr = r & 15, cc = c & 31, ob = rr * 64 + cc * 2; return st * 1024 + (ob ^ (((ob >> 9) & 1) << 5)); }
__host__ __device__ __forceinline__ void stage_rc(int b, int& R, int& C) { const int st = b / 1024, sb = b % 1024, swz = sb ^ (((sb >> 9) & 1) << 5); R = (st >> 1) * 16 + swz / 64; C = (st & 1) * 32 + (swz % 64) / 2; }
__host__ __device__ __forceinline__ int perm32(int rho) { const int n = rho >> 4, i = rho & 15; return 8 * (i >> 2) + 4 * n + (i & 3); }

struct Unit { int pm, pn; };
struct Gemm { const bf16_t* A; const bf16_t* Bt; int M, N, K; int lda, ldb; };

struct StaticOrder {
    int nM, nN, nwg, G, c;
    __host__ __device__ void init(int M, int N, int G_, int c_) { nM = M / BM; nN = N / BM; nwg = nM * nN; G = G_; c = c_; }
    __host__ __device__ bool next(int i, Unit& u) const {
        const long L = (long)i * G + c; if (L >= nwg) return false;
        int wgid = (int)L; { const int q = nwg / NXCD, r = nwg % NXCD, xcd = wgid % NXCD, off = wgid / NXCD; wgid = (xcd < r ? xcd * (q + 1) : r * (q + 1) + (xcd - r) * q) + off; }
        const int nig = WGM * nN, gid = wgid / nig, fm = gid * WGM, gsz = (nM - fm) < WGM ? (nM - fm) : WGM;
        u.pm = fm + ((wgid % nig) % gsz); u.pn = (wgid % nig) / gsz; return true;
    }
    __device__ __forceinline__ void a_ready(const Unit&) const {}
    __device__ __forceinline__ void done(const Unit&) const {}
};

__device__ __forceinline__ unsigned cvt_pk_bf16(float lo, float hi) { unsigned r; asm volatile("v_cvt_pk_bf16_f32 %0, %1, %2" : "=v"(r) : "v"(lo), "v"(hi)); return r; }
typedef float f32x2 __attribute__((ext_vector_type(2)));
__device__ __forceinline__ f32x2 gelu_pk(f32x2 v) {
    const f32x2 av = __builtin_elementwise_abs(v), d = av * 0.2316418882f + 1.0f;
    f32x2 t; t.x = __builtin_amdgcn_rcpf(d.x); t.y = __builtin_amdgcn_rcpf(d.y);
    f32x2 q = t * 0.5307027145f + (-0.7265760135f); q = q * t + 0.7107068705f; q = q * t + (-0.142248368f); q = q * t + 0.127414796f; q = q * t;
    const f32x2 s = (v * v) * (-0.72134752044f);
    f32x2 e; e.x = __builtin_amdgcn_exp2f(s.x); e.y = __builtin_amdgcn_exp2f(s.y);
    const f32x2 m = v * (q * e), r = v - m;
    f32x2 o; o.x = v.x < 0.f ? m.x : r.x; o.y = v.y < 0.f ? m.y : r.y; return o;
}
template <int ACT  > struct EpiBf16 {
    static constexpr bool PERM = true, AFTER_DRAIN = false; static_assert(ACT == 0 || ACT == 1, "EpiBf16: ACT is 0 (none) or 1 (gelu_pk)");
    bf16_t* O; int ldc; const float* bias; int split_cols; size_t split_stride; float scale0;
    __device__ __forceinline__ void operator()(const f32x4 (&acc)[2][2][4][2], const Unit& u, int wr, int wc, int fr, int fq) const {
        const int row0 = u.pm * BM + wr * 64 + fr; int colt = u.pn * BM; bf16_t* base = O;
        float sc = 1.f; if (split_cols) { const int t = colt / split_cols; base += (size_t)t * split_stride; colt -= t * split_cols; if (t == 0) sc = scale0; }
        const int col0 = colt + wc * 32 + 8 * fq, bcol0 = u.pn * BM + wc * 32 + 8 * fq;
        f32x4 bv[2][2];
#pragma unroll
        for (int bj = 0; bj < 2; ++bj)
#pragma unroll
            for (int n = 0; n < 2; ++n) bv[bj][n] = bias ? *(const f32x4*)(bias + bcol0 + bj * HALF + 4 * n) : (f32x4){0.f, 0.f, 0.f, 0.f};
#pragma unroll
        for (int ai = 0; ai < 2; ++ai)
#pragma unroll
            for (int m = 0; m < 4; ++m) { bf16_t* rowp = base + (size_t)(row0 + ai * HALF + m * 16) * ldc + col0;
#pragma unroll
                for (int bj = 0; bj < 2; ++bj) { f32x4 v0 = acc[ai][bj][m][0] + bv[bj][0], v1 = acc[ai][bj][m][1] + bv[bj][1];
                    if (ACT == 1) { f32x2 a = gelu_pk((f32x2){v0[0], v0[1]}), b = gelu_pk((f32x2){v0[2], v0[3]}), c = gelu_pk((f32x2){v1[0], v1[1]}), d = gelu_pk((f32x2){v1[2], v1[3]});
                        v0 = (f32x4){a.x, a.y, b.x, b.y}; v1 = (f32x4){c.x, c.y, d.x, d.y}; }
                    v0 = v0 * sc; v1 = v1 * sc; u32x4 w; w.x = cvt_pk_bf16(v0[0], v0[1]); w.y = cvt_pk_bf16(v0[2], v0[3]); w.z = cvt_pk_bf16(v1[0], v1[1]); w.w = cvt_pk_bf16(v1[2], v1[3]);
                    *(u32x4*)(rowp + bj * HALF) = w; } }
    }
};
template <class Epi, class Sched, bool ALIGN_EPI = false, bool SP2 = false>
__device__ __forceinline__ void gemm_phase(PG8_LAS unsigned char* lds, const Gemm g, const Sched& S, const Epi& E) {
    const int tid = threadIdx.x, wid = __builtin_amdgcn_readfirstlane(tid >> 6), lane = tid & 63, wr = wid >> 2, wc = wid & 3, fr = lane & 15, fq = lane >> 4;
    const int K = g.K, nt = K / BK; const int lda = g.lda ? g.lda : K, ldb = g.ldb ? g.ldb : K;
    unsigned voffA[2], voffB[2];
#pragma unroll
    for (int i = 0; i < 2; ++i) { int R, C; stage_rc(tid * 16 + i * 8192, R, C); const int Rb = Epi::PERM ? ((R & ~31) + perm32(R & 31)) : R;
        voffA[i] = (unsigned)(R * lda + C) * 2u; voffB[i] = (unsigned)(Rb * ldb + C) * 2u; }
    const size_t kstep = (size_t)(BK * 2);
    const size_t hsA = (size_t)HALF * lda * 2, hsB = (size_t)HALF * ldb * 2;
    const size_t tsA = 2 * hsA, tsB = 2 * hsB;
    const unsigned ldsw = (unsigned)wid * 1024u;
    const int aoff = lds_byte(wr * 64 + fr, fq * 8), boff = lds_byte(wc * 32 + fr, fq * 8);
#define PG8_SA(b, h) (((b) * 2 + (h)) * HTB)
#define PG8_SB(b, h) ((4 + (b) * 2 + (h)) * HTB)
#define PG8_STAGE(bufoff, gbase, voff) do { _Pragma("unroll") for (int _i = 0; _i < 2; ++_i) \
        __builtin_amdgcn_global_load_lds((const unsigned*)((const char*)(gbase) + (voff)[_i]), (PG8_LAS unsigned*)(lds + (bufoff) + ldsw + _i * 8192), 16, 0, 0); } while (0)
#define PG8_LDA(dst, b, h) do { _Pragma("unroll") for (int m = 0; m < 4; ++m) _Pragma("unroll") for (int k = 0; k < 2; ++k) dst[m][k] = *(const PG8_LAS bf16x8*)(lds + PG8_SA(b, h) + aoff + m * 2048 + k * 1024); } while (0)
#define PG8_LDB(dst, b, h) do { _Pragma("unroll") for (int n = 0; n < 2; ++n) _Pragma("unroll") for (int k = 0; k < 2; ++k) dst[n][k] = *(const PG8_LAS bf16x8*)(lds + PG8_SB(b, h) + boff + n * 2048 + k * 1024); } while (0)
#define PG8_MMA(ai, bj, At, Bt) do { __builtin_amdgcn_s_setprio(1); _Pragma("unroll") for (int m = 0; m < 4; ++m) _Pragma("unroll") for (int n = 0; n < 2; ++n) _Pragma("unroll") for (int k = 0; k < 2; ++k) \
        acc[ai][bj][m][n] = __builtin_amdgcn_mfma_f32_16x16x32_bf16(Bt[n][k], At[m][k], acc[ai][bj][m][n], 0, 0, 0); __builtin_amdgcn_s_setprio(0); } while (0)
#define PG8_WAIT_V(n) asm volatile("s_waitcnt vmcnt(" #n ")" ::: "memory")
#define PG8_WAIT_L(n) asm volatile("s_waitcnt lgkmcnt(" #n ")" ::: "memory")
#define PG8_BAR __builtin_amdgcn_s_barrier()
#define PG8_SCHED __builtin_amdgcn_sched_barrier(0)
    Unit cur, nxt; int ui = 0;
    if (!S.next(0, cur)) return;
    f32x4 acc[2][2][4][2];
#pragma unroll
    for (int a = 0; a < 2; ++a)
#pragma unroll
        for (int b = 0; b < 2; ++b)
#pragma unroll
            for (int m = 0; m < 4; ++m)
#pragma unroll
                for (int n = 0; n < 2; ++n) acc[a][b][m][n] = (f32x4){0.f, 0.f, 0.f, 0.f};
    bf16x8 At[4][2], B0[2][2], B1[2][2];
    const char* cA = (const char*)g.A + (size_t)cur.pm * tsA; const char* cB = (const char*)g.Bt + (size_t)cur.pn * tsB;
    S.a_ready(cur);
    if constexpr (SP2) {
        PG8_STAGE(PG8_SB(0, 0), cB, voffB); PG8_STAGE(PG8_SB(0, 1), cB + hsB, voffB); PG8_STAGE(PG8_SA(0, 0), cA, voffA); PG8_STAGE(PG8_SA(0, 1), cA + hsA, voffA);
        if (wr == 1) PG8_BAR;
        PG8_WAIT_V(2); PG8_BAR;
        PG8_STAGE(PG8_SB(1, 0), cB + kstep, voffB); PG8_STAGE(PG8_SA(1, 0), cA + kstep, voffA); PG8_STAGE(PG8_SB(1, 1), cB + hsB + kstep, voffB);
        PG8_WAIT_V(6); PG8_BAR;
    } else {
        PG8_STAGE(PG8_SB(0, 0), cB, voffB); PG8_STAGE(PG8_SA(0, 0), cA, voffA); PG8_STAGE(PG8_SB(0, 1), cB + hsB, voffB); PG8_STAGE(PG8_SA(0, 1), cA + hsA, voffA);
        if (wr == 1) PG8_BAR;
        PG8_WAIT_V(4); PG8_BAR;
        PG8_STAGE(PG8_SB(1, 0), cB + kstep, voffB); PG8_STAGE(PG8_SA(1, 0), cA + kstep, voffA); PG8_STAGE(PG8_SB(1, 1), cB + hsB + kstep, voffB);
        PG8_WAIT_V(6); PG8_BAR;
    }
    for (;;) {
        const bool has_next = S.next(ui + 1, nxt);
        const char* nA = has_next ? (const char*)g.A + (size_t)nxt.pm * tsA : cA; const char* nB = has_next ? (const char*)g.Bt + (size_t)nxt.pn * tsB : cB;
        for (int t = 0; t < nt; t += 2) {
            const bool last = (t == nt - 2);
            const char* a1 = cA + (size_t)(t + 1) * kstep;
            const char* a2 = last ? nA : cA + (size_t)(t + 2) * kstep; const char* b2 = last ? nB : cB + (size_t)(t + 2) * kstep;
            const char* a3 = a2 + kstep; const char* b3 = b2 + kstep;
            if (last && has_next) S.a_ready(nxt);
            if constexpr (SP2) {
            PG8_LDB(B0, 0, 0); PG8_LDB(B1, 0, 1); PG8_SCHED; PG8_LDA(At, 0, 0); PG8_STAGE(PG8_SA(1, 1), a1 + hsA, voffA);
            PG8_WAIT_V(8); PG8_WAIT_L(0); PG8_BAR; PG8_MMA(0, 0, At, B0); PG8_MMA(0, 1, At, B1); PG8_BAR; PG8_SCHED;
            PG8_LDA(At, 0, 1); PG8_STAGE(PG8_SB(0, 0), b2, voffB); PG8_STAGE(PG8_SB(0, 1), b2 + hsB, voffB); PG8_STAGE(PG8_SA(0, 0), a2, voffA);
            PG8_WAIT_V(8); PG8_WAIT_L(0); PG8_BAR; PG8_MMA(1, 0, At, B0); PG8_MMA(1, 1, At, B1); PG8_BAR; PG8_SCHED;
            PG8_LDB(B0, 1, 0); PG8_LDB(B1, 1, 1); PG8_SCHED; PG8_LDA(At, 1, 0); PG8_STAGE(PG8_SA(0, 1), a2 + hsA, voffA);
            PG8_WAIT_V(8); PG8_WAIT_L(0); PG8_BAR; PG8_MMA(0, 0, At, B0); PG8_MMA(0, 1, At, B1); PG8_BAR; PG8_SCHED;
            PG8_LDA(At, 1, 1); PG8_STAGE(PG8_SB(1, 0), b3, voffB); PG8_STAGE(PG8_SB(1, 1), b3 + hsB, voffB); PG8_STAGE(PG8_SA(1, 0), a3, voffA);
            PG8_WAIT_V(8); PG8_WAIT_L(0); PG8_BAR; PG8_MMA(1, 0, At, B0); PG8_MMA(1, 1, At, B1); PG8_BAR; PG8_SCHED;
            } else {
            PG8_LDB(B0, 0, 0); PG8_SCHED; PG8_LDA(At, 0, 0); PG8_STAGE(PG8_SA(1, 1), a1 + hsA, voffA);
            PG8_WAIT_L(8); PG8_BAR; PG8_WAIT_L(0); PG8_MMA(0, 0, At, B0); PG8_BAR; PG8_SCHED;
            PG8_LDB(B1, 0, 1); PG8_STAGE(PG8_SB(0, 0), b2, voffB);
            PG8_BAR; PG8_WAIT_L(0); PG8_MMA(0, 1, At, B1); PG8_BAR;
            PG8_LDA(At, 0, 1); PG8_STAGE(PG8_SA(0, 0), a2, voffA);
            PG8_BAR; PG8_WAIT_L(0); PG8_MMA(1, 0, At, B0); PG8_BAR; PG8_SCHED;
            PG8_STAGE(PG8_SB(0, 1), b2 + hsB, voffB);
            PG8_WAIT_V(6); PG8_BAR; PG8_MMA(1, 1, At, B1); PG8_BAR;
            PG8_LDB(B0, 1, 0); PG8_SCHED; PG8_LDA(At, 1, 0); PG8_STAGE(PG8_SA(0, 1), a2 + hsA, voffA);
            PG8_WAIT_L(8); PG8_BAR; PG8_WAIT_L(0); PG8_MMA(0, 0, At, B0); PG8_BAR; PG8_SCHED;
            PG8_LDB(B1, 1, 1); PG8_STAGE(PG8_SB(1, 0), b3, voffB);
            PG8_BAR; PG8_WAIT_L(0); PG8_MMA(0, 1, At, B1); PG8_BAR;
            PG8_LDA(At, 1, 1); PG8_STAGE(PG8_SA(1, 0), a3, voffA);
            PG8_BAR; PG8_WAIT_L(0); PG8_MMA(1, 0, At, B0); PG8_BAR; PG8_SCHED;
            PG8_STAGE(PG8_SB(1, 1), b3 + hsB, voffB);
            PG8_WAIT_V(6); PG8_BAR; PG8_MMA(1, 1, At, B1); PG8_BAR;
            }
        }
        if constexpr (ALIGN_EPI) { if (wr == 0) PG8_BAR; }
        if constexpr (!Epi::AFTER_DRAIN) { E(acc, cur, wr, wc, fr, fq); S.done(cur); }
        if (!has_next) break;
#pragma unroll
        for (int a = 0; a < 2; ++a)
#pragma unroll
            for (int b = 0; b < 2; ++b)
#pragma unroll
                for (int m = 0; m < 4; ++m)
#pragma unroll
                    for (int n = 0; n < 2; ++n) acc[a][b][m][n] = (f32x4){0.f, 0.f, 0.f, 0.f};
        cur = nxt; cA = nA; cB = nB; ++ui;
        if constexpr (ALIGN_EPI) { if (wr == 1) PG8_BAR; }
    }
    PG8_WAIT_V(0);
    if constexpr (!ALIGN_EPI) { if (wr == 0) PG8_BAR; }
    PG8_BAR;
    if constexpr (Epi::AFTER_DRAIN) { E.fused(acc, cur, wr, wc, fr, fq, lds, wid, lane); S.done(cur); }
#undef PG8_SA
#undef PG8_SB
#undef PG8_STAGE
#undef PG8_LDA
#undef PG8_LDB
#undef PG8_MMA
#undef PG8_WAIT_V
#undef PG8_WAIT_L
#undef PG8_BAR
#undef PG8_SCHED
}
}

#define DI __device__ __forceinline__
typedef pg8::bf16_t bf16_t;
typedef short bf16x8 __attribute__((ext_vector_type(8)));
typedef short s16x4 __attribute__((ext_vector_type(4)));
typedef float f32x4 __attribute__((ext_vector_type(4)));
typedef float f32x16 __attribute__((ext_vector_type(16)));
typedef unsigned u32x4 __attribute__((ext_vector_type(4)));
typedef unsigned u32x2 __attribute__((ext_vector_type(2)));
#define LAS __attribute__((address_space(3)))
typedef float f32x2_t __attribute__((ext_vector_type(2)));

constexpr int DM = 1024, NB = 8, SEQ = 2048, CTXL = 256;
constexpr int NLAT = NB * SEQ, NCTX = NB * CTXL, MALL = NLAT + NCTX;
constexpr int FH = 2816, FH2 = 5632, EIN = 1792, OIN = 1280;
constexpr float NORM_EPS = 1e-6f;
constexpr float C2 = 0.125f * 1.4426950408889634f;
constexpr int NTHREADS = 512, NWAVES = 8;
constexpr int LDS_BYTES = 147456 + 8192 + 256, LDS_MISC = 147456 + 8192;
constexpr int NBND_LAT = NB * 31, NBND_CTX = NB * 3;
constexpr int XNE_ROW_L0 = MALL, XNE_ROW_L1 = NLAT;
constexpr int XN_ROWS = MALL + 1280;

constexpr size_t MiB = 1u << 20;
constexpr size_t WS_CTL = 0, CTL_ZERO_BYTES = 64 * 1024;
constexpr size_t WS_MOD = 1 * MiB;
constexpr size_t WS_ROPE = 2 * MiB;
constexpr size_t WS_RGW = 3 * MiB;
constexpr size_t WS_S5AT = 3 * MiB + 512 * 1024;
constexpr size_t WS_RGTOT = 4 * MiB;
constexpr size_t WS_S5E = 7 * MiB, WS_S5MF = 15 * MiB;
constexpr size_t WS_WIN0 = 39 * MiB, WS_WOUT0 = 43 * MiB, WS_WUP0 = 45 * MiB, WS_WDN0 = 56 * MiB;
constexpr size_t WS_WIN1 = 62 * MiB, WS_WOUT1 = 65 * MiB, WS_WUP1 = 67 * MiB, WS_WDN1 = 78 * MiB, WS_WGLU = 84 * MiB;
constexpr size_t WS_HC = 85 * MiB;
constexpr size_t WS_XN = 93 * MiB;
constexpr size_t WS_PROJ = 132 * MiB;
constexpr size_t WS_S5L = 177 * MiB;
constexpr size_t WS_MIX = 195 * MiB;
constexpr size_t WS_HID = 132 * MiB;
constexpr size_t WS_UG = WS_XN;
constexpr size_t WS_Z = 231 * MiB;
constexpr size_t WS_END = 248 * MiB;
static_assert(WS_XN + (size_t)XN_ROWS * DM * 2 <= WS_PROJ, "xn");
static_assert(WS_PROJ + (size_t)MALL * OIN * 2 <= WS_S5L && WS_S5L + (size_t)576 * 32 * 256 * 4 <= WS_MIX, "s5l");
static_assert(WS_HID + (size_t)MALL * FH * 2 <= WS_Z && WS_Z + (size_t)NLAT * 512 * 2 <= WS_END && (size_t)32 * 768 * 768 * 2 <= (size_t)XN_ROWS * DM * 2, "hid/z/ug");

DI float bf2f(bf16_t v) { return __uint_as_float((unsigned)v << 16); }
DI unsigned f2bf(float f) { unsigned u = __float_as_uint(f); return (u + 0x7fffu + ((u >> 16) & 1u)) >> 16; }
DI unsigned pk2(float lo, float hi) { return f2bf(lo) | (f2bf(hi) << 16); }
typedef __bf16 bf16x2v_t __attribute__((ext_vector_type(2)));
DI unsigned cvtpk_(float lo, float hi) { f32x2_t v = {lo, hi}; bf16x2v_t b = __builtin_convertvector(v, bf16x2v_t); return __builtin_bit_cast(unsigned, b); }
DI float wave_sum(float v) {
#pragma unroll
    for (int o = 1; o < 64; o <<= 1) v += __shfl_xor(v, o);
    return v;
}
DI float sigmoidf_(float x) { return __builtin_amdgcn_rcpf(1.f + __expf(-x)); }
DI float gelu_tanh(float x) { const float z = 1.5957691216057308f * (x + 0.044715f * x * x * x); return x * sigmoidf_(z); }
DI float siluf_(float x) { return x * sigmoidf_(x); }

struct EpiRes {
    static constexpr bool PERM = false, AFTER_DRAIN = false;
    const float* baseL; const float* baseC; float* outL; float* outC; const float* gate;
    __device__ __forceinline__ void operator()(const f32x4 (&acc)[2][2][4][2], const pg8::Unit& u, int wr, int wc, int fr, int fq) const {
        const bool isc = u.pm >= 64; const int bb = isc ? 8 : (u.pm >> 3);
        const float* base = isc ? baseC + (size_t)(u.pm - 64) * 256 * DM : baseL + (size_t)u.pm * 256 * DM;
        float* out = isc ? outC + (size_t)(u.pm - 64) * 256 * DM : outL + (size_t)u.pm * 256 * DM;
        const float* g = gate + (size_t)bb * 6144;
        const int col0 = u.pn * 256 + wc * 32 + 4 * fq;
#pragma unroll
        for (int bj = 0; bj < 2; ++bj)
#pragma unroll
            for (int n = 0; n < 2; ++n) {
                const int c = col0 + bj * 128 + n * 16; const f32x4 gv = *(const f32x4*)(g + c);
                f32x4 bs[2][4];
#pragma unroll
                for (int ai = 0; ai < 2; ++ai)
#pragma unroll
                    for (int m = 0; m < 4; ++m) bs[ai][m] = *(const f32x4*)(base + (size_t)(ai * 128 + wr * 64 + m * 16 + fr) * DM + c);
#pragma unroll
                for (int ai = 0; ai < 2; ++ai)
#pragma unroll
                    for (int m = 0; m < 4; ++m) *(f32x4*)(out + (size_t)(ai * 128 + wr * 64 + m * 16 + fr) * DM + c) = bs[ai][m] + gv * acc[ai][bj][m][n];
            }
    }
};

struct EpiConvAct {
    static constexpr bool PERM = true, AFTER_DRAIN = false;
    bf16_t* H; const float* cw; const float* cb; int pm_edge; int nbnd_lat; int nbnd; char* xlds;
    __device__ __forceinline__ void operator()(const f32x4 (&acc)[2][2][4][2], const pg8::Unit& u, int wr_, int wc_, int fr_, int fq_) const {
        int tl = threadIdx.x; asm volatile("" : "+v"(tl));
        const int lane = tl & 63, wid_ = tl >> 6, fr = lane & 15, fq = lane >> 4, wr = wid_ >> 2, wc = wid_ & 3; (void)wr_; (void)wc_; (void)fr_; (void)fq_;
        const bool edge = u.pm >= pm_edge;
        const int hc0 = u.pn * 128 + wc * 32 + 8 * fq;
        u32x2* sc = (u32x2*)(xlds + wid_ * 2048);
        float* wl = (float*)(xlds + 16384 + wid_ * 1024);
        { const int p = lane >> 4, bjl = (lane >> 3) & 1, cg4 = lane & 7;
          const float* src = (p < 3 ? cw + p * FH2 : cb) + bjl * FH + u.pn * 128 + wc * 32 + 4 * cg4;
          *(f32x4*)(wl + (p * 2 + bjl) * 32 + 4 * cg4) = *(const f32x4*)src; }
        asm volatile("" ::: "memory");
#pragma unroll
        for (int n = 0; n < 2; ++n) {
#pragma unroll
            for (int ai = 0; ai < 2; ++ai) {
                float hvv[2][4][4];
#pragma unroll
                for (int bj = 0; bj < 2; ++bj) {
#pragma unroll
                    for (int m = 0; m < 4; ++m) { u32x2 w; w.x = cvtpk_(acc[ai][bj][m][n][0], acc[ai][bj][m][n][1]); w.y = cvtpk_(acc[ai][bj][m][n][2], acc[ai][bj][m][n][3]); sc[(16 * m + fr) * 4 + fq] = w; }
                    asm volatile("" ::: "memory");
                    const f32x4 w0 = *(const f32x4*)(wl + (0 * 2 + bj) * 32 + 8 * fq + 4 * n), w1 = *(const f32x4*)(wl + (1 * 2 + bj) * 32 + 8 * fq + 4 * n),
                                w2 = *(const f32x4*)(wl + (2 * 2 + bj) * 32 + 8 * fq + 4 * n), bb = *(const f32x4*)(wl + (3 * 2 + bj) * 32 + 8 * fq + 4 * n);
#pragma unroll
                    for (int m = 0; m < 4; ++m) {
                        const int row = 16 * m + fr; const int ru = row > 0 ? row - 1 : 0, rd = row < 63 ? row + 1 : 63;
                        u32x2 uu = sc[ru * 4 + fq], dd = sc[rd * 4 + fq];
                        if (row == 0) uu = (u32x2){0u, 0u}; if (row == 63) dd = (u32x2){0u, 0u};
                        const f32x4 up = (f32x4){__uint_as_float(uu.x << 16), __uint_as_float(uu.x & 0xffff0000u), __uint_as_float(uu.y << 16), __uint_as_float(uu.y & 0xffff0000u)};
                        const f32x4 dn = (f32x4){__uint_as_float(dd.x << 16), __uint_as_float(dd.x & 0xffff0000u), __uint_as_float(dd.y << 16), __uint_as_float(dd.y & 0xffff0000u)};
                        const f32x4 hv = bb + w0 * up + w1 * acc[ai][bj][m][n] + w2 * dn;
                        hvv[bj][m][0] = hv.x; hvv[bj][m][1] = hv.y; hvv[bj][m][2] = hv.z; hvv[bj][m][3] = hv.w;
                    }
                    asm volatile("" : "+v"(hvv[bj][0][0]), "+v"(hvv[bj][0][1]), "+v"(hvv[bj][0][2]), "+v"(hvv[bj][0][3]), "+v"(hvv[bj][1][0]), "+v"(hvv[bj][1][1]), "+v"(hvv[bj][1][2]), "+v"(hvv[bj][1][3]),
                                      "+v"(hvv[bj][2][0]), "+v"(hvv[bj][2][1]), "+v"(hvv[bj][2][2]), "+v"(hvv[bj][2][3]), "+v"(hvv[bj][3][0]), "+v"(hvv[bj][3][1]), "+v"(hvv[bj][3][2]), "+v"(hvv[bj][3][3]) :: "memory");
                }
#pragma unroll
                for (int m = 0; m < 4; ++m) {
                    const int R = ai * 128 + wr * 64 + m * 16 + fr;
                    long grow; bool st;
                    if (!edge) {
                        grow = (long)u.pm * 256 + R; st = true;
                        const int r64 = R & 63;
                        if (r64 == 0) st = (R == 0) && (u.pm >= 64 || (u.pm & 7) == 0);
                        if (r64 == 63) st = (R == 255) && (u.pm >= 64 || (u.pm & 7) == 7);
                    } else {
                        const int slot = (u.pm - pm_edge) * 256 + R, q = slot >> 2, pos = slot & 3;
                        st = (pos == 1 || pos == 2) && q < nbnd;
                        int row0;
                        if (q < nbnd_lat) { const int s = q / 31, k = q - s * 31 + 1; row0 = s * SEQ + 64 * k; }
                        else { const int q2 = q - nbnd_lat, s = q2 / 3, k = q2 - s * 3 + 1; row0 = NLAT + s * CTXL + 64 * k; }
                        grow = (long)row0 - 2 + pos;
                    }
                    if (st) { u32x2 w; w.x = cvtpk_(hvv[0][m][0] * siluf_(hvv[1][m][0]), hvv[0][m][1] * siluf_(hvv[1][m][1])); w.y = cvtpk_(hvv[0][m][2] * siluf_(hvv[1][m][2]), hvv[0][m][3] * siluf_(hvv[1][m][3]));
                        *(u32x2*)(H + (size_t)grow * FH + hc0 + 4 * n) = w; }
                }
                asm volatile("" ::: "memory"); __builtin_amdgcn_sched_barrier(0);
            }
        }
    }
};

struct EpiGlu {
    static constexpr bool PERM = true, AFTER_DRAIN = false;
    const bf16_t* Z; bf16_t* O; const float* bias;
    __device__ __forceinline__ void operator()(const f32x4 (&acc)[2][2][4][2], const pg8::Unit& u, int wr, int wc, int fr, int fq) const {
        const int row0 = u.pm * 256 + wr * 64 + fr; const int col0 = u.pn * 256 + wc * 32 + 8 * fq;
#pragma unroll
        for (int bj = 0; bj < 2; ++bj) {
            const f32x4 b0 = *(const f32x4*)(bias + col0 + bj * 128), b1 = *(const f32x4*)(bias + col0 + bj * 128 + 4);
            u32x4 zq[2][4];
#pragma unroll
            for (int ai = 0; ai < 2; ++ai)
#pragma unroll
                for (int m = 0; m < 4; ++m) zq[ai][m] = *(const u32x4*)(Z + (size_t)(row0 + ai * 128 + m * 16) * 512 + col0 + bj * 128);
#pragma unroll
            for (int ai = 0; ai < 2; ++ai)
#pragma unroll
                for (int m = 0; m < 4; ++m) {
                    const size_t r = (size_t)(row0 + ai * 128 + m * 16);
                    const u32x4 zz = zq[ai][m];
                    const f32x4 v0 = acc[ai][bj][m][0] + b0, v1 = acc[ai][bj][m][1] + b1;
                    float o[8];
#pragma unroll
                    for (int j = 0; j < 4; ++j) {
                        const float z0 = __uint_as_float((j & 1) ? (zz[j >> 1] & 0xffff0000u) : (zz[j >> 1] << 16));
                        const float z1 = __uint_as_float((j & 1) ? (zz[2 + (j >> 1)] & 0xffff0000u) : (zz[2 + (j >> 1)] << 16));
                        o[j] = z0 * sigmoidf_(v0[j]); o[4 + j] = z1 * sigmoidf_(v1[j]);
                    }
                    u32x4 w; w.x = pk2(o[0], o[1]); w.y = pk2(o[2], o[3]); w.z = pk2(o[4], o[5]); w.w = pk2(o[6], o[7]);
                    *(u32x4*)(O + r * DM + col0 + bj * 128) = w;
                }
        }
    }
};
#define GAS __attribute__((address_space(1)))
typedef GAS unsigned gu32;
typedef GAS unsigned long long gu64;
#define RLX_AGENT __ATOMIC_RELAXED, __HIP_MEMORY_SCOPE_AGENT
#define LDS_WAIT() asm volatile("s_waitcnt lgkmcnt(0)" ::: "memory")
#define VM_WAIT() asm volatile("s_waitcnt vmcnt(0)" ::: "memory")
__device__ __forceinline__ unsigned long long rt() { return __builtin_amdgcn_s_memrealtime(); }
#define XB_TMO      128
#define XB_XCNT(j)  (256  + 64 * (j))
#define XB_XSUB(j)  (1280 + 64 * (j))
#define XB_XGEN(j)  (2304 + 64 * (j))
#define XB_TOP      3328
#define XB_TOPGEN   3392
#define XCD_BAR_WORDS 3456
#define XB_SPIN_CAP (1u << 18)

__device__ __forceinline__ unsigned xb_ld(unsigned* p)              { return __hip_atomic_load(p, __ATOMIC_RELAXED, __HIP_MEMORY_SCOPE_AGENT); }
__device__ __forceinline__ unsigned xb_add(unsigned* p, unsigned v) { return __hip_atomic_fetch_add(p, v, __ATOMIC_RELAXED, __HIP_MEMORY_SCOPE_AGENT); }
__device__ __forceinline__ unsigned xb_xcc_id() { return (unsigned)__builtin_amdgcn_s_getreg((3 << 11) | 20) & 0xFu; }
#define XB_SPIN(cond, bar) do { unsigned _sp = 0; while (cond) { __builtin_amdgcn_s_sleep(1); \
    if ((++_sp & 255u) == 0u) { if (xb_ld(&(bar)[XB_TMO])) break; if (_sp > XB_SPIN_CAP) { atomicAdd(&(bar)[XB_TMO], 1u); break; } } } } while (0)

struct XcdBarrier {
    unsigned* bar; unsigned x;
    volatile LAS unsigned* st;
};

__device__ __forceinline__ XcdBarrier xcd_barrier_post(unsigned* bar, volatile LAS unsigned* st) {
    XcdBarrier b; b.bar = bar; b.x = xb_xcc_id(); b.st = st;
    if (threadIdx.x == 0) (void)xb_add(&bar[XB_XCNT(b.x)], 1u);
    return b;
}
__device__ __forceinline__ void xcd_barrier_complete(unsigned* bar, unsigned x, unsigned& nloc, unsigned& nx) {
    const unsigned G = gridDim.x * gridDim.y * gridDim.z;
    unsigned sum, cnt, mine, sp = 0u;
    for (;;) {
        sum = 0u; cnt = 0u; mine = 0u;
#pragma unroll
        for (unsigned j = 0; j < 16; ++j) { const unsigned c = xb_ld(&bar[XB_XCNT(j)]); sum += c; cnt += (c > 0u) ? 1u : 0u; mine = (j == x) ? c : mine; }
        if (sum == G) break;
        __builtin_amdgcn_s_sleep(1);
        if ((++sp & 255u) == 0u) { if (xb_ld(&bar[XB_TMO])) break; if (sp > XB_SPIN_CAP) { atomicAdd(&bar[XB_TMO], 1u); break; } }
    }
    nloc = mine > 0u ? mine : 1u; nx = cnt > 0u ? cnt : 1u;
}

__device__ __forceinline__ void xcd_barrier(const XcdBarrier& b) {
    asm volatile("s_waitcnt vmcnt(0)" ::: "memory");
    __syncthreads();
    if (threadIdx.x == 0) {
        unsigned* bar = b.bar;
        __builtin_amdgcn_s_waitcnt(0);
        unsigned nloc = b.st[0], nx = b.st[1];
        if (nloc == 0u) { xcd_barrier_complete(bar, b.x, nloc, nx); b.st[0] = nloc; b.st[1] = nx; }
        const unsigned old = xb_add(&bar[XB_XSUB(b.x)], 1u);
        const unsigned gen = old / nloc;
        if (old + 1u == (gen + 1u) * nloc) {
            __builtin_amdgcn_fence(__ATOMIC_RELEASE, "agent");
            asm volatile("s_waitcnt vmcnt(0)" ::: "memory");
            const unsigned og = xb_add(&bar[XB_TOP], 1u);
            const unsigned tg = og / nx;
            if (og + 1u == (tg + 1u) * nx) xb_add(&bar[XB_TOPGEN], 1u);
            else XB_SPIN(xb_ld(&bar[XB_TOPGEN]) == tg, bar);
            __builtin_amdgcn_fence(__ATOMIC_ACQUIRE, "agent");
            xb_add(&bar[XB_XGEN(b.x)], 1u);
            asm volatile("s_waitcnt vmcnt(0)" ::: "memory");
        } else {
            XB_SPIN(xb_ld(&bar[XB_XGEN(b.x)]) == gen, bar);
            __builtin_amdgcn_fence(__ATOMIC_ACQUIRE, "agent");
            asm volatile("s_waitcnt vmcnt(0)" ::: "memory");
        }
    }
    __syncthreads();
}

DI s16x4 vtr(const char* p) { typedef short v4i16_t __attribute__((ext_vector_type(4))); return __builtin_bit_cast(s16x4, __builtin_amdgcn_ds_read_tr16_b64_v4i16((LAS v4i16_t*)p)); }
typedef __bf16 bf16x2_t __attribute__((ext_vector_type(2)));
DI unsigned cvtpk(float lo, float hi) { f32x2_t v = {lo, hi}; bf16x2_t b = __builtin_convertvector(v, bf16x2_t); return __builtin_bit_cast(unsigned, b); }
DI int crow(int r, int h) { return (r & 3) + 8 * (r >> 2) + 4 * h; }
#define MFMA32(a, b, c) __builtin_amdgcn_mfma_f32_32x32x16_bf16((a), (b), (c), 0, 0, 0)
constexpr int ATT_BUF = 17408, ATT_KB = 9216;

template <int MODE>
DI void attn_unit(const bf16_t* __restrict__ P, int ld, int qoff, int koff, int voff, bf16_t* __restrict__ O, char* lds, int b, int head, int q0, float sink_l2) {
    const int tid = threadIdx.x, lane = tid & 63, wid = tid >> 6, r32 = lane & 31, hi = lane >> 5;
    const int kvh = head >> 2;
    const int qrow0 = (MODE == 1) ? (NLAT + b * CTXL) : (b * SEQ + q0);
    int lat0 = 0, nlat = 0;
    if (MODE == 0) { lat0 = 0; nlat = SEQ / 64; }
    if (MODE == 2) { const int lo = q0 - 128 < 0 ? 0 : q0 - 128; const int hi_ = q0 + 384 > SEQ ? SEQ : q0 + 384; lat0 = lo; nlat = (hi_ - lo) / 64; }
    const int NT = 4 + nlat;
#define KROW(t) ((t) < 4 ? (NLAT + b * CTXL + 64 * (t)) : (b * SEQ + lat0 + 64 * ((t) - 4)))
    const bf16_t* Qp = P + (size_t)(qrow0 + wid * 32 + r32) * ld + qoff + head * 64 + 8 * hi;
    bf16x8 qr[4];
#pragma unroll
    for (int ks = 0; ks < 4; ++ks) qr[ks] = *(const bf16x8*)(Qp + 16 * ks);
    const int srow = tid >> 3, sch = tid & 7;
    const bf16_t* kg = P + koff + kvh * 64 + sch * 8; const bf16_t* vg = P + voff + kvh * 64 + sch * 8;
    const int kw = srow * 144 + sch * 16, vw = ATT_KB + (sch >> 2) * 4096 + srow * 64 + (sch & 3) * 16;
    const int kr_off = r32 * 144 + 16 * hi;
    const int vr_off = ATT_KB + ((lane >> 4) & 1) * 32 + (lane & 3) * 8 + (4 * hi + ((lane & 15) >> 2)) * 64;
    u32x4 kreg, vreg;
    { const size_t r = (size_t)(KROW(0) + srow) * ld; kreg = *(const u32x4*)(kg + r); vreg = *(const u32x4*)(vg + r); }
    *(u32x4*)(lds + kw) = kreg; *(u32x4*)(lds + vw) = vreg;
    if (NT > 1) { const size_t r = (size_t)(KROW(1) + srow) * ld; kreg = *(const u32x4*)(kg + r); vreg = *(const u32x4*)(vg + r); }
    float m = -1e30f, l = 0.f; f32x16 o0 = {}, o1 = {};
    const int qpos = q0 + wid * 32 + r32;
    __syncthreads();
    for (int t = 0; t < NT; ++t) {
        const char* buf = lds + (t & 1) * ATT_BUF;
        bool need = true; int kpos0 = 0;
        if (MODE == 2 && t >= 4) { kpos0 = lat0 + 64 * (t - 4); const int ql = q0 + wid * 32; need = (kpos0 <= ql + 31 + 128) && (kpos0 + 63 >= ql - 128); }
        if (need) {
            f32x16 p0 = {}, p1 = {};
#pragma unroll
            for (int ks = 0; ks < 4; ++ks) {
                const bf16x8 k0 = *(const bf16x8*)(buf + kr_off + ks * 32), k1 = *(const bf16x8*)(buf + kr_off + 32 * 144 + ks * 32);
                p0 = MFMA32(k0, qr[ks], p0); p1 = MFMA32(k1, qr[ks], p1);
            }
            if (MODE == 2 && t >= 4) {
#pragma unroll
                for (int i = 0; i < 16; ++i) { const int kp = kpos0 + crow(i, hi); int d0 = qpos - kp; d0 = d0 < 0 ? -d0 : d0; int d1 = qpos - kp - 32; d1 = d1 < 0 ? -d1 : d1;
                    if (d0 > 128) p0[i] = -1e30f; if (d1 > 128) p1[i] = -1e30f; }
            }
            float mx = p0[0];
#pragma unroll
            for (int i = 1; i < 16; ++i) mx = fmaxf(mx, p0[i]);
#pragma unroll
            for (int i = 0; i < 16; ++i) mx = fmaxf(mx, p1[i]);
            mx = fmaxf(mx, __shfl_xor(mx, 32));
            const float mnew = fmaxf(m, mx); const float alpha = __builtin_amdgcn_exp2f(m - mnew); m = mnew;
            float rs = 0.f;
#pragma unroll
            for (int i = 0; i < 16; ++i) { p0[i] = __builtin_amdgcn_exp2f(p0[i] - m); rs += p0[i]; }
#pragma unroll
            for (int i = 0; i < 16; ++i) { p1[i] = __builtin_amdgcn_exp2f(p1[i] - m); rs += p1[i]; }
            l = l * alpha + rs;
#pragma unroll
            for (int i = 0; i < 16; ++i) { o0[i] *= alpha; o1[i] *= alpha; }
#pragma unroll
            for (int s = 0; s < 4; ++s) {
                u32x4 pw;
                if (s < 2) { pw[0] = cvtpk(p0[8 * (s & 1)], p0[8 * (s & 1) + 1]); pw[1] = cvtpk(p0[8 * (s & 1) + 2], p0[8 * (s & 1) + 3]); pw[2] = cvtpk(p0[8 * (s & 1) + 4], p0[8 * (s & 1) + 5]); pw[3] = cvtpk(p0[8 * (s & 1) + 6], p0[8 * (s & 1) + 7]); }
                else { pw[0] = cvtpk(p1[8 * (s & 1)], p1[8 * (s & 1) + 1]); pw[1] = cvtpk(p1[8 * (s & 1) + 2], p1[8 * (s & 1) + 3]); pw[2] = cvtpk(p1[8 * (s & 1) + 4], p1[8 * (s & 1) + 5]); pw[3] = cvtpk(p1[8 * (s & 1) + 6], p1[8 * (s & 1) + 7]); }
                const bf16x8 pb = __builtin_bit_cast(bf16x8, pw);
                const char* vb = buf + vr_off + s * 1024;
                const s16x4 a0 = vtr(vb), a1 = vtr(vb + 512), c0 = vtr(vb + 4096), c1 = vtr(vb + 4096 + 512);
                const bf16x8 va0 = (bf16x8){a0[0], a0[1], a0[2], a0[3], a1[0], a1[1], a1[2], a1[3]};
                const bf16x8 va1 = (bf16x8){c0[0], c0[1], c0[2], c0[3], c1[0], c1[1], c1[2], c1[3]};
                o0 = MFMA32(va0, pb, o0); o1 = MFMA32(va1, pb, o1);
            }
        }
        if (t + 1 < NT) {
            char* nb = lds + ((t + 1) & 1) * ATT_BUF;
            *(u32x4*)(nb + kw) = kreg; *(u32x4*)(nb + vw) = vreg;
            if (t + 2 < NT) { const size_t r = (size_t)(KROW(t + 2) + srow) * ld; kreg = *(const u32x4*)(kg + r); vreg = *(const u32x4*)(vg + r); }
        }
        __syncthreads();
    }
#undef KROW
    l += __shfl_xor(l, 32);
    if (MODE == 2) l += __builtin_amdgcn_exp2f(sink_l2 - m);
    const float inv = 1.f / l;
    bf16_t* Op = O + (size_t)(qrow0 + wid * 32 + r32) * DM + 512 + head * 64 + 4 * hi;
#pragma unroll
    for (int k = 0; k < 4; ++k) {
        u32x2 w0, w1;
        w0.x = pk2(o0[4 * k] * inv, o0[4 * k + 1] * inv); w0.y = pk2(o0[4 * k + 2] * inv, o0[4 * k + 3] * inv);
        w1.x = pk2(o1[4 * k] * inv, o1[4 * k + 1] * inv); w1.y = pk2(o1[4 * k + 2] * inv, o1[4 * k + 3] * inv);
        *(u32x2*)(Op + 8 * k) = w0; *(u32x2*)(Op + 32 + 8 * k) = w1;
    }
}

constexpr int RG_XA = 0, RG_XF = 9216, RG_GT = RG_XF + 64 * 65 * 4  , RG_SEG = RG_GT + 4 * 64 * 65 * 4  , RG_CAR = RG_SEG + 2 * 64 * 4 * 8  ;
template <int PASS>
DI void rg_item(const float* const* in, unsigned char* ws, char* lds, int item) {
    const int tid = threadIdx.x, lane = tid & 63, wid = tid >> 6;
    const int ci = item % 36, bh = item / 36, head = bh & 7, b = bh >> 3;
    const bf16_t* PROJ = (const bf16_t*)(ws + WS_PROJ);
    const int seqbase = ci < 4 ? NLAT + b * CTXL : b * SEQ, t0 = ci < 4 ? ci * 64 : (ci - 4) * 64, slen = ci < 4 ? CTXL : SEQ;
    bf16_t* XA = (bf16_t*)(lds + RG_XA); float* XF = (float*)(lds + RG_XF); float* GT = (float*)(lds + RG_GT); float* SEGL = (float*)(lds + RG_SEG); float* CAR = (float*)(lds + RG_CAR);
    float* TOT = (float*)(ws + WS_RGTOT);
    const int sdir = tid >> 8, sch = (tid >> 2) & 63, sseg = tid & 3;
    if (PASS == 2) {
        const int pos = sdir == 0 ? ci : (ci < 4 ? 3 - ci : 4 + (35 - ci));
        float pp[9], hh[9];
#pragma unroll
        for (int i = 0; i < 9; ++i) {
            const int k0 = sseg * 9 + i; const int k = k0 < 35 ? k0 : 35;
            const int ck = sdir == 0 ? k : (k < 4 ? 3 - k : 35 - (k - 4));
            const float* tp = TOT + ((size_t)((sdir * NB + b) * 36 + ck) * 2) * 512 + head * 64 + sch; pp[i] = tp[0]; hh[i] = tp[512];
        }
#pragma unroll
        for (int i = 0; i < 9; ++i) { if (sseg * 9 + i >= pos) { pp[i] = 1.f; hh[i] = 0.f; } }
        float Pc = 1.f, Hc = 0.f;
#pragma unroll
        for (int i = 0; i < 9; ++i) { Hc = pp[i] * Hc + hh[i]; Pc *= pp[i]; }
        SEGL[((sdir * 64 + sch) * 4 + sseg) * 2] = Pc; SEGL[((sdir * 64 + sch) * 4 + sseg) * 2 + 1] = Hc;
    }
    {
        const int tok = tid >> 3, cg8 = tid & 7, ch0 = head * 64 + cg8 * 8;
        const float* cw = in[13]; const float* cb = in[14];
        float x[8]; u32x4 uu4[4]; f32x4 wq[5][2];
#pragma unroll
        for (int j = 0; j < 4; ++j) { int tt = t0 + tok + j - 1; tt = tt < 0 ? 0 : (tt >= slen ? slen - 1 : tt); uu4[j] = *(const u32x4*)(PROJ + (size_t)(seqbase + tt) * EIN + ch0); }
#pragma unroll
        for (int j = 0; j < 4; ++j) { wq[j][0] = *(const f32x4*)(cw + j * 512 + ch0); wq[j][1] = *(const f32x4*)(cw + j * 512 + ch0 + 4); }
        wq[4][0] = *(const f32x4*)(cb + ch0); wq[4][1] = *(const f32x4*)(cb + ch0 + 4);
#pragma unroll
        for (int c = 0; c < 8; ++c) x[c] = wq[4][c >> 2][c & 3];
#pragma unroll
        for (int j = 0; j < 4; ++j) {
            const int tt = t0 + tok + j - 1; const float msk = (tt >= 0 && tt < slen) ? 1.f : 0.f;
#pragma unroll
            for (int c = 0; c < 8; ++c) { const float uv = __uint_as_float((c & 1) ? (uu4[j][c >> 1] & 0xffff0000u) : (uu4[j][c >> 1] << 16)); x[c] += (wq[j][c >> 2][c & 3] * msk) * uv; }
        }
        u32x4 w; w.x = pk2(x[0], x[1]); w.y = pk2(x[2], x[3]); w.z = pk2(x[4], x[5]); w.w = pk2(x[6], x[7]);
        *(u32x4*)(XA + tok * 72 + cg8 * 8) = w;
#pragma unroll
        for (int c = 0; c < 8; ++c) XF[tok * 65 + cg8 * 8 + c] = x[c];
    }
    __syncthreads();
    if (PASS == 2) {
        if (tid < 128) { const int d = tid >> 6, ch = tid & 63; float Hc = 0.f;
#pragma unroll
            for (int s = 0; s < 4; ++s) { const float p = SEGL[((d * 64 + ch) * 4 + s) * 2], h = SEGL[((d * 64 + ch) * 4 + s) * 2 + 1]; Hc = p * Hc + h; }
            CAR[d * 64 + ch] = Hc; }
    }
    {
        const int mi = wid & 3, th = wid >> 2, r32 = lane & 31, hi = lane >> 5;
        const bf16_t* W = (const bf16_t*)(ws + WS_RGW) + (size_t)(mi * 8 + head) * 4096;
        const float* bias = (mi & 1) ? in[18] : in[16]; const int dirm = mi >> 1;
#pragma unroll
        for (int nt = 0; nt < 2; ++nt) {
            f32x16 acc = {};
#pragma unroll
            for (int ks = 0; ks < 4; ++ks) {
                const bf16x8 a = *(const bf16x8*)(XA + (32 * th + r32) * 72 + 16 * ks + 8 * hi);
                const bf16x8 bfr = *(const bf16x8*)(W + (32 * nt + r32) * 64 + 16 * ks + 8 * hi);
                acc = MFMA32(a, bfr, acc);
            }
            const float bv = bias[dirm * 512 + head * 64 + 32 * nt + r32];
#pragma unroll
            for (int i = 0; i < 16; ++i) GT[(mi * 64 + 32 * th + crow(i, hi)) * 65 + 32 * nt + r32] = sigmoidf_(acc[i] + bv);
        }
    }
    __syncthreads();
    float av[16], bvv[16];
    {
        const float lam = in[19][sdir * 512 + head * 64 + sch];
        const float nl = -lam; const float sp = nl > 20.f ? nl : log1pf(__expf(nl));
        float hh = 0.f, PP = 1.f;
#pragma unroll
        for (int s = 0; s < 16; ++s) {
            const int k = 16 * sseg + s, tok = sdir == 0 ? k : 63 - k;
            const float r = GT[((2 * sdir) * 64 + tok) * 65 + sch], ig = GT[((2 * sdir + 1) * 64 + tok) * 65 + sch], x = XF[tok * 65 + sch];
            const float la = -8.f * r * sp; const float a = __expf(la); const float bb = __builtin_amdgcn_sqrtf(fmaxf(1.f - a * a, 0.f)) * (ig * x);
            av[s] = a; bvv[s] = bb; hh = a * hh + bb; PP *= a;
        }
        __syncthreads();
        SEGL[((sdir * 64 + sch) * 4 + sseg) * 2] = PP; SEGL[((sdir * 64 + sch) * 4 + sseg) * 2 + 1] = hh;
    }
    __syncthreads();
    {
        float c = (PASS == 2) ? CAR[sdir * 64 + sch] : 0.f; float Pt = 1.f;
        for (int s = 0; s < 4; ++s) { const float p = SEGL[((sdir * 64 + sch) * 4 + s) * 2], h = SEGL[((sdir * 64 + sch) * 4 + s) * 2 + 1];
            if (s < sseg) c = p * c + h;
            if (PASS == 1) { Pt *= p; if (s >= sseg && sseg == 0) {   } } }
        if (PASS == 1) {
            if (sseg == 3) {
                const float p3 = SEGL[((sdir * 64 + sch) * 4 + 3) * 2], h3 = SEGL[((sdir * 64 + sch) * 4 + 3) * 2 + 1];
                float* tp = TOT + ((size_t)((sdir * NB + b) * 36 + ci) * 2) * 512 + head * 64 + sch;
                tp[0] = Pt; tp[512] = p3 * c + h3;
            }
        } else {
            float h = c;
#pragma unroll
            for (int s = 0; s < 16; ++s) { const int k = 16 * sseg + s, tok = sdir == 0 ? k : 63 - k; h = av[s] * h + bvv[s]; GT[(sdir * 64 + tok) * 65 + sch] = h; }
        }
    }
    if (PASS == 2) {
        __syncthreads();
        const int tok = tid >> 3, cg8 = tid & 7, ch0 = head * 64 + cg8 * 8;
        const size_t row = (size_t)(seqbase + t0 + tok);
        const u32x4 gg = *(const u32x4*)(PROJ + row * EIN + 512 + ch0);
        float o[8];
#pragma unroll
        for (int c = 0; c < 8; ++c) { const float gt = __uint_as_float((c & 1) ? (gg[c >> 1] & 0xffff0000u) : (gg[c >> 1] << 16));
            const float y = GT[tok * 65 + cg8 * 8 + c] + GT[(64 + tok) * 65 + cg8 * 8 + c]; o[c] = y * gelu_tanh(gt); }
        u32x4 w; w.x = pk2(o[0], o[1]); w.y = pk2(o[2], o[3]); w.z = pk2(o[4], o[5]); w.w = pk2(o[6], o[7]);
        *(u32x4*)((bf16_t*)(ws + WS_MIX) + row * DM + ch0) = w;
    }
    __syncthreads();
}

DI void s5_pre_item(const float* const* in, unsigned char* ws, char* lds, int item) {
    const int tid = threadIdx.x; const int g = item >> 2, qq = item & 3;
    float* AP = (float*)lds;
    float* BB = AP + 2 * 33 * 64 * 2;
    float* CC = BB + 2 * 64 * 16 * 2;
    float* KT = CC + 2 * 16 * 64 * 2;
    const float* lam_re = in[24]; const float* lam_im = in[25]; const float* lstep = in[26];
    {
        const int p = tid & 63, d = (tid >> 6) & 1, j0 = tid >> 7;
        const float dt = __expf(lstep[d * 32 + g]); const float lr = lam_re[(d * 32 + g) * 64 + p], li = lam_im[(d * 32 + g) * 64 + p];
        for (int j = j0; j < 33; j += 4) { const float mag = __expf((float)j * lr * dt), ang = (float)j * li * dt; const int e = (d * 33 + j) * 64 + p; AP[e * 2] = mag * __cosf(ang); AP[e * 2 + 1] = mag * __sinf(ang); }
    }
    {
        float lr4[4], li4[4], br4[4], bi4[4], cr4[4], ci4[4], dt4[4];
#pragma unroll
        for (int i = 0; i < 4; ++i) { const int e = tid + i * NTHREADS; const int h = e & 15, p = (e >> 4) & 63, d = e >> 10;
            dt4[i] = lstep[d * 32 + g]; lr4[i] = lam_re[(d * 32 + g) * 64 + p]; li4[i] = lam_im[(d * 32 + g) * 64 + p];
            br4[i] = in[27][((size_t)(d * 32 + g) * 64 + p) * 16 + h]; bi4[i] = in[28][((size_t)(d * 32 + g) * 64 + p) * 16 + h];
            const int p2 = e & 63, h2 = (e >> 6) & 15; cr4[i] = in[29][((size_t)(d * 32 + g) * 16 + h2) * 64 + p2]; ci4[i] = in[30][((size_t)(d * 32 + g) * 16 + h2) * 64 + p2]; }
#pragma unroll
        for (int i = 0; i < 4; ++i) { const int e = tid + i * NTHREADS; const float dt = __expf(dt4[i]), lr = lr4[i], li = li4[i];
            const float mag = __expf(lr * dt), ang = li * dt; const float abr = mag * __cosf(ang), abi = mag * __sinf(ang);
            const float den = lr * lr + li * li, nr = abr - 1.f, ni = abi; const float kr = (nr * lr + ni * li) / den, ki = (ni * lr - nr * li) / den;
            BB[e * 2] = kr * br4[i] - ki * bi4[i]; BB[e * 2 + 1] = kr * bi4[i] + ki * br4[i]; CC[e * 2] = cr4[i]; CC[e * 2 + 1] = ci4[i]; }
    }
    __syncthreads();
    for (int task = tid; task < 64 * 16; task += NTHREADS) {
        const int dj = task >> 4, blk = task & 15, d = dj >> 5, j = dj & 31, ho0 = 4 * (blk >> 2), hi0 = 4 * (blk & 3);
        const int jmax = d == 0 ? 8 * qq + 7 : 31 - 8 * qq;
        if (j > jmax) continue;
        float acc4[4][4];
#pragma unroll
        for (int i = 0; i < 4; ++i)
#pragma unroll
            for (int k = 0; k < 4; ++k) acc4[i][k] = 0.f;
        const f32x2_t* ap = (const f32x2_t*)AP + (d * 33 + j) * 64; const f32x2_t* cp = (const f32x2_t*)CC + (d * 16 + ho0) * 64; const f32x4* bp = (const f32x4*)(BB + (size_t)(d * 64) * 16 * 2 + hi0 * 2);
#pragma unroll 2
        for (int p = 0; p < 64; ++p) {
            const f32x2_t av = ap[p]; const f32x4 b01 = bp[p * 8], b23 = bp[p * 8 + 1];
#pragma unroll
            for (int i = 0; i < 4; ++i) { const f32x2_t cv = cp[i * 64 + p]; const float xr = cv.x * av.x - cv.y * av.y, xi = cv.x * av.y + cv.y * av.x;
                acc4[i][0] += xr * b01.x - xi * b01.y; acc4[i][1] += xr * b01.z - xi * b01.w; acc4[i][2] += xr * b23.x - xi * b23.y; acc4[i][3] += xr * b23.z - xi * b23.w; }
        }
#pragma unroll
        for (int i = 0; i < 4; ++i) *(f32x4*)(KT + (d * 32 + j) * 256 + (ho0 + i) * 16 + hi0) = (f32x4){acc4[i][0], acc4[i][1], acc4[i][2], acc4[i][3]};
    }
    __syncthreads();
    bf16_t* Mg = (bf16_t*)(ws + WS_S5MF) + (size_t)g * 512 * 768; bf16_t* Eg = (bf16_t*)(ws + WS_S5E) + (size_t)g * 256 * 512; bf16_t* Fg = Mg + 512;
    const float dval = in[31][g * 16 + (tid & 15)];
    for (int e = tid; e < 128 * 512; e += NTHREADS) { const int k = e & 511, mr = e >> 9, m = qq * 128 + mr; const int t = m >> 4, ho = m & 15, tau = k >> 4, hi = k & 15;
        float v = 0.f; if (tau <= t) v += KT[(0 * 32 + (t - tau)) * 256 + ho * 16 + hi]; if (tau >= t) v += KT[(1 * 32 + (tau - t)) * 256 + ho * 16 + hi];
        if (tau == t && ho == hi) v += dval;
        Mg[(size_t)m * 768 + k] = (bf16_t)f2bf(v); }
    { const int d = qq >> 1, c = qq & 1;
      for (int e = tid; e < 64 * 512; e += NTHREADS) { const int k = e & 511, p = e >> 9, tau = k >> 4, hi = k & 15; const int j = d == 0 ? 31 - tau : tau;
          const float ar = AP[((d * 33 + j) * 64 + p) * 2], ai = AP[((d * 33 + j) * 64 + p) * 2 + 1]; const float br = BB[((d * 64 + p) * 16 + hi) * 2], bi = BB[((d * 64 + p) * 16 + hi) * 2 + 1];
          const float v = c ? (ar * bi + ai * br) : (ar * br - ai * bi);
          Eg[(size_t)(qq * 64 + p) * 512 + k] = (bf16_t)f2bf(v); } }
    for (int e = tid; e < 128 * 256; e += NTHREADS) { const int k = e & 255, mr = e >> 8, m = qq * 128 + mr, t = m >> 4, ho = m & 15; const int d = k >> 7, c = (k >> 6) & 1, p = k & 63;
        const int j = d == 0 ? t + 1 : 32 - t;
        const float ar = AP[((d * 33 + j) * 64 + p) * 2], ai = AP[((d * 33 + j) * 64 + p) * 2 + 1]; const float cr = CC[((d * 16 + ho) * 64 + p) * 2], ci = CC[((d * 16 + ho) * 64 + p) * 2 + 1];
        const float v = c ? -(cr * ai + ci * ar) : (cr * ar - ci * ai);
        Fg[(size_t)m * 768 + k] = (bf16_t)f2bf(v); }
    if (qq == 0) for (int e = tid; e < 2 * 64; e += NTHREADS) { const int p = e & 63, d = e >> 6; float* at = (float*)(ws + WS_S5AT) + ((size_t)(d * 32 + g) * 64 + p) * 2;
        at[0] = AP[((d * 33 + 32) * 64 + p) * 2]; at[1] = AP[((d * 33 + 32) * 64 + p) * 2 + 1]; }
    __syncthreads();
}
DI int s5_chunk_row(int n72) { const int b = n72 / 72, cc = n72 - b * 72; return cc < 8 ? NLAT + b * CTXL + 32 * cc : b * SEQ + 32 * (cc - 8); }
DI void s5_repack_chunk(unsigned char* ws, int n, int lane) {
    const bf16_t* src = (const bf16_t*)(ws + WS_PROJ) + (size_t)s5_chunk_row(n) * OIN + 8 * lane;
    bf16_t* dst = (bf16_t*)(ws + WS_UG) + ((size_t)(lane >> 1) * 768 + n) * 768 + (lane & 1) * 8;
    u32x4 v[8];
#pragma unroll
    for (int t0 = 0; t0 < 32; t0 += 8) {
#pragma unroll
        for (int i = 0; i < 8; ++i) v[i] = *(const u32x4*)(src + (size_t)(t0 + i) * OIN);
#pragma unroll
        for (int i = 0; i < 8; ++i) *(u32x4*)(dst + (t0 + i) * 16) = v[i];
    }
}
struct S5Order {
    int G, c, nb;
    __device__ bool next(int i, pg8::Unit& u) const { const int L = i * G + c; const int per = 3 * nb; if (L >= 32 * per) return false; const int g = L / per, r = L - g * per; u.pm = 3 * g + r / nb; u.pn = nb * g + r % nb; return true; }
    __device__ __forceinline__ void a_ready(const pg8::Unit&) const {}
    __device__ __forceinline__ void done(const pg8::Unit&) const {}
};
struct EpiS5L {
    static constexpr bool PERM = false, AFTER_DRAIN = false;
    float* L;
    __device__ __forceinline__ void operator()(const f32x4 (&acc)[2][2][4][2], const pg8::Unit& u, int wr, int wc, int fr, int fq) const {
        const int g = u.pn, mt = u.pm - 3 * g;
#pragma unroll
        for (int ai = 0; ai < 2; ++ai)
#pragma unroll
            for (int m = 0; m < 4; ++m) { const int n = mt * 256 + ai * 128 + wr * 64 + m * 16 + fr; if (n >= 576) continue;
                float* lp = L + ((size_t)n * 32 + g) * 256 + wc * 32 + 4 * fq;
#pragma unroll
                for (int bj = 0; bj < 2; ++bj)
#pragma unroll
                    for (int nn = 0; nn < 2; ++nn) *(f32x4*)(lp + bj * 128 + nn * 16) = acc[ai][bj][m][nn]; }
    }
};
struct EpiS5Y {
    static constexpr bool PERM = false, AFTER_DRAIN = false;
    bf16_t* Z;
    __device__ __forceinline__ void operator()(const f32x4 (&acc)[2][2][4][2], const pg8::Unit& u, int wr, int wc, int fr, int fq) const {
        const int g = u.pn >> 1, nh = u.pn & 1, mt = u.pm - 3 * g;
#pragma unroll
        for (int ai = 0; ai < 2; ++ai)
#pragma unroll
            for (int m = 0; m < 4; ++m) { const int n = mt * 256 + ai * 128 + wr * 64 + m * 16 + fr; const int b = n / 72, cc = n - b * 72; if (n >= 576 || cc < 8) continue;
                bf16_t* zp = Z + (size_t)(b * SEQ + 32 * (cc - 8)) * 512 + g * 16;
#pragma unroll
                for (int bj = 0; bj < 2; ++bj)
#pragma unroll
                    for (int nn = 0; nn < 2; ++nn) { const int mcol = nh * 256 + bj * 128 + wc * 32 + nn * 16 + 4 * fq, t = mcol >> 4, ho = mcol & 15; const f32x4 y = acc[ai][bj][m][nn];
                        u32x2 w; w.x = pk2(gelu_tanh(y.x), gelu_tanh(y.y)); w.y = pk2(gelu_tanh(y.z), gelu_tanh(y.w)); *(u32x2*)(zp + (size_t)t * 512 + ho) = w; } }
    }
};
DI void s5_scan_thread(unsigned char* ws, int gid) {
    const int p = gid & 63, d = (gid >> 6) & 1, g = (gid >> 7) & 31, b = gid >> 12;
    const float* at = (const float*)(ws + WS_S5AT) + ((size_t)(d * 32 + g) * 64 + p) * 2; const float ar = at[0], ai = at[1];
    const float* L = (const float*)(ws + WS_S5L); bf16_t* UG = (bf16_t*)(ws + WS_UG);
    float sr = 0.f, si = 0.f;
    for (int k0 = 0; k0 < 72; k0 += 8) {
        float lr8[8], li8[8];
#pragma unroll
        for (int i = 0; i < 8; ++i) { const int k = k0 + i; const int cc = d == 0 ? k : (k < 8 ? 7 - k : 71 - (k - 8)); const size_t lo = ((size_t)(b * 72 + cc) * 32 + g) * 256 + d * 128 + p; lr8[i] = L[lo]; li8[i] = L[lo + 64]; }
#pragma unroll
        for (int i = 0; i < 8; ++i) { const int k = k0 + i; const int cc = d == 0 ? k : (k < 8 ? 7 - k : 71 - (k - 8));
            if (cc >= 8) { bf16_t* so = UG + ((size_t)g * 768 + b * 72 + cc) * 768 + 512 + d * 128 + p; so[0] = (bf16_t)f2bf(sr); so[64] = (bf16_t)f2bf(si); }
            const float nr = ar * sr - ai * si + lr8[i], ni = ar * si + ai * sr + li8[i]; sr = nr; si = ni; }
    }
}

DI int up_row_map(int n) { return n < FH ? (n >> 7) * 256 + (n & 127) : ((n - FH) >> 7) * 256 + 128 + ((n - FH) & 127); }
DI void p0_transpose_item(const float* W, int K, int N, bf16_t* WT, bool upmap, float* scr, int item, int lane) {
    const int nblk = N / 32, kb = item / nblk, nb = item % nblk, k0 = 64 * kb, n0 = 32 * nb;
    float tv[32];
#pragma unroll
    for (int i = 0; i < 32; ++i) tv[i] = __builtin_nontemporal_load(W + (size_t)(k0 + 2 * i + (lane >> 5)) * N + n0 + (lane & 31));
#pragma unroll
    for (int i = 0; i < 32; ++i) scr[(2 * i + (lane >> 5)) * 33 + (lane & 31)] = tv[i];
    asm volatile("s_waitcnt lgkmcnt(0)" ::: "memory");
    const int c = lane & 7;
#pragma unroll
    for (int j = 0; j < 4; ++j) { const int n = (lane >> 3) + 8 * j; const float* s = scr + (8 * c) * 33 + n;
        u32x4 o; o.x = pk2(s[0 * 33], s[1 * 33]); o.y = pk2(s[2 * 33], s[3 * 33]); o.z = pk2(s[4 * 33], s[5 * 33]); o.w = pk2(s[6 * 33], s[7 * 33]);
        const int nr = upmap ? up_row_map(n0 + n) : n0 + n;
        *(u32x4*)(WT + (size_t)nr * K + k0 + 8 * c) = o; }
    asm volatile("s_waitcnt lgkmcnt(0)" ::: "memory");
}
DI void norm_row(const float* xrow, const float* g, const float* shift, const float* scale, bf16_t* o1, bf16_t* o2, int lane) {
    f32x4 v[4]; float s = 0.f;
#pragma unroll
    for (int j = 0; j < 4; ++j) { v[j] = *((const f32x4*)xrow + lane + 64 * j); s += (v[j].x * v[j].x + v[j].y * v[j].y) + (v[j].z * v[j].z + v[j].w * v[j].w); }
    const float rstd = rsqrtf(wave_sum(s) * (1.f / DM) + NORM_EPS);
#pragma unroll
    for (int j = 0; j < 4; ++j) {
        const f32x4 gg = *((const f32x4*)g + lane + 64 * j), sh = *((const f32x4*)shift + lane + 64 * j), sc = *((const f32x4*)scale + lane + 64 * j);
        const f32x4 y = (v[j] * rstd) * gg * (sc + 1.0f) + sh;
        u32x2 w; w.x = pk2(y.x, y.y); w.y = pk2(y.z, y.w);
        *((u32x2*)o1 + lane + 64 * j) = w; if (o2) *((u32x2*)o2 + lane + 64 * j) = w;
    }
}
DI void norm_phase(const float* hL, const float* hC, const float* g, const float* mod, int ish, int isc, bf16_t* XN, int nrows, int xne_row, int gw, int NGW, int lane) {
    for (int r = gw; r < nrows; r += NGW) {
        const bool isctx = r >= NLAT; const int bb = isctx ? 8 : r >> 11;
        const float* x = isctx ? hC + (size_t)(r - NLAT) * DM : hL + (size_t)r * DM;
        bf16_t* o2 = nullptr;
        if (xne_row >= 0) {
            const int t = isctx ? (r - NLAT) & 255 : r & 2047, slen = isctx ? CTXL : SEQ, s = isctx ? (r - NLAT) >> 8 : r >> 11;
            const int k = (t + 2) >> 6, pos = (t + 2) & 63;
            if (pos < 4 && k >= 1 && k <= slen / 64 - 1) { const int q = isctx ? NBND_LAT + s * 3 + (k - 1) : s * 31 + (k - 1); o2 = XN + (size_t)(xne_row + 4 * q + pos) * DM; }
        }
        norm_row(x, g, mod + (size_t)bb * 6144 + ish * 1024, mod + (size_t)bb * 6144 + isc * 1024, XN + (size_t)r * DM, o2, lane);
    }
}
DI void qknorm_phase(bf16_t* PROJ, int ld, int qoff, const float* qn, const float* kn, const float* rope, int gw, int NGW, int lane) {
    const float gq = qn[lane], gk = kn[lane];
    const int ridx = (lane >> 5) * 16 + (lane & 15); const bool second = (lane >> 4) & 1;
    for (int r = gw; r < MALL; r += NGW) {
        bf16_t* p = PROJ + (size_t)r * ld + qoff + lane;
        const bool lat = r < NLAT; float cs = 1.f, sn = 0.f;
        if (lat) { const int t = r & 2047; cs = rope[t * 32 + ridx]; sn = rope[SEQ * 32 + t * 32 + ridx]; }
        float v[10];
#pragma unroll
        for (int h = 0; h < 10; ++h) v[h] = bf2f(p[h * 64]);
#pragma unroll
        for (int h = 0; h < 10; ++h) {
            const float ss = wave_sum(v[h] * v[h]); float y = v[h] * rsqrtf(ss * (1.f / 64.f) + NORM_EPS) * (h < 8 ? gq : gk);
            const float yp = __shfl_xor(y, 16);
            if (lat) y = second ? (y * cs + yp * sn) : (y * cs - yp * sn);
            if (h < 8) y *= C2;
            p[h * 64] = (bf16_t)f2bf(y);
        }
    }
}

struct Args { const float* in[37]; float* out; unsigned char* ws; int ph_lo, ph_hi; };
constexpr int NPHASE = 19;

DI void p0_prologue(const Args& a, char* lds, int G, int rep) {
#ifdef P0_REP_EMPTY
    if (rep == 1) return;
#endif
    const int tid = threadIdx.x, lane = tid & 63, wid = tid >> 6;
    unsigned char* ws = a.ws;
    const int gw = blockIdx.x * NWAVES + wid, NGW = G * NWAVES;
    {
        const int gt = blockIdx.x * NTHREADS + tid, NGT = G * NTHREADS;
        float* rope = (float*)(ws + WS_ROPE);
        for (int e = gt; e < SEQ * 32; e += NGT) { const int t = e >> 5, idx = e & 31, i = idx & 15; const float pos = (float)((idx < 16) ? (t >> 6) : (t & 63));
            const float invf = powf(10000.0f, -(float)i / 16.0f); const float ang = pos * invf; rope[e] = cosf(ang); rope[SEQ * 32 + e] = sinf(ang); }
        bf16_t* rgw = (bf16_t*)(ws + WS_RGW);
        for (int e = gt; e < 4 * 8 * 4096; e += NGT) { const int k = e & 63, n = (e >> 6) & 63, hd = (e >> 12) & 7, mi = e >> 15; const int d = mi >> 1;
            const float* w = (mi & 1) ? a.in[17] : a.in[15]; rgw[e] = (bf16_t)f2bf(w[((size_t)(d * 8 + hd) * 64 + k) * 64 + n]); }
    }
    __syncthreads();
    {
        float* cond = (float*)lds;
        float* red = (float*)(lds + 1024 * 12 * 4);
        if (G < 256 || blockIdx.x >= 128) for (int e = tid; e < 9 * 1024; e += NTHREADS) { const int k = e & 1023, bb = e >> 10; const float cv = bb < 8 ? a.in[1][bb * 1024 + k] : a.in[3][k]; cond[k * 12 + bb] = siluf_(cv); }
        __syncthreads();
        float* MOD = (float*)(ws + WS_MOD);
        for (int it = (G >= 256 ? (int)blockIdx.x - 128 : (int)blockIdx.x); it < 2 * 96; it += (G >= 256 ? 128 : G)) { if (it < 0) break;
            const int layer = it / 96, cb = it % 96, col = cb * 64 + lane;
            const float* w = a.in[4] + (size_t)layer * DM * 6144 + col;
            float acc[9];
#pragma unroll
            for (int bb = 0; bb < 9; ++bb) acc[bb] = 0.f;
            for (int kk0 = 0; kk0 < 128; kk0 += 16) {
                float wv16[16];
#pragma unroll
                for (int i = 0; i < 16; ++i) wv16[i] = __builtin_nontemporal_load(w + (size_t)(wid * 128 + kk0 + i) * 6144);
#pragma unroll
                for (int i = 0; i < 16; ++i) { const int k = wid * 128 + kk0 + i; const float wv = wv16[i];
                    const f32x4 c0 = *(const f32x4*)(cond + k * 12), c1 = *(const f32x4*)(cond + k * 12 + 4); const float c8 = cond[k * 12 + 8];
                    acc[0] += c0.x * wv; acc[1] += c0.y * wv; acc[2] += c0.z * wv; acc[3] += c0.w * wv; acc[4] += c1.x * wv; acc[5] += c1.y * wv; acc[6] += c1.z * wv; acc[7] += c1.w * wv; acc[8] += c8 * wv; }
            }
#pragma unroll
            for (int bb = 0; bb < 9; ++bb) red[(wid * 9 + bb) * 64 + lane] = acc[bb];
            __syncthreads();
            for (int e = tid; e < 9 * 64; e += NTHREADS) { const int bb = e >> 6, ln = e & 63; float s = a.in[5][layer * 6144 + cb * 64 + ln];
#pragma unroll
                for (int w8 = 0; w8 < 8; ++w8) s += red[(w8 * 9 + bb) * 64 + ln];
                MOD[((size_t)layer * 9 + bb) * 6144 + cb * 64 + ln] = s; }
            __syncthreads();
        }
    }
    __syncthreads();
#ifdef P0_REP_MODONLY
    if (rep == 0)
#endif
    for (int it = blockIdx.x; it < 128; it += G) s5_pre_item(a.in, ws, lds, it);
    __syncthreads();
    {
        float* scr = (float*)(lds + wid * 16384);
        constexpr int I_IN0 = 16 * (EIN / 32), I_OUT = 16 * 32, I_UP = 16 * (FH2 / 32), I_DN = (FH / 64) * 32, I_IN1 = 16 * (OIN / 32), I_GLU = 8 * 16;
        constexpr int NIT = I_IN0 + I_OUT + I_UP + I_DN + I_IN1 + I_OUT + I_UP + I_DN + I_GLU;
        unsigned* wctr = (unsigned*)(ws + WS_CTL);
        for (;;) {
            int it = 0; if (lane == 0) it = (int)atomicAdd(wctr, 1u); it = __builtin_amdgcn_readfirstlane(it); if (it >= NIT) break;
            int r = it;
            if (r < I_UP) { p0_transpose_item(a.in[7], DM, FH2, (bf16_t*)(ws + WS_WUP0), true, scr, r, lane); continue; } r -= I_UP;
            if (r < I_UP) { p0_transpose_item(a.in[7] + (size_t)DM * FH2, DM, FH2, (bf16_t*)(ws + WS_WUP1), true, scr, r, lane); continue; } r -= I_UP;
            if (r < I_DN) { p0_transpose_item(a.in[10], FH, DM, (bf16_t*)(ws + WS_WDN0), false, scr, r, lane); continue; } r -= I_DN;
            if (r < I_DN) { p0_transpose_item(a.in[10] + (size_t)FH * DM, FH, DM, (bf16_t*)(ws + WS_WDN1), false, scr, r, lane); continue; } r -= I_DN;
            if (r < I_IN0) { p0_transpose_item(a.in[11], DM, EIN, (bf16_t*)(ws + WS_WIN0), false, scr, r, lane); continue; } r -= I_IN0;
            if (r < I_IN1) { p0_transpose_item(a.in[22], DM, OIN, (bf16_t*)(ws + WS_WIN1), false, scr, r, lane); continue; } r -= I_IN1;
            if (r < I_OUT) { p0_transpose_item(a.in[12], DM, DM, (bf16_t*)(ws + WS_WOUT0), false, scr, r, lane); continue; } r -= I_OUT;
            if (r < I_OUT) { p0_transpose_item(a.in[23], DM, DM, (bf16_t*)(ws + WS_WOUT1), false, scr, r, lane); continue; } r -= I_OUT;
            p0_transpose_item(a.in[32], 512, 512, (bf16_t*)(ws + WS_WGLU), false, scr, r, lane);
        }
    }
}

__global__ void __launch_bounds__(NTHREADS, 2) trunk_fwd(Args a) {
    extern __shared__ __attribute__((aligned(16))) unsigned char lds_raw[];
    char* lds = (char*)lds_raw;
    PG8_LAS unsigned char* ldsl = (PG8_LAS unsigned char*)lds_raw;
    cg::grid_group grid = cg::this_grid();
    const int tid = threadIdx.x, lane = tid & 63, wid = tid >> 6, G = gridDim.x;
    const int gw = blockIdx.x * NWAVES + wid, NGW = G * NWAVES;
    unsigned char* ws = a.ws;
    const int lo = a.ph_lo, hi = a.ph_hi;
    float* MOD = (float*)(ws + WS_MOD); float* HC = (float*)(ws + WS_HC);
    bf16_t* XN = (bf16_t*)(ws + WS_XN); bf16_t* PROJ = (bf16_t*)(ws + WS_PROJ); bf16_t* MIX = (bf16_t*)(ws + WS_MIX); bf16_t* HID = (bf16_t*)(ws + WS_HID);
    const float* rope = (const float*)(ws + WS_ROPE);
    volatile LAS unsigned* MISC = (volatile LAS unsigned*)((LAS unsigned char*)lds_raw + LDS_MISC);
    if (tid < 64) MISC[tid] = 0u;
    __syncthreads();
    XcdBarrier xbar; xbar.bar = (unsigned*)(ws + WS_CTL) + 4096; xbar.x = 0; xbar.st = nullptr;
    if (hi - lo > 1) xbar = xcd_barrier_post((unsigned*)(ws + WS_CTL) + 4096, MISC + 8);
#ifndef PHASE_MASK
#define PHASE_MASK 0x7ffff
#endif
#define IN(k) (((PHASE_MASK >> (k)) & 1) && lo <= (k) && (k) < hi)
#ifndef DUP_MASK
#define DUP_MASK 0
#endif
#define REP(k) for (int rep_ = 0; rep_ < (((DUP_MASK >> (k)) & 1) ? 2 : 1); ++rep_, (void)((((DUP_MASK >> (k)) & 1) && rep_ == 1) ? (xcd_barrier(xbar), 0) : 0))
#define SEAM(k) do { if (IN(k) && IN((k) + 1)) { if ((k) == 0) grid.sync(); else xcd_barrier(xbar); } } while (0)

    if (IN(0)) REP(0) { p0_prologue(a, lds, G, rep_); } SEAM(0);
    if (IN(1)) REP(1) norm_phase(a.in[0], a.in[2], a.in[6], MOD, 0, 1, XN, MALL, -1, gw, NGW, lane);
    SEAM(1);
    if (IN(2)) REP(2) { pg8::Gemm g{XN, (const bf16_t*)(ws + WS_WIN0), MALL, EIN, DM}; pg8::StaticOrder S; S.init(MALL, EIN, G, (int)blockIdx.x);
        pg8::EpiBf16<0> E{PROJ, EIN, nullptr, 0, 0, 1.f}; pg8::gemm_phase<pg8::EpiBf16<0>, pg8::StaticOrder, true, true>(ldsl, g, S, E); }
    SEAM(2);
    if (IN(3)) { qknorm_phase(PROJ, EIN, 1024, a.in[20], a.in[21], rope, gw, NGW, lane); __syncthreads();
#ifdef DUP_RG1
        for (int rep2_ = 0; rep2_ < 2; ++rep2_)
#endif
        for (int it = blockIdx.x; it < NB * 8 * 36; it += G) rg_item<1>(a.in, ws, lds, it); }
    SEAM(3);
    if (IN(4)) REP(4) {
#ifndef P4_NO_ATTN
#ifdef DUP_ATT
        for (int rep2_ = 0; rep2_ < 2; ++rep2_)
#endif
        for (int it = blockIdx.x; it < 512 + 64; it += G) {
            if (it < 512) { const int qb = it & 7, head = (it >> 3) & 7, b = it >> 6; attn_unit<0>(PROJ, EIN, 1024, 1536, 1664, MIX, lds, b, head, qb * 256, 0.f); }
            else { const int u = it - 512, head = u & 7, b = u >> 3; attn_unit<1>(PROJ, EIN, 1024, 1536, 1664, MIX, lds, b, head, 0, 0.f); }
        }
#endif
#ifndef P4_NO_RG
        for (int it = (blockIdx.x + G - 64) % G; it < NB * 8 * 36; it += G) rg_item<2>(a.in, ws, lds, it);
#endif
    }
    SEAM(4);
    if (IN(5)) REP(5) { pg8::Gemm g{MIX, (const bf16_t*)(ws + WS_WOUT0), MALL, DM, DM}; pg8::StaticOrder S; S.init(MALL, DM, G, (int)blockIdx.x);
        EpiRes E{a.in[0], a.in[2], a.out, HC, MOD + 2 * 1024}; pg8::gemm_phase<EpiRes, pg8::StaticOrder, true, true>(ldsl, g, S, E); }
    SEAM(5);
    if (IN(6)) REP(6) norm_phase(a.out, HC, a.in[6] + DM, MOD, 3, 4, XN, MALL, XNE_ROW_L0, gw, NGW, lane);
    SEAM(6);
    if (IN(7)) REP(7) { constexpr int MT = MALL + 1280; pg8::Gemm g{XN, (const bf16_t*)(ws + WS_WUP0), MT, FH2, DM}; pg8::StaticOrder S; S.init(MT, FH2, G, (int)blockIdx.x);
        EpiConvAct E{HID, a.in[8], a.in[9], MALL / 256, NBND_LAT, NBND_LAT + NBND_CTX, lds + 131072}; pg8::gemm_phase<EpiConvAct, pg8::StaticOrder, true, true>(ldsl, g, S, E); }
    SEAM(7);
    if (IN(8)) { pg8::Gemm g{HID, (const bf16_t*)(ws + WS_WDN0), MALL, DM, FH}; pg8::StaticOrder S; S.init(MALL, DM, G, (int)blockIdx.x);
        EpiRes E{a.out, HC, a.out, HC, MOD + 5 * 1024}; pg8::gemm_phase<EpiRes, pg8::StaticOrder, true, true>(ldsl, g, S, E); }
    SEAM(8);
    const float* MOD1 = MOD + 9 * 6144;
    if (IN(9)) REP(9) norm_phase(a.out, HC, a.in[6] + 2 * DM, MOD1, 0, 1, XN, MALL, -1, gw, NGW, lane);
    SEAM(9);
    if (IN(10)) REP(10) { pg8::Gemm g{XN, (const bf16_t*)(ws + WS_WIN1), MALL, OIN, DM}; pg8::StaticOrder S; S.init(MALL, OIN, G, (int)blockIdx.x);
        pg8::EpiBf16<0> E{PROJ, OIN, nullptr, 0, 0, 1.f}; pg8::gemm_phase<pg8::EpiBf16<0>, pg8::StaticOrder, true, true>(ldsl, g, S, E); }
    SEAM(10);
    if (IN(11)) { qknorm_phase(PROJ, OIN, 512, a.in[34], a.in[35], rope, gw, NGW, lane);
        for (int n = gw; n < 576; n += NGW) s5_repack_chunk(ws, n, lane);
        xcd_barrier(xbar);
        pg8::Gemm g{(const bf16_t*)(ws + WS_UG), (const bf16_t*)(ws + WS_S5E), 32 * 768, 32 * 256, 512, 768, 512}; S5Order S{G, (int)blockIdx.x, 1};
        EpiS5L E{(float*)(ws + WS_S5L)}; pg8::gemm_phase<EpiS5L, S5Order, true, true>(ldsl, g, S, E); }
    SEAM(11);
    if (IN(12)) REP(12) {
        { const int gt = blockIdx.x * NTHREADS + tid; if (gt < NB * 32 * 2 * 64) s5_scan_thread(ws, gt); }
        __syncthreads();
        const int nskip = (NB * 32 * 2 * 64) / NTHREADS;
        for (int it = (blockIdx.x + G - nskip) % G; it < 512; it += G) { const int qb = it & 7, head = (it >> 3) & 7, b = it >> 6;
            attn_unit<2>(PROJ, OIN, 512, 1024, 1152, MIX, lds, b, head, qb * 256, a.in[36][head] * 1.4426950408889634f); }
    }
    SEAM(12);
    if (IN(13)) REP(13) { pg8::Gemm g{(const bf16_t*)(ws + WS_UG), (const bf16_t*)(ws + WS_S5MF), 32 * 768, 32 * 512, 768, 768, 768}; S5Order S{G, (int)blockIdx.x, 2};
        EpiS5Y E{(bf16_t*)(ws + WS_Z)}; pg8::gemm_phase<EpiS5Y, S5Order, true, true>(ldsl, g, S, E); }
    SEAM(13);
    if (IN(14)) REP(14) { pg8::Gemm g{(const bf16_t*)(ws + WS_Z), (const bf16_t*)(ws + WS_WGLU), NLAT, 512, 512}; pg8::StaticOrder S; S.init(NLAT, 512, G, (int)blockIdx.x);
        EpiGlu E{(const bf16_t*)(ws + WS_Z), MIX, a.in[33]}; pg8::gemm_phase<EpiGlu, pg8::StaticOrder, true, true>(ldsl, g, S, E); }
    SEAM(14);
    if (IN(15)) { pg8::Gemm g{MIX, (const bf16_t*)(ws + WS_WOUT1), NLAT, DM, DM}; pg8::StaticOrder S; S.init(NLAT, DM, G, (int)blockIdx.x);
        EpiRes E{a.out, HC, a.out, HC, MOD1 + 2 * 1024}; pg8::gemm_phase<EpiRes, pg8::StaticOrder, true, true>(ldsl, g, S, E); }
    SEAM(15);
    if (IN(16)) REP(16) norm_phase(a.out, HC, a.in[6] + 3 * DM, MOD1, 3, 4, XN, NLAT, XNE_ROW_L1, gw, NGW, lane);
    SEAM(16);
    if (IN(17)) REP(17) { constexpr int MT = NLAT + 1024; pg8::Gemm g{XN, (const bf16_t*)(ws + WS_WUP1), MT, FH2, DM}; pg8::StaticOrder S; S.init(MT, FH2, G, (int)blockIdx.x);
        EpiConvAct E{HID, a.in[8] + 3 * FH2, a.in[9] + FH2, NLAT / 256, NBND_LAT, NBND_LAT, lds + 131072}; pg8::gemm_phase<EpiConvAct, pg8::StaticOrder, true, true>(ldsl, g, S, E); }
    SEAM(17);
    if (IN(18)) { pg8::Gemm g{HID, (const bf16_t*)(ws + WS_WDN1), NLAT, DM, FH}; pg8::StaticOrder S; S.init(NLAT, DM, G, (int)blockIdx.x);
        EpiRes E{a.out, HC, a.out, HC, MOD1 + 5 * 1024}; pg8::gemm_phase<EpiRes, pg8::StaticOrder, true, true>(ldsl, g, S, E); }
#undef IN
#undef SEAM
}

#ifndef N_LAUNCH_MODE
#define N_LAUNCH_MODE 1
#endif
extern "C" void kernel_launch(void* const* d_in, const int* in_sizes, int n_in, void* d_out, int out_size, void* d_ws, size_t ws_size, hipStream_t stream) {
    static int grid = 0;
    if (grid == 0) {
        if (n_in != 37 || out_size != NLAT * DM || ws_size < WS_END) { fprintf(stderr, "kernel_launch: unexpected problem (n_in %d out %d ws %zu)\n", n_in, out_size, ws_size); grid = -1; return; }
        int dev = 0, cus = 0, per_cu = 0;
        hipGetDevice(&dev); hipDeviceGetAttribute(&cus, hipDeviceAttributeMultiprocessorCount, dev);
        if (hipFuncSetAttribute((const void*)trunk_fwd, hipFuncAttributeMaxDynamicSharedMemorySize, LDS_BYTES) != hipSuccess) { fprintf(stderr, "kernel_launch: hipFuncSetAttribute failed\n"); grid = -1; return; }
        if (hipOccupancyMaxActiveBlocksPerMultiprocessor(&per_cu, (const void*)trunk_fwd, NTHREADS, LDS_BYTES) != hipSuccess || per_cu < 1) { fprintf(stderr, "kernel_launch: occupancy query says %d\n", per_cu); per_cu = 1; }
        (void)hipGetLastError();
        grid = cus;
        fprintf(stderr, "kernel_launch: grid %d (cus %d, per_cu %d)\n", grid, cus, per_cu);
    }
    if (grid < 0) return;
    (void)hipMemsetAsync((char*)d_ws + WS_CTL, 0, CTL_ZERO_BYTES, stream);
    Args a{};
    for (int i = 0; i < 37; ++i) a.in[i] = (const float*)d_in[i];
    a.out = (float*)d_out; a.ws = (unsigned char*)d_ws;
#if N_LAUNCH_MODE == 1
    a.ph_lo = 0; a.ph_hi = NPHASE;
    void* args[] = {&a};
    hipError_t e = hipLaunchCooperativeKernel((const void*)trunk_fwd, dim3(grid), dim3(NTHREADS), args, LDS_BYTES, stream);
    if (e != hipSuccess) fprintf(stderr, "cooperative launch failed: %s (grid %d)\n", hipGetErrorString(e), grid);
#else
    for (int p = 0; p < NPHASE; ++p) { a.ph_lo = p; a.ph_hi = p + 1; hipLaunchKernelGGL(trunk_fwd, dim3(grid), dim3(NTHREADS), LDS_BYTES, stream, a);
#ifdef DBG_CHECK
        Args d = a; d.ph_lo = 0; d.ph_hi = 0;
        static const int chk[NPHASE][2] = {{1,0},{0,0},{2,0},{3,0},{4,5},{6,0},{0,0},{7,8},{0,0},{0,0},{9,0},{10,0},{11,0},{12,0},{15,0},{0,0},{0,0},{14,0},{0,0}};
        for (int q = 0; q < 2; ++q) { const int st = chk[p][q]; if (!st) continue; const bool heavy = (st == 5 || st == 12); hipLaunchKernelGGL(dbg_check, dim3(heavy ? 1 : 4), dim3(heavy ? 64 : 256), 0, stream, d, st); }
        if (p == NPHASE - 1) hipLaunchKernelGGL(dbg_report, dim3(1), dim3(64), 0, stream, d);
#endif
    }
#endif
}
```

```cpp
#include <hip/hip_runtime.h>
#include <hip/hip_cooperative_groups.h>
#include <hip/hip_bf16.h>
#include <cstdio>
#include <cstdint>
#include <cmath>
namespace cg = cooperative_groups;
namespace pg8 {
#define PG8_LAS __attribute__((address_space(3)))
typedef unsigned short bf16_t;
typedef short bf16x8 __attribute__((ext_vector_type(8)));
typedef float f32x4 __attribute__((ext_vector_type(4)));
typedef unsigned u32x4 __attribute__((ext_vector_type(4)));
constexpr int BM = 256, BK = 64, HALF = 128, HTB = HALF * BK * 2  , STAGE_BYTES = 8 * HTB, NXCD = 8, WGM = 8;

__host__ __device__ __forceinline__ int lds_byte(int r, int c) { const int st = (r >> 4) * 2 + (c >> 5), rr = r & 15, cc = c & 31, ob = rr * 64 + cc * 2; return st * 1024 + (ob ^ (((ob >> 9) & 1) << 5)); }
__host__ __device__ __forceinline__ void stage_rc(int b, int& R, int& C) { const int st = b / 1024, sb = b % 1024, swz = sb ^ (((sb >> 9) & 1) << 5); R = (st >> 1) * 16 + swz / 64; C = (st & 1) * 32 + (swz % 64) / 2; }
__host__ __device__ __forceinline__ int perm32(int rho) { const int n = rho >> 4, i = rho & 15; return 8 * (i >> 2) + 4 * n + (i & 3); }

struct Unit { int pm, pn; };
struct Gemm { const bf16_t* A; const bf16_t* Bt; int M, N, K; int lda, ldb; };

struct StaticOrder {
    int nM, nN, nwg, G, c;
    __host__ __device__ void init(int M, int N, int G_, int c_) { nM = M / BM; nN = N / BM; nwg = nM * nN; G = G_; c = c_; }
    __host__ __device__ bool next(int i, Unit& u) const {
        const long L = (long)i * G + c; if (L >= nwg) return false;
        int wgid = (int)L; { const int q = nwg / NXCD, r = nwg % NXCD, xcd = wgid % NXCD, off = wgid / NXCD; wgid = (xcd < r ? xcd * (q + 1) : r * (q + 1) + (xcd - r) * q) + off; }
        const int nig = WGM * nN, gid = wgid / nig, fm = gid * WGM, gsz = (nM - fm) < WGM ? (nM - fm) : WGM;
        u.pm = fm + ((wgid % nig) % gsz); u.pn = (wgid % nig) / gsz; return true;
    }
    __device__ __forceinline__ void a_ready(const Unit&) const {}
    __device__ __forceinline__ void done(const Unit&) const {}
};

__device__ __forceinline__ unsigned cvt_pk_bf16(float lo, float hi) { unsigned r; asm volatile("v_cvt_pk_bf16_f32 %0, %1, %2" : "=v"(r) : "v"(lo), "v"(hi)); return r; }
typedef float f32x2 __attribute__((ext_vector_type(2)));
__device__ __forceinline__ f32x2 gelu_pk(f32x2 v) {
    const f32x2 av = __builtin_elementwise_abs(v), d = av * 0.2316418882f + 1.0f;
    f32x2 t; t.x = __builtin_amdgcn_rcpf(d.x); t.y = __builtin_amdgcn_rcpf(d.y);
    f32x2 q = t * 0.5307027145f + (-0.7265760135f); q = q * t + 0.7107068705f; q = q * t + (-0.142248368f); q = q * t + 0.127414796f; q = q * t;
    const f32x2 s = (v * v) * (-0.72134752044f);
    f32x2 e; e.x = __builtin_amdgcn_exp2f(s.x); e.y = __builtin_amdgcn_exp2f(s.y);
    const f32x2 m = v * (q * e), r = v - m;
    f32x2 o; o.x = v.x < 0.f ? m.x : r.x; o.y = v.y < 0.f ? m.y : r.y; return o;
}
template <int ACT  > struct EpiBf16 {
    static constexpr bool PERM = true, AFTER_DRAIN = false; static_assert(ACT == 0 || ACT == 1, "EpiBf16: ACT is 0 (none) or 1 (gelu_pk)");
    bf16_t* O; int ldc; const float* bias; int split_cols; size_t split_stride; float scale0;
    __device__ __forceinline__ void operator()(const f32x4 (&acc)[2][2][4][2], const Unit& u, int wr, int wc, int fr, int fq) const {
        const int row0 = u.pm * BM + wr * 64 + fr; int colt = u.pn * BM; bf16_t* base = O;
        float sc = 1.f; if (split_cols) { const int t = colt / split_cols; base += (size_t)t * split_stride; colt -= t * split_cols; if (t == 0) sc = scale0; }
        const int col0 = colt + wc * 32 + 8 * fq, bcol0 = u.pn * BM + wc * 32 + 8 * fq;
        f32x4 bv[2][2];
#pragma unroll
        for (int bj = 0; bj < 2; ++bj)
#pragma unroll
            for (int n = 0; n < 2; ++n) bv[bj][n] = bias ? *(const f32x4*)(bias + bcol0 + bj * HALF + 4 * n) : (f32x4){0.f, 0.f, 0.f, 0.f};
#pragma unroll
        for (int ai = 0; ai < 2; ++ai)
#pragma unroll
            for (int m = 0; m < 4; ++m) { bf16_t* rowp = base + (size_t)(row0 + ai * HALF + m * 16) * ldc + col0;
#pragma unroll
                for (int bj = 0; bj < 2; ++bj) { f32x4 v0 = acc[ai][bj][m][0] + bv[bj][0], v1 = acc[ai][bj][m][1] + bv[bj][1];
                    if (ACT == 1) { f32x2 a = gelu_pk((f32x2){v0[0], v0[1]}), b = gelu_pk((f32x2){v0[2], v0[3]}), c = gelu_pk((f32x2){v1[0], v1[1]}), d = gelu_pk((f32x2){v1[2], v1[3]});
                        v0 = (f32x4){a.x, a.y, b.x, b.y}; v1 = (f32x4){c.x, c.y, d.x, d.y}; }
                    v0 = v0 * sc; v1 = v1 * sc; u32x4 w; w.x = cvt_pk_bf16(v0[0], v0[1]); w.y = cvt_pk_bf16(v0[2], v0[3]); w.z = cvt_pk_bf16(v1[0], v1[1]); w.w = cvt_pk_bf16(v1[2], v1[3]);
                    *(u32x4*)(rowp + bj * HALF) = w; } }
    }
};
template <class Epi, class Sched, bool ALIGN_EPI = false, bool SP2 = false>
__device__ __forceinline__ void gemm_phase(PG8_LAS unsigned char* lds, const Gemm g, const Sched& S, const Epi& E) {
    const int tid = threadIdx.x, wid = __builtin_amdgcn_readfirstlane(tid >> 6), lane = tid & 63, wr = wid >> 2, wc = wid & 3, fr = lane & 15, fq = lane >> 4;
    const int K = g.K, nt = K / BK; const int lda = g.lda ? g.lda : K, ldb = g.ldb ? g.ldb : K;
    unsigned voffA[2], voffB[2];
#pragma unroll
    for (int i = 0; i < 2; ++i) { int R, C; stage_rc(tid * 16 + i * 8192, R, C); const int Rb = Epi::PERM ? ((R & ~31) + perm32(R & 31)) : R;
        voffA[i] = (unsigned)(R * lda + C) * 2u; voffB[i] = (unsigned)(Rb * ldb + C) * 2u; }
    const size_t kstep = (size_t)(BK * 2);
    const size_t hsA = (size_t)HALF * lda * 2, hsB = (size_t)HALF * ldb * 2;
    const size_t tsA = 2 * hsA, tsB = 2 * hsB;
    const unsigned ldsw = (unsigned)wid * 1024u;
    const int aoff = lds_byte(wr * 64 + fr, fq * 8), boff = lds_byte(wc * 32 + fr, fq * 8);
#define PG8_SA(b, h) (((b) * 2 + (h)) * HTB)
#define PG8_SB(b, h) ((4 + (b) * 2 + (h)) * HTB)
#define PG8_STAGE(bufoff, gbase, voff) do { _Pragma("unroll") for (int _i = 0; _i < 2; ++_i) \
        __builtin_amdgcn_global_load_lds((const unsigned*)((const char*)(gbase) + (voff)[_i]), (PG8_LAS unsigned*)(lds + (bufoff) + ldsw + _i * 8192), 16, 0, 0); } while (0)
#define PG8_LDA(dst, b, h) do { _Pragma("unroll") for (int m = 0; m < 4; ++m) _Pragma("unroll") for (int k = 0; k < 2; ++k) dst[m][k] = *(const PG8_LAS bf16x8*)(lds + PG8_SA(b, h) + aoff + m * 2048 + k * 1024); } while (0)
#define PG8_LDB(dst, b, h) do { _Pragma("unroll") for (int n = 0; n < 2; ++n) _Pragma("unroll") for (int k = 0; k < 2; ++k) dst[n][k] = *(const PG8_LAS bf16x8*)(lds + PG8_SB(b, h) + boff + n * 2048 + k * 1024); } while (0)
#define PG8_MMA(ai, bj, At, Bt) do { __builtin_amdgcn_s_setprio(1); _Pragma("unroll") for (int m = 0; m < 4; ++m) _Pragma("unroll") for (int n = 0; n < 2; ++n) _Pragma("unroll") for (int k = 0; k < 2; ++k) \
        acc[ai][bj][m][n] = __builtin_amdgcn_mfma_f32_16x16x32_bf16(Bt[n][k], At[m][k], acc[ai][bj][m][n], 0, 0, 0); __builtin_amdgcn_s_setprio(0); } while (0)
#define PG8_WAIT_V(n) asm volatile("s_waitcnt vmcnt(" #n ")" ::: "memory")
#define PG8_WAIT_L(n) asm volatile("s_waitcnt lgkmcnt(" #n ")" ::: "memory")
#define PG8_BAR __builtin_amdgcn_s_barrier()
#define PG8_SCHED __builtin_amdgcn_sched_barrier(0)
    Unit cur, nxt; int ui = 0;
    if (!S.next(0, cur)) return;
    f32x4 acc[2][2][4][2];
#pragma unroll
    for (int a = 0; a < 2; ++a)
#pragma unroll
        for (int b = 0; b < 2; ++b)
#pragma unroll
            for (int m = 0; m < 4; ++m)
#pragma unroll
                for (int n = 0; n < 2; ++n) acc[a][b][m][n] = (f32x4){0.f, 0.f, 0.f, 0.f};
    bf16x8 At[4][2], B0[2][2], B1[2][2];
    const char* cA = (const char*)g.A + (size_t)cur.pm * tsA; const char* cB = (const char*)g.Bt + (size_t)cur.pn * tsB;
    S.a_ready(cur);
    if constexpr (SP2) {
        PG8_STAGE(PG8_SB(0, 0), cB, voffB); PG8_STAGE(PG8_SB(0, 1), cB + hsB, voffB); PG8_STAGE(PG8_SA(0, 0), cA, voffA); PG8_STAGE(PG8_SA(0, 1), cA + hsA, voffA);
        if (wr == 1) PG8_BAR;
        PG8_WAIT_V(2); PG8_BAR;
        PG8_STAGE(PG8_SB(1, 0), cB + kstep, voffB); PG8_STAGE(PG8_SA(1, 0), cA + kstep, voffA); PG8_STAGE(PG8_SB(1, 1), cB + hsB + kstep, voffB);
        PG8_WAIT_V(6); PG8_BAR;
    } else {
        PG8_STAGE(PG8_SB(0, 0), cB, voffB); PG8_STAGE(PG8_SA(0, 0), cA, voffA); PG8_STAGE(PG8_SB(0, 1), cB + hsB, voffB); PG8_STAGE(PG8_SA(0, 1), cA + hsA, voffA);
        if (wr == 1) PG8_BAR;
        PG8_WAIT_V(4); PG8_BAR;
        PG8_STAGE(PG8_SB(1, 0), cB + kstep, voffB); PG8_STAGE(PG8_SA(1, 0), cA + kstep, voffA); PG8_STAGE(PG8_SB(1, 1), cB + hsB + kstep, voffB);
        PG8_WAIT_V(6); PG8_BAR;
    }
    for (;;) {
        const bool has_next = S.next(ui + 1, nxt);
        const char* nA = has_next ? (const char*)g.A + (size_t)nxt.pm * tsA : cA; const char* nB = has_next ? (const char*)g.Bt + (size_t)nxt.pn * tsB : cB;
        for (int t = 0; t < nt; t += 2) {
            const bool last = (t == nt - 2);
            const char* a1 = cA + (size_t)(t + 1) * kstep;
            const char* a2 = last ? nA : cA + (size_t)(t + 2) * kstep; const char* b2 = last ? nB : cB + (size_t)(t + 2) * kstep;
            const char* a3 = a2 + kstep; const char* b3 = b2 + kstep;
            if (last && has_next) S.a_ready(nxt);
            if constexpr (SP2) {
            PG8_LDB(B0, 0, 0); PG8_LDB(B1, 0, 1); PG8_SCHED; PG8_LDA(At, 0, 0); PG8_STAGE(PG8_SA(1, 1), a1 + hsA, voffA);
            PG8_WAIT_V(8); PG8_WAIT_L(0); PG8_BAR; PG8_MMA(0, 0, At, B0); PG8_MMA(0, 1, At, B1); PG8_BAR; PG8_SCHED;
            PG8_LDA(At, 0, 1); PG8_STAGE(PG8_SB(0, 0), b2, voffB); PG8_STAGE(PG8_SB(0, 1), b2 + hsB, voffB); PG8_STAGE(PG8_SA(0, 0), a2, voffA);
            PG8_WAIT_V(8); PG8_WAIT_L(0); PG8_BAR; PG8_MMA(1, 0, At, B0); PG8_MMA(1, 1, At, B1); PG8_BAR; PG8_SCHED;
            PG8_LDB(B0, 1, 0); PG8_LDB(B1, 1, 1); PG8_SCHED; PG8_LDA(At, 1, 0); PG8_STAGE(PG8_SA(0, 1), a2 + hsA, voffA);
            PG8_WAIT_V(8); PG8_WAIT_L(0); PG8_BAR; PG8_MMA(0, 0, At, B0); PG8_MMA(0, 1, At, B1); PG8_BAR; PG8_SCHED;
            PG8_LDA(At, 1, 1); PG8_STAGE(PG8_SB(1, 0), b3, voffB); PG8_STAGE(PG8_SB(1, 1), b3 + hsB, voffB); PG8_STAGE(PG8_SA(1, 0), a3, voffA);
            PG8_WAIT_V(8); PG8_WAIT_L(0); PG8_BAR; PG8_MMA(1, 0, At, B0); PG8_MMA(1, 1, At, B1); PG8_BAR; PG8_SCHED;
            } else {
            PG8_LDB(B0, 0, 0); PG8_SCHED; PG8_LDA(At, 0, 0); PG8_STAGE(PG8_SA(1, 1), a1 + hsA, voffA);
            PG8_WAIT_L(8); PG8_BAR; PG8_WAIT_L(0); PG8_MMA(0, 0, At, B0); PG8_BAR; PG8_SCHED;
            PG8_LDB(B1, 0, 1); PG8_STAGE(PG8_SB(0, 0), b2, voffB);
            PG8_BAR; PG8_WAIT_L(0); PG8_MMA(0, 1, At, B1); PG8_BAR;
            PG8_LDA(At, 0, 1); PG8_STAGE(PG8_SA(0, 0), a2, voffA);
            PG8_BAR; PG8_WAIT_L(0); PG8_MMA(1, 0, At, B0); PG8_BAR; PG8_SCHED;
            PG8_STAGE(PG8_SB(0, 1), b2 + hsB, voffB);
            PG8_WAIT_V(6); PG8_BAR; PG8_MMA(1, 1, At, B1); PG8_BAR;
            PG8_LDB(B0, 1, 0); PG8_SCHED; PG8_LDA(At, 1, 0); PG8_STAGE(PG8_SA(0, 1), a2 + hsA, voffA);
            PG8_WAIT_L(8); PG8_BAR; PG8_WAIT_L(0); PG8_MMA(0, 0, At, B0); PG8_BAR; PG8_SCHED;
            PG8_LDB(B1, 1, 1); PG8_STAGE(PG8_SB(1, 0), b3, voffB);
            PG8_BAR; PG8_WAIT_L(0); PG8_MMA(0, 1, At, B1); PG8_BAR;
            PG8_LDA(At, 1, 1); PG8_STAGE(PG8_SA(1, 0), a3, voffA);
            PG8_BAR; PG8_WAIT_L(0); PG8_MMA(1, 0, At, B0); PG8_BAR; PG8_SCHED;
            PG8_STAGE(PG8_SB(1, 1), b3 + hsB, voffB);
            PG8_WAIT_V(6); PG8_BAR; PG8_MMA(1, 1, At, B1); PG8_BAR;
            }
        }
        if constexpr (ALIGN_EPI) { if (wr == 0) PG8_BAR; }
        if constexpr (!Epi::AFTER_DRAIN) { E(acc, cur, wr, wc, fr, fq); S.done(cur); }
        if (!has_next) break;
#pragma unroll
        for (int a = 0; a < 2; ++a)
#pragma unroll
            for (int b = 0; b < 2; ++b)
#pragma unroll
                for (int m = 0; m < 4; ++m)
#pragma unroll
                    for (int n = 0; n < 2; ++n) acc[a][b][m][n] = (f32x4){0.f, 0.f, 0.f, 0.f};
        cur = nxt; cA = nA; cB = nB; ++ui;
        if constexpr (ALIGN_EPI) { if (wr == 1) PG8_BAR; }
    }
    PG8_WAIT_V(0);
    if constexpr (!ALIGN_EPI) { if (wr == 0) PG8_BAR; }
    PG8_BAR;
    if constexpr (Epi::AFTER_DRAIN) { E.fused(acc, cur, wr, wc, fr, fq, lds, wid, lane); S.done(cur); }
#undef PG8_SA
#undef PG8_SB
#undef PG8_STAGE
#undef PG8_LDA
#undef PG8_LDB
#undef PG8_MMA
#undef PG8_WAIT_V
#undef PG8_WAIT_L
#undef PG8_BAR
#undef PG8_SCHED
}
}

#define DI __device__ __forceinline__
typedef pg8::bf16_t bf16_t;
typedef short bf16x8 __attribute__((ext_vector_type(8)));
typedef short s16x4 __attribute__((ext_vector_type(4)));
typedef float f32x4 __attribute__((ext_vector_type(4)));
typedef float f32x16 __attribute__((ext_vector_type(16)));
typedef unsigned u32x4 __attribute__((ext_vector_type(4)));
typedef unsigned u32x2 __attribute__((ext_vector_type(2)));
#define LAS __attribute__((address_space(3)))
typedef float f32x2_t __attribute__((ext_vector_type(2)));

constexpr int DM = 1024, NB = 8, SEQ = 2048, CTXL = 256;
constexpr int NLAT = NB * SEQ, NCTX = NB * CTXL, MALL = NLAT + NCTX;
constexpr int FH = 2816, FH2 = 5632, EIN = 1792, OIN = 1280;
constexpr float NORM_EPS = 1e-6f;
constexpr float C2 = 0.125f * 1.4426950408889634f;
constexpr int NTHREADS = 512, NWAVES = 8;
constexpr int LDS_BYTES = 147456 + 8192 + 256, LDS_MISC = 147456 + 8192;
constexpr int NBND_LAT = NB * 31, NBND_CTX = NB * 3;
constexpr int XNE_ROW_L0 = MALL, XNE_ROW_L1 = NLAT;
constexpr int XN_ROWS = MALL + 1280;

constexpr size_t MiB = 1u << 20;
constexpr size_t WS_CTL = 0, CTL_ZERO_BYTES = 64 * 1024;
constexpr size_t WS_MOD = 1 * MiB;
constexpr size_t WS_ROPE = 2 * MiB;
constexpr size_t WS_RGW = 3 * MiB;
constexpr size_t WS_S5AT = 3 * MiB + 512 * 1024;
constexpr size_t WS_RGTOT = 4 * MiB;
constexpr size_t WS_S5E = 7 * MiB, WS_S5MF = 15 * MiB;
constexpr size_t WS_WIN0 = 39 * MiB, WS_WOUT0 = 43 * MiB, WS_WUP0 = 45 * MiB, WS_WDN0 = 56 * MiB;
constexpr size_t WS_WIN1 = 62 * MiB, WS_WOUT1 = 65 * MiB, WS_WUP1 = 67 * MiB, WS_WDN1 = 78 * MiB, WS_WGLU = 84 * MiB;
constexpr size_t WS_HC = 85 * MiB;
constexpr size_t WS_XN = 93 * MiB;
constexpr size_t WS_PROJ = 132 * MiB;
constexpr size_t WS_S5L = 177 * MiB;
constexpr size_t WS_MIX = 195 * MiB;
constexpr size_t WS_HID = 132 * MiB;
constexpr size_t WS_UG = WS_XN;
constexpr size_t WS_Z = 231 * MiB;
constexpr size_t WS_END = 250 * MiB;
static_assert(WS_XN + (size_t)XN_ROWS * DM * 2 <= WS_PROJ, "xn");
static_assert(WS_PROJ + (size_t)MALL * OIN * 2 <= WS_S5L && WS_S5L + (size_t)576 * 32 * 256 * 4 <= WS_MIX, "s5l");
static_assert((size_t)2 * MALL * 512 * 2 <= (size_t)XN_ROWS * DM * 2 && WS_Z + (size_t)MALL * 512 * 2 <= WS_END && WS_MIX + (size_t)MALL * DM * 2 <= WS_Z, "rg scratch");
static_assert(WS_HID + (size_t)MALL * FH * 2 <= WS_Z && WS_Z + (size_t)NLAT * 512 * 2 <= WS_END && (size_t)32 * 768 * 768 * 2 <= (size_t)XN_ROWS * DM * 2, "hid/z/ug");

DI float bf2f(bf16_t v) { return __uint_as_float((unsigned)v << 16); }
DI unsigned f2bf(float f) { unsigned u = __float_as_uint(f); return (u + 0x7fffu + ((u >> 16) & 1u)) >> 16; }
DI unsigned pk2(float lo, float hi) { return f2bf(lo) | (f2bf(hi) << 16); }
typedef __bf16 bf16x2v_t __attribute__((ext_vector_type(2)));
DI unsigned cvtpk_(float lo, float hi) { f32x2_t v = {lo, hi}; bf16x2v_t b = __builtin_convertvector(v, bf16x2v_t); return __builtin_bit_cast(unsigned, b); }
DI float wave_sum(float v) {
#pragma unroll
    for (int o = 1; o < 64; o <<= 1) v += __shfl_xor(v, o);
    return v;
}
DI float sigmoidf_(float x) { return __builtin_amdgcn_rcpf(1.f + __expf(-x)); }
DI float gelu_tanh(float x) { const float z = 1.5957691216057308f * (x + 0.044715f * x * x * x); return x * sigmoidf_(z); }
DI float siluf_(float x) { return x * sigmoidf_(x); }

struct EpiRes {
    static constexpr bool PERM = false, AFTER_DRAIN = false;
    const float* baseL; const float* baseC; float* outL; float* outC; const float* gate;
    __device__ __forceinline__ void operator()(const f32x4 (&acc)[2][2][4][2], const pg8::Unit& u, int wr, int wc, int fr, int fq) const {
        const bool isc = u.pm >= 64; const int bb = isc ? 8 : (u.pm >> 3);
        const float* base = isc ? baseC + (size_t)(u.pm - 64) * 256 * DM : baseL + (size_t)u.pm * 256 * DM;
        float* out = isc ? outC + (size_t)(u.pm - 64) * 256 * DM : outL + (size_t)u.pm * 256 * DM;
        const float* g = gate + (size_t)bb * 6144;
        const int col0 = u.pn * 256 + wc * 32 + 4 * fq;
#pragma unroll
        for (int bj = 0; bj < 2; ++bj)
#pragma unroll
            for (int n = 0; n < 2; ++n) {
                const int c = col0 + bj * 128 + n * 16; const f32x4 gv = *(const f32x4*)(g + c);
                f32x4 bs[2][4];
#pragma unroll
                for (int ai = 0; ai < 2; ++ai)
#pragma unroll
                    for (int m = 0; m < 4; ++m) bs[ai][m] = *(const f32x4*)(base + (size_t)(ai * 128 + wr * 64 + m * 16 + fr) * DM + c);
#pragma unroll
                for (int ai = 0; ai < 2; ++ai)
#pragma unroll
                    for (int m = 0; m < 4; ++m) *(f32x4*)(out + (size_t)(ai * 128 + wr * 64 + m * 16 + fr) * DM + c) = bs[ai][m] + gv * acc[ai][bj][m][n];
            }
    }
};

struct EpiCtxHalf {
    static constexpr bool PERM = false, AFTER_DRAIN = false;
    const float* baseC; float* outC; float* cp; const float* gate; int kh;
    __device__ __forceinline__ void operator()(const f32x4 (&acc)[2][2][4][2], const pg8::Unit& u, int wr, int wc, int fr, int fq) const {
        const size_t t0 = (size_t)(u.pm - 64) * 256 * DM; const float* g = gate + (size_t)8 * 6144;
        const int col0 = u.pn * 256 + wc * 32 + 4 * fq;
#pragma unroll
        for (int bj = 0; bj < 2; ++bj)
#pragma unroll
            for (int n = 0; n < 2; ++n) {
                const int c = col0 + bj * 128 + n * 16; const f32x4 gv = *(const f32x4*)(g + c);
                f32x4 bs[2][4];
#pragma unroll
                for (int ai = 0; ai < 2; ++ai)
#pragma unroll
                    for (int m = 0; m < 4; ++m) bs[ai][m] = kh == 0 ? *(const f32x4*)(baseC + t0 + (size_t)(ai * 128 + wr * 64 + m * 16 + fr) * DM + c) : (f32x4){0.f, 0.f, 0.f, 0.f};
                float* o = kh == 0 ? outC : cp;
#pragma unroll
                for (int ai = 0; ai < 2; ++ai)
#pragma unroll
                    for (int m = 0; m < 4; ++m) *(f32x4*)(o + t0 + (size_t)(ai * 128 + wr * 64 + m * 16 + fr) * DM + c) = bs[ai][m] + gv * acc[ai][bj][m][n];
            }
    }
};
struct CtxOrder {
    int c;
    __device__ bool next(int i, pg8::Unit& u) const { if (i != 0 || c < 0 || c >= 32) return false; u.pm = 64 + (c >> 2); u.pn = c & 3; return true; }
    __device__ __forceinline__ void a_ready(const pg8::Unit&) const {}
    __device__ __forceinline__ void done(const pg8::Unit&) const {}
};

struct EpiConvAct {
    static constexpr bool PERM = true, AFTER_DRAIN = false;
    bf16_t* H; const float* cw; const float* cb; int pm_edge; int nbnd_lat; int nbnd; char* xlds;
    __device__ __forceinline__ void operator()(const f32x4 (&acc)[2][2][4][2], const pg8::Unit& u, int wr_, int wc_, int fr_, int fq_) const {
        int tl = threadIdx.x; asm volatile("" : "+v"(tl));
        const int lane = tl & 63, wid_ = tl >> 6, fr = lane & 15, fq = lane >> 4, wr = wid_ >> 2, wc = wid_ & 3; (void)wr_; (void)wc_; (void)fr_; (void)fq_;
        const bool edge = u.pm >= pm_edge;
        const int hc0 = u.pn * 128 + wc * 32 + 8 * fq;
        u32x2* sc = (u32x2*)(xlds + wid_ * 2048);
        float* wl = (float*)(xlds + 16384 + wid_ * 1024);
        { const int p = lane >> 4, bjl = (lane >> 3) & 1, cg4 = lane & 7;
          const float* src = (p < 3 ? cw + p * FH2 : cb) + bjl * FH + u.pn * 128 + wc * 32 + 4 * cg4;
          *(f32x4*)(wl + (p * 2 + bjl) * 32 + 4 * cg4) = *(const f32x4*)src; }
        asm volatile("" ::: "memory");
#pragma unroll
        for (int n = 0; n < 2; ++n) {
#pragma unroll
            for (int ai = 0; ai < 2; ++ai) {
                float hvv[2][4][4];
#pragma unroll
                for (int bj = 0; bj < 2; ++bj) {
#pragma unroll
                    for (int m = 0; m < 4; ++m) { u32x2 w; w.x = cvtpk_(acc[ai][bj][m][n][0], acc[ai][bj][m][n][1]); w.y = cvtpk_(acc[ai][bj][m][n][2], acc[ai][bj][m][n][3]); sc[(16 * m + fr) * 4 + fq] = w; }
                    asm volatile("" ::: "memory");
                    const f32x4 w0 = *(const f32x4*)(wl + (0 * 2 + bj) * 32 + 8 * fq + 4 * n), w1 = *(const f32x4*)(wl + (1 * 2 + bj) * 32 + 8 * fq + 4 * n),
                                w2 = *(const f32x4*)(wl + (2 * 2 + bj) * 32 + 8 * fq + 4 * n), bb = *(const f32x4*)(wl + (3 * 2 + bj) * 32 + 8 * fq + 4 * n);
#pragma unroll
                    for (int m = 0; m < 4; ++m) {
                        const int row = 16 * m + fr; const int ru = row > 0 ? row - 1 : 0, rd = row < 63 ? row + 1 : 63;
                        u32x2 uu = sc[ru * 4 + fq], dd = sc[rd * 4 + fq];
                        if (row == 0) uu = (u32x2){0u, 0u}; if (row == 63) dd = (u32x2){0u, 0u};
                        const f32x4 up = (f32x4){__uint_as_float(uu.x << 16), __uint_as_float(uu.x & 0xffff0000u), __uint_as_float(uu.y << 16), __uint_as_float(uu.y & 0xffff0000u)};
                        const f32x4 dn = (f32x4){__uint_as_float(dd.x << 16), __uint_as_float(dd.x & 0xffff0000u), __uint_as_float(dd.y << 16), __uint_as_float(dd.y & 0xffff0000u)};
                        const f32x4 hv = bb + w0 * up + w1 * acc[ai][bj][m][n] + w2 * dn;
                        hvv[bj][m][0] = hv.x; hvv[bj][m][1] = hv.y; hvv[bj][m][2] = hv.z; hvv[bj][m][3] = hv.w;
                    }
                    asm volatile("" : "+v"(hvv[bj][0][0]), "+v"(hvv[bj][0][1]), "+v"(hvv[bj][0][2]), "+v"(hvv[bj][0][3]), "+v"(hvv[bj][1][0]), "+v"(hvv[bj][1][1]), "+v"(hvv[bj][1][2]), "+v"(hvv[bj][1][3]),
                                      "+v"(hvv[bj][2][0]), "+v"(hvv[bj][2][1]), "+v"(hvv[bj][2][2]), "+v"(hvv[bj][2][3]), "+v"(hvv[bj][3][0]), "+v"(hvv[bj][3][1]), "+v"(hvv[bj][3][2]), "+v"(hvv[bj][3][3]) :: "memory");
                }
#pragma unroll
                for (int m = 0; m < 4; ++m) {
                    const int R = ai * 128 + wr * 64 + m * 16 + fr;
                    long grow; bool st;
                    if (!edge) {
                        grow = (long)u.pm * 256 + R; st = true;
                        const int r64 = R & 63;
                        if (r64 == 0) st = (R == 0) && (u.pm >= 64 || (u.pm & 7) == 0);
                        if (r64 == 63) st = (R == 255) && (u.pm >= 64 || (u.pm & 7) == 7);
                    } else {
                        const int slot = (u.pm - pm_edge) * 256 + R, q = slot >> 2, pos = slot & 3;
                        st = (pos == 1 || pos == 2) && q < nbnd;
                        int row0;
                        if (q < nbnd_lat) { const int s = q / 31, k = q - s * 31 + 1; row0 = s * SEQ + 64 * k; }
                        else { const int q2 = q - nbnd_lat, s = q2 / 3, k = q2 - s * 3 + 1; row0 = NLAT + s * CTXL + 64 * k; }
                        grow = (long)row0 - 2 + pos;
                    }
                    if (st) { u32x2 w; w.x = cvtpk_(hvv[0][m][0] * siluf_(hvv[1][m][0]), hvv[0][m][1] * siluf_(hvv[1][m][1])); w.y = cvtpk_(hvv[0][m][2] * siluf_(hvv[1][m][2]), hvv[0][m][3] * siluf_(hvv[1][m][3]));
                        *(u32x2*)(H + (size_t)grow * FH + hc0 + 4 * n) = w; }
                }
                asm volatile("" ::: "memory"); __builtin_amdgcn_sched_barrier(0);
            }
        }
    }
};

struct EpiGlu {
    static constexpr bool PERM = true, AFTER_DRAIN = false;
    const bf16_t* Z; bf16_t* O; const float* bias;
    __device__ __forceinline__ void operator()(const f32x4 (&acc)[2][2][4][2], const pg8::Unit& u, int wr, int wc, int fr, int fq) const {
        const int row0 = u.pm * 256 + wr * 64 + fr; const int col0 = u.pn * 256 + wc * 32 + 8 * fq;
#pragma unroll
        for (int bj = 0; bj < 2; ++bj) {
            const f32x4 b0 = *(const f32x4*)(bias + col0 + bj * 128), b1 = *(const f32x4*)(bias + col0 + bj * 128 + 4);
            u32x4 zq[2][4];
#pragma unroll
            for (int ai = 0; ai < 2; ++ai)
#pragma unroll
                for (int m = 0; m < 4; ++m) zq[ai][m] = *(const u32x4*)(Z + (size_t)(row0 + ai * 128 + m * 16) * 512 + col0 + bj * 128);
#pragma unroll
            for (int ai = 0; ai < 2; ++ai)
#pragma unroll
                for (int m = 0; m < 4; ++m) {
                    const size_t r = (size_t)(row0 + ai * 128 + m * 16);
                    const u32x4 zz = zq[ai][m];
                    const f32x4 v0 = acc[ai][bj][m][0] + b0, v1 = acc[ai][bj][m][1] + b1;
                    float o[8];
#pragma unroll
                    for (int j = 0; j < 4; ++j) {
                        const float z0 = __uint_as_float((j & 1) ? (zz[j >> 1] & 0xffff0000u) : (zz[j >> 1] << 16));
                        const float z1 = __uint_as_float((j & 1) ? (zz[2 + (j >> 1)] & 0xffff0000u) : (zz[2 + (j >> 1)] << 16));
                        o[j] = z0 * sigmoidf_(v0[j]); o[4 + j] = z1 * sigmoidf_(v1[j]);
                    }
                    u32x4 w; w.x = pk2(o[0], o[1]); w.y = pk2(o[2], o[3]); w.z = pk2(o[4], o[5]); w.w = pk2(o[6], o[7]);
                    *(u32x4*)(O + r * DM + col0 + bj * 128) = w;
                }
        }
    }
};
#define GAS __attribute__((address_space(1)))
typedef GAS unsigned gu32;
typedef GAS unsigned long long gu64;
#define RLX_AGENT __ATOMIC_RELAXED, __HIP_MEMORY_SCOPE_AGENT
#define LDS_WAIT() asm volatile("s_waitcnt lgkmcnt(0)" ::: "memory")
#define VM_WAIT() asm volatile("s_waitcnt vmcnt(0)" ::: "memory")
__device__ __forceinline__ unsigned long long rt() { return __builtin_amdgcn_s_memrealtime(); }
#define XB_TMO      128
#define XB_XCNT(j)  (256  + 64 * (j))
#define XB_XSUB(j)  (1280 + 64 * (j))
#define XB_XGEN(j)  (2304 + 64 * (j))
#define XB_TOP      3328
#define XB_TOPGEN   3392
#define XCD_BAR_WORDS 3456
#define XB_SPIN_CAP (1u << 18)

__device__ __forceinline__ unsigned xb_ld(unsigned* p)              { return __hip_atomic_load(p, __ATOMIC_RELAXED, __HIP_MEMORY_SCOPE_AGENT); }
__device__ __forceinline__ unsigned xb_add(unsigned* p, unsigned v) { return __hip_atomic_fetch_add(p, v, __ATOMIC_RELAXED, __HIP_MEMORY_SCOPE_AGENT); }
__device__ __forceinline__ unsigned xb_xcc_id() { return (unsigned)__builtin_amdgcn_s_getreg((3 << 11) | 20) & 0xFu; }
#define XB_SPIN(cond, bar) do { unsigned _sp = 0; while (cond) { __builtin_amdgcn_s_sleep(1); \
    if ((++_sp & 255u) == 0u) { if (xb_ld(&(bar)[XB_TMO])) break; if (_sp > XB_SPIN_CAP) { atomicAdd(&(bar)[XB_TMO], 1u); break; } } } } while (0)

struct XcdBarrier {
    unsigned* bar; unsigned x;
    volatile LAS unsigned* st;
};

__device__ __forceinline__ XcdBarrier xcd_barrier_post(unsigned* bar, volatile LAS unsigned* st) {
    XcdBarrier b; b.bar = bar; b.x = xb_xcc_id(); b.st = st;
    if (threadIdx.x == 0) (void)xb_add(&bar[XB_XCNT(b.x)], 1u);
    return b;
}
__device__ __forceinline__ void xcd_barrier_complete(unsigned* bar, unsigned x, unsigned& nloc, unsigned& nx) {
    const unsigned G = gridDim.x * gridDim.y * gridDim.z;
    unsigned sum, cnt, mine, sp = 0u;
    for (;;) {
        sum = 0u; cnt = 0u; mine = 0u;
#pragma unroll
        for (unsigned j = 0; j < 16; ++j) { const unsigned c = xb_ld(&bar[XB_XCNT(j)]); sum += c; cnt += (c > 0u) ? 1u : 0u; mine = (j == x) ? c : mine; }
        if (sum == G) break;
        __builtin_amdgcn_s_sleep(1);
        if ((++sp & 255u) == 0u) { if (xb_ld(&bar[XB_TMO])) break; if (sp > XB_SPIN_CAP) { atomicAdd(&bar[XB_TMO], 1u); break; } }
    }
    nloc = mine > 0u ? mine : 1u; nx = cnt > 0u ? cnt : 1u;
}

__device__ __forceinline__ void xcd_barrier(const XcdBarrier& b) {
    asm volatile("s_waitcnt vmcnt(0)" ::: "memory");
    __syncthreads();
    if (threadIdx.x == 0) {
        unsigned* bar = b.bar;
        __builtin_amdgcn_s_waitcnt(0);
        unsigned nloc = b.st[0], nx = b.st[1];
        if (nloc == 0u) { xcd_barrier_complete(bar, b.x, nloc, nx); b.st[0] = nloc; b.st[1] = nx; }
        const unsigned old = xb_add(&bar[XB_XSUB(b.x)], 1u);
        const unsigned gen = old / nloc;
        if (old + 1u == (gen + 1u) * nloc) {
            __builtin_amdgcn_fence(__ATOMIC_RELEASE, "agent");
            asm volatile("s_waitcnt vmcnt(0)" ::: "memory");
            const unsigned og = xb_add(&bar[XB_TOP], 1u);
            const unsigned tg = og / nx;
            if (og + 1u == (tg + 1u) * nx) xb_add(&bar[XB_TOPGEN], 1u);
            else XB_SPIN(xb_ld(&bar[XB_TOPGEN]) == tg, bar);
            __builtin_amdgcn_fence(__ATOMIC_ACQUIRE, "agent");
            xb_add(&bar[XB_XGEN(b.x)], 1u);
            asm volatile("s_waitcnt vmcnt(0)" ::: "memory");
        } else {
            XB_SPIN(xb_ld(&bar[XB_XGEN(b.x)]) == gen, bar);
            __builtin_amdgcn_fence(__ATOMIC_ACQUIRE, "agent");
            asm volatile("s_waitcnt vmcnt(0)" ::: "memory");
        }
    }
    __syncthreads();
}

DI s16x4 vtr(const char* p) { typedef short v4i16_t __attribute__((ext_vector_type(4))); return __builtin_bit_cast(s16x4, __builtin_amdgcn_ds_read_tr16_b64_v4i16((LAS v4i16_t*)p)); }
typedef __bf16 bf16x2_t __attribute__((ext_vector_type(2)));
DI unsigned cvtpk(float lo, float hi) { f32x2_t v = {lo, hi}; bf16x2_t b = __builtin_convertvector(v, bf16x2_t); return __builtin_bit_cast(unsigned, b); }
DI int crow(int r, int h) { return (r & 3) + 8 * (r >> 2) + 4 * h; }
#define MFMA32(a, b, c) __builtin_amdgcn_mfma_f32_32x32x16_bf16((a), (b), (c), 0, 0, 0)
constexpr int ATT_BUF = 17408, ATT_KB = 9216;

template <int MODE>
DI void attn_unit(const bf16_t* __restrict__ P, int ld, int qoff, int koff, int voff, bf16_t* __restrict__ O, char* lds, int b, int head, int q0, float sink_l2) {
    const int tid = threadIdx.x, lane = tid & 63, wid = tid >> 6, r32 = lane & 31, hi = lane >> 5;
    const int kvh = head >> 2;
    const int qrow0 = (MODE == 1) ? (NLAT + b * CTXL) : (b * SEQ + q0);
    int lat0 = 0, nlat = 0;
    if (MODE == 0) { lat0 = 0; nlat = SEQ / 64; }
    if (MODE == 2) { const int lo = q0 - 128 < 0 ? 0 : q0 - 128; const int hi_ = q0 + 384 > SEQ ? SEQ : q0 + 384; lat0 = lo; nlat = (hi_ - lo) / 64; }
    const int NT = 4 + nlat;
#define KROW(t) ((t) < 4 ? (NLAT + b * CTXL + 64 * (t)) : (b * SEQ + lat0 + 64 * ((t) - 4)))
    const bf16_t* Qp = P + (size_t)(qrow0 + wid * 32 + r32) * ld + qoff + head * 64 + 8 * hi;
    bf16x8 qr[4];
#pragma unroll
    for (int ks = 0; ks < 4; ++ks) qr[ks] = *(const bf16x8*)(Qp + 16 * ks);
    const int srow = tid >> 3, sch = tid & 7;
    const bf16_t* kg = P + koff + kvh * 64 + sch * 8; const bf16_t* vg = P + voff + kvh * 64 + sch * 8;
    const int kw = srow * 144 + sch * 16, vw = ATT_KB + (sch >> 2) * 4096 + srow * 64 + (sch & 3) * 16;
    const int kr_off = r32 * 144 + 16 * hi;
    const int vr_off = ATT_KB + ((lane >> 4) & 1) * 32 + (lane & 3) * 8 + (4 * hi + ((lane & 15) >> 2)) * 64;
    u32x4 kreg, vreg;
    { const size_t r = (size_t)(KROW(0) + srow) * ld; kreg = *(const u32x4*)(kg + r); vreg = *(const u32x4*)(vg + r); }
    *(u32x4*)(lds + kw) = kreg; *(u32x4*)(lds + vw) = vreg;
    if (NT > 1) { const size_t r = (size_t)(KROW(1) + srow) * ld; kreg = *(const u32x4*)(kg + r); vreg = *(const u32x4*)(vg + r); }
    float m = 0.f, l = 0.f; f32x16 o0 = {}, o1 = {}, negm = {};
    const int qpos = q0 + wid * 32 + r32;
    __syncthreads();
    for (int t = 0; t < NT; ++t) {
        const char* buf = lds + (t & 1) * ATT_BUF;
        bool need = true; int kpos0 = 0;
        if (MODE == 2 && t >= 4) { kpos0 = lat0 + 64 * (t - 4); const int ql = q0 + wid * 32; need = (kpos0 <= ql + 31 + 128) && (kpos0 + 63 >= ql - 128); }
        if (need) {
            f32x16 p0 = negm, p1 = negm;
#pragma unroll
            for (int ks = 0; ks < 4; ++ks) {
                const bf16x8 k0 = *(const bf16x8*)(buf + kr_off + ks * 32), k1 = *(const bf16x8*)(buf + kr_off + 32 * 144 + ks * 32);
                p0 = MFMA32(k0, qr[ks], p0); p1 = MFMA32(k1, qr[ks], p1);
            }
            if (MODE == 2 && t >= 4) {
#pragma unroll
                for (int i = 0; i < 16; ++i) { const int kp = kpos0 + crow(i, hi); int d0 = qpos - kp; d0 = d0 < 0 ? -d0 : d0; int d1 = qpos - kp - 32; d1 = d1 < 0 ? -d1 : d1;
                    if (d0 > 128) p0[i] = -1e30f; if (d1 > 128) p1[i] = -1e30f; }
            }
            float mx = fmaxf(fmaxf(p0[0], p0[1]), p1[0]), mx2 = fmaxf(fmaxf(p0[2], p0[3]), p1[1]);
#pragma unroll
            for (int i = 4; i < 16; i += 4) { mx = fmaxf(fmaxf(mx, p0[i]), p0[i + 1]); mx2 = fmaxf(fmaxf(mx2, p0[i + 2]), p0[i + 3]); }
#pragma unroll
            for (int i = 2; i < 16; i += 2) { mx = fmaxf(fmaxf(mx, p1[i]), p1[i + 1]); }
            mx = fmaxf(mx, mx2); mx = fmaxf(mx, __shfl_xor(mx, 32));
            if (__any(mx > 8.f)) {
                const float dl = fmaxf(mx, 0.f); m += dl; const float f = __builtin_amdgcn_exp2f(-dl); l *= f;
#pragma unroll
                for (int i = 0; i < 16; ++i) { p0[i] -= dl; p1[i] -= dl; o0[i] *= f; o1[i] *= f; negm[i] = -m; }
            }
            float rs = 0.f, rs2 = 0.f;
#pragma unroll
            for (int i = 0; i < 16; ++i) { p0[i] = __builtin_amdgcn_exp2f(p0[i]); rs += p0[i]; }
#pragma unroll
            for (int i = 0; i < 16; ++i) { p1[i] = __builtin_amdgcn_exp2f(p1[i]); rs2 += p1[i]; }
            l += rs + rs2;
#pragma unroll
            for (int s = 0; s < 4; ++s) {
                u32x4 pw;
                if (s < 2) { pw[0] = cvtpk(p0[8 * (s & 1)], p0[8 * (s & 1) + 1]); pw[1] = cvtpk(p0[8 * (s & 1) + 2], p0[8 * (s & 1) + 3]); pw[2] = cvtpk(p0[8 * (s & 1) + 4], p0[8 * (s & 1) + 5]); pw[3] = cvtpk(p0[8 * (s & 1) + 6], p0[8 * (s & 1) + 7]); }
                else { pw[0] = cvtpk(p1[8 * (s & 1)], p1[8 * (s & 1) + 1]); pw[1] = cvtpk(p1[8 * (s & 1) + 2], p1[8 * (s & 1) + 3]); pw[2] = cvtpk(p1[8 * (s & 1) + 4], p1[8 * (s & 1) + 5]); pw[3] = cvtpk(p1[8 * (s & 1) + 6], p1[8 * (s & 1) + 7]); }
                const bf16x8 pb = __builtin_bit_cast(bf16x8, pw);
                const char* vb = buf + vr_off + s * 1024;
                const s16x4 a0 = vtr(vb), a1 = vtr(vb + 512), c0 = vtr(vb + 4096), c1 = vtr(vb + 4096 + 512);
                const bf16x8 va0 = (bf16x8){a0[0], a0[1], a0[2], a0[3], a1[0], a1[1], a1[2], a1[3]};
                const bf16x8 va1 = (bf16x8){c0[0], c0[1], c0[2], c0[3], c1[0], c1[1], c1[2], c1[3]};
                o0 = MFMA32(va0, pb, o0); o1 = MFMA32(va1, pb, o1);
            }
        }
        if (t + 1 < NT) {
            char* nb = lds + ((t + 1) & 1) * ATT_BUF;
            *(u32x4*)(nb + kw) = kreg; *(u32x4*)(nb + vw) = vreg;
            if (t + 2 < NT) { const size_t r = (size_t)(KROW(t + 2) + srow) * ld; kreg = *(const u32x4*)(kg + r); vreg = *(const u32x4*)(vg + r); }
        }
        __syncthreads();
    }
#undef KROW
    l += __shfl_xor(l, 32);
    if (MODE == 2) l += __builtin_amdgcn_exp2f(sink_l2 - m);
    const float inv = 1.f / l;
    bf16_t* Op = O + (size_t)(qrow0 + wid * 32 + r32) * DM + 512 + head * 64 + 4 * hi;
#pragma unroll
    for (int k = 0; k < 4; ++k) {
        u32x2 w0, w1;
        w0.x = pk2(o0[4 * k] * inv, o0[4 * k + 1] * inv); w0.y = pk2(o0[4 * k + 2] * inv, o0[4 * k + 3] * inv);
        w1.x = pk2(o1[4 * k] * inv, o1[4 * k + 1] * inv); w1.y = pk2(o1[4 * k + 2] * inv, o1[4 * k + 3] * inv);
        *(u32x2*)(Op + 8 * k) = w0; *(u32x2*)(Op + 32 + 8 * k) = w1;
    }
}

constexpr int RG_XA = 0, RG_XF = 9216, RG_GT = RG_XF + 64 * 65 * 4  , RG_SEG = RG_GT + 4 * 64 * 65 * 4  , RG_CAR = RG_SEG + 2 * 64 * 4 * 8  ;
DI bf16_t* rg_yl(unsigned char* ws) { return (bf16_t*)(ws + WS_XN); }
DI bf16_t* rg_pf(unsigned char* ws) { return (bf16_t*)(ws + WS_XN) + (size_t)MALL * 512; }
DI bf16_t* rg_pb(unsigned char* ws) { return (bf16_t*)(ws + WS_Z); }
DI void rg_item1(const float* const* in, unsigned char* ws, char* lds, int item) {
    const int tid = threadIdx.x, lane = tid & 63, wid = tid >> 6;
    const int ci = item % 36, bh = item / 36, head = bh & 7, b = bh >> 3;
    const bf16_t* PROJ = (const bf16_t*)(ws + WS_PROJ);
    const int seqbase = ci < 4 ? NLAT + b * CTXL : b * SEQ, t0 = ci < 4 ? ci * 64 : (ci - 4) * 64, slen = ci < 4 ? CTXL : SEQ;
    bf16_t* XA = (bf16_t*)(lds + RG_XA); float* XF = (float*)(lds + RG_XF); float* GT = (float*)(lds + RG_GT); float* SEGL = (float*)(lds + RG_SEG);
    float* TOT = (float*)(ws + WS_RGTOT);
    const int sdir = tid >> 8, sch = (tid >> 2) & 63, sseg = tid & 3;
    {
        const int tok = tid >> 3, cg8 = tid & 7, ch0 = head * 64 + cg8 * 8;
        const float* cw = in[13]; const float* cb = in[14];
        float x[8]; u32x4 uu4[4]; f32x4 wq[5][2];
#pragma unroll
        for (int j = 0; j < 4; ++j) { int tt = t0 + tok + j - 1; tt = tt < 0 ? 0 : (tt >= slen ? slen - 1 : tt); uu4[j] = *(const u32x4*)(PROJ + (size_t)(seqbase + tt) * EIN + ch0); }
#pragma unroll
        for (int j = 0; j < 4; ++j) { wq[j][0] = *(const f32x4*)(cw + j * 512 + ch0); wq[j][1] = *(const f32x4*)(cw + j * 512 + ch0 + 4); }
        wq[4][0] = *(const f32x4*)(cb + ch0); wq[4][1] = *(const f32x4*)(cb + ch0 + 4);
#pragma unroll
        for (int c = 0; c < 8; ++c) x[c] = wq[4][c >> 2][c & 3];
#pragma unroll
        for (int j = 0; j < 4; ++j) {
            const int tt = t0 + tok + j - 1; const float msk = (tt >= 0 && tt < slen) ? 1.f : 0.f;
#pragma unroll
            for (int c = 0; c < 8; ++c) { const float uv = __uint_as_float((c & 1) ? (uu4[j][c >> 1] & 0xffff0000u) : (uu4[j][c >> 1] << 16)); x[c] += (wq[j][c >> 2][c & 3] * msk) * uv; }
        }
        u32x4 w; w.x = pk2(x[0], x[1]); w.y = pk2(x[2], x[3]); w.z = pk2(x[4], x[5]); w.w = pk2(x[6], x[7]);
        *(u32x4*)(XA + tok * 72 + cg8 * 8) = w;
#pragma unroll
        for (int c = 0; c < 8; ++c) XF[tok * 65 + cg8 * 8 + c] = x[c];
    }
    __syncthreads();
    {
        const int mi = wid & 3, th = wid >> 2, r32 = lane & 31, hi = lane >> 5;
        const bf16_t* W = (const bf16_t*)(ws + WS_RGW) + (size_t)(mi * 8 + head) * 4096;
        const float* bias = (mi & 1) ? in[18] : in[16]; const int dirm = mi >> 1;
#pragma unroll
        for (int nt = 0; nt < 2; ++nt) {
            f32x16 acc = {};
#pragma unroll
            for (int ks = 0; ks < 4; ++ks) {
                const bf16x8 a = *(const bf16x8*)(XA + (32 * th + r32) * 72 + 16 * ks + 8 * hi);
                const bf16x8 bfr = *(const bf16x8*)(W + (32 * nt + r32) * 64 + 16 * ks + 8 * hi);
                acc = MFMA32(a, bfr, acc);
            }
            const float bv = bias[dirm * 512 + head * 64 + 32 * nt + r32];
#pragma unroll
            for (int i = 0; i < 16; ++i) GT[(mi * 64 + 32 * th + crow(i, hi)) * 65 + 32 * nt + r32] = sigmoidf_(acc[i] + bv);
        }
    }
    __syncthreads();
    float av[16], bvv[16];
    {
        const float lam = in[19][sdir * 512 + head * 64 + sch];
        const float nl = -lam; const float sp = nl > 20.f ? nl : log1pf(__expf(nl));
        float hh = 0.f, PP = 1.f;
#pragma unroll
        for (int s = 0; s < 16; ++s) {
            const int k = 16 * sseg + s, tok = sdir == 0 ? k : 63 - k;
            const float r = GT[((2 * sdir) * 64 + tok) * 65 + sch], ig = GT[((2 * sdir + 1) * 64 + tok) * 65 + sch], x = XF[tok * 65 + sch];
            const float la = -8.f * r * sp; const float a = __expf(la); const float bb = __builtin_amdgcn_sqrtf(fmaxf(1.f - a * a, 0.f)) * (ig * x);
            av[s] = a; bvv[s] = bb; hh = a * hh + bb; PP *= a;
        }
        __syncthreads();
        SEGL[((sdir * 64 + sch) * 4 + sseg) * 2] = PP; SEGL[((sdir * 64 + sch) * 4 + sseg) * 2 + 1] = hh;
    }
    __syncthreads();
    {
        float c = 0.f, Pbef = 1.f, Pt = 1.f;
#pragma unroll
        for (int s = 0; s < 4; ++s) { const float p = SEGL[((sdir * 64 + sch) * 4 + s) * 2], h = SEGL[((sdir * 64 + sch) * 4 + s) * 2 + 1];
            if (s < sseg) { c = p * c + h; Pbef *= p; } Pt *= p; }
        float h = c, P = Pbef;
#pragma unroll
        for (int s = 0; s < 16; ++s) { const int k = 16 * sseg + s, tok = sdir == 0 ? k : 63 - k; h = av[s] * h + bvv[s]; P *= av[s];
            GT[(sdir * 64 + tok) * 65 + sch] = h; GT[((2 + sdir) * 64 + tok) * 65 + sch] = P; }
        if (sseg == 3) { float* tp = TOT + ((size_t)((sdir * NB + b) * 36 + ci) * 2) * 512 + head * 64 + sch; tp[0] = Pt; tp[512] = h; }
    }
    __syncthreads();
    {
        const int tok = tid >> 3, cg8 = tid & 7, ch0 = head * 64 + cg8 * 8;
        const size_t off = (size_t)(seqbase + t0 + tok) * 512 + ch0;
        float y[8], pf[8], pb[8];
#pragma unroll
        for (int c = 0; c < 8; ++c) { y[c] = GT[tok * 65 + cg8 * 8 + c] + GT[(64 + tok) * 65 + cg8 * 8 + c]; pf[c] = GT[(128 + tok) * 65 + cg8 * 8 + c]; pb[c] = GT[(192 + tok) * 65 + cg8 * 8 + c]; }
        u32x4 w; w.x = pk2(y[0], y[1]); w.y = pk2(y[2], y[3]); w.z = pk2(y[4], y[5]); w.w = pk2(y[6], y[7]); *(u32x4*)(rg_yl(ws) + off) = w;
        w.x = pk2(pf[0], pf[1]); w.y = pk2(pf[2], pf[3]); w.z = pk2(pf[4], pf[5]); w.w = pk2(pf[6], pf[7]); *(u32x4*)(rg_pf(ws) + off) = w;
        w.x = pk2(pb[0], pb[1]); w.y = pk2(pb[2], pb[3]); w.z = pk2(pb[4], pb[5]); w.w = pk2(pb[6], pb[7]); *(u32x4*)(rg_pb(ws) + off) = w;
    }
    __syncthreads();
}
DI void rg_item2(const float* const* in, unsigned char* ws, char* lds, int item) {
    const int tid = threadIdx.x;
    const int ci = item % 36, bh = item / 36, head = bh & 7, b = bh >> 3;
    const bf16_t* PROJ = (const bf16_t*)(ws + WS_PROJ);
    const int seqbase = ci < 4 ? NLAT + b * CTXL : b * SEQ, t0 = ci < 4 ? ci * 64 : (ci - 4) * 64;
    float* SEGL = (float*)(lds + RG_SEG); float* CAR = (float*)(lds + RG_CAR);
    const float* TOT = (const float*)(ws + WS_RGTOT);
    const int sdir = tid >> 8, sch = (tid >> 2) & 63, sseg = tid & 3;
    const int tok = tid >> 3, cg8 = tid & 7, ch0 = head * 64 + cg8 * 8;
    const size_t row = (size_t)(seqbase + t0 + tok); const size_t off = row * 512 + ch0;
    const u32x4 yv = *(const u32x4*)(rg_yl(ws) + off), pfv = *(const u32x4*)(rg_pf(ws) + off), pbv = *(const u32x4*)(rg_pb(ws) + off), gg = *(const u32x4*)(PROJ + row * EIN + 512 + ch0);
    {
        const int pos = sdir == 0 ? ci : (ci < 4 ? 3 - ci : 4 + (35 - ci));
        float pp[9], hh[9];
#pragma unroll
        for (int i = 0; i < 9; ++i) { const int k0 = sseg * 9 + i; const int k = k0 < 35 ? k0 : 35; const int ck = sdir == 0 ? k : (k < 4 ? 3 - k : 35 - (k - 4));
            const float* tp = TOT + ((size_t)((sdir * NB + b) * 36 + ck) * 2) * 512 + head * 64 + sch; pp[i] = tp[0]; hh[i] = tp[512]; }
#pragma unroll
        for (int i = 0; i < 9; ++i) { if (sseg * 9 + i >= pos) { pp[i] = 1.f; hh[i] = 0.f; } }
        float Pc = 1.f, Hc = 0.f;
#pragma unroll
        for (int i = 0; i < 9; ++i) { Hc = pp[i] * Hc + hh[i]; Pc *= pp[i]; }
        SEGL[((sdir * 64 + sch) * 4 + sseg) * 2] = Pc; SEGL[((sdir * 64 + sch) * 4 + sseg) * 2 + 1] = Hc;
    }
    __syncthreads();
    if (tid < 128) { const int d = tid >> 6, ch = tid & 63; float Hc = 0.f;
#pragma unroll
        for (int s = 0; s < 4; ++s) { const float p = SEGL[((d * 64 + ch) * 4 + s) * 2], h = SEGL[((d * 64 + ch) * 4 + s) * 2 + 1]; Hc = p * Hc + h; }
        CAR[d * 64 + ch] = Hc; }
    __syncthreads();
    {
        float o[8];
#pragma unroll
        for (int c = 0; c < 8; ++c) {
            const float yl = __uint_as_float((c & 1) ? (yv[c >> 1] & 0xffff0000u) : (yv[c >> 1] << 16)), pf = __uint_as_float((c & 1) ? (pfv[c >> 1] & 0xffff0000u) : (pfv[c >> 1] << 16));
            const float pb = __uint_as_float((c & 1) ? (pbv[c >> 1] & 0xffff0000u) : (pbv[c >> 1] << 16)), gt = __uint_as_float((c & 1) ? (gg[c >> 1] & 0xffff0000u) : (gg[c >> 1] << 16));
            const float y = yl + pf * CAR[cg8 * 8 + c] + pb * CAR[64 + cg8 * 8 + c]; o[c] = y * gelu_tanh(gt); }
        u32x4 w; w.x = pk2(o[0], o[1]); w.y = pk2(o[2], o[3]); w.z = pk2(o[4], o[5]); w.w = pk2(o[6], o[7]);
        *(u32x4*)((bf16_t*)(ws + WS_MIX) + row * DM + ch0) = w;
    }
    __syncthreads();
}

DI void s5_pre_item(const float* const* in, unsigned char* ws, char* lds, int item) {
    const int tid = threadIdx.x; const int g = item >> 2, qq = item & 3;
    float* AP = (float*)lds;
    float* BB = AP + 2 * 33 * 64 * 2;
    float* CC = BB + 2 * 64 * 16 * 2;
    float* KT = CC + 2 * 16 * 64 * 2;
    const float* lam_re = in[24]; const float* lam_im = in[25]; const float* lstep = in[26];
    {
        const int p = tid & 63, d = (tid >> 6) & 1, j0 = tid >> 7;
        const float dt = __expf(lstep[d * 32 + g]); const float lr = lam_re[(d * 32 + g) * 64 + p], li = lam_im[(d * 32 + g) * 64 + p];
        for (int j = j0; j < 33; j += 4) { const float mag = __expf((float)j * lr * dt), ang = (float)j * li * dt; const int e = (d * 33 + j) * 64 + p; AP[e * 2] = mag * __cosf(ang); AP[e * 2 + 1] = mag * __sinf(ang); }
    }
    {
        float lr4[4], li4[4], br4[4], bi4[4], cr4[4], ci4[4], dt4[4];
#pragma unroll
        for (int i = 0; i < 4; ++i) { const int e = tid + i * NTHREADS; const int h = e & 15, p = (e >> 4) & 63, d = e >> 10;
            dt4[i] = lstep[d * 32 + g]; lr4[i] = lam_re[(d * 32 + g) * 64 + p]; li4[i] = lam_im[(d * 32 + g) * 64 + p];
            br4[i] = in[27][((size_t)(d * 32 + g) * 64 + p) * 16 + h]; bi4[i] = in[28][((size_t)(d * 32 + g) * 64 + p) * 16 + h];
            const int p2 = e & 63, h2 = (e >> 6) & 15; cr4[i] = in[29][((size_t)(d * 32 + g) * 16 + h2) * 64 + p2]; ci4[i] = in[30][((size_t)(d * 32 + g) * 16 + h2) * 64 + p2]; }
#pragma unroll
        for (int i = 0; i < 4; ++i) { const int e = tid + i * NTHREADS; const float dt = __expf(dt4[i]), lr = lr4[i], li = li4[i];
            const float mag = __expf(lr * dt), ang = li * dt; const float abr = mag * __cosf(ang), abi = mag * __sinf(ang);
            const float den = lr * lr + li * li, nr = abr - 1.f, ni = abi; const float kr = (nr * lr + ni * li) / den, ki = (ni * lr - nr * li) / den;
            BB[e * 2] = kr * br4[i] - ki * bi4[i]; BB[e * 2 + 1] = kr * bi4[i] + ki * br4[i]; CC[e * 2] = cr4[i]; CC[e * 2 + 1] = ci4[i]; }
    }
    __syncthreads();
    for (int task = tid; task < 64 * 16; task += NTHREADS) {
        const int dj = task >> 4, blk = task & 15, d = dj >> 5, j = dj & 31, ho0 = 4 * (blk >> 2), hi0 = 4 * (blk & 3);
        const int jmax = d == 0 ? 8 * qq + 7 : 31 - 8 * qq;
        if (j > jmax) continue;
        float acc4[4][4];
#pragma unroll
        for (int i = 0; i < 4; ++i)
#pragma unroll
            for (int k = 0; k < 4; ++k) acc4[i][k] = 0.f;
        const f32x2_t* ap = (const f32x2_t*)AP + (d * 33 + j) * 64; const f32x2_t* cp = (const f32x2_t*)CC + (d * 16 + ho0) * 64; const f32x4* bp = (const f32x4*)(BB + (size_t)(d * 64) * 16 * 2 + hi0 * 2);
#pragma unroll 2
        for (int p = 0; p < 64; ++p) {
            const f32x2_t av = ap[p]; const f32x4 b01 = bp[p * 8], b23 = bp[p * 8 + 1];
#pragma unroll
            for (int i = 0; i < 4; ++i) { const f32x2_t cv = cp[i * 64 + p]; const float xr = cv.x * av.x - cv.y * av.y, xi = cv.x * av.y + cv.y * av.x;
                acc4[i][0] += xr * b01.x - xi * b01.y; acc4[i][1] += xr * b01.z - xi * b01.w; acc4[i][2] += xr * b23.x - xi * b23.y; acc4[i][3] += xr * b23.z - xi * b23.w; }
        }
#pragma unroll
        for (int i = 0; i < 4; ++i) *(f32x4*)(KT + (d * 32 + j) * 256 + (ho0 + i) * 16 + hi0) = (f32x4){acc4[i][0], acc4[i][1], acc4[i][2], acc4[i][3]};
    }
    __syncthreads();
    bf16_t* Mg = (bf16_t*)(ws + WS_S5MF) + (size_t)g * 512 * 768; bf16_t* Eg = (bf16_t*)(ws + WS_S5E) + (size_t)g * 256 * 512; bf16_t* Fg = Mg + 512;
    const float dval = in[31][g * 16 + (tid & 15)];
    for (int e = tid; e < 128 * 512; e += NTHREADS) { const int k = e & 511, mr = e >> 9, m = qq * 128 + mr; const int t = m >> 4, ho = m & 15, tau = k >> 4, hi = k & 15;
        float v = 0.f; if (tau <= t) v += KT[(0 * 32 + (t - tau)) * 256 + ho * 16 + hi]; if (tau >= t) v += KT[(1 * 32 + (tau - t)) * 256 + ho * 16 + hi];
        if (tau == t && ho == hi) v += dval;
        Mg[(size_t)m * 768 + k] = (bf16_t)f2bf(v); }
    { const int d = qq >> 1, c = qq & 1;
      for (int e = tid; e < 64 * 512; e += NTHREADS) { const int k = e & 511, p = e >> 9, tau = k >> 4, hi = k & 15; const int j = d == 0 ? 31 - tau : tau;
          const float ar = AP[((d * 33 + j) * 64 + p) * 2], ai = AP[((d * 33 + j) * 64 + p) * 2 + 1]; const float br = BB[((d * 64 + p) * 16 + hi) * 2], bi = BB[((d * 64 + p) * 16 + hi) * 2 + 1];
          const float v = c ? (ar * bi + ai * br) : (ar * br - ai * bi);
          Eg[(size_t)(qq * 64 + p) * 512 + k] = (bf16_t)f2bf(v); } }
    for (int e = tid; e < 128 * 256; e += NTHREADS) { const int k = e & 255, mr = e >> 8, m = qq * 128 + mr, t = m >> 4, ho = m & 15; const int d = k >> 7, c = (k >> 6) & 1, p = k & 63;
        const int j = d == 0 ? t + 1 : 32 - t;
        const float ar = AP[((d * 33 + j) * 64 + p) * 2], ai = AP[((d * 33 + j) * 64 + p) * 2 + 1]; const float cr = CC[((d * 16 + ho) * 64 + p) * 2], ci = CC[((d * 16 + ho) * 64 + p) * 2 + 1];
        const float v = c ? -(cr * ai + ci * ar) : (cr * ar - ci * ai);
        Fg[(size_t)m * 768 + k] = (bf16_t)f2bf(v); }
    if (qq == 0) for (int e = tid; e < 2 * 64; e += NTHREADS) { const int p = e & 63, d = e >> 6; float* at = (float*)(ws + WS_S5AT) + ((size_t)(d * 32 + g) * 64 + p) * 2;
        at[0] = AP[((d * 33 + 32) * 64 + p) * 2]; at[1] = AP[((d * 33 + 32) * 64 + p) * 2 + 1]; }
    __syncthreads();
}
DI int s5_chunk_row(int n72) { const int b = n72 / 72, cc = n72 - b * 72; return cc < 8 ? NLAT + b * CTXL + 32 * cc : b * SEQ + 32 * (cc - 8); }
DI void s5_repack_chunk(unsigned char* ws, int n, int lane) {
    const bf16_t* src = (const bf16_t*)(ws + WS_PROJ) + (size_t)s5_chunk_row(n) * OIN + 8 * lane;
    bf16_t* dst = (bf16_t*)(ws + WS_UG) + ((size_t)(lane >> 1) * 768 + n) * 768 + (lane & 1) * 8;
    u32x4 v[8];
#pragma unroll
    for (int t0 = 0; t0 < 32; t0 += 8) {
#pragma unroll
        for (int i = 0; i < 8; ++i) v[i] = *(const u32x4*)(src + (size_t)(t0 + i) * OIN);
#pragma unroll
        for (int i = 0; i < 8; ++i) *(u32x4*)(dst + (t0 + i) * 16) = v[i];
    }
}
struct S5Order {
    int G, c, nb;
    __device__ bool next(int i, pg8::Unit& u) const { const int L = i * G + c; const int per = 3 * nb; if (L >= 32 * per) return false; const int g = L / per, r = L - g * per; u.pm = 3 * g + r / nb; u.pn = nb * g + r % nb; return true; }
    __device__ __forceinline__ void a_ready(const pg8::Unit&) const {}
    __device__ __forceinline__ void done(const pg8::Unit&) const {}
};
struct EpiS5L {
    static constexpr bool PERM = false, AFTER_DRAIN = false;
    float* L;
    __device__ __forceinline__ void operator()(const f32x4 (&acc)[2][2][4][2], const pg8::Unit& u, int wr, int wc, int fr, int fq) const {
        const int g = u.pn, mt = u.pm - 3 * g;
#pragma unroll
        for (int ai = 0; ai < 2; ++ai)
#pragma unroll
            for (int m = 0; m < 4; ++m) { const int n = mt * 256 + ai * 128 + wr * 64 + m * 16 + fr; if (n >= 576) continue;
                float* lp = L + ((size_t)n * 32 + g) * 256 + wc * 32 + 4 * fq;
#pragma unroll
                for (int bj = 0; bj < 2; ++bj)
#pragma unroll
                    for (int nn = 0; nn < 2; ++nn) *(f32x4*)(lp + bj * 128 + nn * 16) = acc[ai][bj][m][nn]; }
    }
};
struct EpiS5Y {
    static constexpr bool PERM = false, AFTER_DRAIN = false;
    bf16_t* Z;
    __device__ __forceinline__ void operator()(const f32x4 (&acc)[2][2][4][2], const pg8::Unit& u, int wr, int wc, int fr, int fq) const {
        const int g = u.pn >> 1, nh = u.pn & 1, mt = u.pm - 3 * g;
#pragma unroll
        for (int ai = 0; ai < 2; ++ai)
#pragma unroll
            for (int m = 0; m < 4; ++m) { const int n = mt * 256 + ai * 128 + wr * 64 + m * 16 + fr; const int b = n / 72, cc = n - b * 72; if (n >= 576 || cc < 8) continue;
                bf16_t* zp = Z + (size_t)(b * SEQ + 32 * (cc - 8)) * 512 + g * 16;
#pragma unroll
                for (int bj = 0; bj < 2; ++bj)
#pragma unroll
                    for (int nn = 0; nn < 2; ++nn) { const int mcol = nh * 256 + bj * 128 + wc * 32 + nn * 16 + 4 * fq, t = mcol >> 4, ho = mcol & 15; const f32x4 y = acc[ai][bj][m][nn];
                        u32x2 w; w.x = pk2(gelu_tanh(y.x), gelu_tanh(y.y)); w.y = pk2(gelu_tanh(y.z), gelu_tanh(y.w)); *(u32x2*)(zp + (size_t)t * 512 + ho) = w; } }
    }
};
DI void s5_scan_thread(unsigned char* ws, int gid) {
    const int p = gid & 63, d = (gid >> 6) & 1, g = (gid >> 7) & 31, b = gid >> 12;
    const float* at = (const float*)(ws + WS_S5AT) + ((size_t)(d * 32 + g) * 64 + p) * 2; const float ar = at[0], ai = at[1];
    const float* L = (const float*)(ws + WS_S5L); bf16_t* UG = (bf16_t*)(ws + WS_UG);
    float sr = 0.f, si = 0.f;
    for (int k0 = 0; k0 < 72; k0 += 8) {
        float lr8[8], li8[8];
#pragma unroll
        for (int i = 0; i < 8; ++i) { const int k = k0 + i; const int cc = d == 0 ? k : (k < 8 ? 7 - k : 71 - (k - 8)); const size_t lo = ((size_t)(b * 72 + cc) * 32 + g) * 256 + d * 128 + p; lr8[i] = L[lo]; li8[i] = L[lo + 64]; }
#pragma unroll
        for (int i = 0; i < 8; ++i) { const int k = k0 + i; const int cc = d == 0 ? k : (k < 8 ? 7 - k : 71 - (k - 8));
            if (cc >= 8) { bf16_t* so = UG + ((size_t)g * 768 + b * 72 + cc) * 768 + 512 + d * 128 + p; so[0] = (bf16_t)f2bf(sr); so[64] = (bf16_t)f2bf(si); }
            const float nr = ar * sr - ai * si + lr8[i], ni = ar * si + ai * sr + li8[i]; sr = nr; si = ni; }
    }
}

DI int up_row_map(int n) { return n < FH ? (n >> 7) * 256 + (n & 127) : ((n - FH) >> 7) * 256 + 128 + ((n - FH) & 127); }
DI void p0_transpose_item(const float* W, int K, int N, bf16_t* WT, bool upmap, float* scr, int item, int lane) {
    const int nblk = N / 32, kb = item / nblk, nb = item % nblk, k0 = 64 * kb, n0 = 32 * nb;
    float tv[32];
#pragma unroll
    for (int i = 0; i < 32; ++i) tv[i] = __builtin_nontemporal_load(W + (size_t)(k0 + 2 * i + (lane >> 5)) * N + n0 + (lane & 31));
#pragma unroll
    for (int i = 0; i < 32; ++i) scr[(2 * i + (lane >> 5)) * 33 + (lane & 31)] = tv[i];
    asm volatile("s_waitcnt lgkmcnt(0)" ::: "memory");
    const int c = lane & 7;
#pragma unroll
    for (int j = 0; j < 4; ++j) { const int n = (lane >> 3) + 8 * j; const float* s = scr + (8 * c) * 33 + n;
        u32x4 o; o.x = pk2(s[0 * 33], s[1 * 33]); o.y = pk2(s[2 * 33], s[3 * 33]); o.z = pk2(s[4 * 33], s[5 * 33]); o.w = pk2(s[6 * 33], s[7 * 33]);
        const int nr = upmap ? up_row_map(n0 + n) : n0 + n;
        *(u32x4*)(WT + (size_t)nr * K + k0 + 8 * c) = o; }
    asm volatile("s_waitcnt lgkmcnt(0)" ::: "memory");
}
DI void norm_row(const float* xrow, const float* g, const float* shift, const float* scale, bf16_t* o1, bf16_t* o2, int lane) {
    f32x4 v[4]; float s = 0.f;
#pragma unroll
    for (int j = 0; j < 4; ++j) { v[j] = *((const f32x4*)xrow + lane + 64 * j); s += (v[j].x * v[j].x + v[j].y * v[j].y) + (v[j].z * v[j].z + v[j].w * v[j].w); }
    const float rstd = rsqrtf(wave_sum(s) * (1.f / DM) + NORM_EPS);
#pragma unroll
    for (int j = 0; j < 4; ++j) {
        const f32x4 gg = *((const f32x4*)g + lane + 64 * j), sh = *((const f32x4*)shift + lane + 64 * j), sc = *((const f32x4*)scale + lane + 64 * j);
        const f32x4 y = (v[j] * rstd) * gg * (sc + 1.0f) + sh;
        u32x2 w; w.x = pk2(y.x, y.y); w.y = pk2(y.z, y.w);
        *((u32x2*)o1 + lane + 64 * j) = w; if (o2) *((u32x2*)o2 + lane + 64 * j) = w;
    }
}
DI bf16_t* norm_xne_ptr(bf16_t* XN, int r, int xne_row) {
    if (xne_row < 0) return nullptr;
    const bool isctx = r >= NLAT; const int t = isctx ? (r - NLAT) & 255 : r & 2047, slen = isctx ? CTXL : SEQ, s = isctx ? (r - NLAT) >> 8 : r >> 11;
    const int k = (t + 2) >> 6, pos = (t + 2) & 63;
    if (pos < 4 && k >= 1 && k <= slen / 64 - 1) { const int q = isctx ? NBND_LAT + s * 3 + (k - 1) : s * 31 + (k - 1); return XN + (size_t)(xne_row + 4 * q + pos) * DM; }
    return nullptr;
}
DI void norm_phase(const float* hL, const float* hC, const float* g, const float* mod, int ish, int isc, bf16_t* XN, int nrows, int xne_row, int gw, int NGW, int lane, const float* cadd = nullptr, float* cwb = nullptr) {
    for (int r0 = gw; r0 < nrows; r0 += 2 * NGW) {
        const int r1 = r0 + NGW; const bool has1 = r1 < nrows; const int r1c = has1 ? r1 : r0;
        const float* x0 = r0 >= NLAT ? hC + (size_t)(r0 - NLAT) * DM : hL + (size_t)r0 * DM;
        const float* x1 = r1c >= NLAT ? hC + (size_t)(r1c - NLAT) * DM : hL + (size_t)r1c * DM;
        f32x4 v0[4], v1[4];
#pragma unroll
        for (int j = 0; j < 4; ++j) { v0[j] = *((const f32x4*)x0 + lane + 64 * j); v1[j] = *((const f32x4*)x1 + lane + 64 * j); }
        if (cadd) {
#pragma unroll
            for (int j = 0; j < 4; ++j) {
                if (r0 >= NLAT) { v0[j] += *((const f32x4*)(cadd + (size_t)(r0 - NLAT) * DM) + lane + 64 * j); if (cwb) *((f32x4*)(cwb + (size_t)(r0 - NLAT) * DM) + lane + 64 * j) = v0[j]; }
                if (has1 && r1 >= NLAT) { v1[j] += *((const f32x4*)(cadd + (size_t)(r1 - NLAT) * DM) + lane + 64 * j); if (cwb) *((f32x4*)(cwb + (size_t)(r1 - NLAT) * DM) + lane + 64 * j) = v1[j]; } } }
        const int bb0 = r0 >= NLAT ? 8 : r0 >> 11, bb1 = r1c >= NLAT ? 8 : r1c >> 11;
        const float* sh0 = mod + (size_t)bb0 * 6144 + ish * 1024; const float* sc0 = mod + (size_t)bb0 * 6144 + isc * 1024;
        const float* sh1 = mod + (size_t)bb1 * 6144 + ish * 1024; const float* sc1 = mod + (size_t)bb1 * 6144 + isc * 1024;
        float s0 = 0.f, s1 = 0.f;
#pragma unroll
        for (int j = 0; j < 4; ++j) { s0 += (v0[j].x * v0[j].x + v0[j].y * v0[j].y) + (v0[j].z * v0[j].z + v0[j].w * v0[j].w); s1 += (v1[j].x * v1[j].x + v1[j].y * v1[j].y) + (v1[j].z * v1[j].z + v1[j].w * v1[j].w); }
#pragma unroll
        for (int o = 1; o < 64; o <<= 1) { s0 += __shfl_xor(s0, o); s1 += __shfl_xor(s1, o); }
        const float rs0 = rsqrtf(s0 * (1.f / DM) + NORM_EPS), rs1 = rsqrtf(s1 * (1.f / DM) + NORM_EPS);
        bf16_t* o0 = XN + (size_t)r0 * DM; bf16_t* o1 = XN + (size_t)r1c * DM; bf16_t* e0 = norm_xne_ptr(XN, r0, xne_row); bf16_t* e1 = norm_xne_ptr(XN, r1c, xne_row);
#pragma unroll
        for (int j = 0; j < 4; ++j) {
            const f32x4 gg = *((const f32x4*)g + lane + 64 * j);
            const f32x4 y0 = (v0[j] * rs0) * gg * (*((const f32x4*)sc0 + lane + 64 * j) + 1.0f) + *((const f32x4*)sh0 + lane + 64 * j);
            const f32x4 y1 = (v1[j] * rs1) * gg * (*((const f32x4*)sc1 + lane + 64 * j) + 1.0f) + *((const f32x4*)sh1 + lane + 64 * j);
            u32x2 w0, w1; w0.x = pk2(y0.x, y0.y); w0.y = pk2(y0.z, y0.w); w1.x = pk2(y1.x, y1.y); w1.y = pk2(y1.z, y1.w);
            *((u32x2*)o0 + lane + 64 * j) = w0; if (e0) *((u32x2*)e0 + lane + 64 * j) = w0;
            if (has1) { *((u32x2*)o1 + lane + 64 * j) = w1; if (e1) *((u32x2*)e1 + lane + 64 * j) = w1; }
        }
    }
}
DI void qknorm_phase(bf16_t* PROJ, int ld, int qoff, const float* qn, const float* kn, const float* rope, int gw, int NGW, int lane) {
    const int d0 = 2 * (lane & 31), hsel = lane >> 5;
    const f32x2_t gq = *(const f32x2_t*)(qn + d0), gk = *(const f32x2_t*)(kn + d0);
    const int ridx = (d0 >> 5) * 16 + (d0 & 15); const bool second = (d0 >> 4) & 1;
    for (int r = gw; r < MALL; r += NGW) {
        unsigned* p = (unsigned*)(PROJ + (size_t)r * ld + qoff) + lane;
        const bool lat = r < NLAT; f32x2_t cs = {1.f, 1.f}, sn = {0.f, 0.f};
        if (lat) { const int t = r & 2047; cs = *(const f32x2_t*)(rope + t * 32 + ridx); sn = *(const f32x2_t*)(rope + SEQ * 32 + t * 32 + ridx); }
        unsigned raw[5];
#pragma unroll
        for (int i = 0; i < 5; ++i) raw[i] = p[64 * i];
#pragma unroll
        for (int i = 0; i < 5; ++i) {
            const float a = __uint_as_float(raw[i] << 16), b = __uint_as_float(raw[i] & 0xffff0000u);
            float ss = a * a + b * b;
#pragma unroll
            for (int o = 1; o < 32; o <<= 1) ss += __shfl_xor(ss, o);
            const float rs = rsqrtf(ss * (1.f / 64.f) + NORM_EPS); const bool isq = (2 * i + hsel) < 8;
            float ya = a * rs * (isq ? gq.x : gk.x), yb = b * rs * (isq ? gq.y : gk.y);
            const float pa = __shfl_xor(ya, 8), pb = __shfl_xor(yb, 8);
            if (lat) { ya = second ? (ya * cs.x + pa * sn.x) : (ya * cs.x - pa * sn.x); yb = second ? (yb * cs.y + pb * sn.y) : (yb * cs.y - pb * sn.y); }
            if (isq) { ya *= C2; yb *= C2; }
            p[64 * i] = pk2(ya, yb);
        }
    }
}

struct Args { const float* in[37]; float* out; unsigned char* ws; int ph_lo, ph_hi; };
constexpr int NPHASE = 19;

DI void p0_prologue(const Args& a, char* lds, int G, int rep) {
#ifdef P0_REP_EMPTY
    if (rep == 1) return;
#endif
    const int tid = threadIdx.x, lane = tid & 63, wid = tid >> 6;
    unsigned char* ws = a.ws;
    const int gw = blockIdx.x * NWAVES + wid, NGW = G * NWAVES;
    {
        const int gt = blockIdx.x * NTHREADS + tid, NGT = G * NTHREADS;
        float* rope = (float*)(ws + WS_ROPE);
        for (int e = gt; e < SEQ * 32; e += NGT) { const int t = e >> 5, idx = e & 31, i = idx & 15; const float pos = (float)((idx < 16) ? (t >> 6) : (t & 63));
            const float invf = powf(10000.0f, -(float)i / 16.0f); const float ang = pos * invf; rope[e] = cosf(ang); rope[SEQ * 32 + e] = sinf(ang); }
        bf16_t* rgw = (bf16_t*)(ws + WS_RGW);
        for (int e = gt; e < 4 * 8 * 4096; e += NGT) { const int k = e & 63, n = (e >> 6) & 63, hd = (e >> 12) & 7, mi = e >> 15; const int d = mi >> 1;
            const float* w = (mi & 1) ? a.in[17] : a.in[15]; rgw[e] = (bf16_t)f2bf(w[((size_t)(d * 8 + hd) * 64 + k) * 64 + n]); }
    }
    __syncthreads();
    {
        float* cond = (float*)lds;
        float* red = (float*)(lds + 1024 * 12 * 4);
        if (G < 256 || blockIdx.x >= 128) for (int e = tid; e < 9 * 1024; e += NTHREADS) { const int k = e & 1023, bb = e >> 10; const float cv = bb < 8 ? a.in[1][bb * 1024 + k] : a.in[3][k]; cond[k * 12 + bb] = siluf_(cv); }
        __syncthreads();
        float* MOD = (float*)(ws + WS_MOD);
        for (int it = (G >= 256 ? (int)blockIdx.x - 128 : (int)blockIdx.x); it < 2 * 96; it += (G >= 256 ? 128 : G)) { if (it < 0) break;
            const int layer = it / 96, cb = it % 96, col = cb * 64 + lane;
            const float* w = a.in[4] + (size_t)layer * DM * 6144 + col;
            float acc[9];
#pragma unroll
            for (int bb = 0; bb < 9; ++bb) acc[bb] = 0.f;
            for (int kk0 = 0; kk0 < 128; kk0 += 16) {
                float wv16[16];
#pragma unroll
                for (int i = 0; i < 16; ++i) wv16[i] = __builtin_nontemporal_load(w + (size_t)(wid * 128 + kk0 + i) * 6144);
#pragma unroll
                for (int i = 0; i < 16; ++i) { const int k = wid * 128 + kk0 + i; const float wv = wv16[i];
                    const f32x4 c0 = *(const f32x4*)(cond + k * 12), c1 = *(const f32x4*)(cond + k * 12 + 4); const float c8 = cond[k * 12 + 8];
                    acc[0] += c0.x * wv; acc[1] += c0.y * wv; acc[2] += c0.z * wv; acc[3] += c0.w * wv; acc[4] += c1.x * wv; acc[5] += c1.y * wv; acc[6] += c1.z * wv; acc[7] += c1.w * wv; acc[8] += c8 * wv; }
            }
#pragma unroll
            for (int bb = 0; bb < 9; ++bb) red[(wid * 9 + bb) * 64 + lane] = acc[bb];
            __syncthreads();
            for (int e = tid; e < 9 * 64; e += NTHREADS) { const int bb = e >> 6, ln = e & 63; float s = a.in[5][layer * 6144 + cb * 64 + ln];
#pragma unroll
                for (int w8 = 0; w8 < 8; ++w8) s += red[(w8 * 9 + bb) * 64 + ln];
                MOD[((size_t)layer * 9 + bb) * 6144 + cb * 64 + ln] = s; }
            __syncthreads();
        }
    }
    __syncthreads();
#ifdef P0_REP_MODONLY
    if (rep == 0)
#endif
    for (int it = blockIdx.x; it < 128; it += G) s5_pre_item(a.in, ws, lds, it);
    __syncthreads();
    {
        float* scr = (float*)(lds + wid * 16384);
        constexpr int I_IN0 = 16 * (EIN / 32), I_OUT = 16 * 32, I_UP = 16 * (FH2 / 32), I_DN = (FH / 64) * 32, I_IN1 = 16 * (OIN / 32), I_GLU = 8 * 16;
        constexpr int NIT = I_IN0 + I_OUT + I_UP + I_DN + I_IN1 + I_OUT + I_UP + I_DN + I_GLU;
        unsigned* wctr = (unsigned*)(ws + WS_CTL);
        for (;;) {
            int it = 0; if (lane == 0) it = (int)atomicAdd(wctr, 1u); it = __builtin_amdgcn_readfirstlane(it); if (it >= NIT) break;
            int r = it;
            if (r < I_UP) { p0_transpose_item(a.in[7], DM, FH2, (bf16_t*)(ws + WS_WUP0), true, scr, r, lane); continue; } r -= I_UP;
            if (r < I_UP) { p0_transpose_item(a.in[7] + (size_t)DM * FH2, DM, FH2, (bf16_t*)(ws + WS_WUP1), true, scr, r, lane); continue; } r -= I_UP;
            if (r < I_DN) { p0_transpose_item(a.in[10], FH, DM, (bf16_t*)(ws + WS_WDN0), false, scr, r, lane); continue; } r -= I_DN;
            if (r < I_DN) { p0_transpose_item(a.in[10] + (size_t)FH * DM, FH, DM, (bf16_t*)(ws + WS_WDN1), false, scr, r, lane); continue; } r -= I_DN;
            if (r < I_IN0) { p0_transpose_item(a.in[11], DM, EIN, (bf16_t*)(ws + WS_WIN0), false, scr, r, lane); continue; } r -= I_IN0;
            if (r < I_IN1) { p0_transpose_item(a.in[22], DM, OIN, (bf16_t*)(ws + WS_WIN1), false, scr, r, lane); continue; } r -= I_IN1;
            if (r < I_OUT) { p0_transpose_item(a.in[12], DM, DM, (bf16_t*)(ws + WS_WOUT0), false, scr, r, lane); continue; } r -= I_OUT;
            if (r < I_OUT) { p0_transpose_item(a.in[23], DM, DM, (bf16_t*)(ws + WS_WOUT1), false, scr, r, lane); continue; } r -= I_OUT;
            p0_transpose_item(a.in[32], 512, 512, (bf16_t*)(ws + WS_WGLU), false, scr, r, lane);
        }
    }
}

__global__ void __launch_bounds__(NTHREADS, 2) trunk_fwd(Args a) {
    extern __shared__ __attribute__((aligned(16))) unsigned char lds_raw[];
    char* lds = (char*)lds_raw;
    PG8_LAS unsigned char* ldsl = (PG8_LAS unsigned char*)lds_raw;
    cg::grid_group grid = cg::this_grid();
    const int tid = threadIdx.x, lane = tid & 63, wid = tid >> 6, G = gridDim.x;
    const int gw = blockIdx.x * NWAVES + wid, NGW = G * NWAVES;
    unsigned char* ws = a.ws;
    const int lo = a.ph_lo, hi = a.ph_hi;
    float* MOD = (float*)(ws + WS_MOD); float* HC = (float*)(ws + WS_HC);
    bf16_t* XN = (bf16_t*)(ws + WS_XN); bf16_t* PROJ = (bf16_t*)(ws + WS_PROJ); bf16_t* MIX = (bf16_t*)(ws + WS_MIX); bf16_t* HID = (bf16_t*)(ws + WS_HID);
    const float* rope = (const float*)(ws + WS_ROPE);
    float* CP = (float*)(ws + WS_Z);
    volatile LAS unsigned* MISC = (volatile LAS unsigned*)((LAS unsigned char*)lds_raw + LDS_MISC);
    if (tid < 64) MISC[tid] = 0u;
    __syncthreads();
    XcdBarrier xbar; xbar.bar = (unsigned*)(ws + WS_CTL) + 4096; xbar.x = 0; xbar.st = nullptr;
    if (hi - lo > 1) xbar = xcd_barrier_post((unsigned*)(ws + WS_CTL) + 4096, MISC + 8);
#ifndef PHASE_MASK
#define PHASE_MASK 0x7ffff
#endif
#define IN(k) (((PHASE_MASK >> (k)) & 1) && lo <= (k) && (k) < hi)
#ifndef DUP_MASK
#define DUP_MASK 0
#endif
#define REP(k) for (int rep_ = 0; rep_ < (((DUP_MASK >> (k)) & 1) ? 2 : 1); ++rep_, (void)((((DUP_MASK >> (k)) & 1) && rep_ == 1) ? (xcd_barrier(xbar), 0) : 0))
#define SEAM(k) do { if (IN(k) && IN((k) + 1)) { xcd_barrier(xbar); } } while (0)

    if (hi > 1000) grid.sync();
    if (IN(0)) REP(0) { p0_prologue(a, lds, G, rep_); } SEAM(0);
    if (IN(1)) REP(1) norm_phase(a.in[0], a.in[2], a.in[6], MOD, 0, 1, XN, MALL, -1, gw, NGW, lane);
    SEAM(1);
    if (IN(2)) REP(2) { pg8::Gemm g{XN, (const bf16_t*)(ws + WS_WIN0), MALL, EIN, DM}; pg8::StaticOrder S; S.init(MALL, EIN, G, (int)blockIdx.x);
        pg8::EpiBf16<0> E{PROJ, EIN, nullptr, 0, 0, 1.f}; pg8::gemm_phase<pg8::EpiBf16<0>, pg8::StaticOrder, true, true>(ldsl, g, S, E); }
    SEAM(2);
    if (IN(3)) { qknorm_phase(PROJ, EIN, 1024, a.in[20], a.in[21], rope, gw, NGW, lane); __syncthreads();
#ifdef DUP_RG1
        for (int rep2_ = 0; rep2_ < 2; ++rep2_)
#endif
        for (int it = blockIdx.x; it < NB * 8 * 36; it += G) rg_item1(a.in, ws, lds, it); }
    SEAM(3);
    if (IN(4)) REP(4) {
#ifndef P4_NO_ATTN
#ifdef DUP_ATT
        for (int rep2_ = 0; rep2_ < 2; ++rep2_)
#endif
        for (int it = blockIdx.x; it < 512 + 64; it += G) {
            if (it < 512) { const int qb = it & 7, head = (it >> 3) & 7, b = it >> 6; attn_unit<0>(PROJ, EIN, 1024, 1536, 1664, MIX, lds, b, head, qb * 256, 0.f); }
            else { const int u = it - 512, head = u & 7, b = u >> 3; attn_unit<1>(PROJ, EIN, 1024, 1536, 1664, MIX, lds, b, head, 0, 0.f); }
        }
#endif
#ifndef P4_NO_RG
        for (int it = (blockIdx.x + G - 64) % G; it < NB * 8 * 36; it += G) rg_item2(a.in, ws, lds, it);
#endif
    }
    SEAM(4);
    if (IN(5)) REP(5) { { pg8::Gemm g{MIX, (const bf16_t*)(ws + WS_WOUT0), NLAT, DM, DM}; pg8::StaticOrder S; S.init(NLAT, DM, G, (int)blockIdx.x);
          EpiRes E{a.in[0], a.in[2], a.out, HC, MOD + 2 * 1024}; pg8::gemm_phase<EpiRes, pg8::StaticOrder, true, true>(ldsl, g, S, E); }
#pragma unroll 1
        for (int kh = 0; kh < 2; ++kh) {
          pg8::Gemm g{MIX + kh * 512, (const bf16_t*)(ws + WS_WOUT0) + kh * 512, MALL, DM, 512, DM, DM}; CtxOrder S{(int)blockIdx.x - 64 * kh};
          EpiCtxHalf E{a.in[2], HC, CP, MOD + 2 * 1024, kh}; pg8::gemm_phase<EpiCtxHalf, CtxOrder, true, true>(ldsl, g, S, E); } }
    SEAM(5);
    if (IN(6)) REP(6) norm_phase(a.out, HC, a.in[6] + DM, MOD, 3, 4, XN, MALL, XNE_ROW_L0, gw, NGW, lane, CP, HC);
    SEAM(6);
    if (IN(7)) REP(7) { constexpr int MT = MALL + 1280; pg8::Gemm g{XN, (const bf16_t*)(ws + WS_WUP0), MT, FH2, DM}; pg8::StaticOrder S; S.init(MT, FH2, G, (int)blockIdx.x);
        EpiConvAct E{HID, a.in[8], a.in[9], MALL / 256, NBND_LAT, NBND_LAT + NBND_CTX, lds + 131072}; pg8::gemm_phase<EpiConvAct, pg8::StaticOrder, true, true>(ldsl, g, S, E); }
    SEAM(7);
    if (IN(8)) { { pg8::Gemm g{HID, (const bf16_t*)(ws + WS_WDN0), NLAT, DM, FH}; pg8::StaticOrder S; S.init(NLAT, DM, G, (int)blockIdx.x);
          EpiRes E{a.out, HC, a.out, HC, MOD + 5 * 1024}; pg8::gemm_phase<EpiRes, pg8::StaticOrder, true, true>(ldsl, g, S, E); }
#pragma unroll 1
        for (int kh = 0; kh < 2; ++kh) {
          pg8::Gemm g{HID + kh * (FH / 2), (const bf16_t*)(ws + WS_WDN0) + kh * (FH / 2), MALL, DM, FH / 2, FH, FH}; CtxOrder S{(int)blockIdx.x - 64 * kh};
          EpiCtxHalf E{HC, HC, CP, MOD + 5 * 1024, kh}; pg8::gemm_phase<EpiCtxHalf, CtxOrder, true, true>(ldsl, g, S, E); } }
    SEAM(8);
    const float* MOD1 = MOD + 9 * 6144;
    if (IN(9)) REP(9) norm_phase(a.out, HC, a.in[6] + 2 * DM, MOD1, 0, 1, XN, MALL, -1, gw, NGW, lane, CP, nullptr);
    SEAM(9);
    if (IN(10)) REP(10) { pg8::Gemm g{XN, (const bf16_t*)(ws + WS_WIN1), MALL, OIN, DM}; pg8::StaticOrder S; S.init(MALL, OIN, G, (int)blockIdx.x);
        pg8::EpiBf16<0> E{PROJ, OIN, nullptr, 0, 0, 1.f}; pg8::gemm_phase<pg8::EpiBf16<0>, pg8::StaticOrder, true, true>(ldsl, g, S, E); }
    SEAM(10);
    if (IN(11)) { qknorm_phase(PROJ, OIN, 512, a.in[34], a.in[35], rope, gw, NGW, lane);
        for (int n = gw; n < 576; n += NGW) s5_repack_chunk(ws, n, lane);
        xcd_barrier(xbar);
        pg8::Gemm g{(const bf16_t*)(ws + WS_UG), (const bf16_t*)(ws + WS_S5E), 32 * 768, 32 * 256, 512, 768, 512}; S5Order S{G, (int)blockIdx.x, 1};
        EpiS5L E{(float*)(ws + WS_S5L)}; pg8::gemm_phase<EpiS5L, S5Order, true, true>(ldsl, g, S, E); }
    SEAM(11);
    if (IN(12)) REP(12) {
        { const int gt = blockIdx.x * NTHREADS + tid; if (gt < NB * 32 * 2 * 64) s5_scan_thread(ws, gt); }
        __syncthreads();
        const int nskip = (NB * 32 * 2 * 64) / NTHREADS;
        for (int it = (blockIdx.x + G - nskip) % G; it < 512; it += G) { const int qb = it & 7, head = (it >> 3) & 7, b = it >> 6;
            attn_unit<2>(PROJ, OIN, 512, 1024, 1152, MIX, lds, b, head, qb * 256, a.in[36][head] * 1.4426950408889634f); }
    }
    SEAM(12);
    if (IN(13)) REP(13) { pg8::Gemm g{(const bf16_t*)(ws + WS_UG), (const bf16_t*)(ws + WS_S5MF), 32 * 768, 32 * 512, 768, 768, 768}; S5Order S{G, (int)blockIdx.x, 2};
        EpiS5Y E{(bf16_t*)(ws + WS_Z)}; pg8::gemm_phase<EpiS5Y, S5Order, true, true>(ldsl, g, S, E); }
    SEAM(13);
    if (IN(14)) REP(14) { pg8::Gemm g{(const bf16_t*)(ws + WS_Z), (const bf16_t*)(ws + WS_WGLU), NLAT, 512, 512}; pg8::StaticOrder S; S.init(NLAT, 512, G, (int)blockIdx.x);
        EpiGlu E{(const bf16_t*)(ws + WS_Z), MIX, a.in[33]}; pg8::gemm_phase<EpiGlu, pg8::StaticOrder, true, true>(ldsl, g, S, E); }
    SEAM(14);
    if (IN(15)) { pg8::Gemm g{MIX, (const bf16_t*)(ws + WS_WOUT1), NLAT, DM, DM}; pg8::StaticOrder S; S.init(NLAT, DM, G, (int)blockIdx.x);
        EpiRes E{a.out, HC, a.out, HC, MOD1 + 2 * 1024}; pg8::gemm_phase<EpiRes, pg8::StaticOrder, true, true>(ldsl, g, S, E); }
    SEAM(15);
    if (IN(16)) REP(16) norm_phase(a.out, HC, a.in[6] + 3 * DM, MOD1, 3, 4, XN, NLAT, XNE_ROW_L1, gw, NGW, lane);
    SEAM(16);
    if (IN(17)) REP(17) { constexpr int MT = NLAT + 1024; pg8::Gemm g{XN, (const bf16_t*)(ws + WS_WUP1), MT, FH2, DM}; pg8::StaticOrder S; S.init(MT, FH2, G, (int)blockIdx.x);
        EpiConvAct E{HID, a.in[8] + 3 * FH2, a.in[9] + FH2, NLAT / 256, NBND_LAT, NBND_LAT, lds + 131072}; pg8::gemm_phase<EpiConvAct, pg8::StaticOrder, true, true>(ldsl, g, S, E); }
    SEAM(17);
    if (IN(18)) { pg8::Gemm g{HID, (const bf16_t*)(ws + WS_WDN1), NLAT, DM, FH}; pg8::StaticOrder S; S.init(NLAT, DM, G, (int)blockIdx.x);
        EpiRes E{a.out, HC, a.out, HC, MOD1 + 5 * 1024}; pg8::gemm_phase<EpiRes, pg8::StaticOrder, true, true>(ldsl, g, S, E); }
#undef IN
#undef SEAM
}

#ifndef N_LAUNCH_MODE
#define N_LAUNCH_MODE 1
#endif
extern "C" void kernel_launch(void* const* d_in, const int* in_sizes, int n_in, void* d_out, int out_size, void* d_ws, size_t ws_size, hipStream_t stream) {
    static int grid = 0;
    if (grid == 0) {
        if (n_in != 37 || out_size != NLAT * DM || ws_size < WS_END) { fprintf(stderr, "kernel_launch: unexpected problem (n_in %d out %d ws %zu)\n", n_in, out_size, ws_size); grid = -1; return; }
        int dev = 0, cus = 0, per_cu = 0;
        hipGetDevice(&dev); hipDeviceGetAttribute(&cus, hipDeviceAttributeMultiprocessorCount, dev);
        if (hipFuncSetAttribute((const void*)trunk_fwd, hipFuncAttributeMaxDynamicSharedMemorySize, LDS_BYTES) != hipSuccess) { fprintf(stderr, "kernel_launch: hipFuncSetAttribute failed\n"); grid = -1; return; }
        if (hipOccupancyMaxActiveBlocksPerMultiprocessor(&per_cu, (const void*)trunk_fwd, NTHREADS, LDS_BYTES) != hipSuccess || per_cu < 1) { fprintf(stderr, "kernel_launch: occupancy query says %d\n", per_cu); per_cu = 1; }
        (void)hipGetLastError();
        grid = cus;
        fprintf(stderr, "kernel_launch: grid %d (cus %d, per_cu %d)\n", grid, cus, per_cu);
    }
    if (grid < 0) return;
    (void)hipMemsetAsync((char*)d_ws + WS_CTL, 0, CTL_ZERO_BYTES, stream);
    Args a{};
    for (int i = 0; i < 37; ++i) a.in[i] = (const float*)d_in[i];
    a.out = (float*)d_out; a.ws = (unsigned char*)d_ws;
#if N_LAUNCH_MODE == 1
    a.ph_lo = 0; a.ph_hi = NPHASE;
    void* args[] = {&a};
    hipError_t e = hipLaunchCooperativeKernel((const void*)trunk_fwd, dim3(grid), dim3(NTHREADS), args, LDS_BYTES, stream);
    if (e != hipSuccess) fprintf(stderr, "cooperative launch failed: %s (grid %d)\n", hipGetErrorString(e), grid);
#else
    for (int p = 0; p < NPHASE; ++p) { a.ph_lo = p; a.ph_hi = p + 1; hipLaunchKernelGGL(trunk_fwd, dim3(grid), dim3(NTHREADS), LDS_BYTES, stream, a);
#ifdef DBG_CHECK
        Args d = a; d.ph_lo = 0; d.ph_hi = 0;
        static const int chk[NPHASE][2] = {{1,0},{0,0},{2,0},{3,0},{4,5},{6,0},{0,0},{7,8},{0,0},{0,0},{9,0},{10,0},{11,0},{12,0},{15,0},{0,0},{0,0},{14,0},{0,0}};
        for (int q = 0; q < 2; ++q) { const int st = chk[p][q]; if (!st) continue; const bool heavy = (st == 5 || st == 12); hipLaunchKernelGGL(dbg_check, dim3(heavy ? 1 : 4), dim3(heavy ? 64 : 256), 0, stream, d, st); }
        if (p == NPHASE - 1) hipLaunchKernelGGL(dbg_report, dim3(1), dim3(64), 0, stream, d);
#endif
    }
#endif
}
```

```cpp
#include <hip/hip_runtime.h>
#include <hip/hip_cooperative_groups.h>
#include <hip/hip_bf16.h>
#include <cstdio>
#include <cstdint>
#include <cmath>
namespace cg = cooperative_groups;
namespace pg8 {
#define PG8_LAS __attribute__((address_space(3)))
typedef unsigned short bf16_t;
typedef short bf16x8 __attribute__((ext_vector_type(8)));
typedef float f32x4 __attribute__((ext_vector_type(4)));
typedef unsigned u32x4 __attribute__((ext_vector_type(4)));
constexpr int BM = 256, BK = 64, HALF = 128, HTB = HALF * BK * 2  , STAGE_BYTES = 8 * HTB, NXCD = 8, WGM = 8;

__host__ __device__ __forceinline__ int lds_byte(int r, int c) { const int st = (r >> 4) * 2 + (c >> 5), rr = r & 15, cc = c & 31, ob = rr * 64 + cc * 2; return st * 1024 + (ob ^ (((ob >> 9) & 1) << 5)); }
__host__ __device__ __forceinline__ void stage_rc(int b, int& R, int& C) { const int st = b / 1024, sb = b % 1024, swz = sb ^ (((sb >> 9) & 1) << 5); R = (st >> 1) * 16 + swz / 64; C = (st & 1) * 32 + (swz % 64) / 2; }
__host__ __device__ __forceinline__ int perm32(int rho) { const int n = rho >> 4, i = rho & 15; return 8 * (i >> 2) + 4 * n + (i & 3); }

struct Unit { int pm, pn; };
struct Gemm { const bf16_t* A; const bf16_t* Bt; int M, N, K; int lda, ldb; };

struct StaticOrder {
    int nM, nN, nwg, G, c;
    __host__ __device__ void init(int M, int N, int G_, int c_) { nM = M / BM; nN = N / BM; nwg = nM * nN; G = G_; c = c_; }
    __host__ __device__ bool next(int i, Unit& u) const {
        const long L = (long)i * G + c; if (L >= nwg) return false;
        int wgid = (int)L; { const int q = nwg / NXCD, r = nwg % NXCD, xcd = wgid % NXCD, off = wgid / NXCD; wgid = (xcd < r ? xcd * (q + 1) : r * (q + 1) + (xcd - r) * q) + off; }
        const int nig = WGM * nN, gid = wgid / nig, fm = gid * WGM, gsz = (nM - fm) < WGM ? (nM - fm) : WGM;
        u.pm = fm + ((wgid % nig) % gsz); u.pn = (wgid % nig) / gsz; return true;
    }
    __device__ __forceinline__ void a_ready(const Unit&) const {}
    __device__ __forceinline__ void done(const Unit&) const {}
};

__device__ __forceinline__ unsigned cvt_pk_bf16(float lo, float hi) { unsigned r; asm volatile("v_cvt_pk_bf16_f32 %0, %1, %2" : "=v"(r) : "v"(lo), "v"(hi)); return r; }
typedef float f32x2 __attribute__((ext_vector_type(2)));
__device__ __forceinline__ f32x2 gelu_pk(f32x2 v) {
    const f32x2 av = __builtin_elementwise_abs(v), d = av * 0.2316418882f + 1.0f;
    f32x2 t; t.x = __builtin_amdgcn_rcpf(d.x); t.y = __builtin_amdgcn_rcpf(d.y);
    f32x2 q = t * 0.5307027145f + (-0.7265760135f); q = q * t + 0.7107068705f; q = q * t + (-0.142248368f); q = q * t + 0.127414796f; q = q * t;
    const f32x2 s = (v * v) * (-0.72134752044f);
    f32x2 e; e.x = __builtin_amdgcn_exp2f(s.x); e.y = __builtin_amdgcn_exp2f(s.y);
    const f32x2 m = v * (q * e), r = v - m;
    f32x2 o; o.x = v.x < 0.f ? m.x : r.x; o.y = v.y < 0.f ? m.y : r.y; return o;
}
template <int ACT  > struct EpiBf16 {
    static constexpr bool PERM = true, AFTER_DRAIN = false; static_assert(ACT == 0 || ACT == 1, "EpiBf16: ACT is 0 (none) or 1 (gelu_pk)");
    bf16_t* O; int ldc; const float* bias; int split_cols; size_t split_stride; float scale0;
    __device__ __forceinline__ void operator()(const f32x4 (&acc)[2][2][4][2], const Unit& u, int wr, int wc, int fr, int fq) const {
        const int row0 = u.pm * BM + wr * 64 + fr; int colt = u.pn * BM; bf16_t* base = O;
        float sc = 1.f; if (split_cols) { const int t = colt / split_cols; base += (size_t)t * split_stride; colt -= t * split_cols; if (t == 0) sc = scale0; }
        const int col0 = colt + wc * 32 + 8 * fq, bcol0 = u.pn * BM + wc * 32 + 8 * fq;
        f32x4 bv[2][2];
#pragma unroll
        for (int bj = 0; bj < 2; ++bj)
#pragma unroll
            for (int n = 0; n < 2; ++n) bv[bj][n] = bias ? *(const f32x4*)(bias + bcol0 + bj * HALF + 4 * n) : (f32x4){0.f, 0.f, 0.f, 0.f};
#pragma unroll
        for (int ai = 0; ai < 2; ++ai)
#pragma unroll
            for (int m = 0; m < 4; ++m) { bf16_t* rowp = base + (size_t)(row0 + ai * HALF + m * 16) * ldc + col0;
#pragma unroll
                for (int bj = 0; bj < 2; ++bj) { f32x4 v0 = acc[ai][bj][m][0] + bv[bj][0], v1 = acc[ai][bj][m][1] + bv[bj][1];
                    if (ACT == 1) { f32x2 a = gelu_pk((f32x2){v0[0], v0[1]}), b = gelu_pk((f32x2){v0[2], v0[3]}), c = gelu_pk((f32x2){v1[0], v1[1]}), d = gelu_pk((f32x2){v1[2], v1[3]});
                        v0 = (f32x4){a.x, a.y, b.x, b.y}; v1 = (f32x4){c.x, c.y, d.x, d.y}; }
                    v0 = v0 * sc; v1 = v1 * sc; u32x4 w; w.x = cvt_pk_bf16(v0[0], v0[1]); w.y = cvt_pk_bf16(v0[2], v0[3]); w.z = cvt_pk_bf16(v1[0], v1[1]); w.w = cvt_pk_bf16(v1[2], v1[3]);
                    *(u32x4*)(rowp + bj * HALF) = w; } }
    }
};
template <class Epi, class Sched, bool ALIGN_EPI = false, bool SP2 = false>
__device__ __forceinline__ void gemm_phase(PG8_LAS unsigned char* lds, const Gemm g, const Sched& S, const Epi& E) {
    const int tid = threadIdx.x, wid = __builtin_amdgcn_readfirstlane(tid >> 6), lane = tid & 63, wr = wid >> 2, wc = wid & 3, fr = lane & 15, fq = lane >> 4;
    const int K = g.K, nt = K / BK; const int lda = g.lda ? g.lda : K, ldb = g.ldb ? g.ldb : K;
    unsigned voffA[2], voffB[2];
#pragma unroll
    for (int i = 0; i < 2; ++i) { int R, C; stage_rc(tid * 16 + i * 8192, R, C); const int Rb = Epi::PERM ? ((R & ~31) + perm32(R & 31)) : R;
        voffA[i] = (unsigned)(R * lda + C) * 2u; voffB[i] = (unsigned)(Rb * ldb + C) * 2u; }
    const size_t kstep = (size_t)(BK * 2);
    const size_t hsA = (size_t)HALF * lda * 2, hsB = (size_t)HALF * ldb * 2;
    const size_t tsA = 2 * hsA, tsB = 2 * hsB;
    const unsigned ldsw = (unsigned)wid * 1024u;
    const int aoff = lds_byte(wr * 64 + fr, fq * 8), boff = lds_byte(wc * 32 + fr, fq * 8);
#define PG8_SA(b, h) (((b) * 2 + (h)) * HTB)
#define PG8_SB(b, h) ((4 + (b) * 2 + (h)) * HTB)
#define PG8_STAGE(bufoff, gbase, voff) do { _Pragma("unroll") for (int _i = 0; _i < 2; ++_i) \
        __builtin_amdgcn_global_load_lds((const unsigned*)((const char*)(gbase) + (voff)[_i]), (PG8_LAS unsigned*)(lds + (bufoff) + ldsw + _i * 8192), 16, 0, 0); } while (0)
#define PG8_LDA(dst, b, h) do { _Pragma("unroll") for (int m = 0; m < 4; ++m) _Pragma("unroll") for (int k = 0; k < 2; ++k) dst[m][k] = *(const PG8_LAS bf16x8*)(lds + PG8_SA(b, h) + aoff + m * 2048 + k * 1024); } while (0)
#define PG8_LDB(dst, b, h) do { _Pragma("unroll") for (int n = 0; n < 2; ++n) _Pragma("unroll") for (int k = 0; k < 2; ++k) dst[n][k] = *(const PG8_LAS bf16x8*)(lds + PG8_SB(b, h) + boff + n * 2048 + k * 1024); } while (0)
#define PG8_MMA(ai, bj, At, Bt) do { __builtin_amdgcn_s_setprio(1); _Pragma("unroll") for (int m = 0; m < 4; ++m) _Pragma("unroll") for (int n = 0; n < 2; ++n) _Pragma("unroll") for (int k = 0; k < 2; ++k) \
        acc[ai][bj][m][n] = __builtin_amdgcn_mfma_f32_16x16x32_bf16(Bt[n][k], At[m][k], acc[ai][bj][m][n], 0, 0, 0); __builtin_amdgcn_s_setprio(0); } while (0)
#define PG8_WAIT_V(n) asm volatile("s_waitcnt vmcnt(" #n ")" ::: "memory")
#define PG8_WAIT_L(n) asm volatile("s_waitcnt lgkmcnt(" #n ")" ::: "memory")
#define PG8_BAR __builtin_amdgcn_s_barrier()
#define PG8_SCHED __builtin_amdgcn_sched_barrier(0)
    Unit cur, nxt; int ui = 0;
    if (!S.next(0, cur)) return;
    f32x4 acc[2][2][4][2];
#pragma unroll
    for (int a = 0; a < 2; ++a)
#pragma unroll
        for (int b = 0; b < 2; ++b)
#pragma unroll
            for (int m = 0; m < 4; ++m)
#pragma unroll
                for (int n = 0; n < 2; ++n) acc[a][b][m][n] = (f32x4){0.f, 0.f, 0.f, 0.f};
    bf16x8 At[4][2], B0[2][2], B1[2][2];
    const char* cA = (const char*)g.A + (size_t)cur.pm * tsA; const char* cB = (const char*)g.Bt + (size_t)cur.pn * tsB;
    S.a_ready(cur);
    if constexpr (SP2) {
        PG8_STAGE(PG8_SB(0, 0), cB, voffB); PG8_STAGE(PG8_SB(0, 1), cB + hsB, voffB); PG8_STAGE(PG8_SA(0, 0), cA, voffA); PG8_STAGE(PG8_SA(0, 1), cA + hsA, voffA);
        if (wr == 1) PG8_BAR;
        PG8_WAIT_V(2); PG8_BAR;
        PG8_STAGE(PG8_SB(1, 0), cB + kstep, voffB); PG8_STAGE(PG8_SA(1, 0), cA + kstep, voffA); PG8_STAGE(PG8_SB(1, 1), cB + hsB + kstep, voffB);
        PG8_WAIT_V(6); PG8_BAR;
    } else {
        PG8_STAGE(PG8_SB(0, 0), cB, voffB); PG8_STAGE(PG8_SA(0, 0), cA, voffA); PG8_STAGE(PG8_SB(0, 1), cB + hsB, voffB); PG8_STAGE(PG8_SA(0, 1), cA + hsA, voffA);
        if (wr == 1) PG8_BAR;
        PG8_WAIT_V(4); PG8_BAR;
        PG8_STAGE(PG8_SB(1, 0), cB + kstep, voffB); PG8_STAGE(PG8_SA(1, 0), cA + kstep, voffA); PG8_STAGE(PG8_SB(1, 1), cB + hsB + kstep, voffB);
        PG8_WAIT_V(6); PG8_BAR;
    }
    for (;;) {
        const bool has_next = S.next(ui + 1, nxt);
        const char* nA = has_next ? (const char*)g.A + (size_t)nxt.pm * tsA : cA; const char* nB = has_next ? (const char*)g.Bt + (size_t)nxt.pn * tsB : cB;
        for (int t = 0; t < nt; t += 2) {
            const bool last = (t == nt - 2);
            const char* a1 = cA + (size_t)(t + 1) * kstep;
            const char* a2 = last ? nA : cA + (size_t)(t + 2) * kstep; const char* b2 = last ? nB : cB + (size_t)(t + 2) * kstep;
            const char* a3 = a2 + kstep; const char* b3 = b2 + kstep;
            if (last && has_next) S.a_ready(nxt);
            if constexpr (SP2) {
            PG8_LDB(B0, 0, 0); PG8_LDB(B1, 0, 1); PG8_SCHED; PG8_LDA(At, 0, 0); PG8_STAGE(PG8_SA(1, 1), a1 + hsA, voffA);
            PG8_WAIT_V(8); PG8_WAIT_L(0); PG8_BAR; PG8_MMA(0, 0, At, B0); PG8_MMA(0, 1, At, B1); PG8_BAR; PG8_SCHED;
            PG8_LDA(At, 0, 1); PG8_STAGE(PG8_SB(0, 0), b2, voffB); PG8_STAGE(PG8_SB(0, 1), b2 + hsB, voffB); PG8_STAGE(PG8_SA(0, 0), a2, voffA);
            PG8_WAIT_V(8); PG8_WAIT_L(0); PG8_BAR; PG8_MMA(1, 0, At, B0); PG8_MMA(1, 1, At, B1); PG8_BAR; PG8_SCHED;
            PG8_LDB(B0, 1, 0); PG8_LDB(B1, 1, 1); PG8_SCHED; PG8_LDA(At, 1, 0); PG8_STAGE(PG8_SA(0, 1), a2 + hsA, voffA);
            PG8_WAIT_V(8); PG8_WAIT_L(0); PG8_BAR; PG8_MMA(0, 0, At, B0); PG8_MMA(0, 1, At, B1); PG8_BAR; PG8_SCHED;
            PG8_LDA(At, 1, 1); PG8_STAGE(PG8_SB(1, 0), b3, voffB); PG8_STAGE(PG8_SB(1, 1), b3 + hsB, voffB); PG8_STAGE(PG8_SA(1, 0), a3, voffA);
            PG8_WAIT_V(8); PG8_WAIT_L(0); PG8_BAR; PG8_MMA(1, 0, At, B0); PG8_MMA(1, 1, At, B1); PG8_BAR; PG8_SCHED;
            } else {
            PG8_LDB(B0, 0, 0); PG8_SCHED; PG8_LDA(At, 0, 0); PG8_STAGE(PG8_SA(1, 1), a1 + hsA, voffA);
            PG8_WAIT_L(8); PG8_BAR; PG8_WAIT_L(0); PG8_MMA(0, 0, At, B0); PG8_BAR; PG8_SCHED;
            PG8_LDB(B1, 0, 1); PG8_STAGE(PG8_SB(0, 0), b2, voffB);
            PG8_BAR; PG8_WAIT_L(0); PG8_MMA(0, 1, At, B1); PG8_BAR;
            PG8_LDA(At, 0, 1); PG8_STAGE(PG8_SA(0, 0), a2, voffA);
            PG8_BAR; PG8_WAIT_L(0); PG8_MMA(1, 0, At, B0); PG8_BAR; PG8_SCHED;
            PG8_STAGE(PG8_SB(0, 1), b2 + hsB, voffB);
            PG8_WAIT_V(6); PG8_BAR; PG8_MMA(1, 1, At, B1); PG8_BAR;
            PG8_LDB(B0, 1, 0); PG8_SCHED; PG8_LDA(At, 1, 0); PG8_STAGE(PG8_SA(0, 1), a2 + hsA, voffA);
            PG8_WAIT_L(8); PG8_BAR; PG8_WAIT_L(0); PG8_MMA(0, 0, At, B0); PG8_BAR; PG8_SCHED;
            PG8_LDB(B1, 1, 1); PG8_STAGE(PG8_SB(1, 0), b3, voffB);
            PG8_BAR; PG8_WAIT_L(0); PG8_MMA(0, 1, At, B1); PG8_BAR;
            PG8_LDA(At, 1, 1); PG8_STAGE(PG8_SA(1, 0), a3, voffA);
            PG8_BAR; PG8_WAIT_L(0); PG8_MMA(1, 0, At, B0); PG8_BAR; PG8_SCHED;
            PG8_STAGE(PG8_SB(1, 1), b3 + hsB, voffB);
            PG8_WAIT_V(6); PG8_BAR; PG8_MMA(1, 1, At, B1); PG8_BAR;
            }
        }
        if constexpr (ALIGN_EPI) { if (wr == 0) PG8_BAR; }
        if constexpr (!Epi::AFTER_DRAIN) { E(acc, cur, wr, wc, fr, fq); S.done(cur); }
        if (!has_next) break;
#pragma unroll
        for (int a = 0; a < 2; ++a)
#pragma unroll
            for (int b = 0; b < 2; ++b)
#pragma unroll
                for (int m = 0; m < 4; ++m)
#pragma unroll
                    for (int n = 0; n < 2; ++n) acc[a][b][m][n] = (f32x4){0.f, 0.f, 0.f, 0.f};
        cur = nxt; cA = nA; cB = nB; ++ui;
        if constexpr (ALIGN_EPI) { if (wr == 1) PG8_BAR; }
    }
    PG8_WAIT_V(0);
    if constexpr (!ALIGN_EPI) { if (wr == 0) PG8_BAR; }
    PG8_BAR;
    if constexpr (Epi::AFTER_DRAIN) { E.fused(acc, cur, wr, wc, fr, fq, lds, wid, lane); S.done(cur); }
#undef PG8_SA
#undef PG8_SB
#undef PG8_STAGE
#undef PG8_LDA
#undef PG8_LDB
#undef PG8_MMA
#undef PG8_WAIT_V
#undef PG8_WAIT_L
#undef PG8_BAR
#undef PG8_SCHED
}
}

#define DI __device__ __forceinline__
typedef pg8::bf16_t bf16_t;
typedef short bf16x8 __attribute__((ext_vector_type(8)));
typedef short s16x4 __attribute__((ext_vector_type(4)));
typedef float f32x4 __attribute__((ext_vector_type(4)));
typedef float f32x16 __attribute__((ext_vector_type(16)));
typedef unsigned u32x4 __attribute__((ext_vector_type(4)));
typedef unsigned u32x2 __attribute__((ext_vector_type(2)));
#define LAS __attribute__((address_space(3)))
typedef float f32x2_t __attribute__((ext_vector_type(2)));

constexpr int DM = 1024, NB = 8, SEQ = 2048, CTXL = 256;
constexpr int NLAT = NB * SEQ, NCTX = NB * CTXL, MALL = NLAT + NCTX;
constexpr int FH = 2816, FH2 = 5632, EIN = 1792, OIN = 1280;
constexpr float NORM_EPS = 1e-6f;
constexpr float C2 = 0.125f * 1.4426950408889634f;
constexpr int NTHREADS = 512, NWAVES = 8;
constexpr int LDS_BYTES = 147456 + 8192 + 256, LDS_MISC = 147456 + 8192;
constexpr int NBND_LAT = NB * 31, NBND_CTX = NB * 3;
constexpr int XNE_ROW_L0 = MALL, XNE_ROW_L1 = NLAT;
constexpr int XN_ROWS = MALL + 1280;

constexpr size_t MiB = 1u << 20;
constexpr size_t WS_CTL = 0, CTL_ZERO_BYTES = 64 * 1024;
constexpr size_t WS_MOD = 1 * MiB;
constexpr size_t WS_ROPE = 2 * MiB;
constexpr size_t WS_RGW = 3 * MiB;
constexpr size_t WS_S5AT = 3 * MiB + 512 * 1024;
constexpr size_t WS_RGTOT = 4 * MiB;
constexpr size_t WS_S5E = 7 * MiB, WS_S5MF = 15 * MiB;
constexpr size_t WS_WIN0 = 39 * MiB, WS_WOUT0 = 43 * MiB, WS_WUP0 = 45 * MiB, WS_WDN0 = 56 * MiB;
constexpr size_t WS_WIN1 = 62 * MiB, WS_WOUT1 = 65 * MiB, WS_WUP1 = 67 * MiB, WS_WDN1 = 78 * MiB, WS_WGLU = 84 * MiB;
constexpr size_t WS_HC = 85 * MiB;
constexpr size_t WS_XN = 93 * MiB;
constexpr size_t WS_PROJ = 132 * MiB;
constexpr size_t WS_S5L = 177 * MiB;
constexpr size_t WS_MIX = 195 * MiB;
constexpr size_t WS_HID = 132 * MiB;
constexpr size_t WS_UG = WS_XN;
constexpr size_t WS_Z = 231 * MiB;
constexpr size_t WS_END = 250 * MiB;
static_assert(WS_XN + (size_t)XN_ROWS * DM * 2 <= WS_PROJ, "xn");
static_assert(WS_PROJ + (size_t)MALL * OIN * 2 <= WS_S5L && WS_S5L + (size_t)576 * 32 * 256 * 4 <= WS_MIX, "s5l");
static_assert((size_t)2 * MALL * 512 * 2 <= (size_t)XN_ROWS * DM * 2 && WS_Z + (size_t)MALL * 512 * 2 <= WS_END && WS_MIX + (size_t)MALL * DM * 2 <= WS_Z, "rg scratch");
static_assert(WS_HID + (size_t)MALL * FH * 2 <= WS_Z && WS_Z + (size_t)NLAT * 512 * 2 <= WS_END && (size_t)32 * 768 * 768 * 2 <= (size_t)XN_ROWS * DM * 2, "hid/z/ug");

DI float bf2f(bf16_t v) { return __uint_as_float((unsigned)v << 16); }
DI unsigned f2bf(float f) { unsigned u = __float_as_uint(f); return (u + 0x7fffu + ((u >> 16) & 1u)) >> 16; }
DI unsigned pk2(float lo, float hi) { return f2bf(lo) | (f2bf(hi) << 16); }
typedef __bf16 bf16x2v_t __attribute__((ext_vector_type(2)));
DI unsigned cvtpk_(float lo, float hi) { f32x2_t v = {lo, hi}; bf16x2v_t b = __builtin_convertvector(v, bf16x2v_t); return __builtin_bit_cast(unsigned, b); }
DI float wave_sum(float v) {
#pragma unroll
    for (int o = 1; o < 64; o <<= 1) v += __shfl_xor(v, o);
    return v;
}
DI float sigmoidf_(float x) { return __builtin_amdgcn_rcpf(1.f + __expf(-x)); }
DI float gelu_tanh(float x) { const float z = 1.5957691216057308f * (x + 0.044715f * x * x * x); return x * sigmoidf_(z); }
DI float siluf_(float x) { return x * sigmoidf_(x); }

struct EpiRes {
    static constexpr bool PERM = false, AFTER_DRAIN = false;
    const float* baseL; const float* baseC; float* outL; float* outC; const float* gate;
    __device__ __forceinline__ void operator()(const f32x4 (&acc)[2][2][4][2], const pg8::Unit& u, int wr, int wc, int fr, int fq) const {
        const bool isc = u.pm >= 64; const int bb = isc ? 8 : (u.pm >> 3);
        const float* base = isc ? baseC + (size_t)(u.pm - 64) * 256 * DM : baseL + (size_t)u.pm * 256 * DM;
        float* out = isc ? outC + (size_t)(u.pm - 64) * 256 * DM : outL + (size_t)u.pm * 256 * DM;
        const float* g = gate + (size_t)bb * 6144;
        const int col0 = u.pn * 256 + wc * 32 + 4 * fq;
#pragma unroll
        for (int bj = 0; bj < 2; ++bj)
#pragma unroll
            for (int n = 0; n < 2; ++n) {
                const int c = col0 + bj * 128 + n * 16; const f32x4 gv = *(const f32x4*)(g + c);
                f32x4 bs[2][4];
#pragma unroll
                for (int ai = 0; ai < 2; ++ai)
#pragma unroll
                    for (int m = 0; m < 4; ++m) bs[ai][m] = *(const f32x4*)(base + (size_t)(ai * 128 + wr * 64 + m * 16 + fr) * DM + c);
#pragma unroll
                for (int ai = 0; ai < 2; ++ai)
#pragma unroll
                    for (int m = 0; m < 4; ++m) *(f32x4*)(out + (size_t)(ai * 128 + wr * 64 + m * 16 + fr) * DM + c) = bs[ai][m] + gv * acc[ai][bj][m][n];
            }
    }
};

struct EpiCtxHalf {
    static constexpr bool PERM = false, AFTER_DRAIN = false;
    const float* baseC; float* outC; float* cp; const float* gate; int kh;
    __device__ __forceinline__ void operator()(const f32x4 (&acc)[2][2][4][2], const pg8::Unit& u, int wr, int wc, int fr, int fq) const {
        const size_t t0 = (size_t)(u.pm - 64) * 256 * DM; const float* g = gate + (size_t)8 * 6144;
        const int col0 = u.pn * 256 + wc * 32 + 4 * fq;
#pragma unroll
        for (int bj = 0; bj < 2; ++bj)
#pragma unroll
            for (int n = 0; n < 2; ++n) {
                const int c = col0 + bj * 128 + n * 16; const f32x4 gv = *(const f32x4*)(g + c);
                f32x4 bs[2][4];
#pragma unroll
                for (int ai = 0; ai < 2; ++ai)
#pragma unroll
                    for (int m = 0; m < 4; ++m) bs[ai][m] = kh == 0 ? *(const f32x4*)(baseC + t0 + (size_t)(ai * 128 + wr * 64 + m * 16 + fr) * DM + c) : (f32x4){0.f, 0.f, 0.f, 0.f};
                float* o = kh == 0 ? outC : cp;
#pragma unroll
                for (int ai = 0; ai < 2; ++ai)
#pragma unroll
                    for (int m = 0; m < 4; ++m) *(f32x4*)(o + t0 + (size_t)(ai * 128 + wr * 64 + m * 16 + fr) * DM + c) = bs[ai][m] + gv * acc[ai][bj][m][n];
            }
    }
};
struct CtxOrder {
    int c;
    __device__ bool next(int i, pg8::Unit& u) const { if (i != 0 || c < 0 || c >= 32) return false; u.pm = 64 + (c >> 2); u.pn = c & 3; return true; }
    __device__ __forceinline__ void a_ready(const pg8::Unit&) const {}
    __device__ __forceinline__ void done(const pg8::Unit&) const {}
};

struct EpiConvAct {
    static constexpr bool PERM = true, AFTER_DRAIN = false;
    bf16_t* H; const float* cw; const float* cb; int pm_edge; int nbnd_lat; int nbnd; char* xlds;
    __device__ __forceinline__ void operator()(const f32x4 (&acc)[2][2][4][2], const pg8::Unit& u, int wr_, int wc_, int fr_, int fq_) const {
        int tl = threadIdx.x; asm volatile("" : "+v"(tl));
        const int lane = tl & 63, wid_ = tl >> 6, fr = lane & 15, fq = lane >> 4, wr = wid_ >> 2, wc = wid_ & 3; (void)wr_; (void)wc_; (void)fr_; (void)fq_;
        const bool edge = u.pm >= pm_edge;
        const int hc0 = u.pn * 128 + wc * 32 + 8 * fq;
        u32x2* sc = (u32x2*)(xlds + wid_ * 2048);
        float* wl = (float*)(xlds + 16384 + wid_ * 1024);
        { const int p = lane >> 4, bjl = (lane >> 3) & 1, cg4 = lane & 7;
          const float* src = (p < 3 ? cw + p * FH2 : cb) + bjl * FH + u.pn * 128 + wc * 32 + 4 * cg4;
          *(f32x4*)(wl + (p * 2 + bjl) * 32 + 4 * cg4) = *(const f32x4*)src; }
        asm volatile("" ::: "memory");
#pragma unroll
        for (int n = 0; n < 2; ++n) {
#pragma unroll
            for (int ai = 0; ai < 2; ++ai) {
                float hvv[2][4][4];
#pragma unroll
                for (int bj = 0; bj < 2; ++bj) {
#pragma unroll
                    for (int m = 0; m < 4; ++m) { u32x2 w; w.x = cvtpk_(acc[ai][bj][m][n][0], acc[ai][bj][m][n][1]); w.y = cvtpk_(acc[ai][bj][m][n][2], acc[ai][bj][m][n][3]); sc[(16 * m + fr) * 4 + fq] = w; }
                    asm volatile("" ::: "memory");
                    const f32x4 w0 = *(const f32x4*)(wl + (0 * 2 + bj) * 32 + 8 * fq + 4 * n), w1 = *(const f32x4*)(wl + (1 * 2 + bj) * 32 + 8 * fq + 4 * n),
                                w2 = *(const f32x4*)(wl + (2 * 2 + bj) * 32 + 8 * fq + 4 * n), bb = *(const f32x4*)(wl + (3 * 2 + bj) * 32 + 8 * fq + 4 * n);
#pragma unroll
                    for (int m = 0; m < 4; ++m) {
                        const int row = 16 * m + fr; const int ru = row > 0 ? row - 1 : 0, rd = row < 63 ? row + 1 : 63;
                        u32x2 uu = sc[ru * 4 + fq], dd = sc[rd * 4 + fq];
                        if (row == 0) uu = (u32x2){0u, 0u}; if (row == 63) dd = (u32x2){0u, 0u};
                        const f32x4 up = (f32x4){__uint_as_float(uu.x << 16), __uint_as_float(uu.x & 0xffff0000u), __uint_as_float(uu.y << 16), __uint_as_float(uu.y & 0xffff0000u)};
                        const f32x4 dn = (f32x4){__uint_as_float(dd.x << 16), __uint_as_float(dd.x & 0xffff0000u), __uint_as_float(dd.y << 16), __uint_as_float(dd.y & 0xffff0000u)};
                        const f32x4 hv = bb + w0 * up + w1 * acc[ai][bj][m][n] + w2 * dn;
                        hvv[bj][m][0] = hv.x; hvv[bj][m][1] = hv.y; hvv[bj][m][2] = hv.z; hvv[bj][m][3] = hv.w;
                    }
                    asm volatile("" : "+v"(hvv[bj][0][0]), "+v"(hvv[bj][0][1]), "+v"(hvv[bj][0][2]), "+v"(hvv[bj][0][3]), "+v"(hvv[bj][1][0]), "+v"(hvv[bj][1][1]), "+v"(hvv[bj][1][2]), "+v"(hvv[bj][1][3]),
                                      "+v"(hvv[bj][2][0]), "+v"(hvv[bj][2][1]), "+v"(hvv[bj][2][2]), "+v"(hvv[bj][2][3]), "+v"(hvv[bj][3][0]), "+v"(hvv[bj][3][1]), "+v"(hvv[bj][3][2]), "+v"(hvv[bj][3][3]) :: "memory");
                }
#pragma unroll
                for (int m = 0; m < 4; ++m) {
                    const int R = ai * 128 + wr * 64 + m * 16 + fr;
                    long grow; bool st;
                    if (!edge) {
                        grow = (long)u.pm * 256 + R; st = true;
                        const int r64 = R & 63;
                        if (r64 == 0) st = (R == 0) && (u.pm >= 64 || (u.pm & 7) == 0);
                        if (r64 == 63) st = (R == 255) && (u.pm >= 64 || (u.pm & 7) == 7);
                    } else {
                        const int slot = (u.pm - pm_edge) * 256 + R, q = slot >> 2, pos = slot & 3;
                        st = (pos == 1 || pos == 2) && q < nbnd;
                        int row0;
                        if (q < nbnd_lat) { const int s = q / 31, k = q - s * 31 + 1; row0 = s * SEQ + 64 * k; }
                        else { const int q2 = q - nbnd_lat, s = q2 / 3, k = q2 - s * 3 + 1; row0 = NLAT + s * CTXL + 64 * k; }
                        grow = (long)row0 - 2 + pos;
                    }
                    if (st) { u32x2 w; w.x = cvtpk_(hvv[0][m][0] * siluf_(hvv[1][m][0]), hvv[0][m][1] * siluf_(hvv[1][m][1])); w.y = cvtpk_(hvv[0][m][2] * siluf_(hvv[1][m][2]), hvv[0][m][3] * siluf_(hvv[1][m][3]));
                        *(u32x2*)(H + (size_t)grow * FH + hc0 + 4 * n) = w; }
                }
                asm volatile("" ::: "memory"); __builtin_amdgcn_sched_barrier(0);
            }
        }
    }
};

struct EpiGlu {
    static constexpr bool PERM = true, AFTER_DRAIN = false;
    const bf16_t* Z; bf16_t* O; const float* bias;
    __device__ __forceinline__ void operator()(const f32x4 (&acc)[2][2][4][2], const pg8::Unit& u, int wr, int wc, int fr, int fq) const {
        const int row0 = u.pm * 256 + wr * 64 + fr; const int col0 = u.pn * 256 + wc * 32 + 8 * fq;
#pragma unroll
        for (int bj = 0; bj < 2; ++bj) {
            const f32x4 b0 = *(const f32x4*)(bias + col0 + bj * 128), b1 = *(const f32x4*)(bias + col0 + bj * 128 + 4);
            u32x4 zq[2][4];
#pragma unroll
            for (int ai = 0; ai < 2; ++ai)
#pragma unroll
                for (int m = 0; m < 4; ++m) zq[ai][m] = *(const u32x4*)(Z + (size_t)(row0 + ai * 128 + m * 16) * 512 + col0 + bj * 128);
#pragma unroll
            for (int ai = 0; ai < 2; ++ai)
#pragma unroll
                for (int m = 0; m < 4; ++m) {
                    const size_t r = (size_t)(row0 + ai * 128 + m * 16);
                    const u32x4 zz = zq[ai][m];
                    const f32x4 v0 = acc[ai][bj][m][0] + b0, v1 = acc[ai][bj][m][1] + b1;
                    float o[8];
#pragma unroll
                    for (int j = 0; j < 4; ++j) {
                        const float z0 = __uint_as_float((j & 1) ? (zz[j >> 1] & 0xffff0000u) : (zz[j >> 1] << 16));
                        const float z1 = __uint_as_float((j & 1) ? (zz[2 + (j >> 1)] & 0xffff0000u) : (zz[2 + (j >> 1)] << 16));
                        o[j] = z0 * sigmoidf_(v0[j]); o[4 + j] = z1 * sigmoidf_(v1[j]);
                    }
                    u32x4 w; w.x = pk2(o[0], o[1]); w.y = pk2(o[2], o[3]); w.z = pk2(o[4], o[5]); w.w = pk2(o[6], o[7]);
                    *(u32x4*)(O + r * DM + col0 + bj * 128) = w;
                }
        }
    }
};
#define GAS __attribute__((address_space(1)))
typedef GAS unsigned gu32;
typedef GAS unsigned long long gu64;
#define RLX_AGENT __ATOMIC_RELAXED, __HIP_MEMORY_SCOPE_AGENT
#define LDS_WAIT() asm volatile("s_waitcnt lgkmcnt(0)" ::: "memory")
#define VM_WAIT() asm volatile("s_waitcnt vmcnt(0)" ::: "memory")
__device__ __forceinline__ unsigned long long rt() { return __builtin_amdgcn_s_memrealtime(); }
#define XB_TMO      128
#define XB_XCNT(j)  (256  + 64 * (j))
#define XB_XSUB(j)  (1280 + 64 * (j))
#define XB_XGEN(j)  (2304 + 64 * (j))
#define XB_TOP      3328
#define XB_TOPGEN   3392
#define XCD_BAR_WORDS 3456
#define XB_SPIN_CAP (1u << 18)

__device__ __forceinline__ unsigned xb_ld(unsigned* p)              { return __hip_atomic_load(p, __ATOMIC_RELAXED, __HIP_MEMORY_SCOPE_AGENT); }
__device__ __forceinline__ unsigned xb_add(unsigned* p, unsigned v) { return __hip_atomic_fetch_add(p, v, __ATOMIC_RELAXED, __HIP_MEMORY_SCOPE_AGENT); }
__device__ __forceinline__ unsigned xb_xcc_id() { return (unsigned)__builtin_amdgcn_s_getreg((3 << 11) | 20) & 0xFu; }
#define XB_SPIN(cond, bar) do { unsigned _sp = 0; while (cond) { __builtin_amdgcn_s_sleep(1); \
    if ((++_sp & 255u) == 0u) { if (xb_ld(&(bar)[XB_TMO])) break; if (_sp > XB_SPIN_CAP) { atomicAdd(&(bar)[XB_TMO], 1u); break; } } } } while (0)

struct XcdBarrier {
    unsigned* bar; unsigned x;
    volatile LAS unsigned* st;
};

__device__ __forceinline__ XcdBarrier xcd_barrier_post(unsigned* bar, volatile LAS unsigned* st) {
    XcdBarrier b; b.bar = bar; b.x = xb_xcc_id(); b.st = st;
    if (threadIdx.x == 0) (void)xb_add(&bar[XB_XCNT(b.x)], 1u);
    return b;
}
__device__ __forceinline__ void xcd_barrier_complete(unsigned* bar, unsigned x, unsigned& nloc, unsigned& nx) {
    const unsigned G = gridDim.x * gridDim.y * gridDim.z;
    unsigned sum, cnt, mine, sp = 0u;
    for (;;) {
        sum = 0u; cnt = 0u; mine = 0u;
#pragma unroll
        for (unsigned j = 0; j < 16; ++j) { const unsigned c = xb_ld(&bar[XB_XCNT(j)]); sum += c; cnt += (c > 0u) ? 1u : 0u; mine = (j == x) ? c : mine; }
        if (sum == G) break;
        __builtin_amdgcn_s_sleep(1);
        if ((++sp & 255u) == 0u) { if (xb_ld(&bar[XB_TMO])) break; if (sp > XB_SPIN_CAP) { atomicAdd(&bar[XB_TMO], 1u); break; } }
    }
    nloc = mine > 0u ? mine : 1u; nx = cnt > 0u ? cnt : 1u;
}

__device__ __forceinline__ void xcd_barrier(const XcdBarrier& b) {
    asm volatile("s_waitcnt vmcnt(0)" ::: "memory");
    __syncthreads();
    if (threadIdx.x == 0) {
        unsigned* bar = b.bar;
        __builtin_amdgcn_s_waitcnt(0);
        unsigned nloc = b.st[0], nx = b.st[1];
        if (nloc == 0u) { xcd_barrier_complete(bar, b.x, nloc, nx); b.st[0] = nloc; b.st[1] = nx; }
        const unsigned old = xb_add(&bar[XB_XSUB(b.x)], 1u);
        const unsigned gen = old / nloc;
        if (old + 1u == (gen + 1u) * nloc) {
            __builtin_amdgcn_fence(__ATOMIC_RELEASE, "agent");
            asm volatile("s_waitcnt vmcnt(0)" ::: "memory");
            const unsigned og = xb_add(&bar[XB_TOP], 1u);
            const unsigned tg = og / nx;
            if (og + 1u == (tg + 1u) * nx) xb_add(&bar[XB_TOPGEN], 1u);
            else XB_SPIN(xb_ld(&bar[XB_TOPGEN]) == tg, bar);
            __builtin_amdgcn_fence(__ATOMIC_ACQUIRE, "agent");
            xb_add(&bar[XB_XGEN(b.x)], 1u);
            asm volatile("s_waitcnt vmcnt(0)" ::: "memory");
        } else {
            XB_SPIN(xb_ld(&bar[XB_XGEN(b.x)]) == gen, bar);
            __builtin_amdgcn_fence(__ATOMIC_ACQUIRE, "agent");
            asm volatile("s_waitcnt vmcnt(0)" ::: "memory");
        }
    }
    __syncthreads();
}

DI s16x4 vtr(const char* p) { typedef short v4i16_t __attribute__((ext_vector_type(4))); return __builtin_bit_cast(s16x4, __builtin_amdgcn_ds_read_tr16_b64_v4i16((LAS v4i16_t*)p)); }
typedef __bf16 bf16x2_t __attribute__((ext_vector_type(2)));
DI unsigned cvtpk(float lo, float hi) { f32x2_t v = {lo, hi}; bf16x2_t b = __builtin_convertvector(v, bf16x2_t); return __builtin_bit_cast(unsigned, b); }
DI int crow(int r, int h) { return (r & 3) + 8 * (r >> 2) + 4 * h; }
#define MFMA32(a, b, c) __builtin_amdgcn_mfma_f32_32x32x16_bf16((a), (b), (c), 0, 0, 0)
constexpr int ATT_BUF = 17408, ATT_KB = 9216;

template <int MODE>
DI void attn_unit(const bf16_t* __restrict__ P, int ld, int qoff, int koff, int voff, bf16_t* __restrict__ O, char* lds, int b, int head, int q0, float sink_l2) {
    const int tid = threadIdx.x, lane = tid & 63, wid = tid >> 6, r32 = lane & 31, hi = lane >> 5;
    const int kvh = head >> 2;
    const int qrow0 = (MODE == 1) ? (NLAT + b * CTXL) : (b * SEQ + q0);
    int lat0 = 0, nlat = 0;
    if (MODE == 0) { lat0 = 0; nlat = SEQ / 64; }
    if (MODE == 2) { const int lo = q0 - 128 < 0 ? 0 : q0 - 128; const int hi_ = q0 + 384 > SEQ ? SEQ : q0 + 384; lat0 = lo; nlat = (hi_ - lo) / 64; }
    const int NT = 4 + nlat;
#define KROW(t) ((t) < 4 ? (NLAT + b * CTXL + 64 * (t)) : (b * SEQ + lat0 + 64 * ((t) - 4)))
    const bf16_t* Qp = P + (size_t)(qrow0 + wid * 32 + r32) * ld + qoff + head * 64 + 8 * hi;
    bf16x8 qr[4];
#pragma unroll
    for (int ks = 0; ks < 4; ++ks) qr[ks] = *(const bf16x8*)(Qp + 16 * ks);
    const int srow = tid >> 3, sch = tid & 7;
    const bf16_t* kg = P + koff + kvh * 64 + sch * 8; const bf16_t* vg = P + voff + kvh * 64 + sch * 8;
    const int kw = srow * 144 + sch * 16, vw = ATT_KB + (sch >> 2) * 4096 + srow * 64 + (sch & 3) * 16;
    const int kr_off = r32 * 144 + 16 * hi;
    const int vr_off = ATT_KB + ((lane >> 4) & 1) * 32 + (lane & 3) * 8 + (4 * hi + ((lane & 15) >> 2)) * 64;
    u32x4 kreg, vreg;
    { const size_t r = (size_t)(KROW(0) + srow) * ld; kreg = *(const u32x4*)(kg + r); vreg = *(const u32x4*)(vg + r); }
    *(u32x4*)(lds + kw) = kreg; *(u32x4*)(lds + vw) = vreg;
    if (NT > 1) { const size_t r = (size_t)(KROW(1) + srow) * ld; kreg = *(const u32x4*)(kg + r); vreg = *(const u32x4*)(vg + r); }
    float m = 0.f, l = 0.f; f32x16 o0 = {}, o1 = {}, negm = {};
    const int qpos = q0 + wid * 32 + r32;
    __syncthreads();
    for (int t = 0; t < NT; ++t) {
        const char* buf = lds + (t & 1) * ATT_BUF;
        bool need = true; int kpos0 = 0;
        if (MODE == 2 && t >= 4) { kpos0 = lat0 + 64 * (t - 4); const int ql = q0 + wid * 32; need = (kpos0 <= ql + 31 + 128) && (kpos0 + 63 >= ql - 128); }
        if (need) {
            f32x16 p0 = negm, p1 = negm;
#pragma unroll
            for (int ks = 0; ks < 4; ++ks) {
                const bf16x8 k0 = *(const bf16x8*)(buf + kr_off + ks * 32), k1 = *(const bf16x8*)(buf + kr_off + 32 * 144 + ks * 32);
                p0 = MFMA32(k0, qr[ks], p0); p1 = MFMA32(k1, qr[ks], p1);
            }
            if (MODE == 2 && t >= 4) {
#pragma unroll
                for (int i = 0; i < 16; ++i) { const int kp = kpos0 + crow(i, hi); int d0 = qpos - kp; d0 = d0 < 0 ? -d0 : d0; int d1 = qpos - kp - 32; d1 = d1 < 0 ? -d1 : d1;
                    if (d0 > 128) p0[i] = -1e30f; if (d1 > 128) p1[i] = -1e30f; }
            }
            float mx = fmaxf(fmaxf(p0[0], p0[1]), p1[0]), mx2 = fmaxf(fmaxf(p0[2], p0[3]), p1[1]);
#pragma unroll
            for (int i = 4; i < 16; i += 4) { mx = fmaxf(fmaxf(mx, p0[i]), p0[i + 1]); mx2 = fmaxf(fmaxf(mx2, p0[i + 2]), p0[i + 3]); }
#pragma unroll
            for (int i = 2; i < 16; i += 2) { mx = fmaxf(fmaxf(mx, p1[i]), p1[i + 1]); }
            mx = fmaxf(mx, mx2); mx = fmaxf(mx, __shfl_xor(mx, 32));
            if (__any(mx > 8.f)) {
                const float dl = fmaxf(mx, 0.f); m += dl; const float f = __builtin_amdgcn_exp2f(-dl); l *= f;
#pragma unroll
                for (int i = 0; i < 16; ++i) { p0[i] -= dl; p1[i] -= dl; o0[i] *= f; o1[i] *= f; negm[i] = -m; }
            }
            float rs = 0.f, rs2 = 0.f;
#pragma unroll
            for (int i = 0; i < 16; ++i) { p0[i] = __builtin_amdgcn_exp2f(p0[i]); rs += p0[i]; }
#pragma unroll
            for (int i = 0; i < 16; ++i) { p1[i] = __builtin_amdgcn_exp2f(p1[i]); rs2 += p1[i]; }
            l += rs + rs2;
#pragma unroll
            for (int s = 0; s < 4; ++s) {
                u32x4 pw;
                if (s < 2) { pw[0] = cvtpk(p0[8 * (s & 1)], p0[8 * (s & 1) + 1]); pw[1] = cvtpk(p0[8 * (s & 1) + 2], p0[8 * (s & 1) + 3]); pw[2] = cvtpk(p0[8 * (s & 1) + 4], p0[8 * (s & 1) + 5]); pw[3] = cvtpk(p0[8 * (s & 1) + 6], p0[8 * (s & 1) + 7]); }
                else { pw[0] = cvtpk(p1[8 * (s & 1)], p1[8 * (s & 1) + 1]); pw[1] = cvtpk(p1[8 * (s & 1) + 2], p1[8 * (s & 1) + 3]); pw[2] = cvtpk(p1[8 * (s & 1) + 4], p1[8 * (s & 1) + 5]); pw[3] = cvtpk(p1[8 * (s & 1) + 6], p1[8 * (s & 1) + 7]); }
                const bf16x8 pb = __builtin_bit_cast(bf16x8, pw);
                const char* vb = buf + vr_off + s * 1024;
                const s16x4 a0 = vtr(vb), a1 = vtr(vb + 512), c0 = vtr(vb + 4096), c1 = vtr(vb + 4096 + 512);
                const bf16x8 va0 = (bf16x8){a0[0], a0[1], a0[2], a0[3], a1[0], a1[1], a1[2], a1[3]};
                const bf16x8 va1 = (bf16x8){c0[0], c0[1], c0[2], c0[3], c1[0], c1[1], c1[2], c1[3]};
                o0 = MFMA32(va0, pb, o0); o1 = MFMA32(va1, pb, o1);
            }
        }
        if (t + 1 < NT) {
            char* nb = lds + ((t + 1) & 1) * ATT_BUF;
            *(u32x4*)(nb + kw) = kreg; *(u32x4*)(nb + vw) = vreg;
            if (t + 2 < NT) { const size_t r = (size_t)(KROW(t + 2) + srow) * ld; kreg = *(const u32x4*)(kg + r); vreg = *(const u32x4*)(vg + r); }
        }
        __syncthreads();
    }
#undef KROW
    l += __shfl_xor(l, 32);
    if (MODE == 2) l += __builtin_amdgcn_exp2f(sink_l2 - m);
    const float inv = 1.f / l;
    bf16_t* Op = O + (size_t)(qrow0 + wid * 32 + r32) * DM + 512 + head * 64 + 4 * hi;
#pragma unroll
    for (int k = 0; k < 4; ++k) {
        u32x2 w0, w1;
        w0.x = pk2(o0[4 * k] * inv, o0[4 * k + 1] * inv); w0.y = pk2(o0[4 * k + 2] * inv, o0[4 * k + 3] * inv);
        w1.x = pk2(o1[4 * k] * inv, o1[4 * k + 1] * inv); w1.y = pk2(o1[4 * k + 2] * inv, o1[4 * k + 3] * inv);
        *(u32x2*)(Op + 8 * k) = w0; *(u32x2*)(Op + 32 + 8 * k) = w1;
    }
}

constexpr int RG_XA = 0, RG_XF = 9216, RG_GT = RG_XF + 64 * 65 * 4  , RG_SEG = RG_GT + 4 * 64 * 65 * 4  , RG_CAR = RG_SEG + 2 * 64 * 4 * 8  ;
DI bf16_t* rg_yl(unsigned char* ws) { return (bf16_t*)(ws + WS_XN); }
DI bf16_t* rg_pf(unsigned char* ws) { return (bf16_t*)(ws + WS_XN) + (size_t)MALL * 512; }
DI bf16_t* rg_pb(unsigned char* ws) { return (bf16_t*)(ws + WS_Z); }
DI void rg_item1(const float* const* in, unsigned char* ws, char* lds, int item) {
    const int tid = threadIdx.x, lane = tid & 63, wid = tid >> 6;
    const int ci = item % 36, bh = item / 36, head = bh & 7, b = bh >> 3;
    const bf16_t* PROJ = (const bf16_t*)(ws + WS_PROJ);
    const int seqbase = ci < 4 ? NLAT + b * CTXL : b * SEQ, t0 = ci < 4 ? ci * 64 : (ci - 4) * 64, slen = ci < 4 ? CTXL : SEQ;
    bf16_t* XA = (bf16_t*)(lds + RG_XA); float* XF = (float*)(lds + RG_XF); float* GT = (float*)(lds + RG_GT); float* SEGL = (float*)(lds + RG_SEG);
    float* TOT = (float*)(ws + WS_RGTOT);
    const int sdir = tid >> 8, sch = (tid >> 2) & 63, sseg = tid & 3;
    {
        const int tok = tid >> 3, cg8 = tid & 7, ch0 = head * 64 + cg8 * 8;
        const float* cw = in[13]; const float* cb = in[14];
        float x[8]; u32x4 uu4[4]; f32x4 wq[5][2];
#pragma unroll
        for (int j = 0; j < 4; ++j) { int tt = t0 + tok + j - 1; tt = tt < 0 ? 0 : (tt >= slen ? slen - 1 : tt); uu4[j] = *(const u32x4*)(PROJ + (size_t)(seqbase + tt) * EIN + ch0); }
#pragma unroll
        for (int j = 0; j < 4; ++j) { wq[j][0] = *(const f32x4*)(cw + j * 512 + ch0); wq[j][1] = *(const f32x4*)(cw + j * 512 + ch0 + 4); }
        wq[4][0] = *(const f32x4*)(cb + ch0); wq[4][1] = *(const f32x4*)(cb + ch0 + 4);
#pragma unroll
        for (int c = 0; c < 8; ++c) x[c] = wq[4][c >> 2][c & 3];
#pragma unroll
        for (int j = 0; j < 4; ++j) {
            const int tt = t0 + tok + j - 1; const float msk = (tt >= 0 && tt < slen) ? 1.f : 0.f;
#pragma unroll
            for (int c = 0; c < 8; ++c) { const float uv = __uint_as_float((c & 1) ? (uu4[j][c >> 1] & 0xffff0000u) : (uu4[j][c >> 1] << 16)); x[c] += (wq[j][c >> 2][c & 3] * msk) * uv; }
        }
        u32x4 w; w.x = pk2(x[0], x[1]); w.y = pk2(x[2], x[3]); w.z = pk2(x[4], x[5]); w.w = pk2(x[6], x[7]);
        *(u32x4*)(XA + tok * 72 + cg8 * 8) = w;
#pragma unroll
        for (int c = 0; c < 8; ++c) XF[tok * 65 + cg8 * 8 + c] = x[c];
    }
    __syncthreads();
    {
        const int mi = wid & 3, th = wid >> 2, r32 = lane & 31, hi = lane >> 5;
        const bf16_t* W = (const bf16_t*)(ws + WS_RGW) + (size_t)(mi * 8 + head) * 4096;
        const float* bias = (mi & 1) ? in[18] : in[16]; const int dirm = mi >> 1;
#pragma unroll
        for (int nt = 0; nt < 2; ++nt) {
            f32x16 acc = {};
#pragma unroll
            for (int ks = 0; ks < 4; ++ks) {
                const bf16x8 a = *(const bf16x8*)(XA + (32 * th + r32) * 72 + 16 * ks + 8 * hi);
                const bf16x8 bfr = *(const bf16x8*)(W + (32 * nt + r32) * 64 + 16 * ks + 8 * hi);
                acc = MFMA32(a, bfr, acc);
            }
            const float bv = bias[dirm * 512 + head * 64 + 32 * nt + r32];
#pragma unroll
            for (int i = 0; i < 16; ++i) GT[(mi * 64 + 32 * th + crow(i, hi)) * 65 + 32 * nt + r32] = sigmoidf_(acc[i] + bv);
        }
    }
    __syncthreads();
    float av[16], bvv[16];
    {
        const float lam = in[19][sdir * 512 + head * 64 + sch];
        const float nl = -lam; const float sp = nl > 20.f ? nl : log1pf(__expf(nl));
        float hh = 0.f, PP = 1.f;
#pragma unroll
        for (int s = 0; s < 16; ++s) {
            const int k = 16 * sseg + s, tok = sdir == 0 ? k : 63 - k;
            const float r = GT[((2 * sdir) * 64 + tok) * 65 + sch], ig = GT[((2 * sdir + 1) * 64 + tok) * 65 + sch], x = XF[tok * 65 + sch];
            const float la = -8.f * r * sp; const float a = __expf(la); const float bb = __builtin_amdgcn_sqrtf(fmaxf(1.f - a * a, 0.f)) * (ig * x);
            av[s] = a; bvv[s] = bb; hh = a * hh + bb; PP *= a;
        }
        __syncthreads();
        SEGL[((sdir * 64 + sch) * 4 + sseg) * 2] = PP; SEGL[((sdir * 64 + sch) * 4 + sseg) * 2 + 1] = hh;
    }
    __syncthreads();
    {
        float c = 0.f, Pbef = 1.f, Pt = 1.f;
#pragma unroll
        for (int s = 0; s < 4; ++s) { const float p = SEGL[((sdir * 64 + sch) * 4 + s) * 2], h = SEGL[((sdir * 64 + sch) * 4 + s) * 2 + 1];
            if (s < sseg) { c = p * c + h; Pbef *= p; } Pt *= p; }
        float h = c, P = Pbef;
#pragma unroll
        for (int s = 0; s < 16; ++s) { const int k = 16 * sseg + s, tok = sdir == 0 ? k : 63 - k; h = av[s] * h + bvv[s]; P *= av[s];
            GT[(sdir * 64 + tok) * 65 + sch] = h; GT[((2 + sdir) * 64 + tok) * 65 + sch] = P; }
        if (sseg == 3) { float* tp = TOT + ((size_t)((sdir * NB + b) * 36 + ci) * 2) * 512 + head * 64 + sch; tp[0] = Pt; tp[512] = h; }
    }
    __syncthreads();
    {
        const int tok = tid >> 3, cg8 = tid & 7, ch0 = head * 64 + cg8 * 8;
        const size_t off = (size_t)(seqbase + t0 + tok) * 512 + ch0;
        float y[8], pf[8], pb[8];
#pragma unroll
        for (int c = 0; c < 8; ++c) { y[c] = GT[tok * 65 + cg8 * 8 + c] + GT[(64 + tok) * 65 + cg8 * 8 + c]; pf[c] = GT[(128 + tok) * 65 + cg8 * 8 + c]; pb[c] = GT[(192 + tok) * 65 + cg8 * 8 + c]; }
        u32x4 w; w.x = pk2(y[0], y[1]); w.y = pk2(y[2], y[3]); w.z = pk2(y[4], y[5]); w.w = pk2(y[6], y[7]); *(u32x4*)(rg_yl(ws) + off) = w;
        w.x = pk2(pf[0], pf[1]); w.y = pk2(pf[2], pf[3]); w.z = pk2(pf[4], pf[5]); w.w = pk2(pf[6], pf[7]); *(u32x4*)(rg_pf(ws) + off) = w;
        w.x = pk2(pb[0], pb[1]); w.y = pk2(pb[2], pb[3]); w.z = pk2(pb[4], pb[5]); w.w = pk2(pb[6], pb[7]); *(u32x4*)(rg_pb(ws) + off) = w;
    }
    __syncthreads();
}
DI void rg_item2(const float* const* in, unsigned char* ws, char* lds, int item) {
    const int tid = threadIdx.x;
    const int ci = item % 36, bh = item / 36, head = bh & 7, b = bh >> 3;
    const bf16_t* PROJ = (const bf16_t*)(ws + WS_PROJ);
    const int seqbase = ci < 4 ? NLAT + b * CTXL : b * SEQ, t0 = ci < 4 ? ci * 64 : (ci - 4) * 64;
    float* SEGL = (float*)(lds + RG_SEG); float* CAR = (float*)(lds + RG_CAR);
    const float* TOT = (const float*)(ws + WS_RGTOT);
    const int sdir = tid >> 8, sch = (tid >> 2) & 63, sseg = tid & 3;
    const int tok = tid >> 3, cg8 = tid & 7, ch0 = head * 64 + cg8 * 8;
    const size_t row = (size_t)(seqbase + t0 + tok); const size_t off = row * 512 + ch0;
    const u32x4 yv = *(const u32x4*)(rg_yl(ws) + off), pfv = *(const u32x4*)(rg_pf(ws) + off), pbv = *(const u32x4*)(rg_pb(ws) + off), gg = *(const u32x4*)(PROJ + row * EIN + 512 + ch0);
    {
        const int pos = sdir == 0 ? ci : (ci < 4 ? 3 - ci : 4 + (35 - ci));
        float pp[9], hh[9];
#pragma unroll
        for (int i = 0; i < 9; ++i) { const int k0 = sseg * 9 + i; const int k = k0 < 35 ? k0 : 35; const int ck = sdir == 0 ? k : (k < 4 ? 3 - k : 35 - (k - 4));
            const float* tp = TOT + ((size_t)((sdir * NB + b) * 36 + ck) * 2) * 512 + head * 64 + sch; pp[i] = tp[0]; hh[i] = tp[512]; }
#pragma unroll
        for (int i = 0; i < 9; ++i) { if (sseg * 9 + i >= pos) { pp[i] = 1.f; hh[i] = 0.f; } }
        float Pc = 1.f, Hc = 0.f;
#pragma unroll
        for (int i = 0; i < 9; ++i) { Hc = pp[i] * Hc + hh[i]; Pc *= pp[i]; }
        SEGL[((sdir * 64 + sch) * 4 + sseg) * 2] = Pc; SEGL[((sdir * 64 + sch) * 4 + sseg) * 2 + 1] = Hc;
    }
    __syncthreads();
    if (tid < 128) { const int d = tid >> 6, ch = tid & 63; float Hc = 0.f;
#pragma unroll
        for (int s = 0; s < 4; ++s) { const float p = SEGL[((d * 64 + ch) * 4 + s) * 2], h = SEGL[((d * 64 + ch) * 4 + s) * 2 + 1]; Hc = p * Hc + h; }
        CAR[d * 64 + ch] = Hc; }
    __syncthreads();
    {
        float o[8];
#pragma unroll
        for (int c = 0; c < 8; ++c) {
            const float yl = __uint_as_float((c & 1) ? (yv[c >> 1] & 0xffff0000u) : (yv[c >> 1] << 16)), pf = __uint_as_float((c & 1) ? (pfv[c >> 1] & 0xffff0000u) : (pfv[c >> 1] << 16));
            const float pb = __uint_as_float((c & 1) ? (pbv[c >> 1] & 0xffff0000u) : (pbv[c >> 1] << 16)), gt = __uint_as_float((c & 1) ? (gg[c >> 1] & 0xffff0000u) : (gg[c >> 1] << 16));
            const float y = yl + pf * CAR[cg8 * 8 + c] + pb * CAR[64 + cg8 * 8 + c]; o[c] = y * gelu_tanh(gt); }
        u32x4 w; w.x = pk2(o[0], o[1]); w.y = pk2(o[2], o[3]); w.z = pk2(o[4], o[5]); w.w = pk2(o[6], o[7]);
        *(u32x4*)((bf16_t*)(ws + WS_MIX) + row * DM + ch0) = w;
    }
    __syncthreads();
}

DI void s5_pre_item(const float* const* in, unsigned char* ws, char* lds, int item) {
    const int tid = threadIdx.x; const int g = item >> 2, qq = item & 3;
    float* AP = (float*)lds;
    float* BB = AP + 2 * 33 * 64 * 2;
    float* CC = BB + 2 * 64 * 16 * 2;
    float* KT = CC + 2 * 16 * 64 * 2;
    const float* lam_re = in[24]; const float* lam_im = in[25]; const float* lstep = in[26];
    {
        const int p = tid & 63, d = (tid >> 6) & 1, j0 = tid >> 7;
        const float dt = __expf(lstep[d * 32 + g]); const float lr = lam_re[(d * 32 + g) * 64 + p], li = lam_im[(d * 32 + g) * 64 + p];
        for (int j = j0; j < 33; j += 4) { const float mag = __expf((float)j * lr * dt), ang = (float)j * li * dt; const int e = (d * 33 + j) * 64 + p; AP[e * 2] = mag * __cosf(ang); AP[e * 2 + 1] = mag * __sinf(ang); }
    }
    {
        float lr4[4], li4[4], br4[4], bi4[4], cr4[4], ci4[4], dt4[4];
#pragma unroll
        for (int i = 0; i < 4; ++i) { const int e = tid + i * NTHREADS; const int h = e & 15, p = (e >> 4) & 63, d = e >> 10;
            dt4[i] = lstep[d * 32 + g]; lr4[i] = lam_re[(d * 32 + g) * 64 + p]; li4[i] = lam_im[(d * 32 + g) * 64 + p];
            br4[i] = in[27][((size_t)(d * 32 + g) * 64 + p) * 16 + h]; bi4[i] = in[28][((size_t)(d * 32 + g) * 64 + p) * 16 + h];
            const int p2 = e & 63, h2 = (e >> 6) & 15; cr4[i] = in[29][((size_t)(d * 32 + g) * 16 + h2) * 64 + p2]; ci4[i] = in[30][((size_t)(d * 32 + g) * 16 + h2) * 64 + p2]; }
#pragma unroll
        for (int i = 0; i < 4; ++i) { const int e = tid + i * NTHREADS; const float dt = __expf(dt4[i]), lr = lr4[i], li = li4[i];
            const float mag = __expf(lr * dt), ang = li * dt; const float abr = mag * __cosf(ang), abi = mag * __sinf(ang);
            const float den = lr * lr + li * li, nr = abr - 1.f, ni = abi; const float kr = (nr * lr + ni * li) / den, ki = (ni * lr - nr * li) / den;
            BB[e * 2] = kr * br4[i] - ki * bi4[i]; BB[e * 2 + 1] = kr * bi4[i] + ki * br4[i]; CC[e * 2] = cr4[i]; CC[e * 2 + 1] = ci4[i]; }
    }
    __syncthreads();
    for (int task = tid; task < 64 * 16; task += NTHREADS) {
        const int dj = task >> 4, blk = task & 15, d = dj >> 5, j = dj & 31, ho0 = 4 * (blk >> 2), hi0 = 4 * (blk & 3);
        const int jmax = d == 0 ? 8 * qq + 7 : 31 - 8 * qq;
        if (j > jmax) continue;
        float acc4[4][4];
#pragma unroll
        for (int i = 0; i < 4; ++i)
#pragma unroll
            for (int k = 0; k < 4; ++k) acc4[i][k] = 0.f;
        const f32x2_t* ap = (const f32x2_t*)AP + (d * 33 + j) * 64; const f32x2_t* cp = (const f32x2_t*)CC + (d * 16 + ho0) * 64; const f32x4* bp = (const f32x4*)(BB + (size_t)(d * 64) * 16 * 2 + hi0 * 2);
#pragma unroll 2
        for (int p = 0; p < 64; ++p) {
            const f32x2_t av = ap[p]; const f32x4 b01 = bp[p * 8], b23 = bp[p * 8 + 1];
#pragma unroll
            for (int i = 0; i < 4; ++i) { const f32x2_t cv = cp[i * 64 + p]; const float xr = cv.x * av.x - cv.y * av.y, xi = cv.x * av.y + cv.y * av.x;
                acc4[i][0] += xr * b01.x - xi * b01.y; acc4[i][1] += xr * b01.z - xi * b01.w; acc4[i][2] += xr * b23.x - xi * b23.y; acc4[i][3] += xr * b23.z - xi * b23.w; }
        }
#pragma unroll
        for (int i = 0; i < 4; ++i) *(f32x4*)(KT + (d * 32 + j) * 256 + (ho0 + i) * 16 + hi0) = (f32x4){acc4[i][0], acc4[i][1], acc4[i][2], acc4[i][3]};
    }
    __syncthreads();
    bf16_t* Mg = (bf16_t*)(ws + WS_S5MF) + (size_t)g * 512 * 768; bf16_t* Eg = (bf16_t*)(ws + WS_S5E) + (size_t)g * 256 * 512; bf16_t* Fg = Mg + 512;
    const float dval = in[31][g * 16 + (tid & 15)];
    for (int e = tid; e < 128 * 512; e += NTHREADS) { const int k = e & 511, mr = e >> 9, m = qq * 128 + mr; const int t = m >> 4, ho = m & 15, tau = k >> 4, hi = k & 15;
        float v = 0.f; if (tau <= t) v += KT[(0 * 32 + (t - tau)) * 256 + ho * 16 + hi]; if (tau >= t) v += KT[(1 * 32 + (tau - t)) * 256 + ho * 16 + hi];
        if (tau == t && ho == hi) v += dval;
        Mg[(size_t)m * 768 + k] = (bf16_t)f2bf(v); }
    { const int d = qq >> 1, c = qq & 1;
      for (int e = tid; e < 64 * 512; e += NTHREADS) { const int k = e & 511, p = e >> 9, tau = k >> 4, hi = k & 15; const int j = d == 0 ? 31 - tau : tau;
          const float ar = AP[((d * 33 + j) * 64 + p) * 2], ai = AP[((d * 33 + j) * 64 + p) * 2 + 1]; const float br = BB[((d * 64 + p) * 16 + hi) * 2], bi = BB[((d * 64 + p) * 16 + hi) * 2 + 1];
          const float v = c ? (ar * bi + ai * br) : (ar * br - ai * bi);
          Eg[(size_t)(qq * 64 + p) * 512 + k] = (bf16_t)f2bf(v); } }
    for (int e = tid; e < 128 * 256; e += NTHREADS) { const int k = e & 255, mr = e >> 8, m = qq * 128 + mr, t = m >> 4, ho = m & 15; const int d = k >> 7, c = (k >> 6) & 1, p = k & 63;
        const int j = d == 0 ? t + 1 : 32 - t;
        const float ar = AP[((d * 33 + j) * 64 + p) * 2], ai = AP[((d * 33 + j) * 64 + p) * 2 + 1]; const float cr = CC[((d * 16 + ho) * 64 + p) * 2], ci = CC[((d * 16 + ho) * 64 + p) * 2 + 1];
        const float v = c ? -(cr * ai + ci * ar) : (cr * ar - ci * ai);
        Fg[(size_t)m * 768 + k] = (bf16_t)f2bf(v); }
    if (qq == 0) for (int e = tid; e < 2 * 64; e += NTHREADS) { const int p = e & 63, d = e >> 6; float* at = (float*)(ws + WS_S5AT) + ((size_t)(d * 32 + g) * 64 + p) * 2;
        at[0] = AP[((d * 33 + 32) * 64 + p) * 2]; at[1] = AP[((d * 33 + 32) * 64 + p) * 2 + 1]; }
    __syncthreads();
}
DI int s5_chunk_row(int n72) { const int b = n72 / 72, cc = n72 - b * 72; return cc < 8 ? NLAT + b * CTXL + 32 * cc : b * SEQ + 32 * (cc - 8); }
DI void s5_repack_chunk(unsigned char* ws, int n, int lane) {
    const bf16_t* src = (const bf16_t*)(ws + WS_PROJ) + (size_t)s5_chunk_row(n) * OIN + 8 * lane;
    bf16_t* dst = (bf16_t*)(ws + WS_UG) + ((size_t)(lane >> 1) * 768 + n) * 768 + (lane & 1) * 8;
    u32x4 v[8];
#pragma unroll
    for (int t0 = 0; t0 < 32; t0 += 8) {
#pragma unroll
        for (int i = 0; i < 8; ++i) v[i] = *(const u32x4*)(src + (size_t)(t0 + i) * OIN);
#pragma unroll
        for (int i = 0; i < 8; ++i) *(u32x4*)(dst + (t0 + i) * 16) = v[i];
    }
}
struct S5Order {
    int G, c, nb;
    __device__ bool next(int i, pg8::Unit& u) const { const int L = i * G + c; const int per = 3 * nb; if (L >= 32 * per) return false; const int g = L / per, r = L - g * per; u.pm = 3 * g + r / nb; u.pn = nb * g + r % nb; return true; }
    __device__ __forceinline__ void a_ready(const pg8::Unit&) const {}
    __device__ __forceinline__ void done(const pg8::Unit&) const {}
};
struct EpiS5L {
    static constexpr bool PERM = false, AFTER_DRAIN = false;
    float* L;
    __device__ __forceinline__ void operator()(const f32x4 (&acc)[2][2][4][2], const pg8::Unit& u, int wr, int wc, int fr, int fq) const {
        const int g = u.pn, mt = u.pm - 3 * g;
#pragma unroll
        for (int ai = 0; ai < 2; ++ai)
#pragma unroll
            for (int m = 0; m < 4; ++m) { const int n = mt * 256 + ai * 128 + wr * 64 + m * 16 + fr; if (n >= 576) continue;
                float* lp = L + ((size_t)n * 32 + g) * 256 + wc * 32 + 4 * fq;
#pragma unroll
                for (int bj = 0; bj < 2; ++bj)
#pragma unroll
                    for (int nn = 0; nn < 2; ++nn) *(f32x4*)(lp + bj * 128 + nn * 16) = acc[ai][bj][m][nn]; }
    }
};
struct EpiS5Y {
    static constexpr bool PERM = false, AFTER_DRAIN = false;
    bf16_t* Z;
    __device__ __forceinline__ void operator()(const f32x4 (&acc)[2][2][4][2], const pg8::Unit& u, int wr, int wc, int fr, int fq) const {
        const int g = u.pn >> 1, nh = u.pn & 1, mt = u.pm - 3 * g;
#pragma unroll
        for (int ai = 0; ai < 2; ++ai)
#pragma unroll
            for (int m = 0; m < 4; ++m) { const int n = mt * 256 + ai * 128 + wr * 64 + m * 16 + fr; const int b = n / 72, cc = n - b * 72; if (n >= 576 || cc < 8) continue;
                bf16_t* zp = Z + (size_t)(b * SEQ + 32 * (cc - 8)) * 512 + g * 16;
#pragma unroll
                for (int bj = 0; bj < 2; ++bj)
#pragma unroll
                    for (int nn = 0; nn < 2; ++nn) { const int mcol = nh * 256 + bj * 128 + wc * 32 + nn * 16 + 4 * fq, t = mcol >> 4, ho = mcol & 15; const f32x4 y = acc[ai][bj][m][nn];
                        u32x2 w; w.x = pk2(gelu_tanh(y.x), gelu_tanh(y.y)); w.y = pk2(gelu_tanh(y.z), gelu_tanh(y.w)); *(u32x2*)(zp + (size_t)t * 512 + ho) = w; } }
    }
};
DI void s5_scan_thread(unsigned char* ws, int gid) {
    const int p = gid & 63, d = (gid >> 6) & 1, g = (gid >> 7) & 31, b = gid >> 12;
    const float* at = (const float*)(ws + WS_S5AT) + ((size_t)(d * 32 + g) * 64 + p) * 2; const float ar = at[0], ai = at[1];
    const float* L = (const float*)(ws + WS_S5L); bf16_t* UG = (bf16_t*)(ws + WS_UG);
    float sr = 0.f, si = 0.f;
    for (int k0 = 0; k0 < 72; k0 += 8) {
        float lr8[8], li8[8];
#pragma unroll
        for (int i = 0; i < 8; ++i) { const int k = k0 + i; const int cc = d == 0 ? k : (k < 8 ? 7 - k : 71 - (k - 8)); const size_t lo = ((size_t)(b * 72 + cc) * 32 + g) * 256 + d * 128 + p; lr8[i] = L[lo]; li8[i] = L[lo + 64]; }
#pragma unroll
        for (int i = 0; i < 8; ++i) { const int k = k0 + i; const int cc = d == 0 ? k : (k < 8 ? 7 - k : 71 - (k - 8));
            if (cc >= 8) { bf16_t* so = UG + ((size_t)g * 768 + b * 72 + cc) * 768 + 512 + d * 128 + p; so[0] = (bf16_t)f2bf(sr); so[64] = (bf16_t)f2bf(si); }
            const float nr = ar * sr - ai * si + lr8[i], ni = ar * si + ai * sr + li8[i]; sr = nr; si = ni; }
    }
}

DI int up_row_map(int n) { return n < FH ? (n >> 7) * 256 + (n & 127) : ((n - FH) >> 7) * 256 + 128 + ((n - FH) & 127); }
DI void p0_transpose_item(const float* W, int K, int N, bf16_t* WT, bool upmap, float* scr, int item, int lane) {
    const int nblk = N / 32, kb = item / nblk, nb = item % nblk, k0 = 64 * kb, n0 = 32 * nb;
    float tv[32];
#pragma unroll
    for (int i = 0; i < 32; ++i) tv[i] = __builtin_nontemporal_load(W + (size_t)(k0 + 2 * i + (lane >> 5)) * N + n0 + (lane & 31));
#pragma unroll
    for (int i = 0; i < 32; ++i) scr[(2 * i + (lane >> 5)) * 33 + (lane & 31)] = tv[i];
    asm volatile("s_waitcnt lgkmcnt(0)" ::: "memory");
    const int c = lane & 7;
#pragma unroll
    for (int j = 0; j < 4; ++j) { const int n = (lane >> 3) + 8 * j; const float* s = scr + (8 * c) * 33 + n;
        u32x4 o; o.x = pk2(s[0 * 33], s[1 * 33]); o.y = pk2(s[2 * 33], s[3 * 33]); o.z = pk2(s[4 * 33], s[5 * 33]); o.w = pk2(s[6 * 33], s[7 * 33]);
        const int nr = upmap ? up_row_map(n0 + n) : n0 + n;
        *(u32x4*)(WT + (size_t)nr * K + k0 + 8 * c) = o; }
    asm volatile("s_waitcnt lgkmcnt(0)" ::: "memory");
}
DI void norm_row(const float* xrow, const float* g, const float* shift, const float* scale, bf16_t* o1, bf16_t* o2, int lane) {
    f32x4 v[4]; float s = 0.f;
#pragma unroll
    for (int j = 0; j < 4; ++j) { v[j] = *((const f32x4*)xrow + lane + 64 * j); s += (v[j].x * v[j].x + v[j].y * v[j].y) + (v[j].z * v[j].z + v[j].w * v[j].w); }
    const float rstd = rsqrtf(wave_sum(s) * (1.f / DM) + NORM_EPS);
#pragma unroll
    for (int j = 0; j < 4; ++j) {
        const f32x4 gg = *((const f32x4*)g + lane + 64 * j), sh = *((const f32x4*)shift + lane + 64 * j), sc = *((const f32x4*)scale + lane + 64 * j);
        const f32x4 y = (v[j] * rstd) * gg * (sc + 1.0f) + sh;
        u32x2 w; w.x = pk2(y.x, y.y); w.y = pk2(y.z, y.w);
        *((u32x2*)o1 + lane + 64 * j) = w; if (o2) *((u32x2*)o2 + lane + 64 * j) = w;
    }
}
DI bf16_t* norm_xne_ptr(bf16_t* XN, int r, int xne_row) {
    if (xne_row < 0) return nullptr;
    const bool isctx = r >= NLAT; const int t = isctx ? (r - NLAT) & 255 : r & 2047, slen = isctx ? CTXL : SEQ, s = isctx ? (r - NLAT) >> 8 : r >> 11;
    const int k = (t + 2) >> 6, pos = (t + 2) & 63;
    if (pos < 4 && k >= 1 && k <= slen / 64 - 1) { const int q = isctx ? NBND_LAT + s * 3 + (k - 1) : s * 31 + (k - 1); return XN + (size_t)(xne_row + 4 * q + pos) * DM; }
    return nullptr;
}
DI void norm_phase(const float* hL, const float* hC, const float* g, const float* mod, int ish, int isc, bf16_t* XN, int nrows, int xne_row, int gw, int NGW, int lane, const float* cadd = nullptr, float* cwb = nullptr) {
    for (int r0 = gw; r0 < nrows; r0 += 2 * NGW) {
        const int r1 = r0 + NGW; const bool has1 = r1 < nrows; const int r1c = has1 ? r1 : r0;
        const float* x0 = r0 >= NLAT ? hC + (size_t)(r0 - NLAT) * DM : hL + (size_t)r0 * DM;
        const float* x1 = r1c >= NLAT ? hC + (size_t)(r1c - NLAT) * DM : hL + (size_t)r1c * DM;
        f32x4 v0[4], v1[4];
#pragma unroll
        for (int j = 0; j < 4; ++j) { v0[j] = *((const f32x4*)x0 + lane + 64 * j); v1[j] = *((const f32x4*)x1 + lane + 64 * j); }
        if (cadd) {
#pragma unroll
            for (int j = 0; j < 4; ++j) {
                if (r0 >= NLAT) { v0[j] += *((const f32x4*)(cadd + (size_t)(r0 - NLAT) * DM) + lane + 64 * j); if (cwb) *((f32x4*)(cwb + (size_t)(r0 - NLAT) * DM) + lane + 64 * j) = v0[j]; }
                if (has1 && r1 >= NLAT) { v1[j] += *((const f32x4*)(cadd + (size_t)(r1 - NLAT) * DM) + lane + 64 * j); if (cwb) *((f32x4*)(cwb + (size_t)(r1 - NLAT) * DM) + lane + 64 * j) = v1[j]; } } }
        const int bb0 = r0 >= NLAT ? 8 : r0 >> 11, bb1 = r1c >= NLAT ? 8 : r1c >> 11;
        const float* sh0 = mod + (size_t)bb0 * 6144 + ish * 1024; const float* sc0 = mod + (size_t)bb0 * 6144 + isc * 1024;
        const float* sh1 = mod + (size_t)bb1 * 6144 + ish * 1024; const float* sc1 = mod + (size_t)bb1 * 6144 + isc * 1024;
        float s0 = 0.f, s1 = 0.f;
#pragma unroll
        for (int j = 0; j < 4; ++j) { s0 += (v0[j].x * v0[j].x + v0[j].y * v0[j].y) + (v0[j].z * v0[j].z + v0[j].w * v0[j].w); s1 += (v1[j].x * v1[j].x + v1[j].y * v1[j].y) + (v1[j].z * v1[j].z + v1[j].w * v1[j].w); }
#pragma unroll
        for (int o = 1; o < 64; o <<= 1) { s0 += __shfl_xor(s0, o); s1 += __shfl_xor(s1, o); }
        const float rs0 = rsqrtf(s0 * (1.f / DM) + NORM_EPS), rs1 = rsqrtf(s1 * (1.f / DM) + NORM_EPS);
        bf16_t* o0 = XN + (size_t)r0 * DM; bf16_t* o1 = XN + (size_t)r1c * DM; bf16_t* e0 = norm_xne_ptr(XN, r0, xne_row); bf16_t* e1 = norm_xne_ptr(XN, r1c, xne_row);
#pragma unroll
        for (int j = 0; j < 4; ++j) {
            const f32x4 gg = *((const f32x4*)g + lane + 64 * j);
            const f32x4 y0 = (v0[j] * rs0) * gg * (*((const f32x4*)sc0 + lane + 64 * j) + 1.0f) + *((const f32x4*)sh0 + lane + 64 * j);
            const f32x4 y1 = (v1[j] * rs1) * gg * (*((const f32x4*)sc1 + lane + 64 * j) + 1.0f) + *((const f32x4*)sh1 + lane + 64 * j);
            u32x2 w0, w1; w0.x = pk2(y0.x, y0.y); w0.y = pk2(y0.z, y0.w); w1.x = pk2(y1.x, y1.y); w1.y = pk2(y1.z, y1.w);
            *((u32x2*)o0 + lane + 64 * j) = w0; if (e0) *((u32x2*)e0 + lane + 64 * j) = w0;
            if (has1) { *((u32x2*)o1 + lane + 64 * j) = w1; if (e1) *((u32x2*)e1 + lane + 64 * j) = w1; }
        }
    }
}
DI void qknorm_phase(bf16_t* PROJ, int ld, int qoff, const float* qn, const float* kn, const float* rope, int gw, int NGW, int lane) {
    const int d0 = 2 * (lane & 31), hsel = lane >> 5;
    const f32x2_t gq = *(const f32x2_t*)(qn + d0), gk = *(const f32x2_t*)(kn + d0);
    const int ridx = (d0 >> 5) * 16 + (d0 & 15); const bool second = (d0 >> 4) & 1;
    for (int r = gw; r < MALL; r += NGW) {
        unsigned* p = (unsigned*)(PROJ + (size_t)r * ld + qoff) + lane;
        const bool lat = r < NLAT; f32x2_t cs = {1.f, 1.f}, sn = {0.f, 0.f};
        if (lat) { const int t = r & 2047; cs = *(const f32x2_t*)(rope + t * 32 + ridx); sn = *(const f32x2_t*)(rope + SEQ * 32 + t * 32 + ridx); }
        unsigned raw[5];
#pragma unroll
        for (int i = 0; i < 5; ++i) raw[i] = p[64 * i];
#pragma unroll
        for (int i = 0; i < 5; ++i) {
            const float a = __uint_as_float(raw[i] << 16), b = __uint_as_float(raw[i] & 0xffff0000u);
            float ss = a * a + b * b;
#pragma unroll
            for (int o = 1; o < 32; o <<= 1) ss += __shfl_xor(ss, o);
            const float rs = rsqrtf(ss * (1.f / 64.f) + NORM_EPS); const bool isq = (2 * i + hsel) < 8;
            float ya = a * rs * (isq ? gq.x : gk.x), yb = b * rs * (isq ? gq.y : gk.y);
            const float pa = __shfl_xor(ya, 8), pb = __shfl_xor(yb, 8);
            if (lat) { ya = second ? (ya * cs.x + pa * sn.x) : (ya * cs.x - pa * sn.x); yb = second ? (yb * cs.y + pb * sn.y) : (yb * cs.y - pb * sn.y); }
            if (isq) { ya *= C2; yb *= C2; }
            p[64 * i] = pk2(ya, yb);
        }
    }
}

struct Args { const float* in[37]; float* out; unsigned char* ws; int ph_lo, ph_hi; };
constexpr int NPHASE = 19;

DI void p0_prologue(const Args& a, char* lds, int G, int rep) {
#ifdef P0_REP_EMPTY
    if (rep == 1) return;
#endif
    const int tid = threadIdx.x, lane = tid & 63, wid = tid >> 6;
    unsigned char* ws = a.ws;
    const int gw = blockIdx.x * NWAVES + wid, NGW = G * NWAVES;
    {
        const int gt = blockIdx.x * NTHREADS + tid, NGT = G * NTHREADS;
        float* rope = (float*)(ws + WS_ROPE);
        for (int e = gt; e < SEQ * 32; e += NGT) { const int t = e >> 5, idx = e & 31, i = idx & 15; const float pos = (float)((idx < 16) ? (t >> 6) : (t & 63));
            const float invf = powf(10000.0f, -(float)i / 16.0f); const float ang = pos * invf; rope[e] = cosf(ang); rope[SEQ * 32 + e] = sinf(ang); }
        bf16_t* rgw = (bf16_t*)(ws + WS_RGW);
        for (int e = gt; e < 4 * 8 * 4096; e += NGT) { const int k = e & 63, n = (e >> 6) & 63, hd = (e >> 12) & 7, mi = e >> 15; const int d = mi >> 1;
            const float* w = (mi & 1) ? a.in[17] : a.in[15]; rgw[e] = (bf16_t)f2bf(w[((size_t)(d * 8 + hd) * 64 + k) * 64 + n]); }
    }
    __syncthreads();
    {
        float* cond = (float*)lds;
        float* red = (float*)(lds + 1024 * 12 * 4);
        if (G < 256 || blockIdx.x >= 128) for (int e = tid; e < 9 * 1024; e += NTHREADS) { const int k = e & 1023, bb = e >> 10; const float cv = bb < 8 ? a.in[1][bb * 1024 + k] : a.in[3][k]; cond[k * 12 + bb] = siluf_(cv); }
        __syncthreads();
        float* MOD = (float*)(ws + WS_MOD);
        for (int it = (G >= 256 ? (int)blockIdx.x - 128 : (int)blockIdx.x); it < 2 * 96; it += (G >= 256 ? 128 : G)) { if (it < 0) break;
            const int layer = it / 96, cb = it % 96, col = cb * 64 + lane;
            const float* w = a.in[4] + (size_t)layer * DM * 6144 + col;
            float acc[9];
#pragma unroll
            for (int bb = 0; bb < 9; ++bb) acc[bb] = 0.f;
            for (int kk0 = 0; kk0 < 128; kk0 += 16) {
                float wv16[16];
#pragma unroll
                for (int i = 0; i < 16; ++i) wv16[i] = __builtin_nontemporal_load(w + (size_t)(wid * 128 + kk0 + i) * 6144);
#pragma unroll
                for (int i = 0; i < 16; ++i) { const int k = wid * 128 + kk0 + i; const float wv = wv16[i];
                    const f32x4 c0 = *(const f32x4*)(cond + k * 12), c1 = *(const f32x4*)(cond + k * 12 + 4); const float c8 = cond[k * 12 + 8];
                    acc[0] += c0.x * wv; acc[1] += c0.y * wv; acc[2] += c0.z * wv; acc[3] += c0.w * wv; acc[4] += c1.x * wv; acc[5] += c1.y * wv; acc[6] += c1.z * wv; acc[7] += c1.w * wv; acc[8] += c8 * wv; }
            }
#pragma unroll
            for (int bb = 0; bb < 9; ++bb) red[(wid * 9 + bb) * 64 + lane] = acc[bb];
            __syncthreads();
            for (int e = tid; e < 9 * 64; e += NTHREADS) { const int bb = e >> 6, ln = e & 63; float s = a.in[5][layer * 6144 + cb * 64 + ln];
#pragma unroll
                for (int w8 = 0; w8 < 8; ++w8) s += red[(w8 * 9 + bb) * 64 + ln];
                MOD[((size_t)layer * 9 + bb) * 6144 + cb * 64 + ln] = s; }
            __syncthreads();
        }
    }
    __syncthreads();
#ifdef P0_REP_MODONLY
    if (rep == 0)
#endif
    for (int it = blockIdx.x; it < 128; it += G) s5_pre_item(a.in, ws, lds, it);
    __syncthreads();
    {
        float* scr = (float*)(lds + wid * 16384);
        constexpr int I_IN0 = 16 * (EIN / 32), I_OUT = 16 * 32, I_UP = 16 * (FH2 / 32), I_DN = (FH / 64) * 32, I_IN1 = 16 * (OIN / 32), I_GLU = 8 * 16;
        constexpr int NIT = I_IN0 + I_OUT + I_UP + I_DN + I_IN1 + I_OUT + I_UP + I_DN + I_GLU;
        for (int it = gw; it < NIT; it += NGW) {
            int r = it;
            if (r < I_UP) { p0_transpose_item(a.in[7], DM, FH2, (bf16_t*)(ws + WS_WUP0), true, scr, r, lane); continue; } r -= I_UP;
            if (r < I_UP) { p0_transpose_item(a.in[7] + (size_t)DM * FH2, DM, FH2, (bf16_t*)(ws + WS_WUP1), true, scr, r, lane); continue; } r -= I_UP;
            if (r < I_DN) { p0_transpose_item(a.in[10], FH, DM, (bf16_t*)(ws + WS_WDN0), false, scr, r, lane); continue; } r -= I_DN;
            if (r < I_DN) { p0_transpose_item(a.in[10] + (size_t)FH * DM, FH, DM, (bf16_t*)(ws + WS_WDN1), false, scr, r, lane); continue; } r -= I_DN;
            if (r < I_IN0) { p0_transpose_item(a.in[11], DM, EIN, (bf16_t*)(ws + WS_WIN0), false, scr, r, lane); continue; } r -= I_IN0;
            if (r < I_IN1) { p0_transpose_item(a.in[22], DM, OIN, (bf16_t*)(ws + WS_WIN1), false, scr, r, lane); continue; } r -= I_IN1;
            if (r < I_OUT) { p0_transpose_item(a.in[12], DM, DM, (bf16_t*)(ws + WS_WOUT0), false, scr, r, lane); continue; } r -= I_OUT;
            if (r < I_OUT) { p0_transpose_item(a.in[23], DM, DM, (bf16_t*)(ws + WS_WOUT1), false, scr, r, lane); continue; } r -= I_OUT;
            p0_transpose_item(a.in[32], 512, 512, (bf16_t*)(ws + WS_WGLU), false, scr, r, lane);
        }
    }
}

__global__ void __launch_bounds__(NTHREADS, 2) trunk_fwd(Args a) {
    extern __shared__ __attribute__((aligned(16))) unsigned char lds_raw[];
    char* lds = (char*)lds_raw;
    PG8_LAS unsigned char* ldsl = (PG8_LAS unsigned char*)lds_raw;
    cg::grid_group grid = cg::this_grid();
    const int tid = threadIdx.x, lane = tid & 63, wid = tid >> 6, G = gridDim.x;
    const int gw = blockIdx.x * NWAVES + wid, NGW = G * NWAVES;
    unsigned char* ws = a.ws;
    const int lo = a.ph_lo, hi = a.ph_hi;
    float* MOD = (float*)(ws + WS_MOD); float* HC = (float*)(ws + WS_HC);
    bf16_t* XN = (bf16_t*)(ws + WS_XN); bf16_t* PROJ = (bf16_t*)(ws + WS_PROJ); bf16_t* MIX = (bf16_t*)(ws + WS_MIX); bf16_t* HID = (bf16_t*)(ws + WS_HID);
    const float* rope = (const float*)(ws + WS_ROPE);
    float* CP = (float*)(ws + WS_Z);
    volatile LAS unsigned* MISC = (volatile LAS unsigned*)((LAS unsigned char*)lds_raw + LDS_MISC);
    if (tid < 64) MISC[tid] = 0u;
    __syncthreads();
    XcdBarrier xbar; xbar.bar = (unsigned*)(ws + WS_CTL) + 4096; xbar.x = 0; xbar.st = nullptr;
    if (hi - lo > 1) xbar = xcd_barrier_post((unsigned*)(ws + WS_CTL) + 4096, MISC + 8);
#ifndef PHASE_MASK
#define PHASE_MASK 0x7ffff
#endif
#define IN(k) (((PHASE_MASK >> (k)) & 1) && lo <= (k) && (k) < hi)
#ifndef DUP_MASK
#define DUP_MASK 0
#endif
#define REP(k) for (int rep_ = 0; rep_ < (((DUP_MASK >> (k)) & 1) ? 2 : 1); ++rep_, (void)((((DUP_MASK >> (k)) & 1) && rep_ == 1) ? (xcd_barrier(xbar), 0) : 0))
#ifdef TIME_MASK
    unsigned long long tprev_ = __builtin_amdgcn_s_memrealtime(), tsum_ = 0ull;
#define TSTAMP(k) do { const unsigned long long tn_ = __builtin_amdgcn_s_memrealtime(); if (((TIME_MASK) >> (k)) & 1) tsum_ += tn_ - tprev_; tprev_ = tn_; } while (0)
#else
#define TSTAMP(k) do {} while (0)
#endif
#define SEAM(k) do { if (IN(k) && IN((k) + 1)) { xcd_barrier(xbar); TSTAMP(k); } } while (0)

    if (hi > 1000) grid.sync();
    if (IN(0)) REP(0) { p0_prologue(a, lds, G, rep_); } SEAM(0);
    if (IN(1)) REP(1) norm_phase(a.in[0], a.in[2], a.in[6], MOD, 0, 1, XN, MALL, -1, gw, NGW, lane);
    SEAM(1);
    if (IN(2)) REP(2) { pg8::Gemm g{XN, (const bf16_t*)(ws + WS_WIN0), MALL, EIN, DM}; pg8::StaticOrder S; S.init(MALL, EIN, G, (int)blockIdx.x);
        pg8::EpiBf16<0> E{PROJ, EIN, nullptr, 0, 0, 1.f}; pg8::gemm_phase<pg8::EpiBf16<0>, pg8::StaticOrder, true, true>(ldsl, g, S, E); }
    SEAM(2);
    if (IN(3)) { qknorm_phase(PROJ, EIN, 1024, a.in[20], a.in[21], rope, gw, NGW, lane); __syncthreads();
#ifdef DUP_RG1
        for (int rep2_ = 0; rep2_ < 2; ++rep2_)
#endif
        for (int it = blockIdx.x; it < NB * 8 * 36; it += G) rg_item1(a.in, ws, lds, it); }
    SEAM(3);
    if (IN(4)) REP(4) {
#ifndef P4_NO_ATTN
#ifdef DUP_ATT
        for (int rep2_ = 0; rep2_ < 2; ++rep2_)
#endif
        for (int it = blockIdx.x; it < 512 + 64; it += G) {
            if (it < 512) { const int qb = it & 7, head = (it >> 3) & 7, b = it >> 6; attn_unit<0>(PROJ, EIN, 1024, 1536, 1664, MIX, lds, b, head, qb * 256, 0.f); }
            else { const int u = it - 512, head = u & 7, b = u >> 3; attn_unit<1>(PROJ, EIN, 1024, 1536, 1664, MIX, lds, b, head, 0, 0.f); }
        }
#endif
#ifndef P4_NO_RG
        for (int it = (blockIdx.x + G - 64) % G; it < NB * 8 * 36; it += G) rg_item2(a.in, ws, lds, it);
#endif
    }
    SEAM(4);
    if (IN(5)) REP(5) { { pg8::Gemm g{MIX, (const bf16_t*)(ws + WS_WOUT0), NLAT, DM, DM}; pg8::StaticOrder S; S.init(NLAT, DM, G, (int)blockIdx.x);
          EpiRes E{a.in[0], a.in[2], a.out, HC, MOD + 2 * 1024}; pg8::gemm_phase<EpiRes, pg8::StaticOrder, true, true>(ldsl, g, S, E); }
#pragma unroll 1
        for (int kh = 0; kh < 2; ++kh) {
          pg8::Gemm g{MIX + kh * 512, (const bf16_t*)(ws + WS_WOUT0) + kh * 512, MALL, DM, 512, DM, DM}; CtxOrder S{(int)blockIdx.x - 64 * kh};
          EpiCtxHalf E{a.in[2], HC, CP, MOD + 2 * 1024, kh}; pg8::gemm_phase<EpiCtxHalf, CtxOrder, true, true>(ldsl, g, S, E); } }
    SEAM(5);
    if (IN(6)) REP(6) norm_phase(a.out, HC, a.in[6] + DM, MOD, 3, 4, XN, MALL, XNE_ROW_L0, gw, NGW, lane, CP, HC);
    SEAM(6);
    if (IN(7)) REP(7) { constexpr int MT = MALL + 1280; pg8::Gemm g{XN, (const bf16_t*)(ws + WS_WUP0), MT, FH2, DM}; pg8::StaticOrder S; S.init(MT, FH2, G, (int)blockIdx.x);
        EpiConvAct E{HID, a.in[8], a.in[9], MALL / 256, NBND_LAT, NBND_LAT + NBND_CTX, lds + 131072}; pg8::gemm_phase<EpiConvAct, pg8::StaticOrder, true, true>(ldsl, g, S, E); }
    SEAM(7);
    if (IN(8)) { { pg8::Gemm g{HID, (const bf16_t*)(ws + WS_WDN0), NLAT, DM, FH}; pg8::StaticOrder S; S.init(NLAT, DM, G, (int)blockIdx.x);
          EpiRes E{a.out, HC, a.out, HC, MOD + 5 * 1024}; pg8::gemm_phase<EpiRes, pg8::StaticOrder, true, true>(ldsl, g, S, E); }
#pragma unroll 1
        for (int kh = 0; kh < 2; ++kh) {
          pg8::Gemm g{HID + kh * (FH / 2), (const bf16_t*)(ws + WS_WDN0) + kh * (FH / 2), MALL, DM, FH / 2, FH, FH}; CtxOrder S{(int)blockIdx.x - 64 * kh};
          EpiCtxHalf E{HC, HC, CP, MOD + 5 * 1024, kh}; pg8::gemm_phase<EpiCtxHalf, CtxOrder, true, true>(ldsl, g, S, E); } }
    SEAM(8);
    const float* MOD1 = MOD + 9 * 6144;
    if (IN(9)) REP(9) norm_phase(a.out, HC, a.in[6] + 2 * DM, MOD1, 0, 1, XN, MALL, -1, gw, NGW, lane, CP, nullptr);
    SEAM(9);
    if (IN(10)) REP(10) { pg8::Gemm g{XN, (const bf16_t*)(ws + WS_WIN1), MALL, OIN, DM}; pg8::StaticOrder S; S.init(MALL, OIN, G, (int)blockIdx.x);
        pg8::EpiBf16<0> E{PROJ, OIN, nullptr, 0, 0, 1.f}; pg8::gemm_phase<pg8::EpiBf16<0>, pg8::StaticOrder, true, true>(ldsl, g, S, E); }
    SEAM(10);
    if (IN(11)) { qknorm_phase(PROJ, OIN, 512, a.in[34], a.in[35], rope, gw, NGW, lane);
        for (int n = gw; n < 576; n += NGW) s5_repack_chunk(ws, n, lane);
        xcd_barrier(xbar);
        pg8::Gemm g{(const bf16_t*)(ws + WS_UG), (const bf16_t*)(ws + WS_S5E), 32 * 768, 32 * 256, 512, 768, 512}; S5Order S{G, (int)blockIdx.x, 1};
        EpiS5L E{(float*)(ws + WS_S5L)}; pg8::gemm_phase<EpiS5L, S5Order, true, true>(ldsl, g, S, E); }
    SEAM(11);
    if (IN(12)) REP(12) {
        { const int gt = blockIdx.x * NTHREADS + tid; if (gt < NB * 32 * 2 * 64) s5_scan_thread(ws, gt); }
        __syncthreads();
        const int nskip = (NB * 32 * 2 * 64) / NTHREADS;
        for (int it = (blockIdx.x + G - nskip) % G; it < 512; it += G) { const int qb = it & 7, head = (it >> 3) & 7, b = it >> 6;
            attn_unit<2>(PROJ, OIN, 512, 1024, 1152, MIX, lds, b, head, qb * 256, a.in[36][head] * 1.4426950408889634f); }
    }
    SEAM(12);
    if (IN(13)) REP(13) { pg8::Gemm g{(const bf16_t*)(ws + WS_UG), (const bf16_t*)(ws + WS_S5MF), 32 * 768, 32 * 512, 768, 768, 768}; S5Order S{G, (int)blockIdx.x, 2};
        EpiS5Y E{(bf16_t*)(ws + WS_Z)}; pg8::gemm_phase<EpiS5Y, S5Order, true, true>(ldsl, g, S, E); }
    SEAM(13);
    if (IN(14)) REP(14) { pg8::Gemm g{(const bf16_t*)(ws + WS_Z), (const bf16_t*)(ws + WS_WGLU), NLAT, 512, 512}; pg8::StaticOrder S; S.init(NLAT, 512, G, (int)blockIdx.x);
        EpiGlu E{(const bf16_t*)(ws + WS_Z), MIX, a.in[33]}; pg8::gemm_phase<EpiGlu, pg8::StaticOrder, true, true>(ldsl, g, S, E); }
    SEAM(14);
    if (IN(15)) { pg8::Gemm g{MIX, (const bf16_t*)(ws + WS_WOUT1), NLAT, DM, DM}; pg8::StaticOrder S; S.init(NLAT, DM, G, (int)blockIdx.x);
        EpiRes E{a.out, HC, a.out, HC, MOD1 + 2 * 1024}; pg8::gemm_phase<EpiRes, pg8::StaticOrder, true, true>(ldsl, g, S, E); }
    SEAM(15);
    if (IN(16)) REP(16) norm_phase(a.out, HC, a.in[6] + 3 * DM, MOD1, 3, 4, XN, NLAT, XNE_ROW_L1, gw, NGW, lane);
    SEAM(16);
    if (IN(17)) REP(17) { constexpr int MT = NLAT + 1024; pg8::Gemm g{XN, (const bf16_t*)(ws + WS_WUP1), MT, FH2, DM}; pg8::StaticOrder S; S.init(MT, FH2, G, (int)blockIdx.x);
        EpiConvAct E{HID, a.in[8] + 3 * FH2, a.in[9] + FH2, NLAT / 256, NBND_LAT, NBND_LAT, lds + 131072}; pg8::gemm_phase<EpiConvAct, pg8::StaticOrder, true, true>(ldsl, g, S, E); }
    SEAM(17);
    if (IN(18)) { pg8::Gemm g{HID, (const bf16_t*)(ws + WS_WDN1), NLAT, DM, FH}; pg8::StaticOrder S; S.init(NLAT, DM, G, (int)blockIdx.x);
        EpiRes E{a.out, HC, a.out, HC, MOD1 + 5 * 1024}; pg8::gemm_phase<EpiRes, pg8::StaticOrder, true, true>(ldsl, g, S, E); }
#ifdef TIME_MASK
    xcd_barrier(xbar); TSTAMP(18);
    if (blockIdx.x == 0 && tid == 0) a.out[0] = 1e4f * ((float)tsum_ * 0.01f);
#endif
#undef IN
#undef SEAM
}

#ifndef N_LAUNCH_MODE
#define N_LAUNCH_MODE 1
#endif
extern "C" void kernel_launch(void* const* d_in, const int* in_sizes, int n_in, void* d_out, int out_size, void* d_ws, size_t ws_size, hipStream_t stream) {
    static int grid = 0;
    if (grid == 0) {
        if (n_in != 37 || out_size != NLAT * DM || ws_size < WS_END) { fprintf(stderr, "kernel_launch: unexpected problem (n_in %d out %d ws %zu)\n", n_in, out_size, ws_size); grid = -1; return; }
        int dev = 0, cus = 0, per_cu = 0;
        hipGetDevice(&dev); hipDeviceGetAttribute(&cus, hipDeviceAttributeMultiprocessorCount, dev);
        if (hipFuncSetAttribute((const void*)trunk_fwd, hipFuncAttributeMaxDynamicSharedMemorySize, LDS_BYTES) != hipSuccess) { fprintf(stderr, "kernel_launch: hipFuncSetAttribute failed\n"); grid = -1; return; }
        if (hipOccupancyMaxActiveBlocksPerMultiprocessor(&per_cu, (const void*)trunk_fwd, NTHREADS, LDS_BYTES) != hipSuccess || per_cu < 1) { fprintf(stderr, "kernel_launch: occupancy query says %d\n", per_cu); per_cu = 1; }
        (void)hipGetLastError();
        grid = cus;
        fprintf(stderr, "kernel_launch: grid %d (cus %d, per_cu %d)\n", grid, cus, per_cu);
    }
    if (grid < 0) return;
    (void)hipMemsetAsync((char*)d_ws + WS_CTL, 0, CTL_ZERO_BYTES, stream);
    Args a{};
    for (int i = 0; i < 37; ++i) a.in[i] = (const float*)d_in[i];
    a.out = (float*)d_out; a.ws = (unsigned char*)d_ws;
#if N_LAUNCH_MODE == 1
    a.ph_lo = 0; a.ph_hi = NPHASE;
    void* args[] = {&a};
    hipError_t e = hipLaunchCooperativeKernel((const void*)trunk_fwd, dim3(grid), dim3(NTHREADS), args, LDS_BYTES, stream);
    if (e != hipSuccess) fprintf(stderr, "cooperative launch failed: %s (grid %d)\n", hipGetErrorString(e), grid);
#else
    for (int p = 0; p < NPHASE; ++p) { a.ph_lo = p; a.ph_hi = p + 1; hipLaunchKernelGGL(trunk_fwd, dim3(grid), dim3(NTHREADS), LDS_BYTES, stream, a);
#ifdef DBG_CHECK
        Args d = a; d.ph_lo = 0; d.ph_hi = 0;
        static const int chk[NPHASE][2] = {{1,0},{0,0},{2,0},{3,0},{4,5},{6,0},{0,0},{7,8},{0,0},{0,0},{9,0},{10,0},{11,0},{12,0},{15,0},{0,0},{0,0},{14,0},{0,0}};
        for (int q = 0; q < 2; ++q) { const int st = chk[p][q]; if (!st) continue; const bool heavy = (st == 5 || st == 12); hipLaunchKernelGGL(dbg_check, dim3(heavy ? 1 : 4), dim3(heavy ? 64 : 256), 0, stream, d, st); }
        if (p == NPHASE - 1) hipLaunchKernelGGL(dbg_report, dim3(1), dim3(64), 0, stream, d);
#endif
    }
#endif
}
```

```cpp
#include <hip/hip_runtime.h>
#include <hip/hip_cooperative_groups.h>
#include <hip/hip_bf16.h>
#include <cstdio>
#include <cstdint>
#include <cmath>
namespace cg = cooperative_groups;
namespace pg8 {
#define PG8_LAS __attribute__((address_space(3)))
typedef unsigned short bf16_t;
typedef short bf16x8 __attribute__((ext_vector_type(8)));
typedef float f32x4 __attribute__((ext_vector_type(4)));
typedef unsigned u32x4 __attribute__((ext_vector_type(4)));
constexpr int BM = 256, BK = 64, HALF = 128, HTB = HALF * BK * 2  , STAGE_BYTES = 8 * HTB, NXCD = 8, WGM = 8;

__host__ __device__ __forceinline__ int lds_byte(int r, int c) { const int st = (r >> 4) * 2 + (c >> 5), rr = r & 15, cc = c & 31, ob = rr * 64 + cc * 2; return st * 1024 + (ob ^ (((ob >> 9) & 1) << 5)); }
__host__ __device__ __forceinline__ void stage_rc(int b, int& R, int& C) { const int st = b / 1024, sb = b % 1024, swz = sb ^ (((sb >> 9) & 1) << 5); R = (st >> 1) * 16 + swz / 64; C = (st & 1) * 32 + (swz % 64) / 2; }
__host__ __device__ __forceinline__ int perm32(int rho) { const int n = rho >> 4, i = rho & 15; return 8 * (i >> 2) + 4 * n + (i & 3); }

struct Unit { int pm, pn; };
struct Gemm { const bf16_t* A; const bf16_t* Bt; int M, N, K; int lda, ldb; };

struct StaticOrder {
    int nM, nN, nwg, G, c;
    __host__ __device__ void init(int M, int N, int G_, int c_) { nM = M / BM; nN = N / BM; nwg = nM * nN; G = G_; c = c_; }
    __host__ __device__ bool next(int i, Unit& u) const {
        const long L = (long)i * G + c; if (L >= nwg) return false;
        int wgid = (int)L; { const int q = nwg / NXCD, r = nwg % NXCD, xcd = wgid % NXCD, off = wgid / NXCD; wgid = (xcd < r ? xcd * (q + 1) : r * (q + 1) + (xcd - r) * q) + off; }
        const int nig = WGM * nN, gid = wgid / nig, fm = gid * WGM, gsz = (nM - fm) < WGM ? (nM - fm) : WGM;
        u.pm = fm + ((wgid % nig) % gsz); u.pn = (wgid % nig) / gsz; return true;
    }
    __device__ __forceinline__ void a_ready(const Unit&) const {}
    __device__ __forceinline__ void done(const Unit&) const {}
};

__device__ __forceinline__ unsigned cvt_pk_bf16(float lo, float hi) { unsigned r; asm volatile("v_cvt_pk_bf16_f32 %0, %1, %2" : "=v"(r) : "v"(lo), "v"(hi)); return r; }
typedef float f32x2 __attribute__((ext_vector_type(2)));
__device__ __forceinline__ f32x2 gelu_pk(f32x2 v) {
    const f32x2 av = __builtin_elementwise_abs(v), d = av * 0.2316418882f + 1.0f;
    f32x2 t; t.x = __builtin_amdgcn_rcpf(d.x); t.y = __builtin_amdgcn_rcpf(d.y);
    f32x2 q = t * 0.5307027145f + (-0.7265760135f); q = q * t + 0.7107068705f; q = q * t + (-0.142248368f); q = q * t + 0.127414796f; q = q * t;
    const f32x2 s = (v * v) * (-0.72134752044f);
    f32x2 e; e.x = __builtin_amdgcn_exp2f(s.x); e.y = __builtin_amdgcn_exp2f(s.y);
    const f32x2 m = v * (q * e), r = v - m;
    f32x2 o; o.x = v.x < 0.f ? m.x : r.x; o.y = v.y < 0.f ? m.y : r.y; return o;
}
template <int ACT  > struct EpiBf16 {
    static constexpr bool PERM = true, AFTER_DRAIN = false; static_assert(ACT == 0 || ACT == 1, "EpiBf16: ACT is 0 (none) or 1 (gelu_pk)");
    bf16_t* O; int ldc; const float* bias; int split_cols; size_t split_stride; float scale0;
    __device__ __forceinline__ void operator()(const f32x4 (&acc)[2][2][4][2], const Unit& u, int wr, int wc, int fr, int fq) const {
        const int row0 = u.pm * BM + wr * 64 + fr; int colt = u.pn * BM; bf16_t* base = O;
        float sc = 1.f; if (split_cols) { const int t = colt / split_cols; base += (size_t)t * split_stride; colt -= t * split_cols; if (t == 0) sc = scale0; }
        const int col0 = colt + wc * 32 + 8 * fq, bcol0 = u.pn * BM + wc * 32 + 8 * fq;
        f32x4 bv[2][2];
#pragma unroll
        for (int bj = 0; bj < 2; ++bj)
#pragma unroll
            for (int n = 0; n < 2; ++n) bv[bj][n] = bias ? *(const f32x4*)(bias + bcol0 + bj * HALF + 4 * n) : (f32x4){0.f, 0.f, 0.f, 0.f};
#pragma unroll
        for (int ai = 0; ai < 2; ++ai)
#pragma unroll
            for (int m = 0; m < 4; ++m) { bf16_t* rowp = base + (size_t)(row0 + ai * HALF + m * 16) * ldc + col0;
#pragma unroll
                for (int bj = 0; bj < 2; ++bj) { f32x4 v0 = acc[ai][bj][m][0] + bv[bj][0], v1 = acc[ai][bj][m][1] + bv[bj][1];
                    if (ACT == 1) { f32x2 a = gelu_pk((f32x2){v0[0], v0[1]}), b = gelu_pk((f32x2){v0[2], v0[3]}), c = gelu_pk((f32x2){v1[0], v1[1]}), d = gelu_pk((f32x2){v1[2], v1[3]});
                        v0 = (f32x4){a.x, a.y, b.x, b.y}; v1 = (f32x4){c.x, c.y, d.x, d.y}; }
                    v0 = v0 * sc; v1 = v1 * sc; u32x4 w; w.x = cvt_pk_bf16(v0[0], v0[1]); w.y = cvt_pk_bf16(v0[2], v0[3]); w.z = cvt_pk_bf16(v1[0], v1[1]); w.w = cvt_pk_bf16(v1[2], v1[3]);
                    *(u32x4*)(rowp + bj * HALF) = w; } }
    }
};
template <class Epi, class Sched, bool ALIGN_EPI = false, bool SP2 = false>
__device__ __forceinline__ void gemm_phase(PG8_LAS unsigned char* lds, const Gemm g, const Sched& S, const Epi& E) {
    const int tid = threadIdx.x, wid = __builtin_amdgcn_readfirstlane(tid >> 6), lane = tid & 63, wr = wid >> 2, wc = wid & 3, fr = lane & 15, fq = lane >> 4;
    const int K = g.K, nt = K / BK; const int lda = g.lda ? g.lda : K, ldb = g.ldb ? g.ldb : K;
    unsigned voffA[2], voffB[2];
#pragma unroll
    for (int i = 0; i < 2; ++i) { int R, C; stage_rc(tid * 16 + i * 8192, R, C); const int Rb = Epi::PERM ? ((R & ~31) + perm32(R & 31)) : R;
        voffA[i] = (unsigned)(R * lda + C) * 2u; voffB[i] = (unsigned)(Rb * ldb + C) * 2u; }
    const size_t kstep = (size_t)(BK * 2);
    const size_t hsA = (size_t)HALF * lda * 2, hsB = (size_t)HALF * ldb * 2;
    const size_t tsA = 2 * hsA, tsB = 2 * hsB;
    const unsigned ldsw = (unsigned)wid * 1024u;
    const int aoff = lds_byte(wr * 64 + fr, fq * 8), boff = lds_byte(wc * 32 + fr, fq * 8);
#define PG8_SA(b, h) (((b) * 2 + (h)) * HTB)
#define PG8_SB(b, h) ((4 + (b) * 2 + (h)) * HTB)
#define PG8_STAGE(bufoff, gbase, voff) do { _Pragma("unroll") for (int _i = 0; _i < 2; ++_i) \
        __builtin_amdgcn_global_load_lds((const unsigned*)((const char*)(gbase) + (voff)[_i]), (PG8_LAS unsigned*)(lds + (bufoff) + ldsw + _i * 8192), 16, 0, 0); } while (0)
#define PG8_LDA(dst, b, h) do { _Pragma("unroll") for (int m = 0; m < 4; ++m) _Pragma("unroll") for (int k = 0; k < 2; ++k) dst[m][k] = *(const PG8_LAS bf16x8*)(lds + PG8_SA(b, h) + aoff + m * 2048 + k * 1024); } while (0)
#define PG8_LDB(dst, b, h) do { _Pragma("unroll") for (int n = 0; n < 2; ++n) _Pragma("unroll") for (int k = 0; k < 2; ++k) dst[n][k] = *(const PG8_LAS bf16x8*)(lds + PG8_SB(b, h) + boff + n * 2048 + k * 1024); } while (0)
#define PG8_MMA(ai, bj, At, Bt) do { __builtin_amdgcn_s_setprio(1); _Pragma("unroll") for (int m = 0; m < 4; ++m) _Pragma("unroll") for (int n = 0; n < 2; ++n) _Pragma("unroll") for (int k = 0; k < 2; ++k) \
        acc[ai][bj][m][n] = __builtin_amdgcn_mfma_f32_16x16x32_bf16(Bt[n][k], At[m][k], acc[ai][bj][m][n], 0, 0, 0); __builtin_amdgcn_s_setprio(0); } while (0)
#define PG8_WAIT_V(n) asm volatile("s_waitcnt vmcnt(" #n ")" ::: "memory")
#define PG8_WAIT_L(n) asm volatile("s_waitcnt lgkmcnt(" #n ")" ::: "memory")
#define PG8_BAR __builtin_amdgcn_s_barrier()
#define PG8_SCHED __builtin_amdgcn_sched_barrier(0)
    Unit cur, nxt; int ui = 0;
    if (!S.next(0, cur)) return;
    f32x4 acc[2][2][4][2];
#pragma unroll
    for (int a = 0; a < 2; ++a)
#pragma unroll
        for (int b = 0; b < 2; ++b)
#pragma unroll
            for (int m = 0; m < 4; ++m)
#pragma unroll
                for (int n = 0; n < 2; ++n) acc[a][b][m][n] = (f32x4){0.f, 0.f, 0.f, 0.f};
    bf16x8 At[4][2], B0[2][2], B1[2][2];
    const char* cA = (const char*)g.A + (size_t)cur.pm * tsA; const char* cB = (const char*)g.Bt + (size_t)cur.pn * tsB;
    S.a_ready(cur);
    if constexpr (SP2) {
        PG8_STAGE(PG8_SB(0, 0), cB, voffB); PG8_STAGE(PG8_SB(0, 1), cB + hsB, voffB); PG8_STAGE(PG8_SA(0, 0), cA, voffA); PG8_STAGE(PG8_SA(0, 1), cA + hsA, voffA);
        if (wr == 1) PG8_BAR;
        PG8_WAIT_V(2); PG8_BAR;
        PG8_STAGE(PG8_SB(1, 0), cB + kstep, voffB); PG8_STAGE(PG8_SA(1, 0), cA + kstep, voffA); PG8_STAGE(PG8_SB(1, 1), cB + hsB + kstep, voffB);
        PG8_WAIT_V(6); PG8_BAR;
    } else {
        PG8_STAGE(PG8_SB(0, 0), cB, voffB); PG8_STAGE(PG8_SA(0, 0), cA, voffA); PG8_STAGE(PG8_SB(0, 1), cB + hsB, voffB); PG8_STAGE(PG8_SA(0, 1), cA + hsA, voffA);
        if (wr == 1) PG8_BAR;
        PG8_WAIT_V(4); PG8_BAR;
        PG8_STAGE(PG8_SB(1, 0), cB + kstep, voffB); PG8_STAGE(PG8_SA(1, 0), cA + kstep, voffA); PG8_STAGE(PG8_SB(1, 1), cB + hsB + kstep, voffB);
        PG8_WAIT_V(6); PG8_BAR;
    }
    for (;;) {
        const bool has_next = S.next(ui + 1, nxt);
        const char* nA = has_next ? (const char*)g.A + (size_t)nxt.pm * tsA : cA; const char* nB = has_next ? (const char*)g.Bt + (size_t)nxt.pn * tsB : cB;
        for (int t = 0; t < nt; t += 2) {
            const bool last = (t == nt - 2);
            const char* a1 = cA + (size_t)(t + 1) * kstep;
            const char* a2 = last ? nA : cA + (size_t)(t + 2) * kstep; const char* b2 = last ? nB : cB + (size_t)(t + 2) * kstep;
            const char* a3 = a2 + kstep; const char* b3 = b2 + kstep;
            if (last && has_next) S.a_ready(nxt);
            if constexpr (SP2) {
            PG8_LDB(B0, 0, 0); PG8_LDB(B1, 0, 1); PG8_SCHED; PG8_LDA(At, 0, 0); PG8_STAGE(PG8_SA(1, 1), a1 + hsA, voffA);
            PG8_WAIT_V(8); PG8_WAIT_L(0); PG8_BAR; PG8_MMA(0, 0, At, B0); PG8_MMA(0, 1, At, B1); PG8_BAR; PG8_SCHED;
            PG8_LDA(At, 0, 1); PG8_STAGE(PG8_SB(0, 0), b2, voffB); PG8_STAGE(PG8_SB(0, 1), b2 + hsB, voffB); PG8_STAGE(PG8_SA(0, 0), a2, voffA);
            PG8_WAIT_V(8); PG8_WAIT_L(0); PG8_BAR; PG8_MMA(1, 0, At, B0); PG8_MMA(1, 1, At, B1); PG8_BAR; PG8_SCHED;
            PG8_LDB(B0, 1, 0); PG8_LDB(B1, 1, 1); PG8_SCHED; PG8_LDA(At, 1, 0); PG8_STAGE(PG8_SA(0, 1), a2 + hsA, voffA);
            PG8_WAIT_V(8); PG8_WAIT_L(0); PG8_BAR; PG8_MMA(0, 0, At, B0); PG8_MMA(0, 1, At, B1); PG8_BAR; PG8_SCHED;
            PG8_LDA(At, 1, 1); PG8_STAGE(PG8_SB(1, 0), b3, voffB); PG8_STAGE(PG8_SB(1, 1), b3 + hsB, voffB); PG8_STAGE(PG8_SA(1, 0), a3, voffA);
            PG8_WAIT_V(8); PG8_WAIT_L(0); PG8_BAR; PG8_MMA(1, 0, At, B0); PG8_MMA(1, 1, At, B1); PG8_BAR; PG8_SCHED;
            } else {
            PG8_LDB(B0, 0, 0); PG8_SCHED; PG8_LDA(At, 0, 0); PG8_STAGE(PG8_SA(1, 1), a1 + hsA, voffA);
            PG8_WAIT_L(8); PG8_BAR; PG8_WAIT_L(0); PG8_MMA(0, 0, At, B0); PG8_BAR; PG8_SCHED;
            PG8_LDB(B1, 0, 1); PG8_STAGE(PG8_SB(0, 0), b2, voffB);
            PG8_BAR; PG8_WAIT_L(0); PG8_MMA(0, 1, At, B1); PG8_BAR;
            PG8_LDA(At, 0, 1); PG8_STAGE(PG8_SA(0, 0), a2, voffA);
            PG8_BAR; PG8_WAIT_L(0); PG8_MMA(1, 0, At, B0); PG8_BAR; PG8_SCHED;
            PG8_STAGE(PG8_SB(0, 1), b2 + hsB, voffB);
            PG8_WAIT_V(6); PG8_BAR; PG8_MMA(1, 1, At, B1); PG8_BAR;
            PG8_LDB(B0, 1, 0); PG8_SCHED; PG8_LDA(At, 1, 0); PG8_STAGE(PG8_SA(0, 1), a2 + hsA, voffA);
            PG8_WAIT_L(8); PG8_BAR; PG8_WAIT_L(0); PG8_MMA(0, 0, At, B0); PG8_BAR; PG8_SCHED;
            PG8_LDB(B1, 1, 1); PG8_STAGE(PG8_SB(1, 0), b3, voffB);
            PG8_BAR; PG8_WAIT_L(0); PG8_MMA(0, 1, At, B1); PG8_BAR;
            PG8_LDA(At, 1, 1); PG8_STAGE(PG8_SA(1, 0), a3, voffA);
            PG8_BAR; PG8_WAIT_L(0); PG8_MMA(1, 0, At, B0); PG8_BAR; PG8_SCHED;
            PG8_STAGE(PG8_SB(1, 1), b3 + hsB, voffB);
            PG8_WAIT_V(6); PG8_BAR; PG8_MMA(1, 1, At, B1); PG8_BAR;
            }
        }
        if constexpr (ALIGN_EPI) { if (wr == 0) PG8_BAR; }
        if constexpr (!Epi::AFTER_DRAIN) { E(acc, cur, wr, wc, fr, fq); S.done(cur); }
        if (!has_next) break;
#pragma unroll
        for (int a = 0; a < 2; ++a)
#pragma unroll
            for (int b = 0; b < 2; ++b)
#pragma unroll
                for (int m = 0; m < 4; ++m)
#pragma unroll
                    for (int n = 0; n < 2; ++n) acc[a][b][m][n] = (f32x4){0.f, 0.f, 0.f, 0.f};
        cur = nxt; cA = nA; cB = nB; ++ui;
        if constexpr (ALIGN_EPI) { if (wr == 1) PG8_BAR; }
    }
    PG8_WAIT_V(0);
    if constexpr (!ALIGN_EPI) { if (wr == 0) PG8_BAR; }
    PG8_BAR;
    if constexpr (Epi::AFTER_DRAIN) { E.fused(acc, cur, wr, wc, fr, fq, lds, wid, lane); S.done(cur); }
#undef PG8_SA
#undef PG8_SB
#undef PG8_STAGE
#undef PG8_LDA
#undef PG8_LDB
#undef PG8_MMA
#undef PG8_WAIT_V
#undef PG8_WAIT_L
#undef PG8_BAR
#undef PG8_SCHED
}
}

#define DI __device__ __forceinline__
typedef pg8::bf16_t bf16_t;
typedef short bf16x8 __attribute__((ext_vector_type(8)));
typedef short s16x4 __attribute__((ext_vector_type(4)));
typedef float f32x4 __attribute__((ext_vector_type(4)));
typedef float f32x16 __attribute__((ext_vector_type(16)));
typedef unsigned u32x4 __attribute__((ext_vector_type(4)));
typedef unsigned u32x2 __attribute__((ext_vector_type(2)));
#define LAS __attribute__((address_space(3)))
typedef float f32x2_t __attribute__((ext_vector_type(2)));

constexpr int DM = 1024, NB = 8, SEQ = 2048, CTXL = 256;
constexpr int NLAT = NB * SEQ, NCTX = NB * CTXL, MALL = NLAT + NCTX;
constexpr int FH = 2816, FH2 = 5632, EIN = 1792, OIN = 1280;
constexpr float NORM_EPS = 1e-6f;
constexpr float C2 = 0.125f * 1.4426950408889634f;
constexpr int NTHREADS = 512, NWAVES = 8;
constexpr int LDS_BYTES = 147456 + 8192 + 256, LDS_MISC = 147456 + 8192;
constexpr int NBND_LAT = NB * 31, NBND_CTX = NB * 3;
constexpr int XNE_ROW_L0 = MALL, XNE_ROW_L1 = NLAT;
constexpr int XN_ROWS = MALL + 1280;

constexpr size_t MiB = 1u << 20;
constexpr size_t WS_CTL = 0, CTL_ZERO_BYTES = 64 * 1024;
constexpr size_t WS_MOD = 1 * MiB;
constexpr size_t WS_ROPE = 2 * MiB;
constexpr size_t WS_RGW = 3 * MiB;
constexpr size_t WS_S5AT = 3 * MiB + 512 * 1024;
constexpr size_t WS_RGTOT = 4 * MiB;
constexpr size_t WS_S5E = 7 * MiB, WS_S5MF = 15 * MiB;
constexpr size_t WS_WIN0 = 39 * MiB, WS_WOUT0 = 43 * MiB, WS_WUP0 = 45 * MiB, WS_WDN0 = 56 * MiB;
constexpr size_t WS_WIN1 = 62 * MiB, WS_WOUT1 = 65 * MiB, WS_WUP1 = 67 * MiB, WS_WDN1 = 78 * MiB, WS_WGLU = 84 * MiB;
constexpr size_t WS_HC = 85 * MiB;
constexpr size_t WS_XN = 93 * MiB;
constexpr size_t WS_PROJ = 132 * MiB;
constexpr size_t WS_S5L = 177 * MiB;
constexpr size_t WS_MIX = 195 * MiB;
constexpr size_t WS_HID = 132 * MiB;
constexpr size_t WS_UG = WS_XN;
constexpr size_t WS_Z = 231 * MiB;
constexpr size_t WS_END = 250 * MiB;
static_assert(WS_XN + (size_t)XN_ROWS * DM * 2 <= WS_PROJ, "xn");
static_assert(WS_PROJ + (size_t)MALL * OIN * 2 <= WS_S5L && WS_S5L + (size_t)576 * 32 * 256 * 4 <= WS_MIX, "s5l");
static_assert((size_t)2 * MALL * 512 * 2 <= (size_t)XN_ROWS * DM * 2 && WS_Z + (size_t)MALL * 512 * 2 <= WS_END && WS_MIX + (size_t)MALL * DM * 2 <= WS_Z, "rg scratch");
static_assert(WS_HID + (size_t)MALL * FH * 2 <= WS_Z && WS_Z + (size_t)NLAT * 512 * 2 <= WS_END && (size_t)32 * 768 * 768 * 2 <= (size_t)XN_ROWS * DM * 2, "hid/z/ug");

DI float bf2f(bf16_t v) { return __uint_as_float((unsigned)v << 16); }
DI unsigned f2bf(float f) { unsigned u = __float_as_uint(f); return (u + 0x7fffu + ((u >> 16) & 1u)) >> 16; }
DI unsigned pk2(float lo, float hi) { return f2bf(lo) | (f2bf(hi) << 16); }
typedef __bf16 bf16x2v_t __attribute__((ext_vector_type(2)));
DI unsigned cvtpk_(float lo, float hi) { f32x2_t v = {lo, hi}; bf16x2v_t b = __builtin_convertvector(v, bf16x2v_t); return __builtin_bit_cast(unsigned, b); }
DI float wave_sum(float v) {
#pragma unroll
    for (int o = 1; o < 64; o <<= 1) v += __shfl_xor(v, o);
    return v;
}
DI float sigmoidf_(float x) { return __builtin_amdgcn_rcpf(1.f + __expf(-x)); }
DI float gelu_tanh(float x) { const float z = 1.5957691216057308f * (x + 0.044715f * x * x * x); return x * sigmoidf_(z); }
DI float siluf_(float x) { return x * sigmoidf_(x); }

struct EpiRes {
    static constexpr bool PERM = false, AFTER_DRAIN = false;
    const float* baseL; const float* baseC; float* outL; float* outC; const float* gate;
    __device__ __forceinline__ void operator()(const f32x4 (&acc)[2][2][4][2], const pg8::Unit& u, int wr, int wc, int fr, int fq) const {
        const bool isc = u.pm >= 64; const int bb = isc ? 8 : (u.pm >> 3);
        const float* base = isc ? baseC + (size_t)(u.pm - 64) * 256 * DM : baseL + (size_t)u.pm * 256 * DM;
        float* out = isc ? outC + (size_t)(u.pm - 64) * 256 * DM : outL + (size_t)u.pm * 256 * DM;
        const float* g = gate + (size_t)bb * 6144;
        const int col0 = u.pn * 256 + wc * 32 + 4 * fq;
#pragma unroll
        for (int bj = 0; bj < 2; ++bj)
#pragma unroll
            for (int n = 0; n < 2; ++n) {
                const int c = col0 + bj * 128 + n * 16; const f32x4 gv = *(const f32x4*)(g + c);
                f32x4 bs[2][4];
#pragma unroll
                for (int ai = 0; ai < 2; ++ai)
#pragma unroll
                    for (int m = 0; m < 4; ++m) bs[ai][m] = *(const f32x4*)(base + (size_t)(ai * 128 + wr * 64 + m * 16 + fr) * DM + c);
#pragma unroll
                for (int ai = 0; ai < 2; ++ai)
#pragma unroll
                    for (int m = 0; m < 4; ++m) *(f32x4*)(out + (size_t)(ai * 128 + wr * 64 + m * 16 + fr) * DM + c) = bs[ai][m] + gv * acc[ai][bj][m][n];
            }
    }
};

struct EpiCtxHalf {
    static constexpr bool PERM = false, AFTER_DRAIN = false;
    const float* baseC; float* outC; float* cp; const float* gate; int kh;
    __device__ __forceinline__ void operator()(const f32x4 (&acc)[2][2][4][2], const pg8::Unit& u, int wr, int wc, int fr, int fq) const {
        const size_t t0 = (size_t)(u.pm - 64) * 256 * DM; const float* g = gate + (size_t)8 * 6144;
        const int col0 = u.pn * 256 + wc * 32 + 4 * fq;
#pragma unroll
        for (int bj = 0; bj < 2; ++bj)
#pragma unroll
            for (int n = 0; n < 2; ++n) {
                const int c = col0 + bj * 128 + n * 16; const f32x4 gv = *(const f32x4*)(g + c);
                f32x4 bs[2][4];
#pragma unroll
                for (int ai = 0; ai < 2; ++ai)
#pragma unroll
                    for (int m = 0; m < 4; ++m) bs[ai][m] = kh == 0 ? *(const f32x4*)(baseC + t0 + (size_t)(ai * 128 + wr * 64 + m * 16 + fr) * DM + c) : (f32x4){0.f, 0.f, 0.f, 0.f};
                float* o = kh == 0 ? outC : cp;
#pragma unroll
                for (int ai = 0; ai < 2; ++ai)
#pragma unroll
                    for (int m = 0; m < 4; ++m) *(f32x4*)(o + t0 + (size_t)(ai * 128 + wr * 64 + m * 16 + fr) * DM + c) = bs[ai][m] + gv * acc[ai][bj][m][n];
            }
    }
};
struct CtxOrder {
    int c;
    __device__ bool next(int i, pg8::Unit& u) const { if (i != 0 || c < 0 || c >= 32) return false; u.pm = 64 + (c >> 2); u.pn = c & 3; return true; }
    __device__ __forceinline__ void a_ready(const pg8::Unit&) const {}
    __device__ __forceinline__ void done(const pg8::Unit&) const {}
};

struct EpiConvAct {
    static constexpr bool PERM = true, AFTER_DRAIN = false;
    bf16_t* H; const float* cw; const float* cb; int pm_edge; int nbnd_lat; int nbnd; char* xlds;
    __device__ __forceinline__ void operator()(const f32x4 (&acc)[2][2][4][2], const pg8::Unit& u, int wr_, int wc_, int fr_, int fq_) const {
        int tl = threadIdx.x; asm volatile("" : "+v"(tl));
        const int lane = tl & 63, wid_ = tl >> 6, fr = lane & 15, fq = lane >> 4, wr = wid_ >> 2, wc = wid_ & 3; (void)wr_; (void)wc_; (void)fr_; (void)fq_;
        const bool edge = u.pm >= pm_edge;
        const int hc0 = u.pn * 128 + wc * 32 + 8 * fq;
        u32x2* sc = (u32x2*)(xlds + wid_ * 2048);
        float* wl = (float*)(xlds + 16384 + wid_ * 1024);
        { const int p = lane >> 4, bjl = (lane >> 3) & 1, cg4 = lane & 7;
          const float* src = (p < 3 ? cw + p * FH2 : cb) + bjl * FH + u.pn * 128 + wc * 32 + 4 * cg4;
          *(f32x4*)(wl + (p * 2 + bjl) * 32 + 4 * cg4) = *(const f32x4*)src; }
        asm volatile("" ::: "memory");
#pragma unroll
        for (int n = 0; n < 2; ++n) {
#pragma unroll
            for (int ai = 0; ai < 2; ++ai) {
                float hvv[2][4][4];
#pragma unroll
                for (int bj = 0; bj < 2; ++bj) {
#pragma unroll
                    for (int m = 0; m < 4; ++m) { u32x2 w; w.x = cvtpk_(acc[ai][bj][m][n][0], acc[ai][bj][m][n][1]); w.y = cvtpk_(acc[ai][bj][m][n][2], acc[ai][bj][m][n][3]); sc[(16 * m + fr) * 4 + fq] = w; }
                    asm volatile("" ::: "memory");
                    const f32x4 w0 = *(const f32x4*)(wl + (0 * 2 + bj) * 32 + 8 * fq + 4 * n), w1 = *(const f32x4*)(wl + (1 * 2 + bj) * 32 + 8 * fq + 4 * n),
                                w2 = *(const f32x4*)(wl + (2 * 2 + bj) * 32 + 8 * fq + 4 * n), bb = *(const f32x4*)(wl + (3 * 2 + bj) * 32 + 8 * fq + 4 * n);
#pragma unroll
                    for (int m = 0; m < 4; ++m) {
                        const int row = 16 * m + fr; const int ru = row > 0 ? row - 1 : 0, rd = row < 63 ? row + 1 : 63;
                        u32x2 uu = sc[ru * 4 + fq], dd = sc[rd * 4 + fq];
                        if (row == 0) uu = (u32x2){0u, 0u}; if (row == 63) dd = (u32x2){0u, 0u};
                        const f32x4 up = (f32x4){__uint_as_float(uu.x << 16), __uint_as_float(uu.x & 0xffff0000u), __uint_as_float(uu.y << 16), __uint_as_float(uu.y & 0xffff0000u)};
                        const f32x4 dn = (f32x4){__uint_as_float(dd.x << 16), __uint_as_float(dd.x & 0xffff0000u), __uint_as_float(dd.y << 16), __uint_as_float(dd.y & 0xffff0000u)};
                        const f32x4 hv = bb + w0 * up + w1 * acc[ai][bj][m][n] + w2 * dn;
                        hvv[bj][m][0] = hv.x; hvv[bj][m][1] = hv.y; hvv[bj][m][2] = hv.z; hvv[bj][m][3] = hv.w;
                    }
                    asm volatile("" : "+v"(hvv[bj][0][0]), "+v"(hvv[bj][0][1]), "+v"(hvv[bj][0][2]), "+v"(hvv[bj][0][3]), "+v"(hvv[bj][1][0]), "+v"(hvv[bj][1][1]), "+v"(hvv[bj][1][2]), "+v"(hvv[bj][1][3]),
                                      "+v"(hvv[bj][2][0]), "+v"(hvv[bj][2][1]), "+v"(hvv[bj][2][2]), "+v"(hvv[bj][2][3]), "+v"(hvv[bj][3][0]), "+v"(hvv[bj][3][1]), "+v"(hvv[bj][3][2]), "+v"(hvv[bj][3][3]) :: "memory");
                }
#pragma unroll
                for (int m = 0; m < 4; ++m) {
                    const int R = ai * 128 + wr * 64 + m * 16 + fr;
                    long grow; bool st;
                    if (!edge) {
                        grow = (long)u.pm * 256 + R; st = true;
                        const int r64 = R & 63;
                        if (r64 == 0) st = (R == 0) && (u.pm >= 64 || (u.pm & 7) == 0);
                        if (r64 == 63) st = (R == 255) && (u.pm >= 64 || (u.pm & 7) == 7);
                    } else {
                        const int slot = (u.pm - pm_edge) * 256 + R, q = slot >> 2, pos = slot & 3;
                        st = (pos == 1 || pos == 2) && q < nbnd;
                        int row0;
                        if (q < nbnd_lat) { const int s = q / 31, k = q - s * 31 + 1; row0 = s * SEQ + 64 * k; }
                        else { const int q2 = q - nbnd_lat, s = q2 / 3, k = q2 - s * 3 + 1; row0 = NLAT + s * CTXL + 64 * k; }
                        grow = (long)row0 - 2 + pos;
                    }
                    if (st) { u32x2 w; w.x = cvtpk_(hvv[0][m][0] * siluf_(hvv[1][m][0]), hvv[0][m][1] * siluf_(hvv[1][m][1])); w.y = cvtpk_(hvv[0][m][2] * siluf_(hvv[1][m][2]), hvv[0][m][3] * siluf_(hvv[1][m][3]));
                        *(u32x2*)(H + (size_t)grow * FH + hc0 + 4 * n) = w; }
                }
                asm volatile("" ::: "memory"); __builtin_amdgcn_sched_barrier(0);
            }
        }
    }
};

struct EpiGlu {
    static constexpr bool PERM = true, AFTER_DRAIN = false;
    const bf16_t* Z; bf16_t* O; const float* bias;
    __device__ __forceinline__ void operator()(const f32x4 (&acc)[2][2][4][2], const pg8::Unit& u, int wr, int wc, int fr, int fq) const {
        const int row0 = u.pm * 256 + wr * 64 + fr; const int col0 = u.pn * 256 + wc * 32 + 8 * fq;
#pragma unroll
        for (int bj = 0; bj < 2; ++bj) {
            const f32x4 b0 = *(const f32x4*)(bias + col0 + bj * 128), b1 = *(const f32x4*)(bias + col0 + bj * 128 + 4);
            u32x4 zq[2][4];
#pragma unroll
            for (int ai = 0; ai < 2; ++ai)
#pragma unroll
                for (int m = 0; m < 4; ++m) zq[ai][m] = *(const u32x4*)(Z + (size_t)(row0 + ai * 128 + m * 16) * 512 + col0 + bj * 128);
#pragma unroll
            for (int ai = 0; ai < 2; ++ai)
#pragma unroll
                for (int m = 0; m < 4; ++m) {
                    const size_t r = (size_t)(row0 + ai * 128 + m * 16);
                    const u32x4 zz = zq[ai][m];
                    const f32x4 v0 = acc[ai][bj][m][0] + b0, v1 = acc[ai][bj][m][1] + b1;
                    float o[8];
#pragma unroll
                    for (int j = 0; j < 4; ++j) {
                        const float z0 = __uint_as_float((j & 1) ? (zz[j >> 1] & 0xffff0000u) : (zz[j >> 1] << 16));
                        const float z1 = __uint_as_float((j & 1) ? (zz[2 + (j >> 1)] & 0xffff0000u) : (zz[2 + (j >> 1)] << 16));
                        o[j] = z0 * sigmoidf_(v0[j]); o[4 + j] = z1 * sigmoidf_(v1[j]);
                    }
                    u32x4 w; w.x = pk2(o[0], o[1]); w.y = pk2(o[2], o[3]); w.z = pk2(o[4], o[5]); w.w = pk2(o[6], o[7]);
                    *(u32x4*)(O + r * DM + col0 + bj * 128) = w;
                }
        }
    }
};
#define GAS __attribute__((address_space(1)))
typedef GAS unsigned gu32;
typedef GAS unsigned long long gu64;
#define RLX_AGENT __ATOMIC_RELAXED, __HIP_MEMORY_SCOPE_AGENT
#define LDS_WAIT() asm volatile("s_waitcnt lgkmcnt(0)" ::: "memory")
#define VM_WAIT() asm volatile("s_waitcnt vmcnt(0)" ::: "memory")
__device__ __forceinline__ unsigned long long rt() { return __builtin_amdgcn_s_memrealtime(); }
#define XB_TMO      128
#define XB_XCNT(j)  (256  + 64 * (j))
#define XB_XSUB(j)  (1280 + 64 * (j))
#define XB_XGEN(j)  (2304 + 64 * (j))
#define XB_TOP      3328
#define XB_TOPGEN   3392
#define XCD_BAR_WORDS 3456
#define XB_SPIN_CAP (1u << 18)

__device__ __forceinline__ unsigned xb_ld(unsigned* p)              { return __hip_atomic_load(p, __ATOMIC_RELAXED, __HIP_MEMORY_SCOPE_AGENT); }
__device__ __forceinline__ unsigned xb_add(unsigned* p, unsigned v) { return __hip_atomic_fetch_add(p, v, __ATOMIC_RELAXED, __HIP_MEMORY_SCOPE_AGENT); }
__device__ __forceinline__ unsigned xb_xcc_id() { return (unsigned)__builtin_amdgcn_s_getreg((3 << 11) | 20) & 0xFu; }
#define XB_SPIN(cond, bar) do { unsigned _sp = 0; while (cond) { __builtin_amdgcn_s_sleep(1); \
    if ((++_sp & 255u) == 0u) { if (xb_ld(&(bar)[XB_TMO])) break; if (_sp > XB_SPIN_CAP) { atomicAdd(&(bar)[XB_TMO], 1u); break; } } } } while (0)

struct XcdBarrier {
    unsigned* bar; unsigned x;
    volatile LAS unsigned* st;
};

__device__ __forceinline__ XcdBarrier xcd_barrier_post(unsigned* bar, volatile LAS unsigned* st) {
    XcdBarrier b; b.bar = bar; b.x = xb_xcc_id(); b.st = st;
    if (threadIdx.x == 0) (void)xb_add(&bar[XB_XCNT(b.x)], 1u);
    return b;
}
__device__ __forceinline__ void xcd_barrier_complete(unsigned* bar, unsigned x, unsigned& nloc, unsigned& nx) {
    const unsigned G = gridDim.x * gridDim.y * gridDim.z;
    unsigned sum, cnt, mine, sp = 0u;
    for (;;) {
        sum = 0u; cnt = 0u; mine = 0u;
#pragma unroll
        for (unsigned j = 0; j < 16; ++j) { const unsigned c = xb_ld(&bar[XB_XCNT(j)]); sum += c; cnt += (c > 0u) ? 1u : 0u; mine = (j == x) ? c : mine; }
        if (sum == G) break;
        __builtin_amdgcn_s_sleep(1);
        if ((++sp & 255u) == 0u) { if (xb_ld(&bar[XB_TMO])) break; if (sp > XB_SPIN_CAP) { atomicAdd(&bar[XB_TMO], 1u); break; } }
    }
    nloc = mine > 0u ? mine : 1u; nx = cnt > 0u ? cnt : 1u;
}

__device__ __forceinline__ void xcd_barrier(const XcdBarrier& b) {
    asm volatile("s_waitcnt vmcnt(0)" ::: "memory");
    __syncthreads();
    if (threadIdx.x == 0) {
        unsigned* bar = b.bar;
        __builtin_amdgcn_s_waitcnt(0);
        unsigned nloc = b.st[0], nx = b.st[1];
        if (nloc == 0u) { xcd_barrier_complete(bar, b.x, nloc, nx); b.st[0] = nloc; b.st[1] = nx; }
        const unsigned old = xb_add(&bar[XB_XSUB(b.x)], 1u);
        const unsigned gen = old / nloc;
        if (old + 1u == (gen + 1u) * nloc) {
            __builtin_amdgcn_fence(__ATOMIC_RELEASE, "agent");
            asm volatile("s_waitcnt vmcnt(0)" ::: "memory");
            const unsigned og = xb_add(&bar[XB_TOP], 1u);
            const unsigned tg = og / nx;
            if (og + 1u == (tg + 1u) * nx) xb_add(&bar[XB_TOPGEN], 1u);
            else XB_SPIN(xb_ld(&bar[XB_TOPGEN]) == tg, bar);
            __builtin_amdgcn_fence(__ATOMIC_ACQUIRE, "agent");
            xb_add(&bar[XB_XGEN(b.x)], 1u);
            asm volatile("s_waitcnt vmcnt(0)" ::: "memory");
        } else {
            XB_SPIN(xb_ld(&bar[XB_XGEN(b.x)]) == gen, bar);
            __builtin_amdgcn_fence(__ATOMIC_ACQUIRE, "agent");
            asm volatile("s_waitcnt vmcnt(0)" ::: "memory");
        }
    }
    __syncthreads();
}

DI s16x4 vtr(const char* p) { typedef short v4i16_t __attribute__((ext_vector_type(4))); return __builtin_bit_cast(s16x4, __builtin_amdgcn_ds_read_tr16_b64_v4i16((LAS v4i16_t*)p)); }
typedef __bf16 bf16x2_t __attribute__((ext_vector_type(2)));
DI unsigned cvtpk(float lo, float hi) { f32x2_t v = {lo, hi}; bf16x2_t b = __builtin_convertvector(v, bf16x2_t); return __builtin_bit_cast(unsigned, b); }
DI int crow(int r, int h) { return (r & 3) + 8 * (r >> 2) + 4 * h; }
#define MFMA32(a, b, c) __builtin_amdgcn_mfma_f32_32x32x16_bf16((a), (b), (c), 0, 0, 0)
constexpr int ATT_BUF = 17408, ATT_KB = 9216;

template <int MODE, int RB>
DI void attn_unit(const bf16_t* __restrict__ P, int ld, int qoff, int koff, int voff, bf16_t* __restrict__ O, char* lds, int b, int head, int q0, float sink_l2) {
    const int tid = threadIdx.x, lane = tid & 63, wid = tid >> 6, r32 = lane & 31, hi = lane >> 5;
    const int kvh = head >> 2;
    const int qrow0 = (MODE == 1) ? (NLAT + b * CTXL) : (b * SEQ + q0);
    int lat0 = 0, nlat = 0;
    if (MODE == 0) { lat0 = 0; nlat = SEQ / 64; }
    if (MODE == 2) { const int lo = q0 - 128 < 0 ? 0 : q0 - 128; const int hi_ = q0 + 256 * RB + 128 > SEQ ? SEQ : q0 + 256 * RB + 128; lat0 = lo; nlat = (hi_ - lo) / 64; }
    const int NT = 4 + nlat;
#define KROW(t) ((t) < 4 ? (NLAT + b * CTXL + 64 * (t)) : (b * SEQ + lat0 + 64 * ((t) - 4)))
    bf16x8 qr[RB][4];
#pragma unroll
    for (int rb = 0; rb < RB; ++rb) { const bf16_t* Qp = P + (size_t)(qrow0 + wid * 32 * RB + rb * 32 + r32) * ld + qoff + head * 64 + 8 * hi;
#pragma unroll
        for (int ks = 0; ks < 4; ++ks) qr[rb][ks] = *(const bf16x8*)(Qp + 16 * ks); }
    const int srow = tid >> 3, sch = tid & 7;
    const bf16_t* kg = P + koff + kvh * 64 + sch * 8; const bf16_t* vg = P + voff + kvh * 64 + sch * 8;
    const int kw = srow * 144 + sch * 16, vw = ATT_KB + (sch >> 2) * 4096 + srow * 64 + (sch & 3) * 16;
    const int kr_off = r32 * 144 + 16 * hi;
    const int vr_off = ATT_KB + ((lane >> 4) & 1) * 32 + (lane & 3) * 8 + (4 * hi + ((lane & 15) >> 2)) * 64;
    u32x4 kreg, vreg;
    { const size_t r = (size_t)(KROW(0) + srow) * ld; kreg = *(const u32x4*)(kg + r); vreg = *(const u32x4*)(vg + r); }
    *(u32x4*)(lds + kw) = kreg; *(u32x4*)(lds + vw) = vreg;
    if (NT > 1) { const size_t r = (size_t)(KROW(1) + srow) * ld; kreg = *(const u32x4*)(kg + r); vreg = *(const u32x4*)(vg + r); }
    float m[RB], l[RB]; f32x16 o0[RB], o1[RB];
#pragma unroll
    for (int rb = 0; rb < RB; ++rb) { m[rb] = 0.f; l[rb] = 0.f; o0[rb] = f32x16{}; o1[rb] = f32x16{}; }
    __syncthreads();
    for (int t = 0; t < NT; ++t) {
        const char* buf = lds + (t & 1) * ATT_BUF;
        bool need = true; int kpos0 = 0;
        if (MODE == 2 && t >= 4) { kpos0 = lat0 + 64 * (t - 4); const int ql = q0 + wid * 32 * RB; need = (kpos0 <= ql + 32 * RB - 1 + 128) && (kpos0 + 63 >= ql - 128); }
        if (need) {
#pragma unroll
            for (int kb = 0; kb < 2; ++kb) {
                f32x16 p[RB];
#pragma unroll
                for (int rb = 0; rb < RB; ++rb) p[rb] = f32x16{};
#pragma unroll
                for (int ks = 0; ks < 4; ++ks) {
                    const bf16x8 kf = *(const bf16x8*)(buf + kr_off + kb * 32 * 144 + ks * 32);
#pragma unroll
                    for (int rb = 0; rb < RB; ++rb) p[rb] = MFMA32(kf, qr[rb][ks], p[rb]);
                }
#pragma unroll
                for (int rb = 0; rb < RB; ++rb) {
                    if (__any(m[rb] != 0.f)) {
#pragma unroll
                        for (int i = 0; i < 16; ++i) p[rb][i] -= m[rb]; }
                    if (MODE == 2 && t >= 4) {
                        const int qpos = q0 + wid * 32 * RB + rb * 32 + r32;
#pragma unroll
                        for (int i = 0; i < 16; ++i) { const int kp = kpos0 + 32 * kb + crow(i, hi); int d0 = qpos - kp; d0 = d0 < 0 ? -d0 : d0; if (d0 > 128) p[rb][i] = -1e30f; }
                    }
                    float mx = fmaxf(fmaxf(p[rb][0], p[rb][1]), p[rb][2]), mx2 = fmaxf(fmaxf(p[rb][3], p[rb][4]), p[rb][5]);
#pragma unroll
                    for (int i = 6; i < 16; i += 4) { mx = fmaxf(fmaxf(mx, p[rb][i]), p[rb][i + 1]); mx2 = fmaxf(fmaxf(mx2, p[rb][i + 2 < 16 ? i + 2 : 15]), p[rb][i + 3 < 16 ? i + 3 : 15]); }
                    mx = fmaxf(mx, mx2); mx = fmaxf(mx, __shfl_xor(mx, 32));
                    if (__any(mx > 8.f)) {
                        const float dl = fmaxf(mx, 0.f); m[rb] += dl; const float f = __builtin_amdgcn_exp2f(-dl); l[rb] *= f;
#pragma unroll
                        for (int i = 0; i < 16; ++i) { p[rb][i] -= dl; o0[rb][i] *= f; o1[rb][i] *= f; }
                    }
                    float rs = 0.f, rs2 = 0.f;
#pragma unroll
                    for (int i = 0; i < 16; i += 2) { p[rb][i] = __builtin_amdgcn_exp2f(p[rb][i]); rs += p[rb][i]; p[rb][i + 1] = __builtin_amdgcn_exp2f(p[rb][i + 1]); rs2 += p[rb][i + 1]; }
                    l[rb] += rs + rs2;
                }
#pragma unroll
                for (int s2 = 0; s2 < 2; ++s2) {
                    const char* vb = buf + vr_off + (2 * kb + s2) * 1024;
                    const s16x4 a0 = vtr(vb), a1 = vtr(vb + 512), c0 = vtr(vb + 4096), c1 = vtr(vb + 4096 + 512);
                    const bf16x8 va0 = (bf16x8){a0[0], a0[1], a0[2], a0[3], a1[0], a1[1], a1[2], a1[3]};
                    const bf16x8 va1 = (bf16x8){c0[0], c0[1], c0[2], c0[3], c1[0], c1[1], c1[2], c1[3]};
#pragma unroll
                    for (int rb = 0; rb < RB; ++rb) {
                        u32x4 pw; pw[0] = cvtpk(p[rb][8 * s2], p[rb][8 * s2 + 1]); pw[1] = cvtpk(p[rb][8 * s2 + 2], p[rb][8 * s2 + 3]); pw[2] = cvtpk(p[rb][8 * s2 + 4], p[rb][8 * s2 + 5]); pw[3] = cvtpk(p[rb][8 * s2 + 6], p[rb][8 * s2 + 7]);
                        const bf16x8 pb = __builtin_bit_cast(bf16x8, pw);
                        o0[rb] = MFMA32(va0, pb, o0[rb]); o1[rb] = MFMA32(va1, pb, o1[rb]);
                    }
                }
            }
        }
        if (t + 1 < NT) {
            char* nb = lds + ((t + 1) & 1) * ATT_BUF;
            *(u32x4*)(nb + kw) = kreg; *(u32x4*)(nb + vw) = vreg;
            if (t + 2 < NT) { const size_t r = (size_t)(KROW(t + 2) + srow) * ld; kreg = *(const u32x4*)(kg + r); vreg = *(const u32x4*)(vg + r); }
        }
        __syncthreads();
    }
#undef KROW
    int tl_ = threadIdx.x; asm volatile("" : "+v"(tl_));
    const int lane2 = tl_ & 63, wid2 = tl_ >> 6, r32b = lane2 & 31, hib = lane2 >> 5;
#pragma unroll
    for (int rb = 0; rb < RB; ++rb) {
        float lt = l[rb] + __shfl_xor(l[rb], 32);
        if (MODE == 2) lt += __builtin_amdgcn_exp2f(sink_l2 - m[rb]);
        const float inv = 1.f / lt;
        bf16_t* Op = O + (size_t)(qrow0 + wid2 * 32 * RB + rb * 32 + r32b) * DM + 512 + head * 64 + 4 * hib;
#pragma unroll
        for (int k = 0; k < 4; ++k) {
            u32x2 w0, w1;
            w0.x = pk2(o0[rb][4 * k] * inv, o0[rb][4 * k + 1] * inv); w0.y = pk2(o0[rb][4 * k + 2] * inv, o0[rb][4 * k + 3] * inv);
            w1.x = pk2(o1[rb][4 * k] * inv, o1[rb][4 * k + 1] * inv); w1.y = pk2(o1[rb][4 * k + 2] * inv, o1[rb][4 * k + 3] * inv);
            *(u32x2*)(Op + 8 * k) = w0; *(u32x2*)(Op + 32 + 8 * k) = w1;
        }
    }
}

constexpr int RG_XA = 0, RG_XF = 9216, RG_GT = RG_XF + 64 * 65 * 4  , RG_SEG = RG_GT + 4 * 64 * 65 * 4  , RG_CAR = RG_SEG + 2 * 64 * 4 * 8  ;
DI bf16_t* rg_yl(unsigned char* ws) { return (bf16_t*)(ws + WS_XN); }
DI bf16_t* rg_pf(unsigned char* ws) { return (bf16_t*)(ws + WS_XN) + (size_t)MALL * 512; }
DI bf16_t* rg_pb(unsigned char* ws) { return (bf16_t*)(ws + WS_Z); }
DI void rg_item1(const float* const* in, unsigned char* ws, char* lds, int item) {
    const int tid = threadIdx.x, lane = tid & 63, wid = tid >> 6;
    const int ci = item % 36, bh = item / 36, head = bh & 7, b = bh >> 3;
    const bf16_t* PROJ = (const bf16_t*)(ws + WS_PROJ);
    const int seqbase = ci < 4 ? NLAT + b * CTXL : b * SEQ, t0 = ci < 4 ? ci * 64 : (ci - 4) * 64, slen = ci < 4 ? CTXL : SEQ;
    bf16_t* XA = (bf16_t*)(lds + RG_XA); float* XF = (float*)(lds + RG_XF); float* GT = (float*)(lds + RG_GT); float* SEGL = (float*)(lds + RG_SEG);
    float* TOT = (float*)(ws + WS_RGTOT);
    const int sdir = tid >> 8, sch = (tid >> 2) & 63, sseg = tid & 3;
    {
        const int tok = tid >> 3, cg8 = tid & 7, ch0 = head * 64 + cg8 * 8;
        const float* cw = in[13]; const float* cb = in[14];
        float x[8]; u32x4 uu4[4]; f32x4 wq[5][2];
#pragma unroll
        for (int j = 0; j < 4; ++j) { int tt = t0 + tok + j - 1; tt = tt < 0 ? 0 : (tt >= slen ? slen - 1 : tt); uu4[j] = *(const u32x4*)(PROJ + (size_t)(seqbase + tt) * EIN + ch0); }
#pragma unroll
        for (int j = 0; j < 4; ++j) { wq[j][0] = *(const f32x4*)(cw + j * 512 + ch0); wq[j][1] = *(const f32x4*)(cw + j * 512 + ch0 + 4); }
        wq[4][0] = *(const f32x4*)(cb + ch0); wq[4][1] = *(const f32x4*)(cb + ch0 + 4);
#pragma unroll
        for (int c = 0; c < 8; ++c) x[c] = wq[4][c >> 2][c & 3];
#pragma unroll
        for (int j = 0; j < 4; ++j) {
            const int tt = t0 + tok + j - 1; const float msk = (tt >= 0 && tt < slen) ? 1.f : 0.f;
#pragma unroll
            for (int c = 0; c < 8; ++c) { const float uv = __uint_as_float((c & 1) ? (uu4[j][c >> 1] & 0xffff0000u) : (uu4[j][c >> 1] << 16)); x[c] += (wq[j][c >> 2][c & 3] * msk) * uv; }
        }
        u32x4 w; w.x = pk2(x[0], x[1]); w.y = pk2(x[2], x[3]); w.z = pk2(x[4], x[5]); w.w = pk2(x[6], x[7]);
        *(u32x4*)(XA + tok * 72 + cg8 * 8) = w;
#pragma unroll
        for (int c = 0; c < 8; ++c) XF[tok * 65 + cg8 * 8 + c] = x[c];
    }
    __syncthreads();
    {
        const int mi = wid & 3, th = wid >> 2, r32 = lane & 31, hi = lane >> 5;
        const bf16_t* W = (const bf16_t*)(ws + WS_RGW) + (size_t)(mi * 8 + head) * 4096;
        const float* bias = (mi & 1) ? in[18] : in[16]; const int dirm = mi >> 1;
#pragma unroll
        for (int nt = 0; nt < 2; ++nt) {
            f32x16 acc = {};
#pragma unroll
            for (int ks = 0; ks < 4; ++ks) {
                const bf16x8 a = *(const bf16x8*)(XA + (32 * th + r32) * 72 + 16 * ks + 8 * hi);
                const bf16x8 bfr = *(const bf16x8*)(W + (32 * nt + r32) * 64 + 16 * ks + 8 * hi);
                acc = MFMA32(a, bfr, acc);
            }
            const float bv = bias[dirm * 512 + head * 64 + 32 * nt + r32];
#pragma unroll
            for (int i = 0; i < 16; ++i) GT[(mi * 64 + 32 * th + crow(i, hi)) * 65 + 32 * nt + r32] = sigmoidf_(acc[i] + bv);
        }
    }
    __syncthreads();
    float av[16], bvv[16];
    {
        const float lam = in[19][sdir * 512 + head * 64 + sch];
        const float nl = -lam; const float sp = nl > 20.f ? nl : log1pf(__expf(nl));
        float hh = 0.f, PP = 1.f;
#pragma unroll
        for (int s = 0; s < 16; ++s) {
            const int k = 16 * sseg + s, tok = sdir == 0 ? k : 63 - k;
            const float r = GT[((2 * sdir) * 64 + tok) * 65 + sch], ig = GT[((2 * sdir + 1) * 64 + tok) * 65 + sch], x = XF[tok * 65 + sch];
            const float la = -8.f * r * sp; const float a = __expf(la); const float bb = __builtin_amdgcn_sqrtf(fmaxf(1.f - a * a, 0.f)) * (ig * x);
            av[s] = a; bvv[s] = bb; hh = a * hh + bb; PP *= a;
        }
        __syncthreads();
        SEGL[((sdir * 64 + sch) * 4 + sseg) * 2] = PP; SEGL[((sdir * 64 + sch) * 4 + sseg) * 2 + 1] = hh;
    }
    __syncthreads();
    {
        float c = 0.f, Pbef = 1.f, Pt = 1.f;
#pragma unroll
        for (int s = 0; s < 4; ++s) { const float p = SEGL[((sdir * 64 + sch) * 4 + s) * 2], h = SEGL[((sdir * 64 + sch) * 4 + s) * 2 + 1];
            if (s < sseg) { c = p * c + h; Pbef *= p; } Pt *= p; }
        float h = c, P = Pbef;
#pragma unroll
        for (int s = 0; s < 16; ++s) { const int k = 16 * sseg + s, tok = sdir == 0 ? k : 63 - k; h = av[s] * h + bvv[s]; P *= av[s];
            GT[(sdir * 64 + tok) * 65 + sch] = h; GT[((2 + sdir) * 64 + tok) * 65 + sch] = P; }
        if (sseg == 3) { float* tp = TOT + ((size_t)((sdir * NB + b) * 36 + ci) * 2) * 512 + head * 64 + sch; tp[0] = Pt; tp[512] = h; }
    }
    __syncthreads();
    {
        const int tok = tid >> 3, cg8 = tid & 7, ch0 = head * 64 + cg8 * 8;
        const size_t off = (size_t)(seqbase + t0 + tok) * 512 + ch0;
        float y[8], pf[8], pb[8];
#pragma unroll
        for (int c = 0; c < 8; ++c) { y[c] = GT[tok * 65 + cg8 * 8 + c] + GT[(64 + tok) * 65 + cg8 * 8 + c]; pf[c] = GT[(128 + tok) * 65 + cg8 * 8 + c]; pb[c] = GT[(192 + tok) * 65 + cg8 * 8 + c]; }
        u32x4 w; w.x = pk2(y[0], y[1]); w.y = pk2(y[2], y[3]); w.z = pk2(y[4], y[5]); w.w = pk2(y[6], y[7]); *(u32x4*)(rg_yl(ws) + off) = w;
        w.x = pk2(pf[0], pf[1]); w.y = pk2(pf[2], pf[3]); w.z = pk2(pf[4], pf[5]); w.w = pk2(pf[6], pf[7]); *(u32x4*)(rg_pf(ws) + off) = w;
        w.x = pk2(pb[0], pb[1]); w.y = pk2(pb[2], pb[3]); w.z = pk2(pb[4], pb[5]); w.w = pk2(pb[6], pb[7]); *(u32x4*)(rg_pb(ws) + off) = w;
    }
    __syncthreads();
}
DI void rg_item2(const float* const* in, unsigned char* ws, char* lds, int item) {
    const int tid = threadIdx.x;
    const int ci = item % 36, bh = item / 36, head = bh & 7, b = bh >> 3;
    const bf16_t* PROJ = (const bf16_t*)(ws + WS_PROJ);
    const int seqbase = ci < 4 ? NLAT + b * CTXL : b * SEQ, t0 = ci < 4 ? ci * 64 : (ci - 4) * 64;
    float* SEGL = (float*)(lds + RG_SEG); float* CAR = (float*)(lds + RG_CAR);
    const float* TOT = (const float*)(ws + WS_RGTOT);
    const int sdir = tid >> 8, sch = (tid >> 2) & 63, sseg = tid & 3;
    const int tok = tid >> 3, cg8 = tid & 7, ch0 = head * 64 + cg8 * 8;
    const size_t row = (size_t)(seqbase + t0 + tok); const size_t off = row * 512 + ch0;
    const u32x4 yv = *(const u32x4*)(rg_yl(ws) + off), pfv = *(const u32x4*)(rg_pf(ws) + off), pbv = *(const u32x4*)(rg_pb(ws) + off), gg = *(const u32x4*)(PROJ + row * EIN + 512 + ch0);
    {
        const int pos = sdir == 0 ? ci : (ci < 4 ? 3 - ci : 4 + (35 - ci));
        float pp[9], hh[9];
#pragma unroll
        for (int i = 0; i < 9; ++i) { const int k0 = sseg * 9 + i; const int k = k0 < 35 ? k0 : 35; const int ck = sdir == 0 ? k : (k < 4 ? 3 - k : 35 - (k - 4));
            const float* tp = TOT + ((size_t)((sdir * NB + b) * 36 + ck) * 2) * 512 + head * 64 + sch; pp[i] = tp[0]; hh[i] = tp[512]; }
#pragma unroll
        for (int i = 0; i < 9; ++i) { if (sseg * 9 + i >= pos) { pp[i] = 1.f; hh[i] = 0.f; } }
        float Pc = 1.f, Hc = 0.f;
#pragma unroll
        for (int i = 0; i < 9; ++i) { Hc = pp[i] * Hc + hh[i]; Pc *= pp[i]; }
        SEGL[((sdir * 64 + sch) * 4 + sseg) * 2] = Pc; SEGL[((sdir * 64 + sch) * 4 + sseg) * 2 + 1] = Hc;
    }
    __syncthreads();
    if (tid < 128) { const int d = tid >> 6, ch = tid & 63; float Hc = 0.f;
#pragma unroll
        for (int s = 0; s < 4; ++s) { const float p = SEGL[((d * 64 + ch) * 4 + s) * 2], h = SEGL[((d * 64 + ch) * 4 + s) * 2 + 1]; Hc = p * Hc + h; }
        CAR[d * 64 + ch] = Hc; }
    __syncthreads();
    {
        float o[8];
#pragma unroll
        for (int c = 0; c < 8; ++c) {
            const float yl = __uint_as_float((c & 1) ? (yv[c >> 1] & 0xffff0000u) : (yv[c >> 1] << 16)), pf = __uint_as_float((c & 1) ? (pfv[c >> 1] & 0xffff0000u) : (pfv[c >> 1] << 16));
            const float pb = __uint_as_float((c & 1) ? (pbv[c >> 1] & 0xffff0000u) : (pbv[c >> 1] << 16)), gt = __uint_as_float((c & 1) ? (gg[c >> 1] & 0xffff0000u) : (gg[c >> 1] << 16));
            const float y = yl + pf * CAR[cg8 * 8 + c] + pb * CAR[64 + cg8 * 8 + c]; o[c] = y * gelu_tanh(gt); }
        u32x4 w; w.x = pk2(o[0], o[1]); w.y = pk2(o[2], o[3]); w.z = pk2(o[4], o[5]); w.w = pk2(o[6], o[7]);
        *(u32x4*)((bf16_t*)(ws + WS_MIX) + row * DM + ch0) = w;
    }
    __syncthreads();
}

DI void s5_pre_item(const float* const* in, unsigned char* ws, char* lds, int item) {
    const int tid = threadIdx.x; const int g = item >> 2, qq = item & 3;
    float* AP = (float*)lds;
    float* BB = AP + 2 * 33 * 64 * 2;
    float* CC = BB + 2 * 64 * 16 * 2;
    float* KT = CC + 2 * 16 * 64 * 2;
    const float* lam_re = in[24]; const float* lam_im = in[25]; const float* lstep = in[26];
    {
        const int p = tid & 63, d = (tid >> 6) & 1, j0 = tid >> 7;
        const float dt = __expf(lstep[d * 32 + g]); const float lr = lam_re[(d * 32 + g) * 64 + p], li = lam_im[(d * 32 + g) * 64 + p];
        for (int j = j0; j < 33; j += 4) { const float mag = __expf((float)j * lr * dt), ang = (float)j * li * dt; const int e = (d * 33 + j) * 64 + p; AP[e * 2] = mag * __cosf(ang); AP[e * 2 + 1] = mag * __sinf(ang); }
    }
    {
        float lr4[4], li4[4], br4[4], bi4[4], cr4[4], ci4[4], dt4[4];
#pragma unroll
        for (int i = 0; i < 4; ++i) { const int e = tid + i * NTHREADS; const int h = e & 15, p = (e >> 4) & 63, d = e >> 10;
            dt4[i] = lstep[d * 32 + g]; lr4[i] = lam_re[(d * 32 + g) * 64 + p]; li4[i] = lam_im[(d * 32 + g) * 64 + p];
            br4[i] = in[27][((size_t)(d * 32 + g) * 64 + p) * 16 + h]; bi4[i] = in[28][((size_t)(d * 32 + g) * 64 + p) * 16 + h];
            const int p2 = e & 63, h2 = (e >> 6) & 15; cr4[i] = in[29][((size_t)(d * 32 + g) * 16 + h2) * 64 + p2]; ci4[i] = in[30][((size_t)(d * 32 + g) * 16 + h2) * 64 + p2]; }
#pragma unroll
        for (int i = 0; i < 4; ++i) { const int e = tid + i * NTHREADS; const float dt = __expf(dt4[i]), lr = lr4[i], li = li4[i];
            const float mag = __expf(lr * dt), ang = li * dt; const float abr = mag * __cosf(ang), abi = mag * __sinf(ang);
            const float den = lr * lr + li * li, nr = abr - 1.f, ni = abi; const float kr = (nr * lr + ni * li) / den, ki = (ni * lr - nr * li) / den;
            BB[e * 2] = kr * br4[i] - ki * bi4[i]; BB[e * 2 + 1] = kr * bi4[i] + ki * br4[i]; CC[e * 2] = cr4[i]; CC[e * 2 + 1] = ci4[i]; }
    }
    __syncthreads();
    for (int task = tid; task < 64 * 16; task += NTHREADS) {
        const int dj = task >> 4, blk = task & 15, d = dj >> 5, j = dj & 31, ho0 = 4 * (blk >> 2), hi0 = 4 * (blk & 3);
        const int jmax = d == 0 ? 8 * qq + 7 : 31 - 8 * qq;
        if (j > jmax) continue;
        float acc4[4][4];
#pragma unroll
        for (int i = 0; i < 4; ++i)
#pragma unroll
            for (int k = 0; k < 4; ++k) acc4[i][k] = 0.f;
        const f32x2_t* ap = (const f32x2_t*)AP + (d * 33 + j) * 64; const f32x2_t* cp = (const f32x2_t*)CC + (d * 16 + ho0) * 64; const f32x4* bp = (const f32x4*)(BB + (size_t)(d * 64) * 16 * 2 + hi0 * 2);
#pragma unroll 2
        for (int p = 0; p < 64; ++p) {
            const f32x2_t av = ap[p]; const f32x4 b01 = bp[p * 8], b23 = bp[p * 8 + 1];
#pragma unroll
            for (int i = 0; i < 4; ++i) { const f32x2_t cv = cp[i * 64 + p]; const float xr = cv.x * av.x - cv.y * av.y, xi = cv.x * av.y + cv.y * av.x;
                acc4[i][0] += xr * b01.x - xi * b01.y; acc4[i][1] += xr * b01.z - xi * b01.w; acc4[i][2] += xr * b23.x - xi * b23.y; acc4[i][3] += xr * b23.z - xi * b23.w; }
        }
#pragma unroll
        for (int i = 0; i < 4; ++i) *(f32x4*)(KT + (d * 32 + j) * 256 + (ho0 + i) * 16 + hi0) = (f32x4){acc4[i][0], acc4[i][1], acc4[i][2], acc4[i][3]};
    }
    __syncthreads();
    bf16_t* Mg = (bf16_t*)(ws + WS_S5MF) + (size_t)g * 512 * 768; bf16_t* Eg = (bf16_t*)(ws + WS_S5E) + (size_t)g * 256 * 512; bf16_t* Fg = Mg + 512;
    const float dval = in[31][g * 16 + (tid & 15)];
    for (int e = tid; e < 128 * 512; e += NTHREADS) { const int k = e & 511, mr = e >> 9, m = qq * 128 + mr; const int t = m >> 4, ho = m & 15, tau = k >> 4, hi = k & 15;
        float v = 0.f; if (tau <= t) v += KT[(0 * 32 + (t - tau)) * 256 + ho * 16 + hi]; if (tau >= t) v += KT[(1 * 32 + (tau - t)) * 256 + ho * 16 + hi];
        if (tau == t && ho == hi) v += dval;
        Mg[(size_t)m * 768 + k] = (bf16_t)f2bf(v); }
    { const int d = qq >> 1, c = qq & 1;
      for (int e = tid; e < 64 * 512; e += NTHREADS) { const int k = e & 511, p = e >> 9, tau = k >> 4, hi = k & 15; const int j = d == 0 ? 31 - tau : tau;
          const float ar = AP[((d * 33 + j) * 64 + p) * 2], ai = AP[((d * 33 + j) * 64 + p) * 2 + 1]; const float br = BB[((d * 64 + p) * 16 + hi) * 2], bi = BB[((d * 64 + p) * 16 + hi) * 2 + 1];
          const float v = c ? (ar * bi + ai * br) : (ar * br - ai * bi);
          Eg[(size_t)(qq * 64 + p) * 512 + k] = (bf16_t)f2bf(v); } }
    for (int e = tid; e < 128 * 256; e += NTHREADS) { const int k = e & 255, mr = e >> 8, m = qq * 128 + mr, t = m >> 4, ho = m & 15; const int d = k >> 7, c = (k >> 6) & 1, p = k & 63;
        const int j = d == 0 ? t + 1 : 32 - t;
        const float ar = AP[((d * 33 + j) * 64 + p) * 2], ai = AP[((d * 33 + j) * 64 + p) * 2 + 1]; const float cr = CC[((d * 16 + ho) * 64 + p) * 2], ci = CC[((d * 16 + ho) * 64 + p) * 2 + 1];
        const float v = c ? -(cr * ai + ci * ar) : (cr * ar - ci * ai);
        Fg[(size_t)m * 768 + k] = (bf16_t)f2bf(v); }
    if (qq == 0) for (int e = tid; e < 2 * 64; e += NTHREADS) { const int p = e & 63, d = e >> 6; float* at = (float*)(ws + WS_S5AT) + ((size_t)(d * 32 + g) * 64 + p) * 2;
        at[0] = AP[((d * 33 + 32) * 64 + p) * 2]; at[1] = AP[((d * 33 + 32) * 64 + p) * 2 + 1]; }
    __syncthreads();
}
DI int s5_chunk_row(int n72) { const int b = n72 / 72, cc = n72 - b * 72; return cc < 8 ? NLAT + b * CTXL + 32 * cc : b * SEQ + 32 * (cc - 8); }
DI void s5_repack_chunk(unsigned char* ws, int n, int lane) {
    const bf16_t* src = (const bf16_t*)(ws + WS_PROJ) + (size_t)s5_chunk_row(n) * OIN + 8 * lane;
    bf16_t* dst = (bf16_t*)(ws + WS_UG) + ((size_t)(lane >> 1) * 768 + n) * 768 + (lane & 1) * 8;
    u32x4 v[8];
#pragma unroll
    for (int t0 = 0; t0 < 32; t0 += 8) {
#pragma unroll
        for (int i = 0; i < 8; ++i) v[i] = *(const u32x4*)(src + (size_t)(t0 + i) * OIN);
#pragma unroll
        for (int i = 0; i < 8; ++i) *(u32x4*)(dst + (t0 + i) * 16) = v[i];
    }
}
struct S5Order {
    int G, c, nb;
    __device__ bool next(int i, pg8::Unit& u) const { const int L = i * G + c; const int per = 3 * nb; if (L >= 32 * per) return false; const int g = L / per, r = L - g * per; u.pm = 3 * g + r / nb; u.pn = nb * g + r % nb; return true; }
    __device__ __forceinline__ void a_ready(const pg8::Unit&) const {}
    __device__ __forceinline__ void done(const pg8::Unit&) const {}
};
struct EpiS5L {
    static constexpr bool PERM = false, AFTER_DRAIN = false;
    float* L;
    __device__ __forceinline__ void operator()(const f32x4 (&acc)[2][2][4][2], const pg8::Unit& u, int wr, int wc, int fr, int fq) const {
        const int g = u.pn, mt = u.pm - 3 * g;
#pragma unroll
        for (int ai = 0; ai < 2; ++ai)
#pragma unroll
            for (int m = 0; m < 4; ++m) { const int n = mt * 256 + ai * 128 + wr * 64 + m * 16 + fr; if (n >= 576) continue;
                float* lp = L + ((size_t)n * 32 + g) * 256 + wc * 32 + 4 * fq;
#pragma unroll
                for (int bj = 0; bj < 2; ++bj)
#pragma unroll
                    for (int nn = 0; nn < 2; ++nn) *(f32x4*)(lp + bj * 128 + nn * 16) = acc[ai][bj][m][nn]; }
    }
};
struct EpiS5Y {
    static constexpr bool PERM = false, AFTER_DRAIN = false;
    bf16_t* Z;
    __device__ __forceinline__ void operator()(const f32x4 (&acc)[2][2][4][2], const pg8::Unit& u, int wr, int wc, int fr, int fq) const {
        const int g = u.pn >> 1, nh = u.pn & 1, mt = u.pm - 3 * g;
#pragma unroll
        for (int ai = 0; ai < 2; ++ai)
#pragma unroll
            for (int m = 0; m < 4; ++m) { const int n = mt * 256 + ai * 128 + wr * 64 + m * 16 + fr; const int b = n / 72, cc = n - b * 72; if (n >= 576 || cc < 8) continue;
                bf16_t* zp = Z + (size_t)(b * SEQ + 32 * (cc - 8)) * 512 + g * 16;
#pragma unroll
                for (int bj = 0; bj < 2; ++bj)
#pragma unroll
                    for (int nn = 0; nn < 2; ++nn) { const int mcol = nh * 256 + bj * 128 + wc * 32 + nn * 16 + 4 * fq, t = mcol >> 4, ho = mcol & 15; const f32x4 y = acc[ai][bj][m][nn];
                        u32x2 w; w.x = pk2(gelu_tanh(y.x), gelu_tanh(y.y)); w.y = pk2(gelu_tanh(y.z), gelu_tanh(y.w)); *(u32x2*)(zp + (size_t)t * 512 + ho) = w; } }
    }
};
DI void s5_scan_thread(unsigned char* ws, int gid) {
    const int p = gid & 63, d = (gid >> 6) & 1, g = (gid >> 7) & 31, b = gid >> 12;
    const float* at = (const float*)(ws + WS_S5AT) + ((size_t)(d * 32 + g) * 64 + p) * 2; const float ar = at[0], ai = at[1];
    const float* L = (const float*)(ws + WS_S5L); bf16_t* UG = (bf16_t*)(ws + WS_UG);
    float sr = 0.f, si = 0.f;
    for (int k0 = 0; k0 < 72; k0 += 8) {
        float lr8[8], li8[8];
#pragma unroll
        for (int i = 0; i < 8; ++i) { const int k = k0 + i; const int cc = d == 0 ? k : (k < 8 ? 7 - k : 71 - (k - 8)); const size_t lo = ((size_t)(b * 72 + cc) * 32 + g) * 256 + d * 128 + p; lr8[i] = L[lo]; li8[i] = L[lo + 64]; }
#pragma unroll
        for (int i = 0; i < 8; ++i) { const int k = k0 + i; const int cc = d == 0 ? k : (k < 8 ? 7 - k : 71 - (k - 8));
            if (cc >= 8) { bf16_t* so = UG + ((size_t)g * 768 + b * 72 + cc) * 768 + 512 + d * 128 + p; so[0] = (bf16_t)f2bf(sr); so[64] = (bf16_t)f2bf(si); }
            const float nr = ar * sr - ai * si + lr8[i], ni = ar * si + ai * sr + li8[i]; sr = nr; si = ni; }
    }
}

DI int up_row_map(int n) { return n < FH ? (n >> 7) * 256 + (n & 127) : ((n - FH) >> 7) * 256 + 128 + ((n - FH) & 127); }
DI void p0_transpose_item(const float* W, int K, int N, bf16_t* WT, bool upmap, float* scr, int item, int lane) {
    const int nblk = N / 32, kb = item / nblk, nb = item % nblk, k0 = 64 * kb, n0 = 32 * nb;
    float tv[32];
#pragma unroll
    for (int i = 0; i < 32; ++i) tv[i] = __builtin_nontemporal_load(W + (size_t)(k0 + 2 * i + (lane >> 5)) * N + n0 + (lane & 31));
#pragma unroll
    for (int i = 0; i < 32; ++i) scr[(2 * i + (lane >> 5)) * 33 + (lane & 31)] = tv[i];
    asm volatile("s_waitcnt lgkmcnt(0)" ::: "memory");
    const int c = lane & 7;
#pragma unroll
    for (int j = 0; j < 4; ++j) { const int n = (lane >> 3) + 8 * j; const float* s = scr + (8 * c) * 33 + n;
        u32x4 o; o.x = pk2(s[0 * 33], s[1 * 33]); o.y = pk2(s[2 * 33], s[3 * 33]); o.z = pk2(s[4 * 33], s[5 * 33]); o.w = pk2(s[6 * 33], s[7 * 33]);
        const int nr = upmap ? up_row_map(n0 + n) : n0 + n;
        *(u32x4*)(WT + (size_t)nr * K + k0 + 8 * c) = o; }
    asm volatile("s_waitcnt lgkmcnt(0)" ::: "memory");
}
DI void norm_row(const float* xrow, const float* g, const float* shift, const float* scale, bf16_t* o1, bf16_t* o2, int lane) {
    f32x4 v[4]; float s = 0.f;
#pragma unroll
    for (int j = 0; j < 4; ++j) { v[j] = *((const f32x4*)xrow + lane + 64 * j); s += (v[j].x * v[j].x + v[j].y * v[j].y) + (v[j].z * v[j].z + v[j].w * v[j].w); }
    const float rstd = rsqrtf(wave_sum(s) * (1.f / DM) + NORM_EPS);
#pragma unroll
    for (int j = 0; j < 4; ++j) {
        const f32x4 gg = *((const f32x4*)g + lane + 64 * j), sh = *((const f32x4*)shift + lane + 64 * j), sc = *((const f32x4*)scale + lane + 64 * j);
        const f32x4 y = (v[j] * rstd) * gg * (sc + 1.0f) + sh;
        u32x2 w; w.x = pk2(y.x, y.y); w.y = pk2(y.z, y.w);
        *((u32x2*)o1 + lane + 64 * j) = w; if (o2) *((u32x2*)o2 + lane + 64 * j) = w;
    }
}
DI bf16_t* norm_xne_ptr(bf16_t* XN, int r, int xne_row) {
    if (xne_row < 0) return nullptr;
    const bool isctx = r >= NLAT; const int t = isctx ? (r - NLAT) & 255 : r & 2047, slen = isctx ? CTXL : SEQ, s = isctx ? (r - NLAT) >> 8 : r >> 11;
    const int k = (t + 2) >> 6, pos = (t + 2) & 63;
    if (pos < 4 && k >= 1 && k <= slen / 64 - 1) { const int q = isctx ? NBND_LAT + s * 3 + (k - 1) : s * 31 + (k - 1); return XN + (size_t)(xne_row + 4 * q + pos) * DM; }
    return nullptr;
}
DI void norm_phase(const float* hL, const float* hC, const float* g, const float* mod, int ish, int isc, bf16_t* XN, int nrows, int xne_row, int gw, int NGW, int lane, const float* cadd = nullptr, float* cwb = nullptr) {
    for (int r0 = gw; r0 < nrows; r0 += 2 * NGW) {
        const int r1 = r0 + NGW; const bool has1 = r1 < nrows; const int r1c = has1 ? r1 : r0;
        const float* x0 = r0 >= NLAT ? hC + (size_t)(r0 - NLAT) * DM : hL + (size_t)r0 * DM;
        const float* x1 = r1c >= NLAT ? hC + (size_t)(r1c - NLAT) * DM : hL + (size_t)r1c * DM;
        f32x4 v0[4], v1[4];
#pragma unroll
        for (int j = 0; j < 4; ++j) { v0[j] = *((const f32x4*)x0 + lane + 64 * j); v1[j] = *((const f32x4*)x1 + lane + 64 * j); }
        if (cadd) {
#pragma unroll
            for (int j = 0; j < 4; ++j) {
                if (r0 >= NLAT) { v0[j] += *((const f32x4*)(cadd + (size_t)(r0 - NLAT) * DM) + lane + 64 * j); if (cwb) *((f32x4*)(cwb + (size_t)(r0 - NLAT) * DM) + lane + 64 * j) = v0[j]; }
                if (has1 && r1 >= NLAT) { v1[j] += *((const f32x4*)(cadd + (size_t)(r1 - NLAT) * DM) + lane + 64 * j); if (cwb) *((f32x4*)(cwb + (size_t)(r1 - NLAT) * DM) + lane + 64 * j) = v1[j]; } } }
        const int bb0 = r0 >= NLAT ? 8 : r0 >> 11, bb1 = r1c >= NLAT ? 8 : r1c >> 11;
        const float* sh0 = mod + (size_t)bb0 * 6144 + ish * 1024; const float* sc0 = mod + (size_t)bb0 * 6144 + isc * 1024;
        const float* sh1 = mod + (size_t)bb1 * 6144 + ish * 1024; const float* sc1 = mod + (size_t)bb1 * 6144 + isc * 1024;
        float s0 = 0.f, s1 = 0.f;
#pragma unroll
        for (int j = 0; j < 4; ++j) { s0 += (v0[j].x * v0[j].x + v0[j].y * v0[j].y) + (v0[j].z * v0[j].z + v0[j].w * v0[j].w); s1 += (v1[j].x * v1[j].x + v1[j].y * v1[j].y) + (v1[j].z * v1[j].z + v1[j].w * v1[j].w); }
#pragma unroll
        for (int o = 1; o < 64; o <<= 1) { s0 += __shfl_xor(s0, o); s1 += __shfl_xor(s1, o); }
        const float rs0 = rsqrtf(s0 * (1.f / DM) + NORM_EPS), rs1 = rsqrtf(s1 * (1.f / DM) + NORM_EPS);
        bf16_t* o0 = XN + (size_t)r0 * DM; bf16_t* o1 = XN + (size_t)r1c * DM; bf16_t* e0 = norm_xne_ptr(XN, r0, xne_row); bf16_t* e1 = norm_xne_ptr(XN, r1c, xne_row);
#pragma unroll
        for (int j = 0; j < 4; ++j) {
            const f32x4 gg = *((const f32x4*)g + lane + 64 * j);
            const f32x4 y0 = (v0[j] * rs0) * gg * (*((const f32x4*)sc0 + lane + 64 * j) + 1.0f) + *((const f32x4*)sh0 + lane + 64 * j);
            const f32x4 y1 = (v1[j] * rs1) * gg * (*((const f32x4*)sc1 + lane + 64 * j) + 1.0f) + *((const f32x4*)sh1 + lane + 64 * j);
            u32x2 w0, w1; w0.x = pk2(y0.x, y0.y); w0.y = pk2(y0.z, y0.w); w1.x = pk2(y1.x, y1.y); w1.y = pk2(y1.z, y1.w);
            *((u32x2*)o0 + lane + 64 * j) = w0; if (e0) *((u32x2*)e0 + lane + 64 * j) = w0;
            if (has1) { *((u32x2*)o1 + lane + 64 * j) = w1; if (e1) *((u32x2*)e1 + lane + 64 * j) = w1; }
        }
    }
}
DI void qknorm_phase(bf16_t* PROJ, int ld, int qoff, const float* qn, const float* kn, const float* rope, int gw, int NGW, int lane) {
    const int d0 = 2 * (lane & 31), hsel = lane >> 5;
    const f32x2_t gq = *(const f32x2_t*)(qn + d0), gk = *(const f32x2_t*)(kn + d0);
    const int ridx = (d0 >> 5) * 16 + (d0 & 15); const bool second = (d0 >> 4) & 1;
    for (int r = gw; r < MALL; r += NGW) {
        unsigned* p = (unsigned*)(PROJ + (size_t)r * ld + qoff) + lane;
        const bool lat = r < NLAT; f32x2_t cs = {1.f, 1.f}, sn = {0.f, 0.f};
        if (lat) { const int t = r & 2047; cs = *(const f32x2_t*)(rope + t * 32 + ridx); sn = *(const f32x2_t*)(rope + SEQ * 32 + t * 32 + ridx); }
        unsigned raw[5];
#pragma unroll
        for (int i = 0; i < 5; ++i) raw[i] = p[64 * i];
#pragma unroll
        for (int i = 0; i < 5; ++i) {
            const float a = __uint_as_float(raw[i] << 16), b = __uint_as_float(raw[i] & 0xffff0000u);
            float ss = a * a + b * b;
#pragma unroll
            for (int o = 1; o < 32; o <<= 1) ss += __shfl_xor(ss, o);
            const float rs = rsqrtf(ss * (1.f / 64.f) + NORM_EPS); const bool isq = (2 * i + hsel) < 8;
            float ya = a * rs * (isq ? gq.x : gk.x), yb = b * rs * (isq ? gq.y : gk.y);
            const float pa = __shfl_xor(ya, 8), pb = __shfl_xor(yb, 8);
            if (lat) { ya = second ? (ya * cs.x + pa * sn.x) : (ya * cs.x - pa * sn.x); yb = second ? (yb * cs.y + pb * sn.y) : (yb * cs.y - pb * sn.y); }
            if (isq) { ya *= C2; yb *= C2; }
            p[64 * i] = pk2(ya, yb);
        }
    }
}

struct Args { const float* in[37]; float* out; unsigned char* ws; int ph_lo, ph_hi; };
constexpr int NPHASE = 19;

DI void p0_transposes(const Args& a, char* lds, int layer, int w0, int nw) {
    const int lane = threadIdx.x & 63, wid = threadIdx.x >> 6; unsigned char* ws = a.ws;
    float* scr = (float*)(lds + wid * 16384);
    constexpr int I_IN0 = 16 * (EIN / 32), I_OUT = 16 * 32, I_UP = 16 * (FH2 / 32), I_DN = (FH / 64) * 32, I_IN1 = 16 * (OIN / 32), I_GLU = 8 * 16;
    if (layer == 0) {
        constexpr int NIT = I_UP + I_DN + I_IN0 + I_OUT;
        for (int it = w0; it < NIT; it += nw) { int r = it;
            if (r < I_UP) { p0_transpose_item(a.in[7], DM, FH2, (bf16_t*)(ws + WS_WUP0), true, scr, r, lane); continue; } r -= I_UP;
            if (r < I_DN) { p0_transpose_item(a.in[10], FH, DM, (bf16_t*)(ws + WS_WDN0), false, scr, r, lane); continue; } r -= I_DN;
            if (r < I_IN0) { p0_transpose_item(a.in[11], DM, EIN, (bf16_t*)(ws + WS_WIN0), false, scr, r, lane); continue; } r -= I_IN0;
            p0_transpose_item(a.in[12], DM, DM, (bf16_t*)(ws + WS_WOUT0), false, scr, r, lane); }
    } else {
        constexpr int NIT = I_UP + I_DN + I_IN1 + I_OUT + I_GLU;
        for (int it = w0; it < NIT; it += nw) { int r = it;
            if (r < I_UP) { p0_transpose_item(a.in[7] + (size_t)DM * FH2, DM, FH2, (bf16_t*)(ws + WS_WUP1), true, scr, r, lane); continue; } r -= I_UP;
            if (r < I_DN) { p0_transpose_item(a.in[10] + (size_t)FH * DM, FH, DM, (bf16_t*)(ws + WS_WDN1), false, scr, r, lane); continue; } r -= I_DN;
            if (r < I_IN1) { p0_transpose_item(a.in[22], DM, OIN, (bf16_t*)(ws + WS_WIN1), false, scr, r, lane); continue; } r -= I_IN1;
            if (r < I_OUT) { p0_transpose_item(a.in[23], DM, DM, (bf16_t*)(ws + WS_WOUT1), false, scr, r, lane); continue; } r -= I_OUT;
            p0_transpose_item(a.in[32], 512, 512, (bf16_t*)(ws + WS_WGLU), false, scr, r, lane); }
    }
}

DI void p0_prologue(const Args& a, char* lds, int G, int rep) {
#ifdef P0_REP_EMPTY
    if (rep == 1) return;
#endif
    const int tid = threadIdx.x, lane = tid & 63, wid = tid >> 6;
    unsigned char* ws = a.ws;
    const int gw = blockIdx.x * NWAVES + wid, NGW = G * NWAVES;
    {
        const int gt = blockIdx.x * NTHREADS + tid, NGT = G * NTHREADS;
        float* rope = (float*)(ws + WS_ROPE);
        for (int e = gt; e < SEQ * 32; e += NGT) { const int t = e >> 5, idx = e & 31, i = idx & 15; const float pos = (float)((idx < 16) ? (t >> 6) : (t & 63));
            const float invf = powf(10000.0f, -(float)i / 16.0f); const float ang = pos * invf; rope[e] = cosf(ang); rope[SEQ * 32 + e] = sinf(ang); }
        bf16_t* rgw = (bf16_t*)(ws + WS_RGW);
        for (int e = gt; e < 4 * 8 * 4096; e += NGT) { const int k = e & 63, n = (e >> 6) & 63, hd = (e >> 12) & 7, mi = e >> 15; const int d = mi >> 1;
            const float* w = (mi & 1) ? a.in[17] : a.in[15]; rgw[e] = (bf16_t)f2bf(w[((size_t)(d * 8 + hd) * 64 + k) * 64 + n]); }
    }
    __syncthreads();
    {
        float* cond = (float*)lds;
        float* red = (float*)(lds + 1024 * 12 * 4);
        if (blockIdx.x < 2 * 96) for (int e = tid; e < 9 * 1024; e += NTHREADS) { const int k = e & 1023, bb = e >> 10; const float cv = bb < 8 ? a.in[1][bb * 1024 + k] : a.in[3][k]; cond[k * 12 + bb] = siluf_(cv); }
        __syncthreads();
        float* MOD = (float*)(ws + WS_MOD);
        for (int it = blockIdx.x; it < 2 * 96; it += G) {
            const int layer = it / 96, cb = it % 96, col = cb * 64 + lane;
            const float* w = a.in[4] + (size_t)layer * DM * 6144 + col;
            float acc[9];
#pragma unroll
            for (int bb = 0; bb < 9; ++bb) acc[bb] = 0.f;
            for (int kk0 = 0; kk0 < 128; kk0 += 16) {
                float wv16[16];
#pragma unroll
                for (int i = 0; i < 16; ++i) wv16[i] = __builtin_nontemporal_load(w + (size_t)(wid * 128 + kk0 + i) * 6144);
#pragma unroll
                for (int i = 0; i < 16; ++i) { const int k = wid * 128 + kk0 + i; const float wv = wv16[i];
                    const f32x4 c0 = *(const f32x4*)(cond + k * 12), c1 = *(const f32x4*)(cond + k * 12 + 4); const float c8 = cond[k * 12 + 8];
                    acc[0] += c0.x * wv; acc[1] += c0.y * wv; acc[2] += c0.z * wv; acc[3] += c0.w * wv; acc[4] += c1.x * wv; acc[5] += c1.y * wv; acc[6] += c1.z * wv; acc[7] += c1.w * wv; acc[8] += c8 * wv; }
            }
#pragma unroll
            for (int bb = 0; bb < 9; ++bb) red[(wid * 9 + bb) * 64 + lane] = acc[bb];
            __syncthreads();
            for (int e = tid; e < 9 * 64; e += NTHREADS) { const int bb = e >> 6, ln = e & 63; float s = a.in[5][layer * 6144 + cb * 64 + ln];
#pragma unroll
                for (int w8 = 0; w8 < 8; ++w8) s += red[(w8 * 9 + bb) * 64 + ln];
                MOD[((size_t)layer * 9 + bb) * 6144 + cb * 64 + ln] = s; }
            __syncthreads();
        }
    }
    __syncthreads();
    p0_transposes(a, lds, 0, gw, NGW);
}

__global__ void __launch_bounds__(NTHREADS, 2) trunk_fwd(Args a) {
    extern __shared__ __attribute__((aligned(16))) unsigned char lds_raw[];
    char* lds = (char*)lds_raw;
    PG8_LAS unsigned char* ldsl = (PG8_LAS unsigned char*)lds_raw;
    cg::grid_group grid = cg::this_grid();
    const int tid = threadIdx.x, lane = tid & 63, wid = tid >> 6, G = gridDim.x;
    const int gw = blockIdx.x * NWAVES + wid, NGW = G * NWAVES;
    unsigned char* ws = a.ws;
    const int lo = a.ph_lo, hi = a.ph_hi;
    float* MOD = (float*)(ws + WS_MOD); float* HC = (float*)(ws + WS_HC);
    bf16_t* XN = (bf16_t*)(ws + WS_XN); bf16_t* PROJ = (bf16_t*)(ws + WS_PROJ); bf16_t* MIX = (bf16_t*)(ws + WS_MIX); bf16_t* HID = (bf16_t*)(ws + WS_HID);
    const float* rope = (const float*)(ws + WS_ROPE);
    float* CP = (float*)(ws + WS_Z);
    volatile LAS unsigned* MISC = (volatile LAS unsigned*)((LAS unsigned char*)lds_raw + LDS_MISC);
    if (tid < 64) MISC[tid] = 0u;
    __syncthreads();
    XcdBarrier xbar; xbar.bar = (unsigned*)(ws + WS_CTL) + 4096; xbar.x = 0; xbar.st = nullptr;
    if (hi - lo > 1) xbar = xcd_barrier_post((unsigned*)(ws + WS_CTL) + 4096, MISC + 8);
#ifndef PHASE_MASK
#define PHASE_MASK 0x7ffff
#endif
#define IN(k) (((PHASE_MASK >> (k)) & 1) && lo <= (k) && (k) < hi)
#ifndef DUP_MASK
#define DUP_MASK 0
#endif
#define REP(k) for (int rep_ = 0; rep_ < (((DUP_MASK >> (k)) & 1) ? 2 : 1); ++rep_, (void)((((DUP_MASK >> (k)) & 1) && rep_ == 1) ? (xcd_barrier(xbar), 0) : 0))
#ifdef TIME_MASK
    unsigned long long tprev_ = __builtin_amdgcn_s_memrealtime(), tsum_ = 0ull;
#define TSTAMP(k) do { const unsigned long long tn_ = __builtin_amdgcn_s_memrealtime(); if (((TIME_MASK) >> (k)) & 1) tsum_ += tn_ - tprev_; tprev_ = tn_; } while (0)
#else
#define TSTAMP(k) do {} while (0)
#endif
#define SEAM(k) do { if (IN(k) && IN((k) + 1)) { xcd_barrier(xbar); TSTAMP(k); } } while (0)

    if (hi > 1000) grid.sync();
    if (IN(0)) REP(0) { p0_prologue(a, lds, G, rep_); } SEAM(0);
    if (IN(1)) REP(1) norm_phase(a.in[0], a.in[2], a.in[6], MOD, 0, 1, XN, MALL, -1, gw, NGW, lane);
    SEAM(1);
    if (IN(2)) REP(2) { pg8::Gemm g{XN, (const bf16_t*)(ws + WS_WIN0), MALL, EIN, DM}; pg8::StaticOrder S; S.init(MALL, EIN, G, (int)blockIdx.x);
        pg8::EpiBf16<0> E{PROJ, EIN, nullptr, 0, 0, 1.f}; pg8::gemm_phase<pg8::EpiBf16<0>, pg8::StaticOrder, true, true>(ldsl, g, S, E); }
    SEAM(2);
    if (IN(3)) { qknorm_phase(PROJ, EIN, 1024, a.in[20], a.in[21], rope, gw, NGW, lane); __syncthreads();
#ifdef DUP_RG1
        for (int rep2_ = 0; rep2_ < 2; ++rep2_)
#endif
        for (int it = blockIdx.x; it < NB * 8 * 36; it += G) rg_item1(a.in, ws, lds, it); }
    SEAM(3);
    if (IN(4)) REP(4) {
#ifndef P4_NO_ATTN
#ifdef DUP_ATT
        for (int rep2_ = 0; rep2_ < 2; ++rep2_)
#endif
        for (int it = blockIdx.x; it < 256; it += G) { const int qb = it & 3, head = (it >> 2) & 7, b = it >> 5; attn_unit<0, 2>(PROJ, EIN, 1024, 1536, 1664, MIX, lds, b, head, qb * 512, 0.f); }
        for (int it = blockIdx.x; it < 64; it += G) { const int head = it & 7, b = it >> 3; attn_unit<1, 1>(PROJ, EIN, 1024, 1536, 1664, MIX, lds, b, head, 0, 0.f); }
#endif
#ifndef P4_NO_RG
        for (int it = (blockIdx.x + G - 64) % G; it < NB * 8 * 36; it += G) rg_item2(a.in, ws, lds, it);
#endif
    }
    SEAM(4);
    if (IN(5)) REP(5) { { pg8::Gemm g{MIX, (const bf16_t*)(ws + WS_WOUT0), NLAT, DM, DM}; pg8::StaticOrder S; S.init(NLAT, DM, G, (int)blockIdx.x);
          EpiRes E{a.in[0], a.in[2], a.out, HC, MOD + 2 * 1024}; pg8::gemm_phase<EpiRes, pg8::StaticOrder, true, true>(ldsl, g, S, E); }
#pragma unroll 1
        for (int kh = 0; kh < 2; ++kh) {
          pg8::Gemm g{MIX + kh * 512, (const bf16_t*)(ws + WS_WOUT0) + kh * 512, MALL, DM, 512, DM, DM}; CtxOrder S{(int)blockIdx.x - 64 * kh};
          EpiCtxHalf E{a.in[2], HC, CP, MOD + 2 * 1024, kh}; pg8::gemm_phase<EpiCtxHalf, CtxOrder, true, true>(ldsl, g, S, E); } }
    SEAM(5);
    if (IN(6)) REP(6) norm_phase(a.out, HC, a.in[6] + DM, MOD, 3, 4, XN, MALL, XNE_ROW_L0, gw, NGW, lane, CP, HC);
    SEAM(6);
    if (IN(7)) REP(7) { constexpr int MT = MALL + 1280; pg8::Gemm g{XN, (const bf16_t*)(ws + WS_WUP0), MT, FH2, DM}; pg8::StaticOrder S; S.init(MT, FH2, G, (int)blockIdx.x);
        EpiConvAct E{HID, a.in[8], a.in[9], MALL / 256, NBND_LAT, NBND_LAT + NBND_CTX, lds + 131072}; pg8::gemm_phase<EpiConvAct, pg8::StaticOrder, true, true>(ldsl, g, S, E); }
    if (IN(7)) { constexpr int NU = ((MALL + 1280) / 256) * (FH2 / 256), NFULL = NU % 256;
        if (G == 256 && (int)blockIdx.x >= NFULL) p0_transposes(a, lds, 1, ((int)blockIdx.x - NFULL) * NWAVES + wid, (256 - NFULL) * NWAVES);
        else if (G != 256) p0_transposes(a, lds, 1, gw, NGW); }
    SEAM(7);
    if (IN(8)) { { pg8::Gemm g{HID, (const bf16_t*)(ws + WS_WDN0), NLAT, DM, FH}; pg8::StaticOrder S; S.init(NLAT, DM, G, (int)blockIdx.x);
          EpiRes E{a.out, HC, a.out, HC, MOD + 5 * 1024}; pg8::gemm_phase<EpiRes, pg8::StaticOrder, true, true>(ldsl, g, S, E); }
#pragma unroll 1
        for (int kh = 0; kh < 2; ++kh) {
          pg8::Gemm g{HID + kh * (FH / 2), (const bf16_t*)(ws + WS_WDN0) + kh * (FH / 2), MALL, DM, FH / 2, FH, FH}; CtxOrder S{(int)blockIdx.x - 64 * kh};
          EpiCtxHalf E{HC, HC, CP, MOD + 5 * 1024, kh}; pg8::gemm_phase<EpiCtxHalf, CtxOrder, true, true>(ldsl, g, S, E); } }
    if (IN(8)) { const int bx = blockIdx.x; const bool busy = (bx < 32) || (bx >= 64 && bx < 96);
        if (G == 256) { if (!busy) { const int idx = bx < 64 ? bx - 32 : bx - 64; for (int it = idx; it < 128; it += 192) s5_pre_item(a.in, ws, lds, it); } }
        else for (int it = bx; it < 128; it += G) s5_pre_item(a.in, ws, lds, it); }
    SEAM(8);
    const float* MOD1 = MOD + 9 * 6144;
    if (IN(9)) REP(9) norm_phase(a.out, HC, a.in[6] + 2 * DM, MOD1, 0, 1, XN, MALL, -1, gw, NGW, lane, CP, nullptr);
    SEAM(9);
    if (IN(10)) REP(10) { pg8::Gemm g{XN, (const bf16_t*)(ws + WS_WIN1), MALL, OIN, DM}; pg8::StaticOrder S; S.init(MALL, OIN, G, (int)blockIdx.x);
        pg8::EpiBf16<0> E{PROJ, OIN, nullptr, 0, 0, 1.f}; pg8::gemm_phase<pg8::EpiBf16<0>, pg8::StaticOrder, true, true>(ldsl, g, S, E); }
    SEAM(10);
    if (IN(11)) { qknorm_phase(PROJ, OIN, 512, a.in[34], a.in[35], rope, gw, NGW, lane);
        for (int n = gw; n < 576; n += NGW) s5_repack_chunk(ws, n, lane);
        xcd_barrier(xbar);
        pg8::Gemm g{(const bf16_t*)(ws + WS_UG), (const bf16_t*)(ws + WS_S5E), 32 * 768, 32 * 256, 512, 768, 512}; S5Order S{G, (int)blockIdx.x, 1};
        EpiS5L E{(float*)(ws + WS_S5L)}; pg8::gemm_phase<EpiS5L, S5Order, true, true>(ldsl, g, S, E); }
    SEAM(11);
    if (IN(12)) REP(12) {
        { const int gt = blockIdx.x * NTHREADS + tid; if (gt < NB * 32 * 2 * 64) s5_scan_thread(ws, gt); }
        __syncthreads();
        const int nskip = (NB * 32 * 2 * 64) / NTHREADS;
        for (int it = (blockIdx.x + G - nskip) % G; it < 512; it += G) { const int qb = it & 7, head = (it >> 3) & 7, b = it >> 6;
            attn_unit<2, 1>(PROJ, OIN, 512, 1024, 1152, MIX, lds, b, head, qb * 256, a.in[36][head] * 1.4426950408889634f); }
    }
    SEAM(12);
    if (IN(13)) REP(13) { pg8::Gemm g{(const bf16_t*)(ws + WS_UG), (const bf16_t*)(ws + WS_S5MF), 32 * 768, 32 * 512, 768, 768, 768}; S5Order S{G, (int)blockIdx.x, 2};
        EpiS5Y E{(bf16_t*)(ws + WS_Z)}; pg8::gemm_phase<EpiS5Y, S5Order, true, true>(ldsl, g, S, E); }
    SEAM(13);
    if (IN(14)) REP(14) { pg8::Gemm g{(const bf16_t*)(ws + WS_Z), (const bf16_t*)(ws + WS_WGLU), NLAT, 512, 512}; pg8::StaticOrder S; S.init(NLAT, 512, G, (int)blockIdx.x);
        EpiGlu E{(const bf16_t*)(ws + WS_Z), MIX, a.in[33]}; pg8::gemm_phase<EpiGlu, pg8::StaticOrder, true, true>(ldsl, g, S, E); }
    SEAM(14);
    if (IN(15)) { pg8::Gemm g{MIX, (const bf16_t*)(ws + WS_WOUT1), NLAT, DM, DM}; pg8::StaticOrder S; S.init(NLAT, DM, G, (int)blockIdx.x);
        EpiRes E{a.out, HC, a.out, HC, MOD1 + 2 * 1024}; pg8::gemm_phase<EpiRes, pg8::StaticOrder, true, true>(ldsl, g, S, E); }
    SEAM(15);
    if (IN(16)) REP(16) norm_phase(a.out, HC, a.in[6] + 3 * DM, MOD1, 3, 4, XN, NLAT, XNE_ROW_L1, gw, NGW, lane);
    SEAM(16);
    if (IN(17)) REP(17) { constexpr int MT = NLAT + 1024; pg8::Gemm g{XN, (const bf16_t*)(ws + WS_WUP1), MT, FH2, DM}; pg8::StaticOrder S; S.init(MT, FH2, G, (int)blockIdx.x);
        EpiConvAct E{HID, a.in[8] + 3 * FH2, a.in[9] + FH2, NLAT / 256, NBND_LAT, NBND_LAT, lds + 131072}; pg8::gemm_phase<EpiConvAct, pg8::StaticOrder, true, true>(ldsl, g, S, E); }
    SEAM(17);
    if (IN(18)) { pg8::Gemm g{HID, (const bf16_t*)(ws + WS_WDN1), NLAT, DM, FH}; pg8::StaticOrder S; S.init(NLAT, DM, G, (int)blockIdx.x);
        EpiRes E{a.out, HC, a.out, HC, MOD1 + 5 * 1024}; pg8::gemm_phase<EpiRes, pg8::StaticOrder, true, true>(ldsl, g, S, E); }
#ifdef TIME_MASK
    xcd_barrier(xbar); TSTAMP(18);
    if (blockIdx.x == 0 && tid == 0) a.out[0] = 1e4f * ((float)tsum_ * 0.01f);
#endif
#undef IN
#undef SEAM
}

#ifndef N_LAUNCH_MODE
#define N_LAUNCH_MODE 1
#endif
extern "C" void kernel_launch(void* const* d_in, const int* in_sizes, int n_in, void* d_out, int out_size, void* d_ws, size_t ws_size, hipStream_t stream) {
    static int grid = 0;
    if (grid == 0) {
        if (n_in != 37 || out_size != NLAT * DM || ws_size < WS_END) { fprintf(stderr, "kernel_launch: unexpected problem (n_in %d out %d ws %zu)\n", n_in, out_size, ws_size); grid = -1; return; }
        int dev = 0, cus = 0, per_cu = 0;
        hipGetDevice(&dev); hipDeviceGetAttribute(&cus, hipDeviceAttributeMultiprocessorCount, dev);
        if (hipFuncSetAttribute((const void*)trunk_fwd, hipFuncAttributeMaxDynamicSharedMemorySize, LDS_BYTES) != hipSuccess) { fprintf(stderr, "kernel_launch: hipFuncSetAttribute failed\n"); grid = -1; return; }
        if (hipOccupancyMaxActiveBlocksPerMultiprocessor(&per_cu, (const void*)trunk_fwd, NTHREADS, LDS_BYTES) != hipSuccess || per_cu < 1) { fprintf(stderr, "kernel_launch: occupancy query says %d\n", per_cu); per_cu = 1; }
        (void)hipGetLastError();
        grid = cus;
        fprintf(stderr, "kernel_launch: grid %d (cus %d, per_cu %d)\n", grid, cus, per_cu);
    }
    if (grid < 0) return;
    (void)hipMemsetAsync((char*)d_ws + WS_CTL, 0, CTL_ZERO_BYTES, stream);
    Args a{};
    for (int i = 0; i < 37; ++i) a.in[i] = (const float*)d_in[i];
    a.out = (float*)d_out; a.ws = (unsigned char*)d_ws;
#if N_LAUNCH_MODE == 1
    a.ph_lo = 0; a.ph_hi = NPHASE;
    void* args[] = {&a};
    hipError_t e = hipLaunchCooperativeKernel((const void*)trunk_fwd, dim3(grid), dim3(NTHREADS), args, LDS_BYTES, stream);
    if (e != hipSuccess) fprintf(stderr, "cooperative launch failed: %s (grid %d)\n", hipGetErrorString(e), grid);
#else
    for (int p = 0; p < NPHASE; ++p) { a.ph_lo = p; a.ph_hi = p + 1; hipLaunchKernelGGL(trunk_fwd, dim3(grid), dim3(NTHREADS), LDS_BYTES, stream, a);
#ifdef DBG_CHECK
        Args d = a; d.ph_lo = 0; d.ph_hi = 0;
        static const int chk[NPHASE][2] = {{1,0},{0,0},{2,0},{3,0},{4,5},{6,0},{0,0},{7,8},{0,0},{0,0},{9,0},{10,0},{11,0},{12,0},{15,0},{0,0},{0,0},{14,0},{0,0}};
        for (int q = 0; q < 2; ++q) { const int st = chk[p][q]; if (!st) continue; const bool heavy = (st == 5 || st == 12); hipLaunchKernelGGL(dbg_check, dim3(heavy ? 1 : 4), dim3(heavy ? 64 : 256), 0, stream, d, st); }
        if (p == NPHASE - 1) hipLaunchKernelGGL(dbg_report, dim3(1), dim3(64), 0, stream, d);
#endif
    }
#endif
}
```

```cpp
#include <hip/hip_runtime.h>
#include <hip/hip_cooperative_groups.h>
#include <hip/hip_bf16.h>
#include <cstdio>
#include <cstdint>
#include <cmath>
namespace cg = cooperative_groups;
namespace pg8 {
#define PG8_LAS __attribute__((address_space(3)))
typedef unsigned short bf16_t;
typedef short bf16x8 __attribute__((ext_vector_type(8)));
typedef float f32x4 __attribute__((ext_vector_type(4)));
typedef unsigned u32x4 __attribute__((ext_vector_type(4)));
constexpr int BM = 256, BK = 64, HALF = 128, HTB = HALF * BK * 2  , STAGE_BYTES = 8 * HTB, NXCD = 8, WGM = 8;

__host__ __device__ __forceinline__ int lds_byte(int r, int c) { const int st = (r >> 4) * 2 + (c >> 5), rr = r & 15, cc = c & 31, ob = rr * 64 + cc * 2; return st * 1024 + (ob ^ (((ob >> 9) & 1) << 5)); }
__host__ __device__ __forceinline__ void stage_rc(int b, int& R, int& C) { const int st = b / 1024, sb = b % 1024, swz = sb ^ (((sb >> 9) & 1) << 5); R = (st >> 1) * 16 + swz / 64; C = (st & 1) * 32 + (swz % 64) / 2; }
__host__ __device__ __forceinline__ int perm32(int rho) { const int n = rho >> 4, i = rho & 15; return 8 * (i >> 2) + 4 * n + (i & 3); }

struct Unit { int pm, pn; };
struct Gemm { const bf16_t* A; const bf16_t* Bt; int M, N, K; int lda, ldb; };

struct StaticOrder {
    int nM, nN, nwg, G, c;
    __host__ __device__ void init(int M, int N, int G_, int c_) { nM = M / BM; nN = N / BM; nwg = nM * nN; G = G_; c = c_; }
    __host__ __device__ bool next(int i, Unit& u) const {
        const long L = (long)i * G + c; if (L >= nwg) return false;
        int wgid = (int)L; { const int q = nwg / NXCD, r = nwg % NXCD, xcd = wgid % NXCD, off = wgid / NXCD; wgid = (xcd < r ? xcd * (q + 1) : r * (q + 1) + (xcd - r) * q) + off; }
        const int nig = WGM * nN, gid = wgid / nig, fm = gid * WGM, gsz = (nM - fm) < WGM ? (nM - fm) : WGM;
        u.pm = fm + ((wgid % nig) % gsz); u.pn = (wgid % nig) / gsz; return true;
    }
    __device__ __forceinline__ void a_ready(const Unit&) const {}
    __device__ __forceinline__ void done(const Unit&) const {}
};

__device__ __forceinline__ unsigned cvt_pk_bf16(float lo, float hi) { unsigned r; asm volatile("v_cvt_pk_bf16_f32 %0, %1, %2" : "=v"(r) : "v"(lo), "v"(hi)); return r; }
typedef float f32x2 __attribute__((ext_vector_type(2)));
__device__ __forceinline__ f32x2 gelu_pk(f32x2 v) {
    const f32x2 av = __builtin_elementwise_abs(v), d = av * 0.2316418882f + 1.0f;
    f32x2 t; t.x = __builtin_amdgcn_rcpf(d.x); t.y = __builtin_amdgcn_rcpf(d.y);
    f32x2 q = t * 0.5307027145f + (-0.7265760135f); q = q * t + 0.7107068705f; q = q * t + (-0.142248368f); q = q * t + 0.127414796f; q = q * t;
    const f32x2 s = (v * v) * (-0.72134752044f);
    f32x2 e; e.x = __builtin_amdgcn_exp2f(s.x); e.y = __builtin_amdgcn_exp2f(s.y);
    const f32x2 m = v * (q * e), r = v - m;
    f32x2 o; o.x = v.x < 0.f ? m.x : r.x; o.y = v.y < 0.f ? m.y : r.y; return o;
}
template <int ACT  > struct EpiBf16 {
    static constexpr bool PERM = true, AFTER_DRAIN = false; static_assert(ACT == 0 || ACT == 1, "EpiBf16: ACT is 0 (none) or 1 (gelu_pk)");
    bf16_t* O; int ldc; const float* bias; int split_cols; size_t split_stride; float scale0;
    __device__ __forceinline__ void operator()(const f32x4 (&acc)[2][2][4][2], const Unit& u, int wr, int wc, int fr, int fq) const {
        const int row0 = u.pm * BM + wr * 64 + fr; int colt = u.pn * BM; bf16_t* base = O;
        float sc = 1.f; if (split_cols) { const int t = colt / split_cols; base += (size_t)t * split_stride; colt -= t * split_cols; if (t == 0) sc = scale0; }
        const int col0 = colt + wc * 32 + 8 * fq, bcol0 = u.pn * BM + wc * 32 + 8 * fq;
        f32x4 bv[2][2];
#pragma unroll
        for (int bj = 0; bj < 2; ++bj)
#pragma unroll
            for (int n = 0; n < 2; ++n) bv[bj][n] = bias ? *(const f32x4*)(bias + bcol0 + bj * HALF + 4 * n) : (f32x4){0.f, 0.f, 0.f, 0.f};
#pragma unroll
        for (int ai = 0; ai < 2; ++ai)
#pragma unroll
            for (int m = 0; m < 4; ++m) { bf16_t* rowp = base + (size_t)(row0 + ai * HALF + m * 16) * ldc + col0;
#pragma unroll
                for (int bj = 0; bj < 2; ++bj) { f32x4 v0 = acc[ai][bj][m][0] + bv[bj][0], v1 = acc[ai][bj][m][1] + bv[bj][1];
                    if (ACT == 1) { f32x2 a = gelu_pk((f32x2){v0[0], v0[1]}), b = gelu_pk((f32x2){v0[2], v0[3]}), c = gelu_pk((f32x2){v1[0], v1[1]}), d = gelu_pk((f32x2){v1[2], v1[3]});
                        v0 = (f32x4){a.x, a.y, b.x, b.y}; v1 = (f32x4){c.x, c.y, d.x, d.y}; }
                    v0 = v0 * sc; v1 = v1 * sc; u32x4 w; w.x = cvt_pk_bf16(v0[0], v0[1]); w.y = cvt_pk_bf16(v0[2], v0[3]); w.z = cvt_pk_bf16(v1[0], v1[1]); w.w = cvt_pk_bf16(v1[2], v1[3]);
                    *(u32x4*)(rowp + bj * HALF) = w; } }
    }
};
template <class Epi, class Sched, bool ALIGN_EPI = false, bool SP2 = false>
__device__ __forceinline__ void gemm_phase(PG8_LAS unsigned char* lds, const Gemm g, const Sched& S, const Epi& E) {
    const int tid = threadIdx.x, wid = __builtin_amdgcn_readfirstlane(tid >> 6), lane = tid & 63, wr = wid >> 2, wc = wid & 3, fr = lane & 15, fq = lane >> 4;
    const int K = g.K, nt = K / BK; const int lda = g.lda ? g.lda : K, ldb = g.ldb ? g.ldb : K;
    unsigned voffA[2], voffB[2];
#pragma unroll
    for (int i = 0; i < 2; ++i) { int R, C; stage_rc(tid * 16 + i * 8192, R, C); const int Rb = Epi::PERM ? ((R & ~31) + perm32(R & 31)) : R;
        voffA[i] = (unsigned)(R * lda + C) * 2u; voffB[i] = (unsigned)(Rb * ldb + C) * 2u; }
    const size_t kstep = (size_t)(BK * 2);
    const size_t hsA = (size_t)HALF * lda * 2, hsB = (size_t)HALF * ldb * 2;
    const size_t tsA = 2 * hsA, tsB = 2 * hsB;
    const unsigned ldsw = (unsigned)wid * 1024u;
    const int aoff = lds_byte(wr * 64 + fr, fq * 8), boff = lds_byte(wc * 32 + fr, fq * 8);
#define PG8_SA(b, h) (((b) * 2 + (h)) * HTB)
#define PG8_SB(b, h) ((4 + (b) * 2 + (h)) * HTB)
#define PG8_STAGE(bufoff, gbase, voff) do { _Pragma("unroll") for (int _i = 0; _i < 2; ++_i) \
        __builtin_amdgcn_global_load_lds((const unsigned*)((const char*)(gbase) + (voff)[_i]), (PG8_LAS unsigned*)(lds + (bufoff) + ldsw + _i * 8192), 16, 0, 0); } while (0)
#define PG8_LDA(dst, b, h) do { _Pragma("unroll") for (int m = 0; m < 4; ++m) _Pragma("unroll") for (int k = 0; k < 2; ++k) dst[m][k] = *(const PG8_LAS bf16x8*)(lds + PG8_SA(b, h) + aoff + m * 2048 + k * 1024); } while (0)
#define PG8_LDB(dst, b, h) do { _Pragma("unroll") for (int n = 0; n < 2; ++n) _Pragma("unroll") for (int k = 0; k < 2; ++k) dst[n][k] = *(const PG8_LAS bf16x8*)(lds + PG8_SB(b, h) + boff + n * 2048 + k * 1024); } while (0)
#define PG8_MMA(ai, bj, At, Bt) do { __builtin_amdgcn_s_setprio(1); _Pragma("unroll") for (int m = 0; m < 4; ++m) _Pragma("unroll") for (int n = 0; n < 2; ++n) _Pragma("unroll") for (int k = 0; k < 2; ++k) \
        acc[ai][bj][m][n] = __builtin_amdgcn_mfma_f32_16x16x32_bf16(Bt[n][k], At[m][k], acc[ai][bj][m][n], 0, 0, 0); __builtin_amdgcn_s_setprio(0); } while (0)
#define PG8_WAIT_V(n) asm volatile("s_waitcnt vmcnt(" #n ")" ::: "memory")
#define PG8_WAIT_L(n) asm volatile("s_waitcnt lgkmcnt(" #n ")" ::: "memory")
#define PG8_BAR __builtin_amdgcn_s_barrier()
#define PG8_SCHED __builtin_amdgcn_sched_barrier(0)
    Unit cur, nxt; int ui = 0;
    if (!S.next(0, cur)) return;
    f32x4 acc[2][2][4][2];
#pragma unroll
    for (int a = 0; a < 2; ++a)
#pragma unroll
        for (int b = 0; b < 2; ++b)
#pragma unroll
            for (int m = 0; m < 4; ++m)
#pragma unroll
                for (int n = 0; n < 2; ++n) acc[a][b][m][n] = (f32x4){0.f, 0.f, 0.f, 0.f};
    bf16x8 At[4][2], B0[2][2], B1[2][2];
    const char* cA = (const char*)g.A + (size_t)cur.pm * tsA; const char* cB = (const char*)g.Bt + (size_t)cur.pn * tsB;
    S.a_ready(cur);
    if constexpr (SP2) {
        PG8_STAGE(PG8_SB(0, 0), cB, voffB); PG8_STAGE(PG8_SB(0, 1), cB + hsB, voffB); PG8_STAGE(PG8_SA(0, 0), cA, voffA); PG8_STAGE(PG8_SA(0, 1), cA + hsA, voffA);
        if (wr == 1) PG8_BAR;
        PG8_WAIT_V(2); PG8_BAR;
        PG8_STAGE(PG8_SB(1, 0), cB + kstep, voffB); PG8_STAGE(PG8_SA(1, 0), cA + kstep, voffA); PG8_STAGE(PG8_SB(1, 1), cB + hsB + kstep, voffB);
        PG8_WAIT_V(6); PG8_BAR;
    } else {
        PG8_STAGE(PG8_SB(0, 0), cB, voffB); PG8_STAGE(PG8_SA(0, 0), cA, voffA); PG8_STAGE(PG8_SB(0, 1), cB + hsB, voffB); PG8_STAGE(PG8_SA(0, 1), cA + hsA, voffA);
        if (wr == 1) PG8_BAR;
        PG8_WAIT_V(4); PG8_BAR;
        PG8_STAGE(PG8_SB(1, 0), cB + kstep, voffB); PG8_STAGE(PG8_SA(1, 0), cA + kstep, voffA); PG8_STAGE(PG8_SB(1, 1), cB + hsB + kstep, voffB);
        PG8_WAIT_V(6); PG8_BAR;
    }
    for (;;) {
        const bool has_next = S.next(ui + 1, nxt);
        const char* nA = has_next ? (const char*)g.A + (size_t)nxt.pm * tsA : cA; const char* nB = has_next ? (const char*)g.Bt + (size_t)nxt.pn * tsB : cB;
        for (int t = 0; t < nt; t += 2) {
            const bool last = (t == nt - 2);
            const char* a1 = cA + (size_t)(t + 1) * kstep;
            const char* a2 = last ? nA : cA + (size_t)(t + 2) * kstep; const char* b2 = last ? nB : cB + (size_t)(t + 2) * kstep;
            const char* a3 = a2 + kstep; const char* b3 = b2 + kstep;
            if (last && has_next) S.a_ready(nxt);
            if constexpr (SP2) {
            PG8_LDB(B0, 0, 0); PG8_LDB(B1, 0, 1); PG8_SCHED; PG8_LDA(At, 0, 0); PG8_STAGE(PG8_SA(1, 1), a1 + hsA, voffA);
            PG8_WAIT_V(8); PG8_WAIT_L(0); PG8_BAR; PG8_MMA(0, 0, At, B0); PG8_MMA(0, 1, At, B1); PG8_BAR; PG8_SCHED;
            PG8_LDA(At, 0, 1); PG8_STAGE(PG8_SB(0, 0), b2, voffB); PG8_STAGE(PG8_SB(0, 1), b2 + hsB, voffB); PG8_STAGE(PG8_SA(0, 0), a2, voffA);
            PG8_WAIT_V(8); PG8_WAIT_L(0); PG8_BAR; PG8_MMA(1, 0, At, B0); PG8_MMA(1, 1, At, B1); PG8_BAR; PG8_SCHED;
            PG8_LDB(B0, 1, 0); PG8_LDB(B1, 1, 1); PG8_SCHED; PG8_LDA(At, 1, 0); PG8_STAGE(PG8_SA(0, 1), a2 + hsA, voffA);
            PG8_WAIT_V(8); PG8_WAIT_L(0); PG8_BAR; PG8_MMA(0, 0, At, B0); PG8_MMA(0, 1, At, B1); PG8_BAR; PG8_SCHED;
            PG8_LDA(At, 1, 1); PG8_STAGE(PG8_SB(1, 0), b3, voffB); PG8_STAGE(PG8_SB(1, 1), b3 + hsB, voffB); PG8_STAGE(PG8_SA(1, 0), a3, voffA);
            PG8_WAIT_V(8); PG8_WAIT_L(0); PG8_BAR; PG8_MMA(1, 0, At, B0); PG8_MMA(1, 1, At, B1); PG8_BAR; PG8_SCHED;
            } else {
            PG8_LDB(B0, 0, 0); PG8_SCHED; PG8_LDA(At, 0, 0); PG8_STAGE(PG8_SA(1, 1), a1 + hsA, voffA);
            PG8_WAIT_L(8); PG8_BAR; PG8_WAIT_L(0); PG8_MMA(0, 0, At, B0); PG8_BAR; PG8_SCHED;
            PG8_LDB(B1, 0, 1); PG8_STAGE(PG8_SB(0, 0), b2, voffB);
            PG8_BAR; PG8_WAIT_L(0); PG8_MMA(0, 1, At, B1); PG8_BAR;
            PG8_LDA(At, 0, 1); PG8_STAGE(PG8_SA(0, 0), a2, voffA);
            PG8_BAR; PG8_WAIT_L(0); PG8_MMA(1, 0, At, B0); PG8_BAR; PG8_SCHED;
            PG8_STAGE(PG8_SB(0, 1), b2 + hsB, voffB);
            PG8_WAIT_V(6); PG8_BAR; PG8_MMA(1, 1, At, B1); PG8_BAR;
            PG8_LDB(B0, 1, 0); PG8_SCHED; PG8_LDA(At, 1, 0); PG8_STAGE(PG8_SA(0, 1), a2 + hsA, voffA);
            PG8_WAIT_L(8); PG8_BAR; PG8_WAIT_L(0); PG8_MMA(0, 0, At, B0); PG8_BAR; PG8_SCHED;
            PG8_LDB(B1, 1, 1); PG8_STAGE(PG8_SB(1, 0), b3, voffB);
            PG8_BAR; PG8_WAIT_L(0); PG8_MMA(0, 1, At, B1); PG8_BAR;
            PG8_LDA(At, 1, 1); PG8_STAGE(PG8_SA(1, 0), a3, voffA);
            PG8_BAR; PG8_WAIT_L(0); PG8_MMA(1, 0, At, B0); PG8_BAR; PG8_SCHED;
            PG8_STAGE(PG8_SB(1, 1), b3 + hsB, voffB);
            PG8_WAIT_V(6); PG8_BAR; PG8_MMA(1, 1, At, B1); PG8_BAR;
            }
        }
        if constexpr (ALIGN_EPI) { if (wr == 0) PG8_BAR; }
        if constexpr (!Epi::AFTER_DRAIN) { E(acc, cur, wr, wc, fr, fq); S.done(cur); }
        if (!has_next) break;
#pragma unroll
        for (int a = 0; a < 2; ++a)
#pragma unroll
            for (int b = 0; b < 2; ++b)
#pragma unroll
                for (int m = 0; m < 4; ++m)
#pragma unroll
                    for (int n = 0; n < 2; ++n) acc[a][b][m][n] = (f32x4){0.f, 0.f, 0.f, 0.f};
        cur = nxt; cA = nA; cB = nB; ++ui;
        if constexpr (ALIGN_EPI) { if (wr == 1) PG8_BAR; }
    }
    PG8_WAIT_V(0);
    if constexpr (!ALIGN_EPI) { if (wr == 0) PG8_BAR; }
    PG8_BAR;
    if constexpr (Epi::AFTER_DRAIN) { E.fused(acc, cur, wr, wc, fr, fq, lds, wid, lane); S.done(cur); }
#undef PG8_SA
#undef PG8_SB
#undef PG8_STAGE
#undef PG8_LDA
#undef PG8_LDB
#undef PG8_MMA
#undef PG8_WAIT_V
#undef PG8_WAIT_L
#undef PG8_BAR
#undef PG8_SCHED
}
}

#define DI __device__ __forceinline__
typedef pg8::bf16_t bf16_t;
typedef short bf16x8 __attribute__((ext_vector_type(8)));
typedef short s16x4 __attribute__((ext_vector_type(4)));
typedef float f32x4 __attribute__((ext_vector_type(4)));
typedef float f32x16 __attribute__((ext_vector_type(16)));
typedef unsigned u32x4 __attribute__((ext_vector_type(4)));
typedef unsigned u32x2 __attribute__((ext_vector_type(2)));
#define LAS __attribute__((address_space(3)))
typedef float f32x2_t __attribute__((ext_vector_type(2)));

constexpr int DM = 1024, NB = 8, SEQ = 2048, CTXL = 256;
constexpr int NLAT = NB * SEQ, NCTX = NB * CTXL, MALL = NLAT + NCTX;
constexpr int FH = 2816, FH2 = 5632, EIN = 1792, OIN = 1280;
constexpr float NORM_EPS = 1e-6f;
constexpr float C2 = 0.125f * 1.4426950408889634f;
constexpr int NTHREADS = 512, NWAVES = 8;
constexpr int LDS_BYTES = 147456 + 8192 + 256, LDS_MISC = 147456 + 8192;
constexpr int NBND_LAT = NB * 31, NBND_CTX = NB * 3;
constexpr int XNE_ROW_L0 = MALL, XNE_ROW_L1 = NLAT;
constexpr int XN_ROWS = MALL + 1280;

constexpr size_t MiB = 1u << 20;
constexpr size_t WS_CTL = 0, CTL_ZERO_BYTES = 64 * 1024;
constexpr size_t WS_MOD = 1 * MiB;
constexpr size_t WS_ROPE = 2 * MiB;
constexpr size_t WS_RGW = 3 * MiB;
constexpr size_t WS_S5AT = 3 * MiB + 512 * 1024;
constexpr size_t WS_RGTOT = 4 * MiB;
constexpr size_t WS_S5E = 7 * MiB, WS_S5MF = 15 * MiB;
constexpr size_t WS_WIN0 = 39 * MiB, WS_WOUT0 = 43 * MiB, WS_WUP0 = 45 * MiB, WS_WDN0 = 56 * MiB;
constexpr size_t WS_WIN1 = 62 * MiB, WS_WOUT1 = 65 * MiB, WS_WUP1 = 67 * MiB, WS_WDN1 = 78 * MiB, WS_WGLU = 84 * MiB;
constexpr size_t WS_HC = 85 * MiB;
constexpr size_t WS_XN = 93 * MiB;
constexpr size_t WS_PROJ = 132 * MiB;
constexpr size_t WS_S5L = 177 * MiB;
constexpr size_t WS_MIX = 195 * MiB;
constexpr size_t WS_HID = 132 * MiB;
constexpr size_t WS_UG = WS_XN;
constexpr size_t WS_Z = 231 * MiB;
constexpr size_t WS_END = 250 * MiB;
static_assert(WS_XN + (size_t)XN_ROWS * DM * 2 <= WS_PROJ, "xn");
static_assert(WS_PROJ + (size_t)MALL * OIN * 2 <= WS_S5L && WS_S5L + (size_t)576 * 32 * 256 * 4 <= WS_MIX, "s5l");
static_assert((size_t)2 * MALL * 512 * 2 <= (size_t)XN_ROWS * DM * 2 && WS_Z + (size_t)MALL * 512 * 2 <= WS_END && WS_MIX + (size_t)MALL * DM * 2 <= WS_Z, "rg scratch");
static_assert(WS_HID + (size_t)MALL * FH * 2 <= WS_Z && WS_Z + (size_t)NLAT * 512 * 2 <= WS_END && (size_t)32 * 768 * 768 * 2 <= (size_t)XN_ROWS * DM * 2, "hid/z/ug");

DI float bf2f(bf16_t v) { return __uint_as_float((unsigned)v << 16); }
DI unsigned f2bf(float f) { unsigned u = __float_as_uint(f); return (u + 0x7fffu + ((u >> 16) & 1u)) >> 16; }
DI unsigned pk2(float lo, float hi) { return f2bf(lo) | (f2bf(hi) << 16); }
typedef __bf16 bf16x2v_t __attribute__((ext_vector_type(2)));
DI unsigned cvtpk_(float lo, float hi) { f32x2_t v = {lo, hi}; bf16x2v_t b = __builtin_convertvector(v, bf16x2v_t); return __builtin_bit_cast(unsigned, b); }
DI float wave_sum(float v) {
#pragma unroll
    for (int o = 1; o < 64; o <<= 1) v += __shfl_xor(v, o);
    return v;
}
DI float sigmoidf_(float x) { return __builtin_amdgcn_rcpf(1.f + __expf(-x)); }
DI float gelu_tanh(float x) { const float z = 1.5957691216057308f * (x + 0.044715f * x * x * x); return x * sigmoidf_(z); }
DI float siluf_(float x) { return x * sigmoidf_(x); }

struct EpiRes {
    static constexpr bool PERM = false, AFTER_DRAIN = false;
    const float* baseL; const float* baseC; float* outL; float* outC; const float* gate;
    __device__ __forceinline__ void operator()(const f32x4 (&acc)[2][2][4][2], const pg8::Unit& u, int wr, int wc, int fr, int fq) const {
        const bool isc = u.pm >= 64; const int bb = isc ? 8 : (u.pm >> 3);
        const float* base = isc ? baseC + (size_t)(u.pm - 64) * 256 * DM : baseL + (size_t)u.pm * 256 * DM;
        float* out = isc ? outC + (size_t)(u.pm - 64) * 256 * DM : outL + (size_t)u.pm * 256 * DM;
        const float* g = gate + (size_t)bb * 6144;
        const int col0 = u.pn * 256 + wc * 32 + 4 * fq;
#pragma unroll
        for (int bj = 0; bj < 2; ++bj)
#pragma unroll
            for (int n = 0; n < 2; ++n) {
                const int c = col0 + bj * 128 + n * 16; const f32x4 gv = *(const f32x4*)(g + c);
                f32x4 bs[2][4];
#pragma unroll
                for (int ai = 0; ai < 2; ++ai)
#pragma unroll
                    for (int m = 0; m < 4; ++m) bs[ai][m] = *(const f32x4*)(base + (size_t)(ai * 128 + wr * 64 + m * 16 + fr) * DM + c);
#pragma unroll
                for (int ai = 0; ai < 2; ++ai)
#pragma unroll
                    for (int m = 0; m < 4; ++m) *(f32x4*)(out + (size_t)(ai * 128 + wr * 64 + m * 16 + fr) * DM + c) = bs[ai][m] + gv * acc[ai][bj][m][n];
            }
    }
};

struct EpiCtxHalf {
    static constexpr bool PERM = false, AFTER_DRAIN = false;
    const float* baseC; float* outC; float* cp; const float* gate; int kh;
    __device__ __forceinline__ void operator()(const f32x4 (&acc)[2][2][4][2], const pg8::Unit& u, int wr, int wc, int fr, int fq) const {
        const size_t t0 = (size_t)(u.pm - 64) * 256 * DM; const float* g = gate + (size_t)8 * 6144;
        const int col0 = u.pn * 256 + wc * 32 + 4 * fq;
#pragma unroll
        for (int bj = 0; bj < 2; ++bj)
#pragma unroll
            for (int n = 0; n < 2; ++n) {
                const int c = col0 + bj * 128 + n * 16; const f32x4 gv = *(const f32x4*)(g + c);
                f32x4 bs[2][4];
#pragma unroll
                for (int ai = 0; ai < 2; ++ai)
#pragma unroll
                    for (int m = 0; m < 4; ++m) bs[ai][m] = kh == 0 ? *(const f32x4*)(baseC + t0 + (size_t)(ai * 128 + wr * 64 + m * 16 + fr) * DM + c) : (f32x4){0.f, 0.f, 0.f, 0.f};
                float* o = kh == 0 ? outC : cp;
#pragma unroll
                for (int ai = 0; ai < 2; ++ai)
#pragma unroll
                    for (int m = 0; m < 4; ++m) *(f32x4*)(o + t0 + (size_t)(ai * 128 + wr * 64 + m * 16 + fr) * DM + c) = bs[ai][m] + gv * acc[ai][bj][m][n];
            }
    }
};
struct CtxOrder {
    int c;
    __device__ bool next(int i, pg8::Unit& u) const { if (i != 0 || c < 0 || c >= 32) return false; u.pm = 64 + (c >> 2); u.pn = c & 3; return true; }
    __device__ __forceinline__ void a_ready(const pg8::Unit&) const {}
    __device__ __forceinline__ void done(const pg8::Unit&) const {}
};

struct EpiConvAct {
    static constexpr bool PERM = true, AFTER_DRAIN = false;
    bf16_t* H; const float* cw; const float* cb; int pm_edge; int nbnd_lat; int nbnd; char* xlds;
    __device__ __forceinline__ void operator()(const f32x4 (&acc)[2][2][4][2], const pg8::Unit& u, int wr_, int wc_, int fr_, int fq_) const {
        int tl = threadIdx.x; asm volatile("" : "+v"(tl));
        const int lane = tl & 63, wid_ = tl >> 6, fr = lane & 15, fq = lane >> 4, wr = wid_ >> 2, wc = wid_ & 3; (void)wr_; (void)wc_; (void)fr_; (void)fq_;
        const bool edge = u.pm >= pm_edge;
        const int hc0 = u.pn * 128 + wc * 32 + 8 * fq;
        u32x2* sc = (u32x2*)(xlds + wid_ * 2048);
        float* wl = (float*)(xlds + 16384 + wid_ * 1024);
        { const int p = lane >> 4, bjl = (lane >> 3) & 1, cg4 = lane & 7;
          const float* src = (p < 3 ? cw + p * FH2 : cb) + bjl * FH + u.pn * 128 + wc * 32 + 4 * cg4;
          *(f32x4*)(wl + (p * 2 + bjl) * 32 + 4 * cg4) = *(const f32x4*)src; }
        asm volatile("" ::: "memory");
#pragma unroll
        for (int n = 0; n < 2; ++n) {
#pragma unroll
            for (int ai = 0; ai < 2; ++ai) {
                float hvv[2][4][4];
#pragma unroll
                for (int bj = 0; bj < 2; ++bj) {
#pragma unroll
                    for (int m = 0; m < 4; ++m) { u32x2 w; w.x = cvtpk_(acc[ai][bj][m][n][0], acc[ai][bj][m][n][1]); w.y = cvtpk_(acc[ai][bj][m][n][2], acc[ai][bj][m][n][3]); sc[(16 * m + fr) * 4 + fq] = w; }
                    asm volatile("" ::: "memory");
                    const f32x4 w0 = *(const f32x4*)(wl + (0 * 2 + bj) * 32 + 8 * fq + 4 * n), w1 = *(const f32x4*)(wl + (1 * 2 + bj) * 32 + 8 * fq + 4 * n),
                                w2 = *(const f32x4*)(wl + (2 * 2 + bj) * 32 + 8 * fq + 4 * n), bb = *(const f32x4*)(wl + (3 * 2 + bj) * 32 + 8 * fq + 4 * n);
#pragma unroll
                    for (int m = 0; m < 4; ++m) {
                        const int row = 16 * m + fr; const int ru = row > 0 ? row - 1 : 0, rd = row < 63 ? row + 1 : 63;
                        u32x2 uu = sc[ru * 4 + fq], dd = sc[rd * 4 + fq];
                        if (row == 0) uu = (u32x2){0u, 0u}; if (row == 63) dd = (u32x2){0u, 0u};
                        const f32x4 up = (f32x4){__uint_as_float(uu.x << 16), __uint_as_float(uu.x & 0xffff0000u), __uint_as_float(uu.y << 16), __uint_as_float(uu.y & 0xffff0000u)};
                        const f32x4 dn = (f32x4){__uint_as_float(dd.x << 16), __uint_as_float(dd.x & 0xffff0000u), __uint_as_float(dd.y << 16), __uint_as_float(dd.y & 0xffff0000u)};
                        const f32x4 hv = bb + w0 * up + w1 * acc[ai][bj][m][n] + w2 * dn;
                        hvv[bj][m][0] = hv.x; hvv[bj][m][1] = hv.y; hvv[bj][m][2] = hv.z; hvv[bj][m][3] = hv.w;
                    }
                    asm volatile("" : "+v"(hvv[bj][0][0]), "+v"(hvv[bj][0][1]), "+v"(hvv[bj][0][2]), "+v"(hvv[bj][0][3]), "+v"(hvv[bj][1][0]), "+v"(hvv[bj][1][1]), "+v"(hvv[bj][1][2]), "+v"(hvv[bj][1][3]),
                                      "+v"(hvv[bj][2][0]), "+v"(hvv[bj][2][1]), "+v"(hvv[bj][2][2]), "+v"(hvv[bj][2][3]), "+v"(hvv[bj][3][0]), "+v"(hvv[bj][3][1]), "+v"(hvv[bj][3][2]), "+v"(hvv[bj][3][3]) :: "memory");
                }
#pragma unroll
                for (int m = 0; m < 4; ++m) {
                    const int R = ai * 128 + wr * 64 + m * 16 + fr;
                    long grow; bool st;
                    if (!edge) {
                        grow = (long)u.pm * 256 + R; st = true;
                        const int r64 = R & 63;
                        if (r64 == 0) st = (R == 0) && (u.pm >= 64 || (u.pm & 7) == 0);
                        if (r64 == 63) st = (R == 255) && (u.pm >= 64 || (u.pm & 7) == 7);
                    } else {
                        const int slot = (u.pm - pm_edge) * 256 + R, q = slot >> 2, pos = slot & 3;
                        st = (pos == 1 || pos == 2) && q < nbnd;
                        int row0;
                        if (q < nbnd_lat) { const int s = q / 31, k = q - s * 31 + 1; row0 = s * SEQ + 64 * k; }
                        else { const int q2 = q - nbnd_lat, s = q2 / 3, k = q2 - s * 3 + 1; row0 = NLAT + s * CTXL + 64 * k; }
                        grow = (long)row0 - 2 + pos;
                    }
                    if (st) { u32x2 w; w.x = cvtpk_(hvv[0][m][0] * siluf_(hvv[1][m][0]), hvv[0][m][1] * siluf_(hvv[1][m][1])); w.y = cvtpk_(hvv[0][m][2] * siluf_(hvv[1][m][2]), hvv[0][m][3] * siluf_(hvv[1][m][3]));
                        *(u32x2*)(H + (size_t)grow * FH + hc0 + 4 * n) = w; }
                }
                asm volatile("" ::: "memory"); __builtin_amdgcn_sched_barrier(0);
            }
        }
    }
};

struct EpiGlu {
    static constexpr bool PERM = true, AFTER_DRAIN = false;
    const bf16_t* Z; bf16_t* O; const float* bias;
    __device__ __forceinline__ void operator()(const f32x4 (&acc)[2][2][4][2], const pg8::Unit& u, int wr, int wc, int fr, int fq) const {
        const int row0 = u.pm * 256 + wr * 64 + fr; const int col0 = u.pn * 256 + wc * 32 + 8 * fq;
#pragma unroll
        for (int bj = 0; bj < 2; ++bj) {
            const f32x4 b0 = *(const f32x4*)(bias + col0 + bj * 128), b1 = *(const f32x4*)(bias + col0 + bj * 128 + 4);
            u32x4 zq[2][4];
#pragma unroll
            for (int ai = 0; ai < 2; ++ai)
#pragma unroll
                for (int m = 0; m < 4; ++m) zq[ai][m] = *(const u32x4*)(Z + (size_t)(row0 + ai * 128 + m * 16) * 512 + col0 + bj * 128);
#pragma unroll
            for (int ai = 0; ai < 2; ++ai)
#pragma unroll
                for (int m = 0; m < 4; ++m) {
                    const size_t r = (size_t)(row0 + ai * 128 + m * 16);
                    const u32x4 zz = zq[ai][m];
                    const f32x4 v0 = acc[ai][bj][m][0] + b0, v1 = acc[ai][bj][m][1] + b1;
                    float o[8];
#pragma unroll
                    for (int j = 0; j < 4; ++j) {
                        const float z0 = __uint_as_float((j & 1) ? (zz[j >> 1] & 0xffff0000u) : (zz[j >> 1] << 16));
                        const float z1 = __uint_as_float((j & 1) ? (zz[2 + (j >> 1)] & 0xffff0000u) : (zz[2 + (j >> 1)] << 16));
                        o[j] = z0 * sigmoidf_(v0[j]); o[4 + j] = z1 * sigmoidf_(v1[j]);
                    }
                    u32x4 w; w.x = pk2(o[0], o[1]); w.y = pk2(o[2], o[3]); w.z = pk2(o[4], o[5]); w.w = pk2(o[6], o[7]);
                    *(u32x4*)(O + r * DM + col0 + bj * 128) = w;
                }
        }
    }
};
#define GAS __attribute__((address_space(1)))
typedef GAS unsigned gu32;
typedef GAS unsigned long long gu64;
#define RLX_AGENT __ATOMIC_RELAXED, __HIP_MEMORY_SCOPE_AGENT
#define LDS_WAIT() asm volatile("s_waitcnt lgkmcnt(0)" ::: "memory")
#define VM_WAIT() asm volatile("s_waitcnt vmcnt(0)" ::: "memory")
__device__ __forceinline__ unsigned long long rt() { return __builtin_amdgcn_s_memrealtime(); }
#define XB_TMO      128
#define XB_XCNT(j)  (256  + 64 * (j))
#define XB_XSUB(j)  (1280 + 64 * (j))
#define XB_XGEN(j)  (2304 + 64 * (j))
#define XB_TOP      3328
#define XB_TOPGEN   3392
#define XCD_BAR_WORDS 3456
#define XB_SPIN_CAP (1u << 18)

__device__ __forceinline__ unsigned xb_ld(unsigned* p)              { return __hip_atomic_load(p, __ATOMIC_RELAXED, __HIP_MEMORY_SCOPE_AGENT); }
__device__ __forceinline__ unsigned xb_add(unsigned* p, unsigned v) { return __hip_atomic_fetch_add(p, v, __ATOMIC_RELAXED, __HIP_MEMORY_SCOPE_AGENT); }
__device__ __forceinline__ unsigned xb_xcc_id() { return (unsigned)__builtin_amdgcn_s_getreg((3 << 11) | 20) & 0xFu; }
#define XB_SPIN(cond, bar) do { unsigned _sp = 0; while (cond) { __builtin_amdgcn_s_sleep(1); \
    if ((++_sp & 255u) == 0u) { if (xb_ld(&(bar)[XB_TMO])) break; if (_sp > XB_SPIN_CAP) { atomicAdd(&(bar)[XB_TMO], 1u); break; } } } } while (0)

struct XcdBarrier {
    unsigned* bar; unsigned x;
    volatile LAS unsigned* st;
};

__device__ __forceinline__ XcdBarrier xcd_barrier_post(unsigned* bar, volatile LAS unsigned* st) {
    XcdBarrier b; b.bar = bar; b.x = xb_xcc_id(); b.st = st;
    if (threadIdx.x == 0) (void)xb_add(&bar[XB_XCNT(b.x)], 1u);
    return b;
}
__device__ __forceinline__ void xcd_barrier_complete(unsigned* bar, unsigned x, unsigned& nloc, unsigned& nx) {
    const unsigned G = gridDim.x * gridDim.y * gridDim.z;
    unsigned sum, cnt, mine, sp = 0u;
    for (;;) {
        sum = 0u; cnt = 0u; mine = 0u;
#pragma unroll
        for (unsigned j = 0; j < 16; ++j) { const unsigned c = xb_ld(&bar[XB_XCNT(j)]); sum += c; cnt += (c > 0u) ? 1u : 0u; mine = (j == x) ? c : mine; }
        if (sum == G) break;
        __builtin_amdgcn_s_sleep(1);
        if ((++sp & 255u) == 0u) { if (xb_ld(&bar[XB_TMO])) break; if (sp > XB_SPIN_CAP) { atomicAdd(&bar[XB_TMO], 1u); break; } }
    }
    nloc = mine > 0u ? mine : 1u; nx = cnt > 0u ? cnt : 1u;
}

__device__ __forceinline__ void xcd_barrier(const XcdBarrier& b) {
    asm volatile("s_waitcnt vmcnt(0)" ::: "memory");
    __syncthreads();
    if (threadIdx.x == 0) {
        unsigned* bar = b.bar;
        __builtin_amdgcn_s_waitcnt(0);
        unsigned nloc = b.st[0], nx = b.st[1];
        if (nloc == 0u) { xcd_barrier_complete(bar, b.x, nloc, nx); b.st[0] = nloc; b.st[1] = nx; }
        const unsigned old = xb_add(&bar[XB_XSUB(b.x)], 1u);
        const unsigned gen = old / nloc;
        if (old + 1u == (gen + 1u) * nloc) {
            __builtin_amdgcn_fence(__ATOMIC_RELEASE, "agent");
            asm volatile("s_waitcnt vmcnt(0)" ::: "memory");
            const unsigned og = xb_add(&bar[XB_TOP], 1u);
            const unsigned tg = og / nx;
            if (og + 1u == (tg + 1u) * nx) xb_add(&bar[XB_TOPGEN], 1u);
            else XB_SPIN(xb_ld(&bar[XB_TOPGEN]) == tg, bar);
            __builtin_amdgcn_fence(__ATOMIC_ACQUIRE, "agent");
            xb_add(&bar[XB_XGEN(b.x)], 1u);
            asm volatile("s_waitcnt vmcnt(0)" ::: "memory");
        } else {
            XB_SPIN(xb_ld(&bar[XB_XGEN(b.x)]) == gen, bar);
            __builtin_amdgcn_fence(__ATOMIC_ACQUIRE, "agent");
            asm volatile("s_waitcnt vmcnt(0)" ::: "memory");
        }
    }
    __syncthreads();
}

DI s16x4 vtr(const char* p) { typedef short v4i16_t __attribute__((ext_vector_type(4))); return __builtin_bit_cast(s16x4, __builtin_amdgcn_ds_read_tr16_b64_v4i16((LAS v4i16_t*)p)); }
typedef __bf16 bf16x2_t __attribute__((ext_vector_type(2)));
DI unsigned cvtpk(float lo, float hi) { f32x2_t v = {lo, hi}; bf16x2_t b = __builtin_convertvector(v, bf16x2_t); return __builtin_bit_cast(unsigned, b); }
DI int crow(int r, int h) { return (r & 3) + 8 * (r >> 2) + 4 * h; }
#define MFMA32(a, b, c) __builtin_amdgcn_mfma_f32_32x32x16_bf16((a), (b), (c), 0, 0, 0)
constexpr int ATT_BUF = 17408, ATT_KB = 9216;

template <int MODE, int RB>
DI void attn_unit(const bf16_t* __restrict__ P, int ld, int qoff, int koff, int voff, bf16_t* __restrict__ O, char* lds, int b, int head, int q0, float sink_l2) {
    const int tid = threadIdx.x, lane = tid & 63, wid = tid >> 6, r32 = lane & 31, hi = lane >> 5;
    const int kvh = head >> 2;
    const int qrow0 = (MODE == 1) ? (NLAT + b * CTXL) : (b * SEQ + q0);
    int lat0 = 0, nlat = 0;
    if (MODE == 0) { lat0 = 0; nlat = SEQ / 64; }
    if (MODE == 2) { const int lo = q0 - 128 < 0 ? 0 : q0 - 128; const int hi_ = q0 + 256 * RB + 128 > SEQ ? SEQ : q0 + 256 * RB + 128; lat0 = lo; nlat = (hi_ - lo) / 64; }
    const int NT = 4 + nlat;
#define KROW(t) ((t) < 4 ? (NLAT + b * CTXL + 64 * (t)) : (b * SEQ + lat0 + 64 * ((t) - 4)))
    bf16x8 qr[RB][4];
#pragma unroll
    for (int rb = 0; rb < RB; ++rb) { const bf16_t* Qp = P + (size_t)(qrow0 + wid * 32 * RB + rb * 32 + r32) * ld + qoff + head * 64 + 8 * hi;
#pragma unroll
        for (int ks = 0; ks < 4; ++ks) qr[rb][ks] = *(const bf16x8*)(Qp + 16 * ks); }
    const int srow = tid >> 3, sch = tid & 7;
    const bf16_t* kg = P + koff + kvh * 64 + sch * 8; const bf16_t* vg = P + voff + kvh * 64 + sch * 8;
    const int kw = srow * 144 + sch * 16, vw = ATT_KB + (sch >> 2) * 4096 + srow * 64 + (sch & 3) * 16;
    const int kr_off = r32 * 144 + 16 * hi;
    const int vr_off = ATT_KB + ((lane >> 4) & 1) * 32 + (lane & 3) * 8 + (4 * hi + ((lane & 15) >> 2)) * 64;
    u32x4 kreg, vreg;
    { const size_t r = (size_t)(KROW(0) + srow) * ld; kreg = *(const u32x4*)(kg + r); vreg = *(const u32x4*)(vg + r); }
    *(u32x4*)(lds + kw) = kreg; *(u32x4*)(lds + vw) = vreg;
    if (NT > 1) { const size_t r = (size_t)(KROW(1) + srow) * ld; kreg = *(const u32x4*)(kg + r); vreg = *(const u32x4*)(vg + r); }
    float m[RB], l[RB]; f32x16 o0[RB], o1[RB];
#pragma unroll
    for (int rb = 0; rb < RB; ++rb) { m[rb] = 0.f; l[rb] = 0.f; o0[rb] = f32x16{}; o1[rb] = f32x16{}; }
    __syncthreads();
    for (int t = 0; t < NT; ++t) {
        const char* buf = lds + (t & 1) * ATT_BUF;
        bool need = true; int kpos0 = 0;
        if (MODE == 2 && t >= 4) { kpos0 = lat0 + 64 * (t - 4); const int ql = q0 + wid * 32 * RB; need = (kpos0 <= ql + 32 * RB - 1 + 128) && (kpos0 + 63 >= ql - 128); }
        if (need) {
#pragma unroll
            for (int kb = 0; kb < 2; ++kb) {
                f32x16 p[RB];
#pragma unroll
                for (int rb = 0; rb < RB; ++rb) p[rb] = f32x16{};
#pragma unroll
                for (int ks = 0; ks < 4; ++ks) {
                    const bf16x8 kf = *(const bf16x8*)(buf + kr_off + kb * 32 * 144 + ks * 32);
#pragma unroll
                    for (int rb = 0; rb < RB; ++rb) p[rb] = MFMA32(kf, qr[rb][ks], p[rb]);
                }
#pragma unroll
                for (int rb = 0; rb < RB; ++rb) {
                    if (__any(m[rb] != 0.f)) {
#pragma unroll
                        for (int i = 0; i < 16; ++i) p[rb][i] -= m[rb]; }
                    if (MODE == 2 && t >= 4) {
                        const int qpos = q0 + wid * 32 * RB + rb * 32 + r32;
#pragma unroll
                        for (int i = 0; i < 16; ++i) { const int kp = kpos0 + 32 * kb + crow(i, hi); int d0 = qpos - kp; d0 = d0 < 0 ? -d0 : d0; if (d0 > 128) p[rb][i] = -1e30f; }
                    }
                    float mx = fmaxf(fmaxf(p[rb][0], p[rb][1]), p[rb][2]), mx2 = fmaxf(fmaxf(p[rb][3], p[rb][4]), p[rb][5]);
#pragma unroll
                    for (int i = 6; i < 16; i += 4) { mx = fmaxf(fmaxf(mx, p[rb][i]), p[rb][i + 1]); mx2 = fmaxf(fmaxf(mx2, p[rb][i + 2 < 16 ? i + 2 : 15]), p[rb][i + 3 < 16 ? i + 3 : 15]); }
                    mx = fmaxf(mx, mx2); mx = fmaxf(mx, __shfl_xor(mx, 32));
                    if (__any(mx > 8.f)) {
                        const float dl = fmaxf(mx, 0.f); m[rb] += dl; const float f = __builtin_amdgcn_exp2f(-dl); l[rb] *= f;
#pragma unroll
                        for (int i = 0; i < 16; ++i) { p[rb][i] -= dl; o0[rb][i] *= f; o1[rb][i] *= f; }
                    }
                    float rs = 0.f, rs2 = 0.f;
#pragma unroll
                    for (int i = 0; i < 16; i += 2) { p[rb][i] = __builtin_amdgcn_exp2f(p[rb][i]); rs += p[rb][i]; p[rb][i + 1] = __builtin_amdgcn_exp2f(p[rb][i + 1]); rs2 += p[rb][i + 1]; }
                    l[rb] += rs + rs2;
                }
#pragma unroll
                for (int s2 = 0; s2 < 2; ++s2) {
                    const char* vb = buf + vr_off + (2 * kb + s2) * 1024;
                    const s16x4 a0 = vtr(vb), a1 = vtr(vb + 512), c0 = vtr(vb + 4096), c1 = vtr(vb + 4096 + 512);
                    const bf16x8 va0 = (bf16x8){a0[0], a0[1], a0[2], a0[3], a1[0], a1[1], a1[2], a1[3]};
                    const bf16x8 va1 = (bf16x8){c0[0], c0[1], c0[2], c0[3], c1[0], c1[1], c1[2], c1[3]};
#pragma unroll
                    for (int rb = 0; rb < RB; ++rb) {
                        u32x4 pw; pw[0] = cvtpk(p[rb][8 * s2], p[rb][8 * s2 + 1]); pw[1] = cvtpk(p[rb][8 * s2 + 2], p[rb][8 * s2 + 3]); pw[2] = cvtpk(p[rb][8 * s2 + 4], p[rb][8 * s2 + 5]); pw[3] = cvtpk(p[rb][8 * s2 + 6], p[rb][8 * s2 + 7]);
                        const bf16x8 pb = __builtin_bit_cast(bf16x8, pw);
                        o0[rb] = MFMA32(va0, pb, o0[rb]); o1[rb] = MFMA32(va1, pb, o1[rb]);
                    }
                }
            }
        }
        if (t + 1 < NT) {
            char* nb = lds + ((t + 1) & 1) * ATT_BUF;
            *(u32x4*)(nb + kw) = kreg; *(u32x4*)(nb + vw) = vreg;
            if (t + 2 < NT) { const size_t r = (size_t)(KROW(t + 2) + srow) * ld; kreg = *(const u32x4*)(kg + r); vreg = *(const u32x4*)(vg + r); }
        }
        __syncthreads();
    }
#undef KROW
    int tl_ = threadIdx.x; asm volatile("" : "+v"(tl_));
    const int lane2 = tl_ & 63, wid2 = tl_ >> 6, r32b = lane2 & 31, hib = lane2 >> 5;
#pragma unroll
    for (int rb = 0; rb < RB; ++rb) {
        float lt = l[rb] + __shfl_xor(l[rb], 32);
        if (MODE == 2) lt += __builtin_amdgcn_exp2f(sink_l2 - m[rb]);
        const float inv = 1.f / lt;
        bf16_t* Op = O + (size_t)(qrow0 + wid2 * 32 * RB + rb * 32 + r32b) * DM + 512 + head * 64 + 4 * hib;
#pragma unroll
        for (int k = 0; k < 4; ++k) {
            u32x2 w0, w1;
            w0.x = pk2(o0[rb][4 * k] * inv, o0[rb][4 * k + 1] * inv); w0.y = pk2(o0[rb][4 * k + 2] * inv, o0[rb][4 * k + 3] * inv);
            w1.x = pk2(o1[rb][4 * k] * inv, o1[rb][4 * k + 1] * inv); w1.y = pk2(o1[rb][4 * k + 2] * inv, o1[rb][4 * k + 3] * inv);
            *(u32x2*)(Op + 8 * k) = w0; *(u32x2*)(Op + 32 + 8 * k) = w1;
        }
    }
}

constexpr int RG_XA = 0, RG_XF = 9216, RG_GT = RG_XF + 64 * 65 * 4  , RG_SEG = RG_GT + 4 * 64 * 65 * 4  , RG_CAR = RG_SEG + 2 * 64 * 4 * 8  ;
DI bf16_t* rg_yl(unsigned char* ws) { return (bf16_t*)(ws + WS_XN); }
DI bf16_t* rg_pf(unsigned char* ws) { return (bf16_t*)(ws + WS_XN) + (size_t)MALL * 512; }
DI bf16_t* rg_pb(unsigned char* ws) { return (bf16_t*)(ws + WS_Z); }
DI void rg_item1(const float* const* in, unsigned char* ws, char* lds, int item) {
    const int tid = threadIdx.x, lane = tid & 63, wid = tid >> 6;
    const int ci = item % 36, bh = item / 36, head = bh & 7, b = bh >> 3;
    const bf16_t* PROJ = (const bf16_t*)(ws + WS_PROJ);
    const int seqbase = ci < 4 ? NLAT + b * CTXL : b * SEQ, t0 = ci < 4 ? ci * 64 : (ci - 4) * 64, slen = ci < 4 ? CTXL : SEQ;
    bf16_t* XA = (bf16_t*)(lds + RG_XA); float* XF = (float*)(lds + RG_XF); float* GT = (float*)(lds + RG_GT); float* SEGL = (float*)(lds + RG_SEG);
    float* TOT = (float*)(ws + WS_RGTOT);
    const int sdir = tid >> 8, sch = (tid >> 2) & 63, sseg = tid & 3;
    {
        const int tok = tid >> 3, cg8 = tid & 7, ch0 = head * 64 + cg8 * 8;
        const float* cw = in[13]; const float* cb = in[14];
        float x[8]; u32x4 uu4[4]; f32x4 wq[5][2];
#pragma unroll
        for (int j = 0; j < 4; ++j) { int tt = t0 + tok + j - 1; tt = tt < 0 ? 0 : (tt >= slen ? slen - 1 : tt); uu4[j] = *(const u32x4*)(PROJ + (size_t)(seqbase + tt) * EIN + ch0); }
#pragma unroll
        for (int j = 0; j < 4; ++j) { wq[j][0] = *(const f32x4*)(cw + j * 512 + ch0); wq[j][1] = *(const f32x4*)(cw + j * 512 + ch0 + 4); }
        wq[4][0] = *(const f32x4*)(cb + ch0); wq[4][1] = *(const f32x4*)(cb + ch0 + 4);
#pragma unroll
        for (int c = 0; c < 8; ++c) x[c] = wq[4][c >> 2][c & 3];
#pragma unroll
        for (int j = 0; j < 4; ++j) {
            const int tt = t0 + tok + j - 1; const float msk = (tt >= 0 && tt < slen) ? 1.f : 0.f;
#pragma unroll
            for (int c = 0; c < 8; ++c) { const float uv = __uint_as_float((c & 1) ? (uu4[j][c >> 1] & 0xffff0000u) : (uu4[j][c >> 1] << 16)); x[c] += (wq[j][c >> 2][c & 3] * msk) * uv; }
        }
        u32x4 w; w.x = pk2(x[0], x[1]); w.y = pk2(x[2], x[3]); w.z = pk2(x[4], x[5]); w.w = pk2(x[6], x[7]);
        *(u32x4*)(XA + tok * 72 + cg8 * 8) = w;
#pragma unroll
        for (int c = 0; c < 8; ++c) XF[tok * 65 + cg8 * 8 + c] = x[c];
    }
    __syncthreads();
    {
        const int mi = wid & 3, th = wid >> 2, r32 = lane & 31, hi = lane >> 5;
        const bf16_t* W = (const bf16_t*)(ws + WS_RGW) + (size_t)(mi * 8 + head) * 4096;
        const float* bias = (mi & 1) ? in[18] : in[16]; const int dirm = mi >> 1;
#pragma unroll
        for (int nt = 0; nt < 2; ++nt) {
            f32x16 acc = {};
#pragma unroll
            for (int ks = 0; ks < 4; ++ks) {
                const bf16x8 a = *(const bf16x8*)(XA + (32 * th + r32) * 72 + 16 * ks + 8 * hi);
                const bf16x8 bfr = *(const bf16x8*)(W + (32 * nt + r32) * 64 + 16 * ks + 8 * hi);
                acc = MFMA32(a, bfr, acc);
            }
            const float bv = bias[dirm * 512 + head * 64 + 32 * nt + r32];
#pragma unroll
            for (int i = 0; i < 16; ++i) GT[(mi * 64 + 32 * th + crow(i, hi)) * 65 + 32 * nt + r32] = sigmoidf_(acc[i] + bv);
        }
    }
    __syncthreads();
    float av[16], bvv[16];
    {
        const float lam = in[19][sdir * 512 + head * 64 + sch];
        const float nl = -lam; const float sp = nl > 20.f ? nl : log1pf(__expf(nl));
        float hh = 0.f, PP = 1.f;
#pragma unroll
        for (int s = 0; s < 16; ++s) {
            const int k = 16 * sseg + s, tok = sdir == 0 ? k : 63 - k;
            const float r = GT[((2 * sdir) * 64 + tok) * 65 + sch], ig = GT[((2 * sdir + 1) * 64 + tok) * 65 + sch], x = XF[tok * 65 + sch];
            const float la = -8.f * r * sp; const float a = __expf(la); const float bb = __builtin_amdgcn_sqrtf(fmaxf(1.f - a * a, 0.f)) * (ig * x);
            av[s] = a; bvv[s] = bb; hh = a * hh + bb; PP *= a;
        }
        __syncthreads();
        SEGL[((sdir * 64 + sch) * 4 + sseg) * 2] = PP; SEGL[((sdir * 64 + sch) * 4 + sseg) * 2 + 1] = hh;
    }
    __syncthreads();
    {
        float c = 0.f, Pbef = 1.f, Pt = 1.f;
#pragma unroll
        for (int s = 0; s < 4; ++s) { const float p = SEGL[((sdir * 64 + sch) * 4 + s) * 2], h = SEGL[((sdir * 64 + sch) * 4 + s) * 2 + 1];
            if (s < sseg) { c = p * c + h; Pbef *= p; } Pt *= p; }
        float h = c, P = Pbef;
#pragma unroll
        for (int s = 0; s < 16; ++s) { const int k = 16 * sseg + s, tok = sdir == 0 ? k : 63 - k; h = av[s] * h + bvv[s]; P *= av[s];
            GT[(sdir * 64 + tok) * 65 + sch] = h; GT[((2 + sdir) * 64 + tok) * 65 + sch] = P; }
        if (sseg == 3) { float* tp = TOT + ((size_t)((sdir * NB + b) * 36 + ci) * 2) * 512 + head * 64 + sch; tp[0] = Pt; tp[512] = h; }
    }
    __syncthreads();
    {
        const int tok = tid >> 3, cg8 = tid & 7, ch0 = head * 64 + cg8 * 8;
        const size_t off = (size_t)(seqbase + t0 + tok) * 512 + ch0;
        float y[8], pf[8], pb[8];
#pragma unroll
        for (int c = 0; c < 8; ++c) { y[c] = GT[tok * 65 + cg8 * 8 + c] + GT[(64 + tok) * 65 + cg8 * 8 + c]; pf[c] = GT[(128 + tok) * 65 + cg8 * 8 + c]; pb[c] = GT[(192 + tok) * 65 + cg8 * 8 + c]; }
        u32x4 w; w.x = pk2(y[0], y[1]); w.y = pk2(y[2], y[3]); w.z = pk2(y[4], y[5]); w.w = pk2(y[6], y[7]); *(u32x4*)(rg_yl(ws) + off) = w;
        w.x = pk2(pf[0], pf[1]); w.y = pk2(pf[2], pf[3]); w.z = pk2(pf[4], pf[5]); w.w = pk2(pf[6], pf[7]); *(u32x4*)(rg_pf(ws) + off) = w;
        w.x = pk2(pb[0], pb[1]); w.y = pk2(pb[2], pb[3]); w.z = pk2(pb[4], pb[5]); w.w = pk2(pb[6], pb[7]); *(u32x4*)(rg_pb(ws) + off) = w;
    }
    __syncthreads();
}
DI void rg_item2(const float* const* in, unsigned char* ws, char* lds, int item) {
    const int tid = threadIdx.x;
    const int ci = item % 36, bh = item / 36, head = bh & 7, b = bh >> 3;
    const bf16_t* PROJ = (const bf16_t*)(ws + WS_PROJ);
    const int seqbase = ci < 4 ? NLAT + b * CTXL : b * SEQ, t0 = ci < 4 ? ci * 64 : (ci - 4) * 64;
    float* SEGL = (float*)(lds + RG_SEG); float* CAR = (float*)(lds + RG_CAR);
    const float* TOT = (const float*)(ws + WS_RGTOT);
    const int sdir = tid >> 8, sch = (tid >> 2) & 63, sseg = tid & 3;
    const int tok = tid >> 3, cg8 = tid & 7, ch0 = head * 64 + cg8 * 8;
    const size_t row = (size_t)(seqbase + t0 + tok); const size_t off = row * 512 + ch0;
    const u32x4 yv = *(const u32x4*)(rg_yl(ws) + off), pfv = *(const u32x4*)(rg_pf(ws) + off), pbv = *(const u32x4*)(rg_pb(ws) + off), gg = *(const u32x4*)(PROJ + row * EIN + 512 + ch0);
    {
        const int pos = sdir == 0 ? ci : (ci < 4 ? 3 - ci : 4 + (35 - ci));
        float pp[9], hh[9];
#pragma unroll
        for (int i = 0; i < 9; ++i) { const int k0 = sseg * 9 + i; const int k = k0 < 35 ? k0 : 35; const int ck = sdir == 0 ? k : (k < 4 ? 3 - k : 35 - (k - 4));
            const float* tp = TOT + ((size_t)((sdir * NB + b) * 36 + ck) * 2) * 512 + head * 64 + sch; pp[i] = tp[0]; hh[i] = tp[512]; }
#pragma unroll
        for (int i = 0; i < 9; ++i) { if (sseg * 9 + i >= pos) { pp[i] = 1.f; hh[i] = 0.f; } }
        float Pc = 1.f, Hc = 0.f;
#pragma unroll
        for (int i = 0; i < 9; ++i) { Hc = pp[i] * Hc + hh[i]; Pc *= pp[i]; }
        SEGL[((sdir * 64 + sch) * 4 + sseg) * 2] = Pc; SEGL[((sdir * 64 + sch) * 4 + sseg) * 2 + 1] = Hc;
    }
    __syncthreads();
    if (tid < 128) { const int d = tid >> 6, ch = tid & 63; float Hc = 0.f;
#pragma unroll
        for (int s = 0; s < 4; ++s) { const float p = SEGL[((d * 64 + ch) * 4 + s) * 2], h = SEGL[((d * 64 + ch) * 4 + s) * 2 + 1]; Hc = p * Hc + h; }
        CAR[d * 64 + ch] = Hc; }
    __syncthreads();
    {
        float o[8];
#pragma unroll
        for (int c = 0; c < 8; ++c) {
            const float yl = __uint_as_float((c & 1) ? (yv[c >> 1] & 0xffff0000u) : (yv[c >> 1] << 16)), pf = __uint_as_float((c & 1) ? (pfv[c >> 1] & 0xffff0000u) : (pfv[c >> 1] << 16));
            const float pb = __uint_as_float((c & 1) ? (pbv[c >> 1] & 0xffff0000u) : (pbv[c >> 1] << 16)), gt = __uint_as_float((c & 1) ? (gg[c >> 1] & 0xffff0000u) : (gg[c >> 1] << 16));
            const float y = yl + pf * CAR[cg8 * 8 + c] + pb * CAR[64 + cg8 * 8 + c]; o[c] = y * gelu_tanh(gt); }
        u32x4 w; w.x = pk2(o[0], o[1]); w.y = pk2(o[2], o[3]); w.z = pk2(o[4], o[5]); w.w = pk2(o[6], o[7]);
        *(u32x4*)((bf16_t*)(ws + WS_MIX) + row * DM + ch0) = w;
    }
    __syncthreads();
}

DI void s5_pre_item(const float* const* in, unsigned char* ws, char* lds, int item) {
    const int tid = threadIdx.x; const int g = item >> 2, qq = item & 3;
    float* AP = (float*)lds;
    float* BB = AP + 2 * 33 * 64 * 2;
    float* CC = BB + 2 * 64 * 16 * 2;
    float* KT = CC + 2 * 16 * 64 * 2;
    const float* lam_re = in[24]; const float* lam_im = in[25]; const float* lstep = in[26];
    {
        const int p = tid & 63, d = (tid >> 6) & 1, j0 = tid >> 7;
        const float dt = __expf(lstep[d * 32 + g]); const float lr = lam_re[(d * 32 + g) * 64 + p], li = lam_im[(d * 32 + g) * 64 + p];
        for (int j = j0; j < 33; j += 4) { const float mag = __expf((float)j * lr * dt), ang = (float)j * li * dt; const int e = (d * 33 + j) * 64 + p; AP[e * 2] = mag * __cosf(ang); AP[e * 2 + 1] = mag * __sinf(ang); }
    }
    {
        float lr4[4], li4[4], br4[4], bi4[4], cr4[4], ci4[4], dt4[4];
#pragma unroll
        for (int i = 0; i < 4; ++i) { const int e = tid + i * NTHREADS; const int h = e & 15, p = (e >> 4) & 63, d = e >> 10;
            dt4[i] = lstep[d * 32 + g]; lr4[i] = lam_re[(d * 32 + g) * 64 + p]; li4[i] = lam_im[(d * 32 + g) * 64 + p];
            br4[i] = in[27][((size_t)(d * 32 + g) * 64 + p) * 16 + h]; bi4[i] = in[28][((size_t)(d * 32 + g) * 64 + p) * 16 + h];
            const int p2 = e & 63, h2 = (e >> 6) & 15; cr4[i] = in[29][((size_t)(d * 32 + g) * 16 + h2) * 64 + p2]; ci4[i] = in[30][((size_t)(d * 32 + g) * 16 + h2) * 64 + p2]; }
#pragma unroll
        for (int i = 0; i < 4; ++i) { const int e = tid + i * NTHREADS; const float dt = __expf(dt4[i]), lr = lr4[i], li = li4[i];
            const float mag = __expf(lr * dt), ang = li * dt; const float abr = mag * __cosf(ang), abi = mag * __sinf(ang);
            const float den = lr * lr + li * li, nr = abr - 1.f, ni = abi; const float kr = (nr * lr + ni * li) / den, ki = (ni * lr - nr * li) / den;
            BB[e * 2] = kr * br4[i] - ki * bi4[i]; BB[e * 2 + 1] = kr * bi4[i] + ki * br4[i]; CC[e * 2] = cr4[i]; CC[e * 2 + 1] = ci4[i]; }
    }
    __syncthreads();
    for (int task = tid; task < 64 * 16; task += NTHREADS) {
        const int dj = task >> 4, blk = task & 15, d = dj >> 5, j = dj & 31, ho0 = 4 * (blk >> 2), hi0 = 4 * (blk & 3);
        const int jmax = d == 0 ? 8 * qq + 7 : 31 - 8 * qq;
        if (j > jmax) continue;
        float acc4[4][4];
#pragma unroll
        for (int i = 0; i < 4; ++i)
#pragma unroll
            for (int k = 0; k < 4; ++k) acc4[i][k] = 0.f;
        const f32x2_t* ap = (const f32x2_t*)AP + (d * 33 + j) * 64; const f32x2_t* cp = (const f32x2_t*)CC + (d * 16 + ho0) * 64; const f32x4* bp = (const f32x4*)(BB + (size_t)(d * 64) * 16 * 2 + hi0 * 2);
#pragma unroll 2
        for (int p = 0; p < 64; ++p) {
            const f32x2_t av = ap[p]; const f32x4 b01 = bp[p * 8], b23 = bp[p * 8 + 1];
#pragma unroll
            for (int i = 0; i < 4; ++i) { const f32x2_t cv = cp[i * 64 + p]; const float xr = cv.x * av.x - cv.y * av.y, xi = cv.x * av.y + cv.y * av.x;
                acc4[i][0] += xr * b01.x - xi * b01.y; acc4[i][1] += xr * b01.z - xi * b01.w; acc4[i][2] += xr * b23.x - xi * b23.y; acc4[i][3] += xr * b23.z - xi * b23.w; }
        }
#pragma unroll
        for (int i = 0; i < 4; ++i) *(f32x4*)(KT + (d * 32 + j) * 256 + (ho0 + i) * 16 + hi0) = (f32x4){acc4[i][0], acc4[i][1], acc4[i][2], acc4[i][3]};
    }
    __syncthreads();
    bf16_t* Mg = (bf16_t*)(ws + WS_S5MF) + (size_t)g * 512 * 768; bf16_t* Eg = (bf16_t*)(ws + WS_S5E) + (size_t)g * 256 * 512; bf16_t* Fg = Mg + 512;
    const float dval = in[31][g * 16 + (tid & 15)];
    for (int e = tid; e < 128 * 512; e += NTHREADS) { const int k = e & 511, mr = e >> 9, m = qq * 128 + mr; const int t = m >> 4, ho = m & 15, tau = k >> 4, hi = k & 15;
        float v = 0.f; if (tau <= t) v += KT[(0 * 32 + (t - tau)) * 256 + ho * 16 + hi]; if (tau >= t) v += KT[(1 * 32 + (tau - t)) * 256 + ho * 16 + hi];
        if (tau == t && ho == hi) v += dval;
        Mg[(size_t)m * 768 + k] = (bf16_t)f2bf(v); }
    { const int d = qq >> 1, c = qq & 1;
      for (int e = tid; e < 64 * 512; e += NTHREADS) { const int k = e & 511, p = e >> 9, tau = k >> 4, hi = k & 15; const int j = d == 0 ? 31 - tau : tau;
          const float ar = AP[((d * 33 + j) * 64 + p) * 2], ai = AP[((d * 33 + j) * 64 + p) * 2 + 1]; const float br = BB[((d * 64 + p) * 16 + hi) * 2], bi = BB[((d * 64 + p) * 16 + hi) * 2 + 1];
          const float v = c ? (ar * bi + ai * br) : (ar * br - ai * bi);
          Eg[(size_t)(qq * 64 + p) * 512 + k] = (bf16_t)f2bf(v); } }
    for (int e = tid; e < 128 * 256; e += NTHREADS) { const int k = e & 255, mr = e >> 8, m = qq * 128 + mr, t = m >> 4, ho = m & 15; const int d = k >> 7, c = (k >> 6) & 1, p = k & 63;
        const int j = d == 0 ? t + 1 : 32 - t;
        const float ar = AP[((d * 33 + j) * 64 + p) * 2], ai = AP[((d * 33 + j) * 64 + p) * 2 + 1]; const float cr = CC[((d * 16 + ho) * 64 + p) * 2], ci = CC[((d * 16 + ho) * 64 + p) * 2 + 1];
        const float v = c ? -(cr * ai + ci * ar) : (cr * ar - ci * ai);
        Fg[(size_t)m * 768 + k] = (bf16_t)f2bf(v); }
    if (qq == 0) for (int e = tid; e < 2 * 64; e += NTHREADS) { const int p = e & 63, d = e >> 6; float* at = (float*)(ws + WS_S5AT) + ((size_t)(d * 32 + g) * 64 + p) * 2;
        at[0] = AP[((d * 33 + 32) * 64 + p) * 2]; at[1] = AP[((d * 33 + 32) * 64 + p) * 2 + 1]; }
    __syncthreads();
}
DI int s5_chunk_row(int n72) { const int b = n72 / 72, cc = n72 - b * 72; return cc < 8 ? NLAT + b * CTXL + 32 * cc : b * SEQ + 32 * (cc - 8); }
DI void s5_repack_chunk(unsigned char* ws, int n, int lane) {
    const bf16_t* src = (const bf16_t*)(ws + WS_PROJ) + (size_t)s5_chunk_row(n) * OIN + 8 * lane;
    bf16_t* dst = (bf16_t*)(ws + WS_UG) + ((size_t)(lane >> 1) * 768 + n) * 768 + (lane & 1) * 8;
    u32x4 v[8];
#pragma unroll
    for (int t0 = 0; t0 < 32; t0 += 8) {
#pragma unroll
        for (int i = 0; i < 8; ++i) v[i] = *(const u32x4*)(src + (size_t)(t0 + i) * OIN);
#pragma unroll
        for (int i = 0; i < 8; ++i) *(u32x4*)(dst + (t0 + i) * 16) = v[i];
    }
}
struct S5Order {
    int G, c, nb;
    __device__ bool next(int i, pg8::Unit& u) const { const int L = i * G + c; const int per = 3 * nb; if (L >= 32 * per) return false; const int g = L / per, r = L - g * per; u.pm = 3 * g + r / nb; u.pn = nb * g + r % nb; return true; }
    __device__ __forceinline__ void a_ready(const pg8::Unit&) const {}
    __device__ __forceinline__ void done(const pg8::Unit&) const {}
};
struct EpiS5L {
    static constexpr bool PERM = false, AFTER_DRAIN = false;
    float* L;
    __device__ __forceinline__ void operator()(const f32x4 (&acc)[2][2][4][2], const pg8::Unit& u, int wr, int wc, int fr, int fq) const {
        const int g = u.pn, mt = u.pm - 3 * g;
#pragma unroll
        for (int ai = 0; ai < 2; ++ai)
#pragma unroll
            for (int m = 0; m < 4; ++m) { const int n = mt * 256 + ai * 128 + wr * 64 + m * 16 + fr; if (n >= 576) continue;
                float* lp = L + ((size_t)n * 32 + g) * 256 + wc * 32 + 4 * fq;
#pragma unroll
                for (int bj = 0; bj < 2; ++bj)
#pragma unroll
                    for (int nn = 0; nn < 2; ++nn) *(f32x4*)(lp + bj * 128 + nn * 16) = acc[ai][bj][m][nn]; }
    }
};
struct EpiS5Y {
    static constexpr bool PERM = false, AFTER_DRAIN = false;
    bf16_t* Z;
    __device__ __forceinline__ void operator()(const f32x4 (&acc)[2][2][4][2], const pg8::Unit& u, int wr, int wc, int fr, int fq) const {
        const int g = u.pn >> 1, nh = u.pn & 1, mt = u.pm - 3 * g;
#pragma unroll
        for (int ai = 0; ai < 2; ++ai)
#pragma unroll
            for (int m = 0; m < 4; ++m) { const int n = mt * 256 + ai * 128 + wr * 64 + m * 16 + fr; const int b = n / 72, cc = n - b * 72; if (n >= 576 || cc < 8) continue;
                bf16_t* zp = Z + (size_t)(b * SEQ + 32 * (cc - 8)) * 512 + g * 16;
#pragma unroll
                for (int bj = 0; bj < 2; ++bj)
#pragma unroll
                    for (int nn = 0; nn < 2; ++nn) { const int mcol = nh * 256 + bj * 128 + wc * 32 + nn * 16 + 4 * fq, t = mcol >> 4, ho = mcol & 15; const f32x4 y = acc[ai][bj][m][nn];
                        u32x2 w; w.x = pk2(gelu_tanh(y.x), gelu_tanh(y.y)); w.y = pk2(gelu_tanh(y.z), gelu_tanh(y.w)); *(u32x2*)(zp + (size_t)t * 512 + ho) = w; } }
    }
};
DI void s5_scan_thread(unsigned char* ws, int gid) {
    const int p = gid & 63, d = (gid >> 6) & 1, g = (gid >> 7) & 31, b = gid >> 12;
    const float* at = (const float*)(ws + WS_S5AT) + ((size_t)(d * 32 + g) * 64 + p) * 2; const float ar = at[0], ai = at[1];
    const float* L = (const float*)(ws + WS_S5L); bf16_t* UG = (bf16_t*)(ws + WS_UG);
    float sr = 0.f, si = 0.f;
    for (int k0 = 0; k0 < 72; k0 += 8) {
        float lr8[8], li8[8];
#pragma unroll
        for (int i = 0; i < 8; ++i) { const int k = k0 + i; const int cc = d == 0 ? k : (k < 8 ? 7 - k : 71 - (k - 8)); const size_t lo = ((size_t)(b * 72 + cc) * 32 + g) * 256 + d * 128 + p; lr8[i] = L[lo]; li8[i] = L[lo + 64]; }
#pragma unroll
        for (int i = 0; i < 8; ++i) { const int k = k0 + i; const int cc = d == 0 ? k : (k < 8 ? 7 - k : 71 - (k - 8));
            if (cc >= 8) { bf16_t* so = UG + ((size_t)g * 768 + b * 72 + cc) * 768 + 512 + d * 128 + p; so[0] = (bf16_t)f2bf(sr); so[64] = (bf16_t)f2bf(si); }
            const float nr = ar * sr - ai * si + lr8[i], ni = ar * si + ai * sr + li8[i]; sr = nr; si = ni; }
    }
}

DI int up_row_map(int n) { return n < FH ? (n >> 7) * 256 + (n & 127) : ((n - FH) >> 7) * 256 + 128 + ((n - FH) & 127); }
DI void p0_transpose_item(const float* W, int K, int N, bf16_t* WT, bool upmap, float* scr, int item, int lane) {
    const int nblk = N / 32, kb = item / nblk, nb = item % nblk, k0 = 64 * kb, n0 = 32 * nb;
    float tv[32];
#pragma unroll
    for (int i = 0; i < 32; ++i) tv[i] = __builtin_nontemporal_load(W + (size_t)(k0 + 2 * i + (lane >> 5)) * N + n0 + (lane & 31));
#pragma unroll
    for (int i = 0; i < 32; ++i) scr[(2 * i + (lane >> 5)) * 33 + (lane & 31)] = tv[i];
    asm volatile("s_waitcnt lgkmcnt(0)" ::: "memory");
    const int c = lane & 7;
#pragma unroll
    for (int j = 0; j < 4; ++j) { const int n = (lane >> 3) + 8 * j; const float* s = scr + (8 * c) * 33 + n;
        u32x4 o; o.x = pk2(s[0 * 33], s[1 * 33]); o.y = pk2(s[2 * 33], s[3 * 33]); o.z = pk2(s[4 * 33], s[5 * 33]); o.w = pk2(s[6 * 33], s[7 * 33]);
        const int nr = upmap ? up_row_map(n0 + n) : n0 + n;
        *(u32x4*)(WT + (size_t)nr * K + k0 + 8 * c) = o; }
    asm volatile("s_waitcnt lgkmcnt(0)" ::: "memory");
}
DI void norm_row(const float* xrow, const float* g, const float* shift, const float* scale, bf16_t* o1, bf16_t* o2, int lane) {
    f32x4 v[4]; float s = 0.f;
#pragma unroll
    for (int j = 0; j < 4; ++j) { v[j] = *((const f32x4*)xrow + lane + 64 * j); s += (v[j].x * v[j].x + v[j].y * v[j].y) + (v[j].z * v[j].z + v[j].w * v[j].w); }
    const float rstd = rsqrtf(wave_sum(s) * (1.f / DM) + NORM_EPS);
#pragma unroll
    for (int j = 0; j < 4; ++j) {
        const f32x4 gg = *((const f32x4*)g + lane + 64 * j), sh = *((const f32x4*)shift + lane + 64 * j), sc = *((const f32x4*)scale + lane + 64 * j);
        const f32x4 y = (v[j] * rstd) * gg * (sc + 1.0f) + sh;
        u32x2 w; w.x = pk2(y.x, y.y); w.y = pk2(y.z, y.w);
        *((u32x2*)o1 + lane + 64 * j) = w; if (o2) *((u32x2*)o2 + lane + 64 * j) = w;
    }
}
DI bf16_t* norm_xne_ptr(bf16_t* XN, int r, int xne_row) {
    if (xne_row < 0) return nullptr;
    const bool isctx = r >= NLAT; const int t = isctx ? (r - NLAT) & 255 : r & 2047, slen = isctx ? CTXL : SEQ, s = isctx ? (r - NLAT) >> 8 : r >> 11;
    const int k = (t + 2) >> 6, pos = (t + 2) & 63;
    if (pos < 4 && k >= 1 && k <= slen / 64 - 1) { const int q = isctx ? NBND_LAT + s * 3 + (k - 1) : s * 31 + (k - 1); return XN + (size_t)(xne_row + 4 * q + pos) * DM; }
    return nullptr;
}
DI void norm_phase(const float* hL, const float* hC, const float* g, const float* mod, int ish, int isc, bf16_t* XN, int nrows, int xne_row, int gw, int NGW, int lane, const float* cadd = nullptr, float* cwb = nullptr) {
    for (int r0 = gw; r0 < nrows; r0 += 2 * NGW) {
        const int r1 = r0 + NGW; const bool has1 = r1 < nrows; const int r1c = has1 ? r1 : r0;
        const float* x0 = r0 >= NLAT ? hC + (size_t)(r0 - NLAT) * DM : hL + (size_t)r0 * DM;
        const float* x1 = r1c >= NLAT ? hC + (size_t)(r1c - NLAT) * DM : hL + (size_t)r1c * DM;
        f32x4 v0[4], v1[4];
#pragma unroll
        for (int j = 0; j < 4; ++j) { v0[j] = *((const f32x4*)x0 + lane + 64 * j); v1[j] = *((const f32x4*)x1 + lane + 64 * j); }
        if (cadd) {
#pragma unroll
            for (int j = 0; j < 4; ++j) {
                if (r0 >= NLAT) { v0[j] += *((const f32x4*)(cadd + (size_t)(r0 - NLAT) * DM) + lane + 64 * j); if (cwb) *((f32x4*)(cwb + (size_t)(r0 - NLAT) * DM) + lane + 64 * j) = v0[j]; }
                if (has1 && r1 >= NLAT) { v1[j] += *((const f32x4*)(cadd + (size_t)(r1 - NLAT) * DM) + lane + 64 * j); if (cwb) *((f32x4*)(cwb + (size_t)(r1 - NLAT) * DM) + lane + 64 * j) = v1[j]; } } }
        const int bb0 = r0 >= NLAT ? 8 : r0 >> 11, bb1 = r1c >= NLAT ? 8 : r1c >> 11;
        const float* sh0 = mod + (size_t)bb0 * 6144 + ish * 1024; const float* sc0 = mod + (size_t)bb0 * 6144 + isc * 1024;
        const float* sh1 = mod + (size_t)bb1 * 6144 + ish * 1024; const float* sc1 = mod + (size_t)bb1 * 6144 + isc * 1024;
        float s0 = 0.f, s1 = 0.f;
#pragma unroll
        for (int j = 0; j < 4; ++j) { s0 += (v0[j].x * v0[j].x + v0[j].y * v0[j].y) + (v0[j].z * v0[j].z + v0[j].w * v0[j].w); s1 += (v1[j].x * v1[j].x + v1[j].y * v1[j].y) + (v1[j].z * v1[j].z + v1[j].w * v1[j].w); }
#pragma unroll
        for (int o = 1; o < 64; o <<= 1) { s0 += __shfl_xor(s0, o); s1 += __shfl_xor(s1, o); }
        const float rs0 = rsqrtf(s0 * (1.f / DM) + NORM_EPS), rs1 = rsqrtf(s1 * (1.f / DM) + NORM_EPS);
        bf16_t* o0 = XN + (size_t)r0 * DM; bf16_t* o1 = XN + (size_t)r1c * DM; bf16_t* e0 = norm_xne_ptr(XN, r0, xne_row); bf16_t* e1 = norm_xne_ptr(XN, r1c, xne_row);
#pragma unroll
        for (int j = 0; j < 4; ++j) {
            const f32x4 gg = *((const f32x4*)g + lane + 64 * j);
            const f32x4 y0 = (v0[j] * rs0) * gg * (*((const f32x4*)sc0 + lane + 64 * j) + 1.0f) + *((const f32x4*)sh0 + lane + 64 * j);
            const f32x4 y1 = (v1[j] * rs1) * gg * (*((const f32x4*)sc1 + lane + 64 * j) + 1.0f) + *((const f32x4*)sh1 + lane + 64 * j);
            u32x2 w0, w1; w0.x = pk2(y0.x, y0.y); w0.y = pk2(y0.z, y0.w); w1.x = pk2(y1.x, y1.y); w1.y = pk2(y1.z, y1.w);
            *((u32x2*)o0 + lane + 64 * j) = w0; if (e0) *((u32x2*)e0 + lane + 64 * j) = w0;
            if (has1) { *((u32x2*)o1 + lane + 64 * j) = w1; if (e1) *((u32x2*)e1 + lane + 64 * j) = w1; }
        }
    }
}
DI void qknorm_phase(bf16_t* PROJ, int ld, int qoff, const float* qn, const float* kn, const float* rope, int gw, int NGW, int lane) {
    const int d0 = 2 * (lane & 31), hsel = lane >> 5;
    const f32x2_t gq = *(const f32x2_t*)(qn + d0), gk = *(const f32x2_t*)(kn + d0);
    const int ridx = (d0 >> 5) * 16 + (d0 & 15); const bool second = (d0 >> 4) & 1;
    for (int r = gw; r < MALL; r += NGW) {
        unsigned* p = (unsigned*)(PROJ + (size_t)r * ld + qoff) + lane;
        const bool lat = r < NLAT; f32x2_t cs = {1.f, 1.f}, sn = {0.f, 0.f};
        if (lat) { const int t = r & 2047; cs = *(const f32x2_t*)(rope + t * 32 + ridx); sn = *(const f32x2_t*)(rope + SEQ * 32 + t * 32 + ridx); }
        unsigned raw[5];
#pragma unroll
        for (int i = 0; i < 5; ++i) raw[i] = p[64 * i];
#pragma unroll
        for (int i = 0; i < 5; ++i) {
            const float a = __uint_as_float(raw[i] << 16), b = __uint_as_float(raw[i] & 0xffff0000u);
            float ss = a * a + b * b;
#pragma unroll
            for (int o = 1; o < 32; o <<= 1) ss += __shfl_xor(ss, o);
            const float rs = rsqrtf(ss * (1.f / 64.f) + NORM_EPS); const bool isq = (2 * i + hsel) < 8;
            float ya = a * rs * (isq ? gq.x : gk.x), yb = b * rs * (isq ? gq.y : gk.y);
            const float pa = __shfl_xor(ya, 8), pb = __shfl_xor(yb, 8);
            if (lat) { ya = second ? (ya * cs.x + pa * sn.x) : (ya * cs.x - pa * sn.x); yb = second ? (yb * cs.y + pb * sn.y) : (yb * cs.y - pb * sn.y); }
            if (isq) { ya *= C2; yb *= C2; }
            p[64 * i] = pk2(ya, yb);
        }
    }
}

struct Args { const float* in[37]; float* out; unsigned char* ws; int ph_lo, ph_hi; };
constexpr int NPHASE = 19;

DI void p0_mod_items(const Args& a, char* lds, int layer, int idx, int nwg) {
    const int tid = threadIdx.x, lane = tid & 63, wid = tid >> 6; unsigned char* ws = a.ws;
    float* cond = (float*)lds;
    float* red = (float*)(lds + 1024 * 12 * 4);
    if (idx < 96) for (int e = tid; e < 9 * 1024; e += NTHREADS) { const int k = e & 1023, bb = e >> 10; const float cv = bb < 8 ? a.in[1][bb * 1024 + k] : a.in[3][k]; cond[k * 12 + bb] = siluf_(cv); }
    __syncthreads();
    float* MOD = (float*)(ws + WS_MOD);
    for (int cb = idx; cb < 96; cb += nwg) {
        const int col = cb * 64 + lane;
        const float* w = a.in[4] + (size_t)layer * DM * 6144 + col;
        float acc[9];
#pragma unroll
        for (int bb = 0; bb < 9; ++bb) acc[bb] = 0.f;
        for (int kk0 = 0; kk0 < 128; kk0 += 16) {
            float wv16[16];
#pragma unroll
            for (int i = 0; i < 16; ++i) wv16[i] = __builtin_nontemporal_load(w + (size_t)(wid * 128 + kk0 + i) * 6144);
#pragma unroll
            for (int i = 0; i < 16; ++i) { const int k = wid * 128 + kk0 + i; const float wv = wv16[i];
                const f32x4 c0 = *(const f32x4*)(cond + k * 12), c1 = *(const f32x4*)(cond + k * 12 + 4); const float c8 = cond[k * 12 + 8];
                acc[0] += c0.x * wv; acc[1] += c0.y * wv; acc[2] += c0.z * wv; acc[3] += c0.w * wv; acc[4] += c1.x * wv; acc[5] += c1.y * wv; acc[6] += c1.z * wv; acc[7] += c1.w * wv; acc[8] += c8 * wv; }
        }
#pragma unroll
        for (int bb = 0; bb < 9; ++bb) red[(wid * 9 + bb) * 64 + lane] = acc[bb];
        __syncthreads();
        for (int e = tid; e < 9 * 64; e += NTHREADS) { const int bb = e >> 6, ln = e & 63; float sacc = a.in[5][layer * 6144 + cb * 64 + ln];
#pragma unroll
            for (int w8 = 0; w8 < 8; ++w8) sacc += red[(w8 * 9 + bb) * 64 + ln];
            MOD[((size_t)layer * 9 + bb) * 6144 + cb * 64 + ln] = sacc; }
        __syncthreads();
    }
}

DI void p0_transposes(const Args& a, char* lds, int layer, int w0, int nw) {
    const int lane = threadIdx.x & 63, wid = threadIdx.x >> 6; unsigned char* ws = a.ws;
    float* scr = (float*)(lds + wid * 16384);
    constexpr int I_IN0 = 16 * (EIN / 32), I_OUT = 16 * 32, I_UP = 16 * (FH2 / 32), I_DN = (FH / 64) * 32, I_IN1 = 16 * (OIN / 32), I_GLU = 8 * 16;
    if (layer == 0) {
        constexpr int NIT = I_IN0 + I_OUT;
        for (int it = w0; it < NIT; it += nw) { int r = it;
            if (r < I_IN0) { p0_transpose_item(a.in[11], DM, EIN, (bf16_t*)(ws + WS_WIN0), false, scr, r, lane); continue; } r -= I_IN0;
            p0_transpose_item(a.in[12], DM, DM, (bf16_t*)(ws + WS_WOUT0), false, scr, r, lane); }
    } else if (layer == 2) {
        constexpr int NIT = I_UP + I_DN;
        for (int it = w0; it < NIT; it += nw) { int r = it;
            if (r < I_UP) { p0_transpose_item(a.in[7], DM, FH2, (bf16_t*)(ws + WS_WUP0), true, scr, r, lane); continue; } r -= I_UP;
            p0_transpose_item(a.in[10], FH, DM, (bf16_t*)(ws + WS_WDN0), false, scr, r, lane); }
    } else {
        constexpr int NIT = I_UP + I_DN + I_IN1 + I_OUT + I_GLU;
        for (int it = w0; it < NIT; it += nw) { int r = it;
            if (r < I_UP) { p0_transpose_item(a.in[7] + (size_t)DM * FH2, DM, FH2, (bf16_t*)(ws + WS_WUP1), true, scr, r, lane); continue; } r -= I_UP;
            if (r < I_DN) { p0_transpose_item(a.in[10] + (size_t)FH * DM, FH, DM, (bf16_t*)(ws + WS_WDN1), false, scr, r, lane); continue; } r -= I_DN;
            if (r < I_IN1) { p0_transpose_item(a.in[22], DM, OIN, (bf16_t*)(ws + WS_WIN1), false, scr, r, lane); continue; } r -= I_IN1;
            if (r < I_OUT) { p0_transpose_item(a.in[23], DM, DM, (bf16_t*)(ws + WS_WOUT1), false, scr, r, lane); continue; } r -= I_OUT;
            p0_transpose_item(a.in[32], 512, 512, (bf16_t*)(ws + WS_WGLU), false, scr, r, lane); }
    }
}

DI void p0_prologue(const Args& a, char* lds, int G, int rep) {
#ifdef P0_REP_EMPTY
    if (rep == 1) return;
#endif
    const int tid = threadIdx.x, lane = tid & 63, wid = tid >> 6;
    unsigned char* ws = a.ws;
    const int gw = blockIdx.x * NWAVES + wid, NGW = G * NWAVES;
    {
        const int gt = blockIdx.x * NTHREADS + tid, NGT = G * NTHREADS;
        float* rope = (float*)(ws + WS_ROPE);
        for (int e = gt; e < SEQ * 32; e += NGT) { const int t = e >> 5, idx = e & 31, i = idx & 15; const float pos = (float)((idx < 16) ? (t >> 6) : (t & 63));
            const float invf = powf(10000.0f, -(float)i / 16.0f); const float ang = pos * invf; rope[e] = cosf(ang); rope[SEQ * 32 + e] = sinf(ang); }
        bf16_t* rgw = (bf16_t*)(ws + WS_RGW);
        for (int e = gt; e < 4 * 8 * 4096; e += NGT) { const int k = e & 63, n = (e >> 6) & 63, hd = (e >> 12) & 7, mi = e >> 15; const int d = mi >> 1;
            const float* w = (mi & 1) ? a.in[17] : a.in[15]; rgw[e] = (bf16_t)f2bf(w[((size_t)(d * 8 + hd) * 64 + k) * 64 + n]); }
    }
    __syncthreads();
    p0_mod_items(a, lds, 0, (int)blockIdx.x, G);
    __syncthreads();
    p0_transposes(a, lds, 0, gw, NGW);
}

__global__ void __launch_bounds__(NTHREADS, 2) trunk_fwd(Args a) {
    extern __shared__ __attribute__((aligned(16))) unsigned char lds_raw[];
    char* lds = (char*)lds_raw;
    PG8_LAS unsigned char* ldsl = (PG8_LAS unsigned char*)lds_raw;
    cg::grid_group grid = cg::this_grid();
    const int tid = threadIdx.x, lane = tid & 63, wid = tid >> 6, G = gridDim.x;
    const int gw = blockIdx.x * NWAVES + wid, NGW = G * NWAVES;
    unsigned char* ws = a.ws;
    const int lo = a.ph_lo, hi = a.ph_hi;
    float* MOD = (float*)(ws + WS_MOD); float* HC = (float*)(ws + WS_HC);
    bf16_t* XN = (bf16_t*)(ws + WS_XN); bf16_t* PROJ = (bf16_t*)(ws + WS_PROJ); bf16_t* MIX = (bf16_t*)(ws + WS_MIX); bf16_t* HID = (bf16_t*)(ws + WS_HID);
    const float* rope = (const float*)(ws + WS_ROPE);
    float* CP = (float*)(ws + WS_Z);
    volatile LAS unsigned* MISC = (volatile LAS unsigned*)((LAS unsigned char*)lds_raw + LDS_MISC);
    if (tid < 64) MISC[tid] = 0u;
    __syncthreads();
    XcdBarrier xbar; xbar.bar = (unsigned*)(ws + WS_CTL) + 4096; xbar.x = 0; xbar.st = nullptr;
    if (hi - lo > 1) xbar = xcd_barrier_post((unsigned*)(ws + WS_CTL) + 4096, MISC + 8);
#ifndef PHASE_MASK
#define PHASE_MASK 0x7ffff
#endif
#define IN(k) (((PHASE_MASK >> (k)) & 1) && lo <= (k) && (k) < hi)
#ifndef DUP_MASK
#define DUP_MASK 0
#endif
#define REP(k) for (int rep_ = 0; rep_ < (((DUP_MASK >> (k)) & 1) ? 2 : 1); ++rep_, (void)((((DUP_MASK >> (k)) & 1) && rep_ == 1) ? (xcd_barrier(xbar), 0) : 0))
#ifdef TIME_MASK
    unsigned long long tprev_ = __builtin_amdgcn_s_memrealtime(), tsum_ = 0ull;
#define TSTAMP(k) do { const unsigned long long tn_ = __builtin_amdgcn_s_memrealtime(); if (((TIME_MASK) >> (k)) & 1) tsum_ += tn_ - tprev_; tprev_ = tn_; } while (0)
#else
#define TSTAMP(k) do {} while (0)
#endif
#define SEAM(k) do { if (IN(k) && IN((k) + 1)) { xcd_barrier(xbar); TSTAMP(k); } } while (0)

    if (hi > 1000) grid.sync();
    if (IN(0)) REP(0) { p0_prologue(a, lds, G, rep_); } SEAM(0);
    if (IN(1)) REP(1) norm_phase(a.in[0], a.in[2], a.in[6], MOD, 0, 1, XN, MALL, -1, gw, NGW, lane);
    SEAM(1);
    if (IN(2)) REP(2) { pg8::Gemm g{XN, (const bf16_t*)(ws + WS_WIN0), MALL, EIN, DM}; pg8::StaticOrder S; S.init(MALL, EIN, G, (int)blockIdx.x);
        pg8::EpiBf16<0> E{PROJ, EIN, nullptr, 0, 0, 1.f}; pg8::gemm_phase<pg8::EpiBf16<0>, pg8::StaticOrder, true, true>(ldsl, g, S, E); }
    SEAM(2);
    if (IN(3)) { qknorm_phase(PROJ, EIN, 1024, a.in[20], a.in[21], rope, gw, NGW, lane); __syncthreads();
#ifdef DUP_RG1
        for (int rep2_ = 0; rep2_ < 2; ++rep2_)
#endif
        for (int it = blockIdx.x; it < NB * 8 * 36; it += G) rg_item1(a.in, ws, lds, it); }
    SEAM(3);
    if (IN(4)) REP(4) {
#ifndef P4_NO_ATTN
#ifdef DUP_ATT
        for (int rep2_ = 0; rep2_ < 2; ++rep2_)
#endif
        for (int it = blockIdx.x; it < 256; it += G) { const int qb = it & 3, head = (it >> 2) & 7, b = it >> 5; attn_unit<0, 2>(PROJ, EIN, 1024, 1536, 1664, MIX, lds, b, head, qb * 512, 0.f); }
        for (int it = blockIdx.x; it < 64; it += G) { const int head = it & 7, b = it >> 3; attn_unit<1, 1>(PROJ, EIN, 1024, 1536, 1664, MIX, lds, b, head, 0, 0.f); }
#endif
#ifndef P4_NO_RG
        for (int it = (blockIdx.x + G - 64) % G; it < NB * 8 * 36; it += G) rg_item2(a.in, ws, lds, it);
#endif
    }
    SEAM(4);
    if (IN(5)) REP(5) { { pg8::Gemm g{MIX, (const bf16_t*)(ws + WS_WOUT0), NLAT, DM, DM}; pg8::StaticOrder S; S.init(NLAT, DM, G, (int)blockIdx.x);
          EpiRes E{a.in[0], a.in[2], a.out, HC, MOD + 2 * 1024}; pg8::gemm_phase<EpiRes, pg8::StaticOrder, true, true>(ldsl, g, S, E); }
#pragma unroll 1
        for (int kh = 0; kh < 2; ++kh) {
          pg8::Gemm g{MIX + kh * 512, (const bf16_t*)(ws + WS_WOUT0) + kh * 512, MALL, DM, 512, DM, DM}; CtxOrder S{(int)blockIdx.x - 64 * kh};
          EpiCtxHalf E{a.in[2], HC, CP, MOD + 2 * 1024, kh}; pg8::gemm_phase<EpiCtxHalf, CtxOrder, true, true>(ldsl, g, S, E); } }
    if (IN(5)) { const int bx = blockIdx.x; const bool busy = (bx < 32) || (bx >= 64 && bx < 96);
        if (G == 256) { if (!busy) { const int idx = bx < 64 ? bx - 32 : bx - 64; p0_transposes(a, lds, 2, idx * NWAVES + wid, 192 * NWAVES); } }
        else p0_transposes(a, lds, 2, gw, NGW); }
    SEAM(5);
    if (IN(6)) REP(6) norm_phase(a.out, HC, a.in[6] + DM, MOD, 3, 4, XN, MALL, XNE_ROW_L0, gw, NGW, lane, CP, HC);
    SEAM(6);
    if (IN(7)) REP(7) { constexpr int MT = MALL + 1280; pg8::Gemm g{XN, (const bf16_t*)(ws + WS_WUP0), MT, FH2, DM}; pg8::StaticOrder S; S.init(MT, FH2, G, (int)blockIdx.x);
        EpiConvAct E{HID, a.in[8], a.in[9], MALL / 256, NBND_LAT, NBND_LAT + NBND_CTX, lds + 131072}; pg8::gemm_phase<EpiConvAct, pg8::StaticOrder, true, true>(ldsl, g, S, E); }
    if (IN(7)) { constexpr int NU = ((MALL + 1280) / 256) * (FH2 / 256), NFULL = NU % 256;
        if (G == 256 && (int)blockIdx.x >= NFULL) p0_transposes(a, lds, 1, ((int)blockIdx.x - NFULL) * NWAVES + wid, (256 - NFULL) * NWAVES);
        else if (G != 256) p0_transposes(a, lds, 1, gw, NGW); }
    SEAM(7);
    if (IN(8)) { { pg8::Gemm g{HID, (const bf16_t*)(ws + WS_WDN0), NLAT, DM, FH}; pg8::StaticOrder S; S.init(NLAT, DM, G, (int)blockIdx.x);
          EpiRes E{a.out, HC, a.out, HC, MOD + 5 * 1024}; pg8::gemm_phase<EpiRes, pg8::StaticOrder, true, true>(ldsl, g, S, E); }
#pragma unroll 1
        for (int kh = 0; kh < 2; ++kh) {
          pg8::Gemm g{HID + kh * (FH / 2), (const bf16_t*)(ws + WS_WDN0) + kh * (FH / 2), MALL, DM, FH / 2, FH, FH}; CtxOrder S{(int)blockIdx.x - 64 * kh};
          EpiCtxHalf E{HC, HC, CP, MOD + 5 * 1024, kh}; pg8::gemm_phase<EpiCtxHalf, CtxOrder, true, true>(ldsl, g, S, E); } }
    if (IN(8)) { const int bx = blockIdx.x; const bool busy = (bx < 32) || (bx >= 64 && bx < 96);
        if (G == 256) { if (!busy) { const int idx = bx < 64 ? bx - 32 : bx - 64; if (idx < 128) s5_pre_item(a.in, ws, lds, idx); else p0_mod_items(a, lds, 1, idx - 128, 64); } }
        else { for (int it = bx; it < 128; it += G) s5_pre_item(a.in, ws, lds, it); p0_mod_items(a, lds, 1, bx, G); } }
    SEAM(8);
    const float* MOD1 = MOD + 9 * 6144;
    if (IN(9)) REP(9) norm_phase(a.out, HC, a.in[6] + 2 * DM, MOD1, 0, 1, XN, MALL, -1, gw, NGW, lane, CP, nullptr);
    SEAM(9);
    if (IN(10)) REP(10) { pg8::Gemm g{XN, (const bf16_t*)(ws + WS_WIN1), MALL, OIN, DM}; pg8::StaticOrder S; S.init(MALL, OIN, G, (int)blockIdx.x);
        pg8::EpiBf16<0> E{PROJ, OIN, nullptr, 0, 0, 1.f}; pg8::gemm_phase<pg8::EpiBf16<0>, pg8::StaticOrder, true, true>(ldsl, g, S, E); }
    SEAM(10);
    if (IN(11)) { qknorm_phase(PROJ, OIN, 512, a.in[34], a.in[35], rope, gw, NGW, lane);
        for (int n = gw; n < 576; n += NGW) s5_repack_chunk(ws, n, lane);
        xcd_barrier(xbar);
        pg8::Gemm g{(const bf16_t*)(ws + WS_UG), (const bf16_t*)(ws + WS_S5E), 32 * 768, 32 * 256, 512, 768, 512}; S5Order S{G, (int)blockIdx.x, 1};
        EpiS5L E{(float*)(ws + WS_S5L)}; pg8::gemm_phase<EpiS5L, S5Order, true, true>(ldsl, g, S, E); }
    SEAM(11);
    if (IN(12)) REP(12) {
        { const int gt = blockIdx.x * NTHREADS + tid; if (gt < NB * 32 * 2 * 64) s5_scan_thread(ws, gt); }
        __syncthreads();
        const int nskip = (NB * 32 * 2 * 64) / NTHREADS;
        for (int it = (blockIdx.x + G - nskip) % G; it < 512; it += G) { const int qb = it & 7, head = (it >> 3) & 7, b = it >> 6;
            attn_unit<2, 1>(PROJ, OIN, 512, 1024, 1152, MIX, lds, b, head, qb * 256, a.in[36][head] * 1.4426950408889634f); }
    }
    SEAM(12);
    if (IN(13)) REP(13) { pg8::Gemm g{(const bf16_t*)(ws + WS_UG), (const bf16_t*)(ws + WS_S5MF), 32 * 768, 32 * 512, 768, 768, 768}; S5Order S{G, (int)blockIdx.x, 2};
        EpiS5Y E{(bf16_t*)(ws + WS_Z)}; pg8::gemm_phase<EpiS5Y, S5Order, true, true>(ldsl, g, S, E); }
    SEAM(13);
    if (IN(14)) REP(14) { pg8::Gemm g{(const bf16_t*)(ws + WS_Z), (const bf16_t*)(ws + WS_WGLU), NLAT, 512, 512}; pg8::StaticOrder S; S.init(NLAT, 512, G, (int)blockIdx.x);
        EpiGlu E{(const bf16_t*)(ws + WS_Z), MIX, a.in[33]}; pg8::gemm_phase<EpiGlu, pg8::StaticOrder, true, true>(ldsl, g, S, E); }
    SEAM(14);
    if (IN(15)) { pg8::Gemm g{MIX, (const bf16_t*)(ws + WS_WOUT1), NLAT, DM, DM}; pg8::StaticOrder S; S.init(NLAT, DM, G, (int)blockIdx.x);
        EpiRes E{a.out, HC, a.out, HC, MOD1 + 2 * 1024}; pg8::gemm_phase<EpiRes, pg8::StaticOrder, true, true>(ldsl, g, S, E); }
    SEAM(15);
    if (IN(16)) REP(16) norm_phase(a.out, HC, a.in[6] + 3 * DM, MOD1, 3, 4, XN, NLAT, XNE_ROW_L1, gw, NGW, lane);
    SEAM(16);
    if (IN(17)) REP(17) { constexpr int MT = NLAT + 1024; pg8::Gemm g{XN, (const bf16_t*)(ws + WS_WUP1), MT, FH2, DM}; pg8::StaticOrder S; S.init(MT, FH2, G, (int)blockIdx.x);
        EpiConvAct E{HID, a.in[8] + 3 * FH2, a.in[9] + FH2, NLAT / 256, NBND_LAT, NBND_LAT, lds + 131072}; pg8::gemm_phase<EpiConvAct, pg8::StaticOrder, true, true>(ldsl, g, S, E); }
    SEAM(17);
    if (IN(18)) { pg8::Gemm g{HID, (const bf16_t*)(ws + WS_WDN1), NLAT, DM, FH}; pg8::StaticOrder S; S.init(NLAT, DM, G, (int)blockIdx.x);
        EpiRes E{a.out, HC, a.out, HC, MOD1 + 5 * 1024}; pg8::gemm_phase<EpiRes, pg8::StaticOrder, true, true>(ldsl, g, S, E); }
#ifdef TIME_MASK
    xcd_barrier(xbar); TSTAMP(18);
    if (blockIdx.x == 0 && tid == 0) a.out[0] = 1e4f * ((float)tsum_ * 0.01f);
#endif
#undef IN
#undef SEAM
}

#ifndef N_LAUNCH_MODE
#define N_LAUNCH_MODE 1
#endif
extern "C" void kernel_launch(void* const* d_in, const int* in_sizes, int n_in, void* d_out, int out_size, void* d_ws, size_t ws_size, hipStream_t stream) {
    static int grid = 0;
    if (grid == 0) {
        if (n_in != 37 || out_size != NLAT * DM || ws_size < WS_END) { fprintf(stderr, "kernel_launch: unexpected problem (n_in %d out %d ws %zu)\n", n_in, out_size, ws_size); grid = -1; return; }
        int dev = 0, cus = 0, per_cu = 0;
        hipGetDevice(&dev); hipDeviceGetAttribute(&cus, hipDeviceAttributeMultiprocessorCount, dev);
        if (hipFuncSetAttribute((const void*)trunk_fwd, hipFuncAttributeMaxDynamicSharedMemorySize, LDS_BYTES) != hipSuccess) { fprintf(stderr, "kernel_launch: hipFuncSetAttribute failed\n"); grid = -1; return; }
        if (hipOccupancyMaxActiveBlocksPerMultiprocessor(&per_cu, (const void*)trunk_fwd, NTHREADS, LDS_BYTES) != hipSuccess || per_cu < 1) { fprintf(stderr, "kernel_launch: occupancy query says %d\n", per_cu); per_cu = 1; }
        (void)hipGetLastError();
        grid = cus;
        fprintf(stderr, "kernel_launch: grid %d (cus %d, per_cu %d)\n", grid, cus, per_cu);
    }
    if (grid < 0) return;
    (void)hipMemsetAsync((char*)d_ws + WS_CTL, 0, CTL_ZERO_BYTES, stream);
    Args a{};
    for (int i = 0; i < 37; ++i) a.in[i] = (const float*)d_in[i];
    a.out = (float*)d_out; a.ws = (unsigned char*)d_ws;
#if N_LAUNCH_MODE == 1
    a.ph_lo = 0; a.ph_hi = NPHASE;
    void* args[] = {&a};
    hipError_t e = hipLaunchCooperativeKernel((const void*)trunk_fwd, dim3(grid), dim3(NTHREADS), args, LDS_BYTES, stream);
    if (e != hipSuccess) fprintf(stderr, "cooperative launch failed: %s (grid %d)\n", hipGetErrorString(e), grid);
#else
    for (int p = 0; p < NPHASE; ++p) { a.ph_lo = p; a.ph_hi = p + 1; hipLaunchKernelGGL(trunk_fwd, dim3(grid), dim3(NTHREADS), LDS_BYTES, stream, a);
#ifdef DBG_CHECK
        Args d = a; d.ph_lo = 0; d.ph_hi = 0;
        static const int chk[NPHASE][2] = {{1,0},{0,0},{2,0},{3,0},{4,5},{6,0},{0,0},{7,8},{0,0},{0,0},{9,0},{10,0},{11,0},{12,0},{15,0},{0,0},{0,0},{14,0},{0,0}};
        for (int q = 0; q < 2; ++q) { const int st = chk[p][q]; if (!st) continue; const bool heavy = (st == 5 || st == 12); hipLaunchKernelGGL(dbg_check, dim3(heavy ? 1 : 4), dim3(heavy ? 64 : 256), 0, stream, d, st); }
        if (p == NPHASE - 1) hipLaunchKernelGGL(dbg_report, dim3(1), dim3(64), 0, stream, d);
#endif
    }
#endif
}
```

```cpp
#include <hip/hip_runtime.h>
#include <hip/hip_cooperative_groups.h>
#include <hip/hip_bf16.h>
#include <cstdio>
#include <cstdint>
#include <cmath>
namespace cg = cooperative_groups;
namespace pg8 {
#define PG8_LAS __attribute__((address_space(3)))
typedef unsigned short bf16_t;
typedef short bf16x8 __attribute__((ext_vector_type(8)));
typedef float f32x4 __attribute__((ext_vector_type(4)));
typedef unsigned u32x4 __attribute__((ext_vector_type(4)));
constexpr int BM = 256, BK = 64, HALF = 128, HTB = HALF * BK * 2  , STAGE_BYTES = 8 * HTB, NXCD = 8, WGM = 8;

__host__ __device__ __forceinline__ int lds_byte(int r, int c) { const int st = (r >> 4) * 2 + (c >> 5), rr = r & 15, cc = c & 31, ob = rr * 64 + cc * 2; return st * 1024 + (ob ^ (((ob >> 9) & 1) << 5)); }
__host__ __device__ __forceinline__ void stage_rc(int b, int& R, int& C) { const int st = b / 1024, sb = b % 1024, swz = sb ^ (((sb >> 9) & 1) << 5); R = (st >> 1) * 16 + swz / 64; C = (st & 1) * 32 + (swz % 64) / 2; }
__host__ __device__ __forceinline__ int perm32(int rho) { const int n = rho >> 4, i = rho & 15; return 8 * (i >> 2) + 4 * n + (i & 3); }

struct Unit { int pm, pn; };
struct Gemm { const bf16_t* A; const bf16_t* Bt; int M, N, K; int lda, ldb; };

struct StaticOrder {
    int nM, nN, nwg, G, c;
    __host__ __device__ void init(int M, int N, int G_, int c_) { nM = M / BM; nN = N / BM; nwg = nM * nN; G = G_; c = c_; }
    __host__ __device__ bool next(int i, Unit& u) const {
        const long L = (long)i * G + c; if (L >= nwg) return false;
        int wgid = (int)L; { const int q = nwg / NXCD, r = nwg % NXCD, xcd = wgid % NXCD, off = wgid / NXCD; wgid = (xcd < r ? xcd * (q + 1) : r * (q + 1) + (xcd - r) * q) + off; }
        const int nig = WGM * nN, gid = wgid / nig, fm = gid * WGM, gsz = (nM - fm) < WGM ? (nM - fm) : WGM;
        u.pm = fm + ((wgid % nig) % gsz); u.pn = (wgid % nig) / gsz; return true;
    }
    __device__ __forceinline__ void a_ready(const Unit&) const {}
    __device__ __forceinline__ void done(const Unit&) const {}
};

__device__ __forceinline__ unsigned cvt_pk_bf16(float lo, float hi) { unsigned r; asm volatile("v_cvt_pk_bf16_f32 %0, %1, %2" : "=v"(r) : "v"(lo), "v"(hi)); return r; }
typedef float f32x2 __attribute__((ext_vector_type(2)));
__device__ __forceinline__ f32x2 gelu_pk(f32x2 v) {
    const f32x2 av = __builtin_elementwise_abs(v), d = av * 0.2316418882f + 1.0f;
    f32x2 t; t.x = __builtin_amdgcn_rcpf(d.x); t.y = __builtin_amdgcn_rcpf(d.y);
    f32x2 q = t * 0.5307027145f + (-0.7265760135f); q = q * t + 0.7107068705f; q = q * t + (-0.142248368f); q = q * t + 0.127414796f; q = q * t;
    const f32x2 s = (v * v) * (-0.72134752044f);
    f32x2 e; e.x = __builtin_amdgcn_exp2f(s.x); e.y = __builtin_amdgcn_exp2f(s.y);
    const f32x2 m = v * (q * e), r = v - m;
    f32x2 o; o.x = v.x < 0.f ? m.x : r.x; o.y = v.y < 0.f ? m.y : r.y; return o;
}
template <int ACT  > struct EpiBf16 {
    static constexpr bool PERM = true, AFTER_DRAIN = false; static_assert(ACT == 0 || ACT == 1, "EpiBf16: ACT is 0 (none) or 1 (gelu_pk)");
    bf16_t* O; int ldc; const float* bias; int split_cols; size_t split_stride; float scale0;
    __device__ __forceinline__ void operator()(const f32x4 (&acc)[2][2][4][2], const Unit& u, int wr, int wc, int fr, int fq) const {
        const int row0 = u.pm * BM + wr * 64 + fr; int colt = u.pn * BM; bf16_t* base = O;
        float sc = 1.f; if (split_cols) { const int t = colt / split_cols; base += (size_t)t * split_stride; colt -= t * split_cols; if (t == 0) sc = scale0; }
        const int col0 = colt + wc * 32 + 8 * fq, bcol0 = u.pn * BM + wc * 32 + 8 * fq;
        f32x4 bv[2][2];
#pragma unroll
        for (int bj = 0; bj < 2; ++bj)
#pragma unroll
            for (int n = 0; n < 2; ++n) bv[bj][n] = bias ? *(const f32x4*)(bias + bcol0 + bj * HALF + 4 * n) : (f32x4){0.f, 0.f, 0.f, 0.f};
#pragma unroll
        for (int ai = 0; ai < 2; ++ai)
#pragma unroll
            for (int m = 0; m < 4; ++m) { bf16_t* rowp = base + (size_t)(row0 + ai * HALF + m * 16) * ldc + col0;
#pragma unroll
                for (int bj = 0; bj < 2; ++bj) { f32x4 v0 = acc[ai][bj][m][0] + bv[bj][0], v1 = acc[ai][bj][m][1] + bv[bj][1];
                    if (ACT == 1) { f32x2 a = gelu_pk((f32x2){v0[0], v0[1]}), b = gelu_pk((f32x2){v0[2], v0[3]}), c = gelu_pk((f32x2){v1[0], v1[1]}), d = gelu_pk((f32x2){v1[2], v1[3]});
                        v0 = (f32x4){a.x, a.y, b.x, b.y}; v1 = (f32x4){c.x, c.y, d.x, d.y}; }
                    v0 = v0 * sc; v1 = v1 * sc; u32x4 w; w.x = cvt_pk_bf16(v0[0], v0[1]); w.y = cvt_pk_bf16(v0[2], v0[3]); w.z = cvt_pk_bf16(v1[0], v1[1]); w.w = cvt_pk_bf16(v1[2], v1[3]);
                    *(u32x4*)(rowp + bj * HALF) = w; } }
    }
};
template <class Epi, class Sched, bool ALIGN_EPI = false, bool SP2 = false>
__device__ __forceinline__ void gemm_phase(PG8_LAS unsigned char* lds, const Gemm g, const Sched& S, const Epi& E) {
    const int tid = threadIdx.x, wid = __builtin_amdgcn_readfirstlane(tid >> 6), lane = tid & 63, wr = wid >> 2, wc = wid & 3, fr = lane & 15, fq = lane >> 4;
    const int K = g.K, nt = K / BK; const int lda = g.lda ? g.lda : K, ldb = g.ldb ? g.ldb : K;
    unsigned voffA[2], voffB[2];
#pragma unroll
    for (int i = 0; i < 2; ++i) { int R, C; stage_rc(tid * 16 + i * 8192, R, C); const int Rb = Epi::PERM ? ((R & ~31) + perm32(R & 31)) : R;
        voffA[i] = (unsigned)(R * lda + C) * 2u; voffB[i] = (unsigned)(Rb * ldb + C) * 2u; }
    const size_t kstep = (size_t)(BK * 2);
    const size_t hsA = (size_t)HALF * lda * 2, hsB = (size_t)HALF * ldb * 2;
    const size_t tsA = 2 * hsA, tsB = 2 * hsB;
    const unsigned ldsw = (unsigned)wid * 1024u;
    const int aoff = lds_byte(wr * 64 + fr, fq * 8), boff = lds_byte(wc * 32 + fr, fq * 8);
#define PG8_SA(b, h) (((b) * 2 + (h)) * HTB)
#define PG8_SB(b, h) ((4 + (b) * 2 + (h)) * HTB)
#define PG8_STAGE(bufoff, gbase, voff) do { _Pragma("unroll") for (int _i = 0; _i < 2; ++_i) \
        __builtin_amdgcn_global_load_lds((const unsigned*)((const char*)(gbase) + (voff)[_i]), (PG8_LAS unsigned*)(lds + (bufoff) + ldsw + _i * 8192), 16, 0, 0); } while (0)
#define PG8_LDA(dst, b, h) do { _Pragma("unroll") for (int m = 0; m < 4; ++m) _Pragma("unroll") for (int k = 0; k < 2; ++k) dst[m][k] = *(const PG8_LAS bf16x8*)(lds + PG8_SA(b, h) + aoff + m * 2048 + k * 1024); } while (0)
#define PG8_LDB(dst, b, h) do { _Pragma("unroll") for (int n = 0; n < 2; ++n) _Pragma("unroll") for (int k = 0; k < 2; ++k) dst[n][k] = *(const PG8_LAS bf16x8*)(lds + PG8_SB(b, h) + boff + n * 2048 + k * 1024); } while (0)
#define PG8_MMA(ai, bj, At, Bt) do { __builtin_amdgcn_s_setprio(1); _Pragma("unroll") for (int m = 0; m < 4; ++m) _Pragma("unroll") for (int n = 0; n < 2; ++n) _Pragma("unroll") for (int k = 0; k < 2; ++k) \
        acc[ai][bj][m][n] = __builtin_amdgcn_mfma_f32_16x16x32_bf16(Bt[n][k], At[m][k], acc[ai][bj][m][n], 0, 0, 0); __builtin_amdgcn_s_setprio(0); } while (0)
#define PG8_WAIT_V(n) asm volatile("s_waitcnt vmcnt(" #n ")" ::: "memory")
#define PG8_WAIT_L(n) asm volatile("s_waitcnt lgkmcnt(" #n ")" ::: "memory")
#define PG8_BAR __builtin_amdgcn_s_barrier()
#define PG8_SCHED __builtin_amdgcn_sched_barrier(0)
    Unit cur, nxt; int ui = 0;
    if (!S.next(0, cur)) return;
    f32x4 acc[2][2][4][2];
#pragma unroll
    for (int a = 0; a < 2; ++a)
#pragma unroll
        for (int b = 0; b < 2; ++b)
#pragma unroll
            for (int m = 0; m < 4; ++m)
#pragma unroll
                for (int n = 0; n < 2; ++n) acc[a][b][m][n] = (f32x4){0.f, 0.f, 0.f, 0.f};
    bf16x8 At[4][2], B0[2][2], B1[2][2];
    const char* cA = (const char*)g.A + (size_t)cur.pm * tsA; const char* cB = (const char*)g.Bt + (size_t)cur.pn * tsB;
    S.a_ready(cur);
    if constexpr (SP2) {
        PG8_STAGE(PG8_SB(0, 0), cB, voffB); PG8_STAGE(PG8_SB(0, 1), cB + hsB, voffB); PG8_STAGE(PG8_SA(0, 0), cA, voffA); PG8_STAGE(PG8_SA(0, 1), cA + hsA, voffA);
        if (wr == 1) PG8_BAR;
        PG8_WAIT_V(2); PG8_BAR;
        PG8_STAGE(PG8_SB(1, 0), cB + kstep, voffB); PG8_STAGE(PG8_SA(1, 0), cA + kstep, voffA); PG8_STAGE(PG8_SB(1, 1), cB + hsB + kstep, voffB);
        PG8_WAIT_V(6); PG8_BAR;
    } else {
        PG8_STAGE(PG8_SB(0, 0), cB, voffB); PG8_STAGE(PG8_SA(0, 0), cA, voffA); PG8_STAGE(PG8_SB(0, 1), cB + hsB, voffB); PG8_STAGE(PG8_SA(0, 1), cA + hsA, voffA);
        if (wr == 1) PG8_BAR;
        PG8_WAIT_V(4); PG8_BAR;
        PG8_STAGE(PG8_SB(1, 0), cB + kstep, voffB); PG8_STAGE(PG8_SA(1, 0), cA + kstep, voffA); PG8_STAGE(PG8_SB(1, 1), cB + hsB + kstep, voffB);
        PG8_WAIT_V(6); PG8_BAR;
    }
    for (;;) {
        const bool has_next = S.next(ui + 1, nxt);
        const char* nA = has_next ? (const char*)g.A + (size_t)nxt.pm * tsA : cA; const char* nB = has_next ? (const char*)g.Bt + (size_t)nxt.pn * tsB : cB;
        for (int t = 0; t < nt; t += 2) {
            const bool last = (t == nt - 2);
            const char* a1 = cA + (size_t)(t + 1) * kstep;
            const char* a2 = last ? nA : cA + (size_t)(t + 2) * kstep; const char* b2 = last ? nB : cB + (size_t)(t + 2) * kstep;
            const char* a3 = a2 + kstep; const char* b3 = b2 + kstep;
            if (last && has_next) S.a_ready(nxt);
            if constexpr (SP2) {
            PG8_LDB(B0, 0, 0); PG8_LDB(B1, 0, 1); PG8_SCHED; PG8_LDA(At, 0, 0); PG8_STAGE(PG8_SA(1, 1), a1 + hsA, voffA);
            PG8_WAIT_V(8); PG8_WAIT_L(0); PG8_BAR; PG8_MMA(0, 0, At, B0); PG8_MMA(0, 1, At, B1); PG8_BAR; PG8_SCHED;
            PG8_LDA(At, 0, 1); PG8_STAGE(PG8_SB(0, 0), b2, voffB); PG8_STAGE(PG8_SB(0, 1), b2 + hsB, voffB); PG8_STAGE(PG8_SA(0, 0), a2, voffA);
            PG8_WAIT_V(8); PG8_WAIT_L(0); PG8_BAR; PG8_MMA(1, 0, At, B0); PG8_MMA(1, 1, At, B1); PG8_BAR; PG8_SCHED;
            PG8_LDB(B0, 1, 0); PG8_LDB(B1, 1, 1); PG8_SCHED; PG8_LDA(At, 1, 0); PG8_STAGE(PG8_SA(0, 1), a2 + hsA, voffA);
            PG8_WAIT_V(8); PG8_WAIT_L(0); PG8_BAR; PG8_MMA(0, 0, At, B0); PG8_MMA(0, 1, At, B1); PG8_BAR; PG8_SCHED;
            PG8_LDA(At, 1, 1); PG8_STAGE(PG8_SB(1, 0), b3, voffB); PG8_STAGE(PG8_SB(1, 1), b3 + hsB, voffB); PG8_STAGE(PG8_SA(1, 0), a3, voffA);
            PG8_WAIT_V(8); PG8_WAIT_L(0); PG8_BAR; PG8_MMA(1, 0, At, B0); PG8_MMA(1, 1, At, B1); PG8_BAR; PG8_SCHED;
            } else {
            PG8_LDB(B0, 0, 0); PG8_SCHED; PG8_LDA(At, 0, 0); PG8_STAGE(PG8_SA(1, 1), a1 + hsA, voffA);
            PG8_WAIT_L(8); PG8_BAR; PG8_WAIT_L(0); PG8_MMA(0, 0, At, B0); PG8_BAR; PG8_SCHED;
            PG8_LDB(B1, 0, 1); PG8_STAGE(PG8_SB(0, 0), b2, voffB);
            PG8_BAR; PG8_WAIT_L(0); PG8_MMA(0, 1, At, B1); PG8_BAR;
            PG8_LDA(At, 0, 1); PG8_STAGE(PG8_SA(0, 0), a2, voffA);
            PG8_BAR; PG8_WAIT_L(0); PG8_MMA(1, 0, At, B0); PG8_BAR; PG8_SCHED;
            PG8_STAGE(PG8_SB(0, 1), b2 + hsB, voffB);
            PG8_WAIT_V(6); PG8_BAR; PG8_MMA(1, 1, At, B1); PG8_BAR;
            PG8_LDB(B0, 1, 0); PG8_SCHED; PG8_LDA(At, 1, 0); PG8_STAGE(PG8_SA(0, 1), a2 + hsA, voffA);
            PG8_WAIT_L(8); PG8_BAR; PG8_WAIT_L(0); PG8_MMA(0, 0, At, B0); PG8_BAR; PG8_SCHED;
            PG8_LDB(B1, 1, 1); PG8_STAGE(PG8_SB(1, 0), b3, voffB);
            PG8_BAR; PG8_WAIT_L(0); PG8_MMA(0, 1, At, B1); PG8_BAR;
            PG8_LDA(At, 1, 1); PG8_STAGE(PG8_SA(1, 0), a3, voffA);
            PG8_BAR; PG8_WAIT_L(0); PG8_MMA(1, 0, At, B0); PG8_BAR; PG8_SCHED;
            PG8_STAGE(PG8_SB(1, 1), b3 + hsB, voffB);
            PG8_WAIT_V(6); PG8_BAR; PG8_MMA(1, 1, At, B1); PG8_BAR;
            }
        }
        if constexpr (ALIGN_EPI) { if (wr == 0) PG8_BAR; }
        if constexpr (!Epi::AFTER_DRAIN) { E(acc, cur, wr, wc, fr, fq); S.done(cur); }
        if (!has_next) break;
#pragma unroll
        for (int a = 0; a < 2; ++a)
#pragma unroll
            for (int b = 0; b < 2; ++b)
#pragma unroll
                for (int m = 0; m < 4; ++m)
#pragma unroll
                    for (int n = 0; n < 2; ++n) acc[a][b][m][n] = (f32x4){0.f, 0.f, 0.f, 0.f};
        cur = nxt; cA = nA; cB = nB; ++ui;
        if constexpr (ALIGN_EPI) { if (wr == 1) PG8_BAR; }
    }
    PG8_WAIT_V(0);
    if constexpr (!ALIGN_EPI) { if (wr == 0) PG8_BAR; }
    PG8_BAR;
    if constexpr (Epi::AFTER_DRAIN) { E.fused(acc, cur, wr, wc, fr, fq, lds, wid, lane); S.done(cur); }
#undef PG8_SA
#undef PG8_SB
#undef PG8_STAGE
#undef PG8_LDA
#undef PG8_LDB
#undef PG8_MMA
#undef PG8_WAIT_V
#undef PG8_WAIT_L
#undef PG8_BAR
#undef PG8_SCHED
}
}

#define DI __device__ __forceinline__
typedef pg8::bf16_t bf16_t;
typedef short bf16x8 __attribute__((ext_vector_type(8)));
typedef short s16x4 __attribute__((ext_vector_type(4)));
typedef float f32x4 __attribute__((ext_vector_type(4)));
typedef float f32x16 __attribute__((ext_vector_type(16)));
typedef unsigned u32x4 __attribute__((ext_vector_type(4)));
typedef unsigned u32x2 __attribute__((ext_vector_type(2)));
#define LAS __attribute__((address_space(3)))
typedef float f32x2_t __attribute__((ext_vector_type(2)));

constexpr int DM = 1024, NB = 8, SEQ = 2048, CTXL = 256;
constexpr int NLAT = NB * SEQ, NCTX = NB * CTXL, MALL = NLAT + NCTX;
constexpr int FH = 2816, FH2 = 5632, EIN = 1792, OIN = 1280;
constexpr float NORM_EPS = 1e-6f;
constexpr float C2 = 0.125f * 1.4426950408889634f;
constexpr int NTHREADS = 512, NWAVES = 8;
constexpr int LDS_BYTES = 147456 + 8192 + 256, LDS_MISC = 147456 + 8192;
constexpr int NBND_LAT = NB * 31, NBND_CTX = NB * 3;
constexpr int XNE_ROW_L0 = MALL, XNE_ROW_L1 = NLAT;
constexpr int XN_ROWS = MALL + 1280;

constexpr size_t MiB = 1u << 20;
constexpr size_t WS_CTL = 0, CTL_ZERO_BYTES = 64 * 1024;
constexpr size_t WS_MOD = 1 * MiB;
constexpr size_t WS_ROPE = 2 * MiB;
constexpr size_t WS_RGW = 3 * MiB;
constexpr size_t WS_S5AT = 3 * MiB + 512 * 1024;
constexpr size_t WS_RGTOT = 4 * MiB;
constexpr size_t WS_S5E = 7 * MiB, WS_S5MF = 15 * MiB;
constexpr size_t WS_WIN0 = 39 * MiB, WS_WOUT0 = 43 * MiB, WS_WUP0 = 45 * MiB, WS_WDN0 = 56 * MiB;
constexpr size_t WS_WIN1 = 62 * MiB, WS_WOUT1 = 65 * MiB, WS_WUP1 = 67 * MiB, WS_WDN1 = 78 * MiB, WS_WGLU = 84 * MiB;
constexpr size_t WS_HC = 85 * MiB;
constexpr size_t WS_XN = 93 * MiB;
constexpr size_t WS_PROJ = 132 * MiB;
constexpr size_t WS_S5L = 177 * MiB;
constexpr size_t WS_MIX = 195 * MiB;
constexpr size_t WS_HID = 132 * MiB;
constexpr size_t WS_UG = WS_XN;
constexpr size_t WS_Z = 231 * MiB;
constexpr size_t WS_END = 250 * MiB;
static_assert(WS_XN + (size_t)XN_ROWS * DM * 2 <= WS_PROJ, "xn");
static_assert(WS_PROJ + (size_t)MALL * OIN * 2 <= WS_S5L && WS_S5L + (size_t)576 * 32 * 256 * 4 <= WS_MIX, "s5l");
static_assert((size_t)2 * MALL * 512 * 2 <= (size_t)XN_ROWS * DM * 2 && WS_Z + (size_t)MALL * 512 * 2 <= WS_END && WS_MIX + (size_t)MALL * DM * 2 <= WS_Z, "rg scratch");
static_assert(WS_HID + (size_t)MALL * FH * 2 <= WS_Z && WS_Z + (size_t)NLAT * 512 * 2 <= WS_END && (size_t)32 * 768 * 768 * 2 <= (size_t)XN_ROWS * DM * 2, "hid/z/ug");

DI float bf2f(bf16_t v) { return __uint_as_float((unsigned)v << 16); }
DI unsigned f2bf(float f) { unsigned u = __float_as_uint(f); return (u + 0x7fffu + ((u >> 16) & 1u)) >> 16; }
DI unsigned pk2(float lo, float hi) { return f2bf(lo) | (f2bf(hi) << 16); }
typedef __bf16 bf16x2v_t __attribute__((ext_vector_type(2)));
DI unsigned cvtpk_(float lo, float hi) { f32x2_t v = {lo, hi}; bf16x2v_t b = __builtin_convertvector(v, bf16x2v_t); return __builtin_bit_cast(unsigned, b); }
DI float wave_sum(float v) {
#pragma unroll
    for (int o = 1; o < 64; o <<= 1) v += __shfl_xor(v, o);
    return v;
}
DI float sigmoidf_(float x) { return __builtin_amdgcn_rcpf(1.f + __expf(-x)); }
DI float gelu_tanh(float x) { const float z = 1.5957691216057308f * (x + 0.044715f * x * x * x); return x * sigmoidf_(z); }
DI float siluf_(float x) { return x * sigmoidf_(x); }

struct EpiRes {
    static constexpr bool PERM = true, AFTER_DRAIN = false;
    const float* baseL; const float* baseC; float* outL; float* outC; const float* gate;
    __device__ __forceinline__ void operator()(const f32x4 (&acc)[2][2][4][2], const pg8::Unit& u, int wr, int wc, int fr, int fq) const {
        const bool isc = u.pm >= 64; const int bb = isc ? 8 : (u.pm >> 3);
        const float* base = isc ? baseC + (size_t)(u.pm - 64) * 256 * DM : baseL + (size_t)u.pm * 256 * DM;
        float* out = isc ? outC + (size_t)(u.pm - 64) * 256 * DM : outL + (size_t)u.pm * 256 * DM;
        const float* g = gate + (size_t)bb * 6144;
        const int col0 = u.pn * 256 + wc * 32 + 8 * fq;
#pragma unroll
        for (int bj = 0; bj < 2; ++bj) {
            const int c = col0 + bj * 128; const f32x4 g0 = *(const f32x4*)(g + c), g1 = *(const f32x4*)(g + c + 4);
#pragma unroll
            for (int ai = 0; ai < 2; ++ai) {
                f32x4 bs[4][2];
#pragma unroll
                for (int m = 0; m < 4; ++m) { const float* bp = base + (size_t)(ai * 128 + wr * 64 + m * 16 + fr) * DM + c; bs[m][0] = *(const f32x4*)bp; bs[m][1] = *(const f32x4*)(bp + 4); }
#pragma unroll
                for (int m = 0; m < 4; ++m) { float* op = out + (size_t)(ai * 128 + wr * 64 + m * 16 + fr) * DM + c; *(f32x4*)op = bs[m][0] + g0 * acc[ai][bj][m][0]; *(f32x4*)(op + 4) = bs[m][1] + g1 * acc[ai][bj][m][1]; }
            }
        }
    }
};

struct EpiCtxHalf {
    static constexpr bool PERM = true, AFTER_DRAIN = false;
    const float* baseC; float* outC; float* cp; const float* gate; int kh;
    __device__ __forceinline__ void operator()(const f32x4 (&acc)[2][2][4][2], const pg8::Unit& u, int wr, int wc, int fr, int fq) const {
        const size_t t0 = (size_t)(u.pm - 64) * 256 * DM; const float* g = gate + (size_t)8 * 6144;
        const int col0 = u.pn * 256 + wc * 32 + 8 * fq;
#pragma unroll
        for (int bj = 0; bj < 2; ++bj) {
            const int c = col0 + bj * 128; const f32x4 g0 = *(const f32x4*)(g + c), g1 = *(const f32x4*)(g + c + 4);
            float* o = kh == 0 ? outC : cp;
#pragma unroll
            for (int ai = 0; ai < 2; ++ai) {
                f32x4 bs[4][2];
#pragma unroll
                for (int m = 0; m < 4; ++m) { const float* bp = baseC + t0 + (size_t)(ai * 128 + wr * 64 + m * 16 + fr) * DM + c;
                    bs[m][0] = kh == 0 ? *(const f32x4*)bp : (f32x4){0.f, 0.f, 0.f, 0.f}; bs[m][1] = kh == 0 ? *(const f32x4*)(bp + 4) : (f32x4){0.f, 0.f, 0.f, 0.f}; }
#pragma unroll
                for (int m = 0; m < 4; ++m) { float* op = o + t0 + (size_t)(ai * 128 + wr * 64 + m * 16 + fr) * DM + c; *(f32x4*)op = bs[m][0] + g0 * acc[ai][bj][m][0]; *(f32x4*)(op + 4) = bs[m][1] + g1 * acc[ai][bj][m][1]; }
            }
        }
    }
};
struct CtxOrder {
    int c;
    __device__ bool next(int i, pg8::Unit& u) const { if (i != 0 || c < 0 || c >= 32) return false; u.pm = 64 + (c >> 2); u.pn = c & 3; return true; }
    __device__ __forceinline__ void a_ready(const pg8::Unit&) const {}
    __device__ __forceinline__ void done(const pg8::Unit&) const {}
};

struct EpiConvAct {
    static constexpr bool PERM = true, AFTER_DRAIN = false;
    bf16_t* H; const float* cw; const float* cb; int pm_edge; int nbnd_lat; int nbnd; char* xlds;
    __device__ __forceinline__ void operator()(const f32x4 (&acc)[2][2][4][2], const pg8::Unit& u, int wr_, int wc_, int fr_, int fq_) const {
        int tl = threadIdx.x; asm volatile("" : "+v"(tl));
        const int lane = tl & 63, wid_ = tl >> 6, fr = lane & 15, fq = lane >> 4, wr = wid_ >> 2, wc = wid_ & 3; (void)wr_; (void)wc_; (void)fr_; (void)fq_;
        const bool edge = u.pm >= pm_edge;
        const int hc0 = u.pn * 128 + wc * 32 + 8 * fq;
        u32x2* sc = (u32x2*)(xlds + wid_ * 2048);
        float* wl = (float*)(xlds + 16384 + wid_ * 1024);
        { const int p = lane >> 4, bjl = (lane >> 3) & 1, cg4 = lane & 7;
          const float* src = (p < 3 ? cw + p * FH2 : cb) + bjl * FH + u.pn * 128 + wc * 32 + 4 * cg4;
          *(f32x4*)(wl + (p * 2 + bjl) * 32 + 4 * cg4) = *(const f32x4*)src; }
        asm volatile("" ::: "memory");
#pragma unroll
        for (int ai = 0; ai < 2; ++ai) {
            u32x2 wd[2][4];
#pragma unroll
            for (int n = 0; n < 2; ++n) {
                float hvv[2][4][4];
#pragma unroll
                for (int bj = 0; bj < 2; ++bj) {
#pragma unroll
                    for (int m = 0; m < 4; ++m) { u32x2 w; w.x = cvtpk_(acc[ai][bj][m][n][0], acc[ai][bj][m][n][1]); w.y = cvtpk_(acc[ai][bj][m][n][2], acc[ai][bj][m][n][3]); sc[(16 * m + fr) * 4 + fq] = w; }
                    asm volatile("" ::: "memory");
                    const f32x4 w0 = *(const f32x4*)(wl + (0 * 2 + bj) * 32 + 8 * fq + 4 * n), w1 = *(const f32x4*)(wl + (1 * 2 + bj) * 32 + 8 * fq + 4 * n),
                                w2 = *(const f32x4*)(wl + (2 * 2 + bj) * 32 + 8 * fq + 4 * n), bb = *(const f32x4*)(wl + (3 * 2 + bj) * 32 + 8 * fq + 4 * n);
#pragma unroll
                    for (int m = 0; m < 4; ++m) {
                        const int row = 16 * m + fr; const int ru = row > 0 ? row - 1 : 0, rd = row < 63 ? row + 1 : 63;
                        u32x2 uu = sc[ru * 4 + fq], dd = sc[rd * 4 + fq];
                        if (row == 0) uu = (u32x2){0u, 0u}; if (row == 63) dd = (u32x2){0u, 0u};
                        const f32x4 up = (f32x4){__uint_as_float(uu.x << 16), __uint_as_float(uu.x & 0xffff0000u), __uint_as_float(uu.y << 16), __uint_as_float(uu.y & 0xffff0000u)};
                        const f32x4 dn = (f32x4){__uint_as_float(dd.x << 16), __uint_as_float(dd.x & 0xffff0000u), __uint_as_float(dd.y << 16), __uint_as_float(dd.y & 0xffff0000u)};
                        const f32x4 hv = bb + w0 * up + w1 * acc[ai][bj][m][n] + w2 * dn;
                        hvv[bj][m][0] = hv.x; hvv[bj][m][1] = hv.y; hvv[bj][m][2] = hv.z; hvv[bj][m][3] = hv.w;
                    }
                    asm volatile("" : "+v"(hvv[bj][0][0]), "+v"(hvv[bj][0][1]), "+v"(hvv[bj][0][2]), "+v"(hvv[bj][0][3]), "+v"(hvv[bj][1][0]), "+v"(hvv[bj][1][1]), "+v"(hvv[bj][1][2]), "+v"(hvv[bj][1][3]),
                                      "+v"(hvv[bj][2][0]), "+v"(hvv[bj][2][1]), "+v"(hvv[bj][2][2]), "+v"(hvv[bj][2][3]), "+v"(hvv[bj][3][0]), "+v"(hvv[bj][3][1]), "+v"(hvv[bj][3][2]), "+v"(hvv[bj][3][3]) :: "memory");
                }
#pragma unroll
                for (int m = 0; m < 4; ++m) { wd[n][m].x = cvtpk_(hvv[0][m][0] * siluf_(hvv[1][m][0]), hvv[0][m][1] * siluf_(hvv[1][m][1])); wd[n][m].y = cvtpk_(hvv[0][m][2] * siluf_(hvv[1][m][2]), hvv[0][m][3] * siluf_(hvv[1][m][3])); }
                asm volatile("" : "+v"(wd[n][0].x), "+v"(wd[n][0].y), "+v"(wd[n][1].x), "+v"(wd[n][1].y), "+v"(wd[n][2].x), "+v"(wd[n][2].y), "+v"(wd[n][3].x), "+v"(wd[n][3].y) :: "memory");
            }
#pragma unroll
            for (int m = 0; m < 4; ++m) {
                const int R = ai * 128 + wr * 64 + m * 16 + fr;
                long grow; bool st;
                if (!edge) {
                    grow = (long)u.pm * 256 + R; st = true;
                    const int r64 = R & 63;
                    if (r64 == 0) st = (R == 0) && (u.pm >= 64 || (u.pm & 7) == 0);
                    if (r64 == 63) st = (R == 255) && (u.pm >= 64 || (u.pm & 7) == 7);
                } else {
                    const int slot = (u.pm - pm_edge) * 256 + R, q = slot >> 2, pos = slot & 3;
                    st = (pos == 1 || pos == 2) && q < nbnd;
                    int row0;
                    if (q < nbnd_lat) { const int s = q / 31, k = q - s * 31 + 1; row0 = s * SEQ + 64 * k; }
                    else { const int q2 = q - nbnd_lat, s = q2 / 3, k = q2 - s * 3 + 1; row0 = NLAT + s * CTXL + 64 * k; }
                    grow = (long)row0 - 2 + pos;
                }
                if (st) { u32x4 w; w.x = wd[0][m].x; w.y = wd[0][m].y; w.z = wd[1][m].x; w.w = wd[1][m].y; *(u32x4*)(H + (size_t)grow * FH + hc0) = w; }
            }
            asm volatile("" ::: "memory"); __builtin_amdgcn_sched_barrier(0);
        }
    }
};

struct EpiGlu {
    static constexpr bool PERM = true, AFTER_DRAIN = false;
    const bf16_t* Z; bf16_t* O; const float* bias;
    __device__ __forceinline__ void operator()(const f32x4 (&acc)[2][2][4][2], const pg8::Unit& u, int wr, int wc, int fr, int fq) const {
        const int row0 = u.pm * 256 + wr * 64 + fr; const int col0 = u.pn * 256 + wc * 32 + 8 * fq;
#pragma unroll
        for (int bj = 0; bj < 2; ++bj) {
            const f32x4 b0 = *(const f32x4*)(bias + col0 + bj * 128), b1 = *(const f32x4*)(bias + col0 + bj * 128 + 4);
            u32x4 zq[2][4];
#pragma unroll
            for (int ai = 0; ai < 2; ++ai)
#pragma unroll
                for (int m = 0; m < 4; ++m) zq[ai][m] = *(const u32x4*)(Z + (size_t)(row0 + ai * 128 + m * 16) * 512 + col0 + bj * 128);
#pragma unroll
            for (int ai = 0; ai < 2; ++ai)
#pragma unroll
                for (int m = 0; m < 4; ++m) {
                    const size_t r = (size_t)(row0 + ai * 128 + m * 16);
                    const u32x4 zz = zq[ai][m];
                    const f32x4 v0 = acc[ai][bj][m][0] + b0, v1 = acc[ai][bj][m][1] + b1;
                    float o[8];
#pragma unroll
                    for (int j = 0; j < 4; ++j) {
                        const float z0 = __uint_as_float((j & 1) ? (zz[j >> 1] & 0xffff0000u) : (zz[j >> 1] << 16));
                        const float z1 = __uint_as_float((j & 1) ? (zz[2 + (j >> 1)] & 0xffff0000u) : (zz[2 + (j >> 1)] << 16));
                        o[j] = z0 * sigmoidf_(v0[j]); o[4 + j] = z1 * sigmoidf_(v1[j]);
                    }
                    u32x4 w; w.x = pk2(o[0], o[1]); w.y = pk2(o[2], o[3]); w.z = pk2(o[4], o[5]); w.w = pk2(o[6], o[7]);
                    *(u32x4*)(O + r * DM + col0 + bj * 128) = w;
                }
        }
    }
};
#define GAS __attribute__((address_space(1)))
typedef GAS unsigned gu32;
typedef GAS unsigned long long gu64;
#define RLX_AGENT __ATOMIC_RELAXED, __HIP_MEMORY_SCOPE_AGENT
#define LDS_WAIT() asm volatile("s_waitcnt lgkmcnt(0)" ::: "memory")
#define VM_WAIT() asm volatile("s_waitcnt vmcnt(0)" ::: "memory")
__device__ __forceinline__ unsigned long long rt() { return __builtin_amdgcn_s_memrealtime(); }
#define XB_TMO      128
#define XB_XCNT(j)  (256  + 64 * (j))
#define XB_XSUB(j)  (1280 + 64 * (j))
#define XB_XGEN(j)  (2304 + 64 * (j))
#define XB_TOP      3328
#define XB_TOPGEN   3392
#define XCD_BAR_WORDS 3456
#define XB_SPIN_CAP (1u << 18)

__device__ __forceinline__ unsigned xb_ld(unsigned* p)              { return __hip_atomic_load(p, __ATOMIC_RELAXED, __HIP_MEMORY_SCOPE_AGENT); }
__device__ __forceinline__ unsigned xb_add(unsigned* p, unsigned v) { return __hip_atomic_fetch_add(p, v, __ATOMIC_RELAXED, __HIP_MEMORY_SCOPE_AGENT); }
__device__ __forceinline__ unsigned xb_xcc_id() { return (unsigned)__builtin_amdgcn_s_getreg((3 << 11) | 20) & 0xFu; }
#define XB_SPIN(cond, bar) do { unsigned _sp = 0; while (cond) { __builtin_amdgcn_s_sleep(1); \
    if ((++_sp & 255u) == 0u) { if (xb_ld(&(bar)[XB_TMO])) break; if (_sp > XB_SPIN_CAP) { atomicAdd(&(bar)[XB_TMO], 1u); break; } } } } while (0)

struct XcdBarrier {
    unsigned* bar; unsigned x;
    volatile LAS unsigned* st;
};

__device__ __forceinline__ XcdBarrier xcd_barrier_post(unsigned* bar, volatile LAS unsigned* st) {
    XcdBarrier b; b.bar = bar; b.x = xb_xcc_id(); b.st = st;
    if (threadIdx.x == 0) (void)xb_add(&bar[XB_XCNT(b.x)], 1u);
    return b;
}
__device__ __forceinline__ void xcd_barrier_complete(unsigned* bar, unsigned x, unsigned& nloc, unsigned& nx) {
    const unsigned G = gridDim.x * gridDim.y * gridDim.z;
    unsigned sum, cnt, mine, sp = 0u;
    for (;;) {
        sum = 0u; cnt = 0u; mine = 0u;
#pragma unroll
        for (unsigned j = 0; j < 16; ++j) { const unsigned c = xb_ld(&bar[XB_XCNT(j)]); sum += c; cnt += (c > 0u) ? 1u : 0u; mine = (j == x) ? c : mine; }
        if (sum == G) break;
        __builtin_amdgcn_s_sleep(1);
        if ((++sp & 255u) == 0u) { if (xb_ld(&bar[XB_TMO])) break; if (sp > XB_SPIN_CAP) { atomicAdd(&bar[XB_TMO], 1u); break; } }
    }
    nloc = mine > 0u ? mine : 1u; nx = cnt > 0u ? cnt : 1u;
}

__device__ __forceinline__ void xcd_barrier(const XcdBarrier& b) {
    asm volatile("s_waitcnt vmcnt(0)" ::: "memory");
    __syncthreads();
    if (threadIdx.x == 0) {
        unsigned* bar = b.bar;
        __builtin_amdgcn_s_waitcnt(0);
        unsigned nloc = b.st[0], nx = b.st[1];
        if (nloc == 0u) { xcd_barrier_complete(bar, b.x, nloc, nx); b.st[0] = nloc; b.st[1] = nx; }
        const unsigned old = xb_add(&bar[XB_XSUB(b.x)], 1u);
        const unsigned gen = old / nloc;
        if (old + 1u == (gen + 1u) * nloc) {
            __builtin_amdgcn_fence(__ATOMIC_RELEASE, "agent");
            asm volatile("s_waitcnt vmcnt(0)" ::: "memory");
            const unsigned og = xb_add(&bar[XB_TOP], 1u);
            const unsigned tg = og / nx;
            if (og + 1u == (tg + 1u) * nx) xb_add(&bar[XB_TOPGEN], 1u);
            else XB_SPIN(xb_ld(&bar[XB_TOPGEN]) == tg, bar);
            __builtin_amdgcn_fence(__ATOMIC_ACQUIRE, "agent");
            xb_add(&bar[XB_XGEN(b.x)], 1u);
            asm volatile("s_waitcnt vmcnt(0)" ::: "memory");
        } else {
            XB_SPIN(xb_ld(&bar[XB_XGEN(b.x)]) == gen, bar);
            __builtin_amdgcn_fence(__ATOMIC_ACQUIRE, "agent");
            asm volatile("s_waitcnt vmcnt(0)" ::: "memory");
        }
    }
    __syncthreads();
}

DI s16x4 vtr(const char* p) { typedef short v4i16_t __attribute__((ext_vector_type(4))); return __builtin_bit_cast(s16x4, __builtin_amdgcn_ds_read_tr16_b64_v4i16((LAS v4i16_t*)p)); }
typedef __bf16 bf16x2_t __attribute__((ext_vector_type(2)));
DI unsigned cvtpk(float lo, float hi) { f32x2_t v = {lo, hi}; bf16x2_t b = __builtin_convertvector(v, bf16x2_t); return __builtin_bit_cast(unsigned, b); }
DI int crow(int r, int h) { return (r & 3) + 8 * (r >> 2) + 4 * h; }
#define MFMA32(a, b, c) __builtin_amdgcn_mfma_f32_32x32x16_bf16((a), (b), (c), 0, 0, 0)
constexpr int ATT_BUF = 17408, ATT_KB = 9216;

template <int MODE, int RB>
DI void attn_unit(const bf16_t* __restrict__ P, int ld, int qoff, int koff, int voff, bf16_t* __restrict__ O, char* lds, int b, int head, int q0, float sink_l2) {
    const int tid = threadIdx.x, lane = tid & 63, wid = tid >> 6, r32 = lane & 31, hi = lane >> 5;
    const int kvh = head >> 2;
    const int qrow0 = (MODE == 1) ? (NLAT + b * CTXL) : (b * SEQ + q0);
    int lat0 = 0, nlat = 0;
    if (MODE == 0) { lat0 = 0; nlat = SEQ / 64; }
    if (MODE == 2) { const int lo = q0 - 128 < 0 ? 0 : q0 - 128; const int hi_ = q0 + 256 * RB + 128 > SEQ ? SEQ : q0 + 256 * RB + 128; lat0 = lo; nlat = (hi_ - lo) / 64; }
    const int NT = 4 + nlat;
#define KROW(t) ((t) < 4 ? (NLAT + b * CTXL + 64 * (t)) : (b * SEQ + lat0 + 64 * ((t) - 4)))
    bf16x8 qr[RB][4];
#pragma unroll
    for (int rb = 0; rb < RB; ++rb) { const bf16_t* Qp = P + (size_t)(qrow0 + wid * 32 * RB + rb * 32 + r32) * ld + qoff + head * 64 + 8 * hi;
#pragma unroll
        for (int ks = 0; ks < 4; ++ks) qr[rb][ks] = *(const bf16x8*)(Qp + 16 * ks); }
    const int srow = tid >> 3, sch = tid & 7;
    const bf16_t* kg = P + koff + kvh * 64 + sch * 8; const bf16_t* vg = P + voff + kvh * 64 + sch * 8;
    const int kw = srow * 144 + sch * 16, vw = ATT_KB + (sch >> 2) * 4096 + srow * 64 + (sch & 3) * 16;
    const int kr_off = r32 * 144 + 16 * hi;
    const int vr_off = ATT_KB + ((lane >> 4) & 1) * 32 + (lane & 3) * 8 + (4 * hi + ((lane & 15) >> 2)) * 64;
    u32x4 kreg, vreg;
    { const size_t r = (size_t)(KROW(0) + srow) * ld; kreg = *(const u32x4*)(kg + r); vreg = *(const u32x4*)(vg + r); }
    *(u32x4*)(lds + kw) = kreg; *(u32x4*)(lds + vw) = vreg;
    if (NT > 1) { const size_t r = (size_t)(KROW(1) + srow) * ld; kreg = *(const u32x4*)(kg + r); vreg = *(const u32x4*)(vg + r); }
    float m[RB], l[RB]; f32x16 o0[RB], o1[RB];
#pragma unroll
    for (int rb = 0; rb < RB; ++rb) { m[rb] = 0.f; l[rb] = 0.f; o0[rb] = f32x16{}; o1[rb] = f32x16{}; }
    __syncthreads();
    for (int t = 0; t < NT; ++t) {
        const char* buf = lds + (t & 1) * ATT_BUF;
        bool need = true; int kpos0 = 0;
        if (MODE == 2 && t >= 4) { kpos0 = lat0 + 64 * (t - 4); const int ql = q0 + wid * 32 * RB; need = (kpos0 <= ql + 32 * RB - 1 + 128) && (kpos0 + 63 >= ql - 128); }
        if (need) {
#pragma unroll
            for (int kb = 0; kb < 2; ++kb) {
                f32x16 p[RB];
#pragma unroll
                for (int rb = 0; rb < RB; ++rb) p[rb] = f32x16{};
#pragma unroll
                for (int ks = 0; ks < 4; ++ks) {
                    const bf16x8 kf = *(const bf16x8*)(buf + kr_off + kb * 32 * 144 + ks * 32);
#pragma unroll
                    for (int rb = 0; rb < RB; ++rb) p[rb] = MFMA32(kf, qr[rb][ks], p[rb]);
                }
#pragma unroll
                for (int rb = 0; rb < RB; ++rb) {
                    if (__any(m[rb] != 0.f)) {
#pragma unroll
                        for (int i = 0; i < 16; ++i) p[rb][i] -= m[rb]; }
                    if (MODE == 2 && t >= 4) {
                        const int qpos = q0 + wid * 32 * RB + rb * 32 + r32;
#pragma unroll
                        for (int i = 0; i < 16; ++i) { const int kp = kpos0 + 32 * kb + crow(i, hi); int d0 = qpos - kp; d0 = d0 < 0 ? -d0 : d0; if (d0 > 128) p[rb][i] = -1e30f; }
                    }
                    float mx = fmaxf(fmaxf(p[rb][0], p[rb][1]), p[rb][2]), mx2 = fmaxf(fmaxf(p[rb][3], p[rb][4]), p[rb][5]);
#pragma unroll
                    for (int i = 6; i < 16; i += 4) { mx = fmaxf(fmaxf(mx, p[rb][i]), p[rb][i + 1]); mx2 = fmaxf(fmaxf(mx2, p[rb][i + 2 < 16 ? i + 2 : 15]), p[rb][i + 3 < 16 ? i + 3 : 15]); }
                    mx = fmaxf(mx, mx2); mx = fmaxf(mx, __shfl_xor(mx, 32));
                    if (__any(mx > 8.f)) {
                        const float dl = fmaxf(mx, 0.f); m[rb] += dl; const float f = __builtin_amdgcn_exp2f(-dl); l[rb] *= f;
#pragma unroll
                        for (int i = 0; i < 16; ++i) { p[rb][i] -= dl; o0[rb][i] *= f; o1[rb][i] *= f; }
                    }
                    float rs = 0.f, rs2 = 0.f;
#pragma unroll
                    for (int i = 0; i < 16; i += 2) { p[rb][i] = __builtin_amdgcn_exp2f(p[rb][i]); rs += p[rb][i]; p[rb][i + 1] = __builtin_amdgcn_exp2f(p[rb][i + 1]); rs2 += p[rb][i + 1]; }
                    l[rb] += rs + rs2;
                }
#pragma unroll
                for (int s2 = 0; s2 < 2; ++s2) {
                    const char* vb = buf + vr_off + (2 * kb + s2) * 1024;
                    const s16x4 a0 = vtr(vb), a1 = vtr(vb + 512), c0 = vtr(vb + 4096), c1 = vtr(vb + 4096 + 512);
                    const bf16x8 va0 = (bf16x8){a0[0], a0[1], a0[2], a0[3], a1[0], a1[1], a1[2], a1[3]};
                    const bf16x8 va1 = (bf16x8){c0[0], c0[1], c0[2], c0[3], c1[0], c1[1], c1[2], c1[3]};
#pragma unroll
                    for (int rb = 0; rb < RB; ++rb) {
                        u32x4 pw; pw[0] = cvtpk(p[rb][8 * s2], p[rb][8 * s2 + 1]); pw[1] = cvtpk(p[rb][8 * s2 + 2], p[rb][8 * s2 + 3]); pw[2] = cvtpk(p[rb][8 * s2 + 4], p[rb][8 * s2 + 5]); pw[3] = cvtpk(p[rb][8 * s2 + 6], p[rb][8 * s2 + 7]);
                        const bf16x8 pb = __builtin_bit_cast(bf16x8, pw);
                        o0[rb] = MFMA32(va0, pb, o0[rb]); o1[rb] = MFMA32(va1, pb, o1[rb]);
                    }
                }
            }
        }
        if (t + 1 < NT) {
            char* nb = lds + ((t + 1) & 1) * ATT_BUF;
            *(u32x4*)(nb + kw) = kreg; *(u32x4*)(nb + vw) = vreg;
            if (t + 2 < NT) { const size_t r = (size_t)(KROW(t + 2) + srow) * ld; kreg = *(const u32x4*)(kg + r); vreg = *(const u32x4*)(vg + r); }
        }
        __syncthreads();
    }
#undef KROW
    int tl_ = threadIdx.x; asm volatile("" : "+v"(tl_));
    const int lane2 = tl_ & 63, wid2 = tl_ >> 6, r32b = lane2 & 31, hib = lane2 >> 5;
#pragma unroll
    for (int rb = 0; rb < RB; ++rb) {
        float lt = l[rb] + __shfl_xor(l[rb], 32);
        if (MODE == 2) lt += __builtin_amdgcn_exp2f(sink_l2 - m[rb]);
        const float inv = 1.f / lt;
        bf16_t* Op = O + (size_t)(qrow0 + wid2 * 32 * RB + rb * 32 + r32b) * DM + 512 + head * 64 + 4 * hib;
#pragma unroll
        for (int k = 0; k < 4; ++k) {
            u32x2 w0, w1;
            w0.x = pk2(o0[rb][4 * k] * inv, o0[rb][4 * k + 1] * inv); w0.y = pk2(o0[rb][4 * k + 2] * inv, o0[rb][4 * k + 3] * inv);
            w1.x = pk2(o1[rb][4 * k] * inv, o1[rb][4 * k + 1] * inv); w1.y = pk2(o1[rb][4 * k + 2] * inv, o1[rb][4 * k + 3] * inv);
            *(u32x2*)(Op + 8 * k) = w0; *(u32x2*)(Op + 32 + 8 * k) = w1;
        }
    }
}

constexpr int RG_XA = 0, RG_XF = 9216, RG_GT = RG_XF + 64 * 65 * 4  , RG_SEG = RG_GT + 4 * 64 * 65 * 4  , RG_CAR = RG_SEG + 2 * 64 * 4 * 8  ;
DI bf16_t* rg_yl(unsigned char* ws) { return (bf16_t*)(ws + WS_XN); }
DI bf16_t* rg_pf(unsigned char* ws) { return (bf16_t*)(ws + WS_XN) + (size_t)MALL * 512; }
DI bf16_t* rg_pb(unsigned char* ws) { return (bf16_t*)(ws + WS_Z); }
DI void rg_item1(const float* const* in, unsigned char* ws, char* lds, int item) {
    const int tid = threadIdx.x, lane = tid & 63, wid = tid >> 6;
    const int ci = item % 36, bh = item / 36, head = bh & 7, b = bh >> 3;
    const bf16_t* PROJ = (const bf16_t*)(ws + WS_PROJ);
    const int seqbase = ci < 4 ? NLAT + b * CTXL : b * SEQ, t0 = ci < 4 ? ci * 64 : (ci - 4) * 64, slen = ci < 4 ? CTXL : SEQ;
    bf16_t* XA = (bf16_t*)(lds + RG_XA); float* XF = (float*)(lds + RG_XF); float* GT = (float*)(lds + RG_GT); float* SEGL = (float*)(lds + RG_SEG);
    float* TOT = (float*)(ws + WS_RGTOT);
    const int sdir = tid >> 8, sch = (tid >> 2) & 63, sseg = tid & 3;
    {
        const int tok = tid >> 3, cg8 = tid & 7, ch0 = head * 64 + cg8 * 8;
        const float* cw = in[13]; const float* cb = in[14];
        float x[8]; u32x4 uu4[4]; f32x4 wq[5][2];
#pragma unroll
        for (int j = 0; j < 4; ++j) { int tt = t0 + tok + j - 1; tt = tt < 0 ? 0 : (tt >= slen ? slen - 1 : tt); uu4[j] = *(const u32x4*)(PROJ + (size_t)(seqbase + tt) * EIN + ch0); }
#pragma unroll
        for (int j = 0; j < 4; ++j) { wq[j][0] = *(const f32x4*)(cw + j * 512 + ch0); wq[j][1] = *(const f32x4*)(cw + j * 512 + ch0 + 4); }
        wq[4][0] = *(const f32x4*)(cb + ch0); wq[4][1] = *(const f32x4*)(cb + ch0 + 4);
#pragma unroll
        for (int c = 0; c < 8; ++c) x[c] = wq[4][c >> 2][c & 3];
#pragma unroll
        for (int j = 0; j < 4; ++j) {
            const int tt = t0 + tok + j - 1; const float msk = (tt >= 0 && tt < slen) ? 1.f : 0.f;
#pragma unroll
            for (int c = 0; c < 8; ++c) { const float uv = __uint_as_float((c & 1) ? (uu4[j][c >> 1] & 0xffff0000u) : (uu4[j][c >> 1] << 16)); x[c] += (wq[j][c >> 2][c & 3] * msk) * uv; }
        }
        u32x4 w; w.x = pk2(x[0], x[1]); w.y = pk2(x[2], x[3]); w.z = pk2(x[4], x[5]); w.w = pk2(x[6], x[7]);
        *(u32x4*)(XA + tok * 72 + cg8 * 8) = w;
#pragma unroll
        for (int c = 0; c < 8; ++c) XF[tok * 65 + cg8 * 8 + c] = x[c];
    }
    __syncthreads();
    {
        const int mi = wid & 3, th = wid >> 2, r32 = lane & 31, hi = lane >> 5;
        const bf16_t* W = (const bf16_t*)(ws + WS_RGW) + (size_t)(mi * 8 + head) * 4096;
        const float* bias = (mi & 1) ? in[18] : in[16]; const int dirm = mi >> 1;
#pragma unroll
        for (int nt = 0; nt < 2; ++nt) {
            f32x16 acc = {};
#pragma unroll
            for (int ks = 0; ks < 4; ++ks) {
                const bf16x8 a = *(const bf16x8*)(XA + (32 * th + r32) * 72 + 16 * ks + 8 * hi);
                const bf16x8 bfr = *(const bf16x8*)(W + (32 * nt + r32) * 64 + 16 * ks + 8 * hi);
                acc = MFMA32(a, bfr, acc);
            }
            const float bv = bias[dirm * 512 + head * 64 + 32 * nt + r32];
#pragma unroll
            for (int i = 0; i < 16; ++i) GT[(mi * 64 + 32 * th + crow(i, hi)) * 65 + 32 * nt + r32] = sigmoidf_(acc[i] + bv);
        }
    }
    __syncthreads();
    float av[16], bvv[16];
    {
        const float lam = in[19][sdir * 512 + head * 64 + sch];
        const float nl = -lam; const float sp = nl > 20.f ? nl : log1pf(__expf(nl));
        float hh = 0.f, PP = 1.f;
#pragma unroll
        for (int s = 0; s < 16; ++s) {
            const int k = 16 * sseg + s, tok = sdir == 0 ? k : 63 - k;
            const float r = GT[((2 * sdir) * 64 + tok) * 65 + sch], ig = GT[((2 * sdir + 1) * 64 + tok) * 65 + sch], x = XF[tok * 65 + sch];
            const float la = -8.f * r * sp; const float a = __expf(la); const float bb = __builtin_amdgcn_sqrtf(fmaxf(1.f - a * a, 0.f)) * (ig * x);
            av[s] = a; bvv[s] = bb; hh = a * hh + bb; PP *= a;
        }
        __syncthreads();
        SEGL[((sdir * 64 + sch) * 4 + sseg) * 2] = PP; SEGL[((sdir * 64 + sch) * 4 + sseg) * 2 + 1] = hh;
    }
    __syncthreads();
    {
        float c = 0.f, Pbef = 1.f, Pt = 1.f;
#pragma unroll
        for (int s = 0; s < 4; ++s) { const float p = SEGL[((sdir * 64 + sch) * 4 + s) * 2], h = SEGL[((sdir * 64 + sch) * 4 + s) * 2 + 1];
            if (s < sseg) { c = p * c + h; Pbef *= p; } Pt *= p; }
        float h = c, P = Pbef;
#pragma unroll
        for (int s = 0; s < 16; ++s) { const int k = 16 * sseg + s, tok = sdir == 0 ? k : 63 - k; h = av[s] * h + bvv[s]; P *= av[s];
            GT[(sdir * 64 + tok) * 65 + sch] = h; GT[((2 + sdir) * 64 + tok) * 65 + sch] = P; }
        if (sseg == 3) { float* tp = TOT + ((size_t)((sdir * NB + b) * 36 + ci) * 2) * 512 + head * 64 + sch; tp[0] = Pt; tp[512] = h; }
    }
    __syncthreads();
    {
        const int tok = tid >> 3, cg8 = tid & 7, ch0 = head * 64 + cg8 * 8;
        const size_t off = (size_t)(seqbase + t0 + tok) * 512 + ch0;
        float y[8], pf[8], pb[8];
#pragma unroll
        for (int c = 0; c < 8; ++c) { y[c] = GT[tok * 65 + cg8 * 8 + c] + GT[(64 + tok) * 65 + cg8 * 8 + c]; pf[c] = GT[(128 + tok) * 65 + cg8 * 8 + c]; pb[c] = GT[(192 + tok) * 65 + cg8 * 8 + c]; }
        u32x4 w; w.x = pk2(y[0], y[1]); w.y = pk2(y[2], y[3]); w.z = pk2(y[4], y[5]); w.w = pk2(y[6], y[7]); *(u32x4*)(rg_yl(ws) + off) = w;
        w.x = pk2(pf[0], pf[1]); w.y = pk2(pf[2], pf[3]); w.z = pk2(pf[4], pf[5]); w.w = pk2(pf[6], pf[7]); *(u32x4*)(rg_pf(ws) + off) = w;
        w.x = pk2(pb[0], pb[1]); w.y = pk2(pb[2], pb[3]); w.z = pk2(pb[4], pb[5]); w.w = pk2(pb[6], pb[7]); *(u32x4*)(rg_pb(ws) + off) = w;
    }
    __syncthreads();
}
DI void rg_item2(const float* const* in, unsigned char* ws, char* lds, int item) {
    const int tid = threadIdx.x;
    const int ci = item % 36, bh = item / 36, head = bh & 7, b = bh >> 3;
    const bf16_t* PROJ = (const bf16_t*)(ws + WS_PROJ);
    const int seqbase = ci < 4 ? NLAT + b * CTXL : b * SEQ, t0 = ci < 4 ? ci * 64 : (ci - 4) * 64;
    float* SEGL = (float*)(lds + RG_SEG); float* CAR = (float*)(lds + RG_CAR);
    const float* TOT = (const float*)(ws + WS_RGTOT);
    const int sdir = tid >> 8, sch = (tid >> 2) & 63, sseg = tid & 3;
    const int tok = tid >> 3, cg8 = tid & 7, ch0 = head * 64 + cg8 * 8;
    const size_t row = (size_t)(seqbase + t0 + tok); const size_t off = row * 512 + ch0;
    const u32x4 yv = *(const u32x4*)(rg_yl(ws) + off), pfv = *(const u32x4*)(rg_pf(ws) + off), pbv = *(const u32x4*)(rg_pb(ws) + off), gg = *(const u32x4*)(PROJ + row * EIN + 512 + ch0);
    {
        const int pos = sdir == 0 ? ci : (ci < 4 ? 3 - ci : 4 + (35 - ci));
        float pp[9], hh[9];
#pragma unroll
        for (int i = 0; i < 9; ++i) { const int k0 = sseg * 9 + i; const int k = k0 < 35 ? k0 : 35; const int ck = sdir == 0 ? k : (k < 4 ? 3 - k : 35 - (k - 4));
            const float* tp = TOT + ((size_t)((sdir * NB + b) * 36 + ck) * 2) * 512 + head * 64 + sch; pp[i] = tp[0]; hh[i] = tp[512]; }
#pragma unroll
        for (int i = 0; i < 9; ++i) { if (sseg * 9 + i >= pos) { pp[i] = 1.f; hh[i] = 0.f; } }
        float Pc = 1.f, Hc = 0.f;
#pragma unroll
        for (int i = 0; i < 9; ++i) { Hc = pp[i] * Hc + hh[i]; Pc *= pp[i]; }
        SEGL[((sdir * 64 + sch) * 4 + sseg) * 2] = Pc; SEGL[((sdir * 64 + sch) * 4 + sseg) * 2 + 1] = Hc;
    }
    __syncthreads();
    if (tid < 128) { const int d = tid >> 6, ch = tid & 63; float Hc = 0.f;
#pragma unroll
        for (int s = 0; s < 4; ++s) { const float p = SEGL[((d * 64 + ch) * 4 + s) * 2], h = SEGL[((d * 64 + ch) * 4 + s) * 2 + 1]; Hc = p * Hc + h; }
        CAR[d * 64 + ch] = Hc; }
    __syncthreads();
    {
        float o[8];
#pragma unroll
        for (int c = 0; c < 8; ++c) {
            const float yl = __uint_as_float((c & 1) ? (yv[c >> 1] & 0xffff0000u) : (yv[c >> 1] << 16)), pf = __uint_as_float((c & 1) ? (pfv[c >> 1] & 0xffff0000u) : (pfv[c >> 1] << 16));
            const float pb = __uint_as_float((c & 1) ? (pbv[c >> 1] & 0xffff0000u) : (pbv[c >> 1] << 16)), gt = __uint_as_float((c & 1) ? (gg[c >> 1] & 0xffff0000u) : (gg[c >> 1] << 16));
            const float y = yl + pf * CAR[cg8 * 8 + c] + pb * CAR[64 + cg8 * 8 + c]; o[c] = y * gelu_tanh(gt); }
        u32x4 w; w.x = pk2(o[0], o[1]); w.y = pk2(o[2], o[3]); w.z = pk2(o[4], o[5]); w.w = pk2(o[6], o[7]);
        *(u32x4*)((bf16_t*)(ws + WS_MIX) + row * DM + ch0) = w;
    }
    __syncthreads();
}

DI void s5_pre_item(const float* const* in, unsigned char* ws, char* lds, int item) {
    const int tid = threadIdx.x; const int g = item >> 2, qq = item & 3;
    float* AP = (float*)lds;
    float* BB = AP + 2 * 33 * 64 * 2;
    float* CC = BB + 2 * 64 * 16 * 2;
    float* KT = CC + 2 * 16 * 64 * 2;
    const float* lam_re = in[24]; const float* lam_im = in[25]; const float* lstep = in[26];
    {
        const int p = tid & 63, d = (tid >> 6) & 1, j0 = tid >> 7;
        const float dt = __expf(lstep[d * 32 + g]); const float lr = lam_re[(d * 32 + g) * 64 + p], li = lam_im[(d * 32 + g) * 64 + p];
        for (int j = j0; j < 33; j += 4) { const float mag = __expf((float)j * lr * dt), ang = (float)j * li * dt; const int e = (d * 33 + j) * 64 + p; AP[e * 2] = mag * __cosf(ang); AP[e * 2 + 1] = mag * __sinf(ang); }
    }
    {
        float lr4[4], li4[4], br4[4], bi4[4], cr4[4], ci4[4], dt4[4];
#pragma unroll
        for (int i = 0; i < 4; ++i) { const int e = tid + i * NTHREADS; const int h = e & 15, p = (e >> 4) & 63, d = e >> 10;
            dt4[i] = lstep[d * 32 + g]; lr4[i] = lam_re[(d * 32 + g) * 64 + p]; li4[i] = lam_im[(d * 32 + g) * 64 + p];
            br4[i] = in[27][((size_t)(d * 32 + g) * 64 + p) * 16 + h]; bi4[i] = in[28][((size_t)(d * 32 + g) * 64 + p) * 16 + h];
            const int p2 = e & 63, h2 = (e >> 6) & 15; cr4[i] = in[29][((size_t)(d * 32 + g) * 16 + h2) * 64 + p2]; ci4[i] = in[30][((size_t)(d * 32 + g) * 16 + h2) * 64 + p2]; }
#pragma unroll
        for (int i = 0; i < 4; ++i) { const int e = tid + i * NTHREADS; const float dt = __expf(dt4[i]), lr = lr4[i], li = li4[i];
            const float mag = __expf(lr * dt), ang = li * dt; const float abr = mag * __cosf(ang), abi = mag * __sinf(ang);
            const float den = lr * lr + li * li, nr = abr - 1.f, ni = abi; const float kr = (nr * lr + ni * li) / den, ki = (ni * lr - nr * li) / den;
            BB[e * 2] = kr * br4[i] - ki * bi4[i]; BB[e * 2 + 1] = kr * bi4[i] + ki * br4[i]; CC[e * 2] = cr4[i]; CC[e * 2 + 1] = ci4[i]; }
    }
    __syncthreads();
    for (int task = tid; task < 64 * 16; task += NTHREADS) {
        const int dj = task >> 4, blk = task & 15, d = dj >> 5, j = dj & 31, ho0 = 4 * (blk >> 2), hi0 = 4 * (blk & 3);
        const int jmax = d == 0 ? 8 * qq + 7 : 31 - 8 * qq;
        if (j > jmax) continue;
        float acc4[4][4];
#pragma unroll
        for (int i = 0; i < 4; ++i)
#pragma unroll
            for (int k = 0; k < 4; ++k) acc4[i][k] = 0.f;
        const f32x2_t* ap = (const f32x2_t*)AP + (d * 33 + j) * 64; const f32x2_t* cp = (const f32x2_t*)CC + (d * 16 + ho0) * 64; const f32x4* bp = (const f32x4*)(BB + (size_t)(d * 64) * 16 * 2 + hi0 * 2);
#pragma unroll 2
        for (int p = 0; p < 64; ++p) {
            const f32x2_t av = ap[p]; const f32x4 b01 = bp[p * 8], b23 = bp[p * 8 + 1];
#pragma unroll
            for (int i = 0; i < 4; ++i) { const f32x2_t cv = cp[i * 64 + p]; const float xr = cv.x * av.x - cv.y * av.y, xi = cv.x * av.y + cv.y * av.x;
                acc4[i][0] += xr * b01.x - xi * b01.y; acc4[i][1] += xr * b01.z - xi * b01.w; acc4[i][2] += xr * b23.x - xi * b23.y; acc4[i][3] += xr * b23.z - xi * b23.w; }
        }
#pragma unroll
        for (int i = 0; i < 4; ++i) *(f32x4*)(KT + (d * 32 + j) * 256 + (ho0 + i) * 16 + hi0) = (f32x4){acc4[i][0], acc4[i][1], acc4[i][2], acc4[i][3]};
    }
    __syncthreads();
    bf16_t* Mg = (bf16_t*)(ws + WS_S5MF) + (size_t)g * 512 * 768; bf16_t* Eg = (bf16_t*)(ws + WS_S5E) + (size_t)g * 256 * 512; bf16_t* Fg = Mg + 512;
    const float dval = in[31][g * 16 + (tid & 15)];
    for (int e = tid; e < 128 * 512; e += NTHREADS) { const int k = e & 511, mr = e >> 9, m = qq * 128 + mr; const int t = m >> 4, ho = m & 15, tau = k >> 4, hi = k & 15;
        float v = 0.f; if (tau <= t) v += KT[(0 * 32 + (t - tau)) * 256 + ho * 16 + hi]; if (tau >= t) v += KT[(1 * 32 + (tau - t)) * 256 + ho * 16 + hi];
        if (tau == t && ho == hi) v += dval;
        Mg[(size_t)m * 768 + k] = (bf16_t)f2bf(v); }
    { const int d = qq >> 1, c = qq & 1;
      for (int e = tid; e < 64 * 512; e += NTHREADS) { const int k = e & 511, p = e >> 9, tau = k >> 4, hi = k & 15; const int j = d == 0 ? 31 - tau : tau;
          const float ar = AP[((d * 33 + j) * 64 + p) * 2], ai = AP[((d * 33 + j) * 64 + p) * 2 + 1]; const float br = BB[((d * 64 + p) * 16 + hi) * 2], bi = BB[((d * 64 + p) * 16 + hi) * 2 + 1];
          const float v = c ? (ar * bi + ai * br) : (ar * br - ai * bi);
          Eg[(size_t)(qq * 64 + p) * 512 + k] = (bf16_t)f2bf(v); } }
    for (int e = tid; e < 128 * 256; e += NTHREADS) { const int k = e & 255, mr = e >> 8, m = qq * 128 + mr, t = m >> 4, ho = m & 15; const int d = k >> 7, c = (k >> 6) & 1, p = k & 63;
        const int j = d == 0 ? t + 1 : 32 - t;
        const float ar = AP[((d * 33 + j) * 64 + p) * 2], ai = AP[((d * 33 + j) * 64 + p) * 2 + 1]; const float cr = CC[((d * 16 + ho) * 64 + p) * 2], ci = CC[((d * 16 + ho) * 64 + p) * 2 + 1];
        const float v = c ? -(cr * ai + ci * ar) : (cr * ar - ci * ai);
        Fg[(size_t)m * 768 + k] = (bf16_t)f2bf(v); }
    if (qq == 0) for (int e = tid; e < 2 * 64; e += NTHREADS) { const int p = e & 63, d = e >> 6; float* at = (float*)(ws + WS_S5AT) + ((size_t)(d * 32 + g) * 64 + p) * 2;
        at[0] = AP[((d * 33 + 32) * 64 + p) * 2]; at[1] = AP[((d * 33 + 32) * 64 + p) * 2 + 1]; }
    __syncthreads();
}
DI int s5_chunk_row(int n72) { const int b = n72 / 72, cc = n72 - b * 72; return cc < 8 ? NLAT + b * CTXL + 32 * cc : b * SEQ + 32 * (cc - 8); }
DI void s5_repack_chunk(unsigned char* ws, int n, int lane) {
    const bf16_t* src = (const bf16_t*)(ws + WS_PROJ) + (size_t)s5_chunk_row(n) * OIN + 8 * lane;
    bf16_t* dst = (bf16_t*)(ws + WS_UG) + ((size_t)(lane >> 1) * 768 + n) * 768 + (lane & 1) * 8;
    u32x4 v[8];
#pragma unroll
    for (int t0 = 0; t0 < 32; t0 += 8) {
#pragma unroll
        for (int i = 0; i < 8; ++i) v[i] = *(const u32x4*)(src + (size_t)(t0 + i) * OIN);
#pragma unroll
        for (int i = 0; i < 8; ++i) *(u32x4*)(dst + (t0 + i) * 16) = v[i];
    }
}
struct S5Order {
    int G, c, nb;
    __device__ bool next(int i, pg8::Unit& u) const { const int L = i * G + c; const int per = 3 * nb; if (L >= 32 * per) return false; const int g = L / per, r = L - g * per; u.pm = 3 * g + r / nb; u.pn = nb * g + r % nb; return true; }
    __device__ __forceinline__ void a_ready(const pg8::Unit&) const {}
    __device__ __forceinline__ void done(const pg8::Unit&) const {}
};
struct EpiS5L {
    static constexpr bool PERM = false, AFTER_DRAIN = false;
    float* L;
    __device__ __forceinline__ void operator()(const f32x4 (&acc)[2][2][4][2], const pg8::Unit& u, int wr, int wc, int fr, int fq) const {
        const int g = u.pn, mt = u.pm - 3 * g;
#pragma unroll
        for (int ai = 0; ai < 2; ++ai)
#pragma unroll
            for (int m = 0; m < 4; ++m) { const int n = mt * 256 + ai * 128 + wr * 64 + m * 16 + fr; if (n >= 576) continue;
                float* lp = L + ((size_t)n * 32 + g) * 256 + wc * 32 + 4 * fq;
#pragma unroll
                for (int bj = 0; bj < 2; ++bj)
#pragma unroll
                    for (int nn = 0; nn < 2; ++nn) *(f32x4*)(lp + bj * 128 + nn * 16) = acc[ai][bj][m][nn]; }
    }
};
struct EpiS5Y {
    static constexpr bool PERM = false, AFTER_DRAIN = false;
    bf16_t* Z;
    __device__ __forceinline__ void operator()(const f32x4 (&acc)[2][2][4][2], const pg8::Unit& u, int wr, int wc, int fr, int fq) const {
        const int g = u.pn >> 1, nh = u.pn & 1, mt = u.pm - 3 * g;
#pragma unroll
        for (int ai = 0; ai < 2; ++ai)
#pragma unroll
            for (int m = 0; m < 4; ++m) { const int n = mt * 256 + ai * 128 + wr * 64 + m * 16 + fr; const int b = n / 72, cc = n - b * 72; if (n >= 576 || cc < 8) continue;
                bf16_t* zp = Z + (size_t)(b * SEQ + 32 * (cc - 8)) * 512 + g * 16;
#pragma unroll
                for (int bj = 0; bj < 2; ++bj)
#pragma unroll
                    for (int nn = 0; nn < 2; ++nn) { const int mcol = nh * 256 + bj * 128 + wc * 32 + nn * 16 + 4 * fq, t = mcol >> 4, ho = mcol & 15; const f32x4 y = acc[ai][bj][m][nn];
                        u32x2 w; w.x = pk2(gelu_tanh(y.x), gelu_tanh(y.y)); w.y = pk2(gelu_tanh(y.z), gelu_tanh(y.w)); *(u32x2*)(zp + (size_t)t * 512 + ho) = w; } }
    }
};
DI void s5_scan_thread(unsigned char* ws, int gid) {
    const int p = gid & 63, d = (gid >> 6) & 1, g = (gid >> 7) & 31, b = gid >> 12;
    const float* at = (const float*)(ws + WS_S5AT) + ((size_t)(d * 32 + g) * 64 + p) * 2; const float ar = at[0], ai = at[1];
    const float* L = (const float*)(ws + WS_S5L); bf16_t* UG = (bf16_t*)(ws + WS_UG);
    float sr = 0.f, si = 0.f;
    for (int k0 = 0; k0 < 72; k0 += 8) {
        float lr8[8], li8[8];
#pragma unroll
        for (int i = 0; i < 8; ++i) { const int k = k0 + i; const int cc = d == 0 ? k : (k < 8 ? 7 - k : 71 - (k - 8)); const size_t lo = ((size_t)(b * 72 + cc) * 32 + g) * 256 + d * 128 + p; lr8[i] = L[lo]; li8[i] = L[lo + 64]; }
#pragma unroll
        for (int i = 0; i < 8; ++i) { const int k = k0 + i; const int cc = d == 0 ? k : (k < 8 ? 7 - k : 71 - (k - 8));
            if (cc >= 8) { bf16_t* so = UG + ((size_t)g * 768 + b * 72 + cc) * 768 + 512 + d * 128 + p; so[0] = (bf16_t)f2bf(sr); so[64] = (bf16_t)f2bf(si); }
            const float nr = ar * sr - ai * si + lr8[i], ni = ar * si + ai * sr + li8[i]; sr = nr; si = ni; }
    }
}

DI int up_row_map(int n) { return n < FH ? (n >> 7) * 256 + (n & 127) : ((n - FH) >> 7) * 256 + 128 + ((n - FH) & 127); }
DI void p0_transpose_item(const float* W, int K, int N, bf16_t* WT, bool upmap, float* scr, int item, int lane) {
    const int nblk = N / 32, kb = item / nblk, nb = item % nblk, k0 = 64 * kb, n0 = 32 * nb;
    float tv[32];
#pragma unroll
    for (int i = 0; i < 32; ++i) tv[i] = __builtin_nontemporal_load(W + (size_t)(k0 + 2 * i + (lane >> 5)) * N + n0 + (lane & 31));
#pragma unroll
    for (int i = 0; i < 32; ++i) scr[(2 * i + (lane >> 5)) * 33 + (lane & 31)] = tv[i];
    asm volatile("s_waitcnt lgkmcnt(0)" ::: "memory");
    const int c = lane & 7;
#pragma unroll
    for (int j = 0; j < 4; ++j) { const int n = (lane >> 3) + 8 * j; const float* s = scr + (8 * c) * 33 + n;
        u32x4 o; o.x = pk2(s[0 * 33], s[1 * 33]); o.y = pk2(s[2 * 33], s[3 * 33]); o.z = pk2(s[4 * 33], s[5 * 33]); o.w = pk2(s[6 * 33], s[7 * 33]);
        const int nr = upmap ? up_row_map(n0 + n) : n0 + n;
        *(u32x4*)(WT + (size_t)nr * K + k0 + 8 * c) = o; }
    asm volatile("s_waitcnt lgkmcnt(0)" ::: "memory");
}
DI void norm_row(const float* xrow, const float* g, const float* shift, const float* scale, bf16_t* o1, bf16_t* o2, int lane) {
    f32x4 v[4]; float s = 0.f;
#pragma unroll
    for (int j = 0; j < 4; ++j) { v[j] = *((const f32x4*)xrow + lane + 64 * j); s += (v[j].x * v[j].x + v[j].y * v[j].y) + (v[j].z * v[j].z + v[j].w * v[j].w); }
    const float rstd = rsqrtf(wave_sum(s) * (1.f / DM) + NORM_EPS);
#pragma unroll
    for (int j = 0; j < 4; ++j) {
        const f32x4 gg = *((const f32x4*)g + lane + 64 * j), sh = *((const f32x4*)shift + lane + 64 * j), sc = *((const f32x4*)scale + lane + 64 * j);
        const f32x4 y = (v[j] * rstd) * gg * (sc + 1.0f) + sh;
        u32x2 w; w.x = pk2(y.x, y.y); w.y = pk2(y.z, y.w);
        *((u32x2*)o1 + lane + 64 * j) = w; if (o2) *((u32x2*)o2 + lane + 64 * j) = w;
    }
}
DI bf16_t* norm_xne_ptr(bf16_t* XN, int r, int xne_row) {
    if (xne_row < 0) return nullptr;
    const bool isctx = r >= NLAT; const int t = isctx ? (r - NLAT) & 255 : r & 2047, slen = isctx ? CTXL : SEQ, s = isctx ? (r - NLAT) >> 8 : r >> 11;
    const int k = (t + 2) >> 6, pos = (t + 2) & 63;
    if (pos < 4 && k >= 1 && k <= slen / 64 - 1) { const int q = isctx ? NBND_LAT + s * 3 + (k - 1) : s * 31 + (k - 1); return XN + (size_t)(xne_row + 4 * q + pos) * DM; }
    return nullptr;
}
DI void norm_phase(const float* hL, const float* hC, const float* g, const float* mod, int ish, int isc, bf16_t* XN, int nrows, int xne_row, int gw, int NGW, int lane, const float* cadd = nullptr, float* cwb = nullptr) {
    for (int r0 = gw; r0 < nrows; r0 += 2 * NGW) {
        const int r1 = r0 + NGW; const bool has1 = r1 < nrows; const int r1c = has1 ? r1 : r0;
        const float* x0 = r0 >= NLAT ? hC + (size_t)(r0 - NLAT) * DM : hL + (size_t)r0 * DM;
        const float* x1 = r1c >= NLAT ? hC + (size_t)(r1c - NLAT) * DM : hL + (size_t)r1c * DM;
        f32x4 v0[4], v1[4];
#pragma unroll
        for (int j = 0; j < 4; ++j) { v0[j] = *((const f32x4*)x0 + lane + 64 * j); v1[j] = *((const f32x4*)x1 + lane + 64 * j); }
        if (cadd) {
#pragma unroll
            for (int j = 0; j < 4; ++j) {
                if (r0 >= NLAT) { v0[j] += *((const f32x4*)(cadd + (size_t)(r0 - NLAT) * DM) + lane + 64 * j); if (cwb) *((f32x4*)(cwb + (size_t)(r0 - NLAT) * DM) + lane + 64 * j) = v0[j]; }
                if (has1 && r1 >= NLAT) { v1[j] += *((const f32x4*)(cadd + (size_t)(r1 - NLAT) * DM) + lane + 64 * j); if (cwb) *((f32x4*)(cwb + (size_t)(r1 - NLAT) * DM) + lane + 64 * j) = v1[j]; } } }
        const int bb0 = r0 >= NLAT ? 8 : r0 >> 11, bb1 = r1c >= NLAT ? 8 : r1c >> 11;
        const float* sh0 = mod + (size_t)bb0 * 6144 + ish * 1024; const float* sc0 = mod + (size_t)bb0 * 6144 + isc * 1024;
        const float* sh1 = mod + (size_t)bb1 * 6144 + ish * 1024; const float* sc1 = mod + (size_t)bb1 * 6144 + isc * 1024;
        float s0 = 0.f, s1 = 0.f;
#pragma unroll
        for (int j = 0; j < 4; ++j) { s0 += (v0[j].x * v0[j].x + v0[j].y * v0[j].y) + (v0[j].z * v0[j].z + v0[j].w * v0[j].w); s1 += (v1[j].x * v1[j].x + v1[j].y * v1[j].y) + (v1[j].z * v1[j].z + v1[j].w * v1[j].w); }
#pragma unroll
        for (int o = 1; o < 64; o <<= 1) { s0 += __shfl_xor(s0, o); s1 += __shfl_xor(s1, o); }
        const float rs0 = rsqrtf(s0 * (1.f / DM) + NORM_EPS), rs1 = rsqrtf(s1 * (1.f / DM) + NORM_EPS);
        bf16_t* o0 = XN + (size_t)r0 * DM; bf16_t* o1 = XN + (size_t)r1c * DM; bf16_t* e0 = norm_xne_ptr(XN, r0, xne_row); bf16_t* e1 = norm_xne_ptr(XN, r1c, xne_row);
#pragma unroll
        for (int j = 0; j < 4; ++j) {
            const f32x4 gg = *((const f32x4*)g + lane + 64 * j);
            const f32x4 y0 = (v0[j] * rs0) * gg * (*((const f32x4*)sc0 + lane + 64 * j) + 1.0f) + *((const f32x4*)sh0 + lane + 64 * j);
            const f32x4 y1 = (v1[j] * rs1) * gg * (*((const f32x4*)sc1 + lane + 64 * j) + 1.0f) + *((const f32x4*)sh1 + lane + 64 * j);
            u32x2 w0, w1; w0.x = pk2(y0.x, y0.y); w0.y = pk2(y0.z, y0.w); w1.x = pk2(y1.x, y1.y); w1.y = pk2(y1.z, y1.w);
            *((u32x2*)o0 + lane + 64 * j) = w0; if (e0) *((u32x2*)e0 + lane + 64 * j) = w0;
            if (has1) { *((u32x2*)o1 + lane + 64 * j) = w1; if (e1) *((u32x2*)e1 + lane + 64 * j) = w1; }
        }
    }
}
DI void qknorm_phase(bf16_t* PROJ, int ld, int qoff, const float* qn, const float* kn, const float* rope, int gw, int NGW, int lane) {
    const int d0 = 2 * (lane & 31), hsel = lane >> 5;
    const f32x2_t gq = *(const f32x2_t*)(qn + d0), gk = *(const f32x2_t*)(kn + d0);
    const int ridx = (d0 >> 5) * 16 + (d0 & 15); const bool second = (d0 >> 4) & 1;
    for (int r = gw; r < MALL; r += NGW) {
        unsigned* p = (unsigned*)(PROJ + (size_t)r * ld + qoff) + lane;
        const bool lat = r < NLAT; f32x2_t cs = {1.f, 1.f}, sn = {0.f, 0.f};
        if (lat) { const int t = r & 2047; cs = *(const f32x2_t*)(rope + t * 32 + ridx); sn = *(const f32x2_t*)(rope + SEQ * 32 + t * 32 + ridx); }
        unsigned raw[5];
#pragma unroll
        for (int i = 0; i < 5; ++i) raw[i] = p[64 * i];
#pragma unroll
        for (int i = 0; i < 5; ++i) {
            const float a = __uint_as_float(raw[i] << 16), b = __uint_as_float(raw[i] & 0xffff0000u);
            float ss = a * a + b * b;
#pragma unroll
            for (int o = 1; o < 32; o <<= 1) ss += __shfl_xor(ss, o);
            const float rs = rsqrtf(ss * (1.f / 64.f) + NORM_EPS); const bool isq = (2 * i + hsel) < 8;
            float ya = a * rs * (isq ? gq.x : gk.x), yb = b * rs * (isq ? gq.y : gk.y);
            const float pa = __shfl_xor(ya, 8), pb = __shfl_xor(yb, 8);
            if (lat) { ya = second ? (ya * cs.x + pa * sn.x) : (ya * cs.x - pa * sn.x); yb = second ? (yb * cs.y + pb * sn.y) : (yb * cs.y - pb * sn.y); }
            if (isq) { ya *= C2; yb *= C2; }
            p[64 * i] = pk2(ya, yb);
        }
    }
}

struct Args { const float* in[37]; float* out; unsigned char* ws; int ph_lo, ph_hi; };
constexpr int NPHASE = 19;

DI void p0_mod_items(const Args& a, char* lds, int layer, int idx, int nwg) {
    const int tid = threadIdx.x, lane = tid & 63, wid = tid >> 6; unsigned char* ws = a.ws;
    float* cond = (float*)lds;
    float* red = (float*)(lds + 1024 * 12 * 4);
    if (idx < 96) for (int e = tid; e < 9 * 1024; e += NTHREADS) { const int k = e & 1023, bb = e >> 10; const float cv = bb < 8 ? a.in[1][bb * 1024 + k] : a.in[3][k]; cond[k * 12 + bb] = siluf_(cv); }
    __syncthreads();
    float* MOD = (float*)(ws + WS_MOD);
    for (int cb = idx; cb < 96; cb += nwg) {
        const int col = cb * 64 + lane;
        const float* w = a.in[4] + (size_t)layer * DM * 6144 + col;
        float acc[9];
#pragma unroll
        for (int bb = 0; bb < 9; ++bb) acc[bb] = 0.f;
        for (int kk0 = 0; kk0 < 128; kk0 += 16) {
            float wv16[16];
#pragma unroll
            for (int i = 0; i < 16; ++i) wv16[i] = __builtin_nontemporal_load(w + (size_t)(wid * 128 + kk0 + i) * 6144);
#pragma unroll
            for (int i = 0; i < 16; ++i) { const int k = wid * 128 + kk0 + i; const float wv = wv16[i];
                const f32x4 c0 = *(const f32x4*)(cond + k * 12), c1 = *(const f32x4*)(cond + k * 12 + 4); const float c8 = cond[k * 12 + 8];
                acc[0] += c0.x * wv; acc[1] += c0.y * wv; acc[2] += c0.z * wv; acc[3] += c0.w * wv; acc[4] += c1.x * wv; acc[5] += c1.y * wv; acc[6] += c1.z * wv; acc[7] += c1.w * wv; acc[8] += c8 * wv; }
        }
#pragma unroll
        for (int bb = 0; bb < 9; ++bb) red[(wid * 9 + bb) * 64 + lane] = acc[bb];
        __syncthreads();
        for (int e = tid; e < 9 * 64; e += NTHREADS) { const int bb = e >> 6, ln = e & 63; float sacc = a.in[5][layer * 6144 + cb * 64 + ln];
#pragma unroll
            for (int w8 = 0; w8 < 8; ++w8) sacc += red[(w8 * 9 + bb) * 64 + ln];
            MOD[((size_t)layer * 9 + bb) * 6144 + cb * 64 + ln] = sacc; }
        __syncthreads();
    }
}

DI void p0_transposes(const Args& a, char* lds, int layer, int w0, int nw) {
    const int lane = threadIdx.x & 63, wid = threadIdx.x >> 6; unsigned char* ws = a.ws;
    float* scr = (float*)(lds + wid * 16384);
    constexpr int I_IN0 = 16 * (EIN / 32), I_OUT = 16 * 32, I_UP = 16 * (FH2 / 32), I_DN = (FH / 64) * 32, I_IN1 = 16 * (OIN / 32), I_GLU = 8 * 16;
    if (layer == 0) {
        constexpr int NIT = I_IN0 + I_OUT;
        for (int it = w0; it < NIT; it += nw) { int r = it;
            if (r < I_IN0) { p0_transpose_item(a.in[11], DM, EIN, (bf16_t*)(ws + WS_WIN0), false, scr, r, lane); continue; } r -= I_IN0;
            p0_transpose_item(a.in[12], DM, DM, (bf16_t*)(ws + WS_WOUT0), false, scr, r, lane); }
    } else if (layer == 2) {
        constexpr int NIT = I_UP + I_DN;
        for (int it = w0; it < NIT; it += nw) { int r = it;
            if (r < I_UP) { p0_transpose_item(a.in[7], DM, FH2, (bf16_t*)(ws + WS_WUP0), true, scr, r, lane); continue; } r -= I_UP;
            p0_transpose_item(a.in[10], FH, DM, (bf16_t*)(ws + WS_WDN0), false, scr, r, lane); }
    } else {
        constexpr int NIT = I_UP + I_DN + I_IN1 + I_OUT + I_GLU;
        for (int it = w0; it < NIT; it += nw) { int r = it;
            if (r < I_UP) { p0_transpose_item(a.in[7] + (size_t)DM * FH2, DM, FH2, (bf16_t*)(ws + WS_WUP1), true, scr, r, lane); continue; } r -= I_UP;
            if (r < I_DN) { p0_transpose_item(a.in[10] + (size_t)FH * DM, FH, DM, (bf16_t*)(ws + WS_WDN1), false, scr, r, lane); continue; } r -= I_DN;
            if (r < I_IN1) { p0_transpose_item(a.in[22], DM, OIN, (bf16_t*)(ws + WS_WIN1), false, scr, r, lane); continue; } r -= I_IN1;
            if (r < I_OUT) { p0_transpose_item(a.in[23], DM, DM, (bf16_t*)(ws + WS_WOUT1), false, scr, r, lane); continue; } r -= I_OUT;
            p0_transpose_item(a.in[32], 512, 512, (bf16_t*)(ws + WS_WGLU), false, scr, r, lane); }
    }
}

DI void p0_prologue(const Args& a, char* lds, int G, int rep) {
#ifdef P0_REP_EMPTY
    if (rep == 1) return;
#endif
    const int tid = threadIdx.x, lane = tid & 63, wid = tid >> 6;
    unsigned char* ws = a.ws;
    const int gw = blockIdx.x * NWAVES + wid, NGW = G * NWAVES;
    {
        const int gt = blockIdx.x * NTHREADS + tid, NGT = G * NTHREADS;
        float* rope = (float*)(ws + WS_ROPE);
        for (int e = gt; e < SEQ * 32; e += NGT) { const int t = e >> 5, idx = e & 31, i = idx & 15; const float pos = (float)((idx < 16) ? (t >> 6) : (t & 63));
            const float invf = powf(10000.0f, -(float)i / 16.0f); const float ang = pos * invf; rope[e] = cosf(ang); rope[SEQ * 32 + e] = sinf(ang); }
        bf16_t* rgw = (bf16_t*)(ws + WS_RGW);
        for (int e = gt; e < 4 * 8 * 4096; e += NGT) { const int k = e & 63, n = (e >> 6) & 63, hd = (e >> 12) & 7, mi = e >> 15; const int d = mi >> 1;
            const float* w = (mi & 1) ? a.in[17] : a.in[15]; rgw[e] = (bf16_t)f2bf(w[((size_t)(d * 8 + hd) * 64 + k) * 64 + n]); }
    }
    __syncthreads();
    p0_mod_items(a, lds, 0, (int)blockIdx.x, G);
    __syncthreads();
    p0_transposes(a, lds, 0, gw, NGW);
}

__global__ void __launch_bounds__(NTHREADS, 2) trunk_fwd(Args a) {
    extern __shared__ __attribute__((aligned(16))) unsigned char lds_raw[];
    char* lds = (char*)lds_raw;
    PG8_LAS unsigned char* ldsl = (PG8_LAS unsigned char*)lds_raw;
    cg::grid_group grid = cg::this_grid();
    const int tid = threadIdx.x, lane = tid & 63, wid = tid >> 6, G = gridDim.x;
    const int gw = blockIdx.x * NWAVES + wid, NGW = G * NWAVES;
    unsigned char* ws = a.ws;
    const int lo = a.ph_lo, hi = a.ph_hi;
    float* MOD = (float*)(ws + WS_MOD); float* HC = (float*)(ws + WS_HC);
    bf16_t* XN = (bf16_t*)(ws + WS_XN); bf16_t* PROJ = (bf16_t*)(ws + WS_PROJ); bf16_t* MIX = (bf16_t*)(ws + WS_MIX); bf16_t* HID = (bf16_t*)(ws + WS_HID);
    const float* rope = (const float*)(ws + WS_ROPE);
    float* CP = (float*)(ws + WS_Z);
    volatile LAS unsigned* MISC = (volatile LAS unsigned*)((LAS unsigned char*)lds_raw + LDS_MISC);
    if (tid < 64) MISC[tid] = 0u;
    __syncthreads();
    XcdBarrier xbar; xbar.bar = (unsigned*)(ws + WS_CTL) + 4096; xbar.x = 0; xbar.st = nullptr;
    if (hi - lo > 1) xbar = xcd_barrier_post((unsigned*)(ws + WS_CTL) + 4096, MISC + 8);
#ifndef PHASE_MASK
#define PHASE_MASK 0x7ffff
#endif
#define IN(k) (((PHASE_MASK >> (k)) & 1) && lo <= (k) && (k) < hi)
#ifndef DUP_MASK
#define DUP_MASK 0
#endif
#define REP(k) for (int rep_ = 0; rep_ < (((DUP_MASK >> (k)) & 1) ? 2 : 1); ++rep_, (void)((((DUP_MASK >> (k)) & 1) && rep_ == 1) ? (xcd_barrier(xbar), 0) : 0))
#ifdef TIME_MASK
    unsigned long long tprev_ = __builtin_amdgcn_s_memrealtime(), tsum_ = 0ull;
#define TSTAMP(k) do { const unsigned long long tn_ = __builtin_amdgcn_s_memrealtime(); if (((TIME_MASK) >> (k)) & 1) tsum_ += tn_ - tprev_; tprev_ = tn_; } while (0)
#else
#define TSTAMP(k) do {} while (0)
#endif
#define SEAM(k) do { if (IN(k) && IN((k) + 1)) { xcd_barrier(xbar); TSTAMP(k); } } while (0)

    if (hi > 1000) grid.sync();
    if (IN(0)) REP(0) { p0_prologue(a, lds, G, rep_); } SEAM(0);
    if (IN(1)) REP(1) norm_phase(a.in[0], a.in[2], a.in[6], MOD, 0, 1, XN, MALL, -1, gw, NGW, lane);
    SEAM(1);
    if (IN(2)) REP(2) { pg8::Gemm g{XN, (const bf16_t*)(ws + WS_WIN0), MALL, EIN, DM}; pg8::StaticOrder S; S.init(MALL, EIN, G, (int)blockIdx.x);
        pg8::EpiBf16<0> E{PROJ, EIN, nullptr, 0, 0, 1.f}; pg8::gemm_phase<pg8::EpiBf16<0>, pg8::StaticOrder, true, true>(ldsl, g, S, E); }
    SEAM(2);
    if (IN(3)) { qknorm_phase(PROJ, EIN, 1024, a.in[20], a.in[21], rope, gw, NGW, lane); __syncthreads();
#ifdef DUP_RG1
        for (int rep2_ = 0; rep2_ < 2; ++rep2_)
#endif
        for (int it = blockIdx.x; it < NB * 8 * 36; it += G) rg_item1(a.in, ws, lds, it); }
    SEAM(3);
    if (IN(4)) REP(4) {
#ifndef P4_NO_ATTN
#ifdef DUP_ATT
        for (int rep2_ = 0; rep2_ < 2; ++rep2_)
#endif
        for (int it = blockIdx.x; it < 256; it += G) { const int qb = it & 3, head = (it >> 2) & 7, b = it >> 5; attn_unit<0, 2>(PROJ, EIN, 1024, 1536, 1664, MIX, lds, b, head, qb * 512, 0.f); }
        for (int it = blockIdx.x; it < 64; it += G) { const int head = it & 7, b = it >> 3; attn_unit<1, 1>(PROJ, EIN, 1024, 1536, 1664, MIX, lds, b, head, 0, 0.f); }
#endif
#ifndef P4_NO_RG
        for (int it = (blockIdx.x + G - 64) % G; it < NB * 8 * 36; it += G) rg_item2(a.in, ws, lds, it);
#endif
    }
    SEAM(4);
    if (IN(5)) REP(5) { { pg8::Gemm g{MIX, (const bf16_t*)(ws + WS_WOUT0), NLAT, DM, DM}; pg8::StaticOrder S; S.init(NLAT, DM, G, (int)blockIdx.x);
          EpiRes E{a.in[0], a.in[2], a.out, HC, MOD + 2 * 1024}; pg8::gemm_phase<EpiRes, pg8::StaticOrder, true, true>(ldsl, g, S, E); }
#pragma unroll 1
        for (int kh = 0; kh < 2; ++kh) {
          pg8::Gemm g{MIX + kh * 512, (const bf16_t*)(ws + WS_WOUT0) + kh * 512, MALL, DM, 512, DM, DM}; CtxOrder S{(int)blockIdx.x - 64 * kh};
          EpiCtxHalf E{a.in[2], HC, CP, MOD + 2 * 1024, kh}; pg8::gemm_phase<EpiCtxHalf, CtxOrder, true, true>(ldsl, g, S, E); } }
    if (IN(5)) { const int bx = blockIdx.x; const bool busy = (bx < 32) || (bx >= 64 && bx < 96);
        if (G == 256) { if (!busy) { const int idx = bx < 64 ? bx - 32 : bx - 64; p0_transposes(a, lds, 2, idx * NWAVES + wid, 192 * NWAVES); } }
        else p0_transposes(a, lds, 2, gw, NGW); }
    SEAM(5);
    if (IN(6)) REP(6) norm_phase(a.out, HC, a.in[6] + DM, MOD, 3, 4, XN, MALL, XNE_ROW_L0, gw, NGW, lane, CP, HC);
    SEAM(6);
    if (IN(7)) REP(7) { constexpr int MT = MALL + 1280; pg8::Gemm g{XN, (const bf16_t*)(ws + WS_WUP0), MT, FH2, DM}; pg8::StaticOrder S; S.init(MT, FH2, G, (int)blockIdx.x);
        EpiConvAct E{HID, a.in[8], a.in[9], MALL / 256, NBND_LAT, NBND_LAT + NBND_CTX, lds + 131072}; pg8::gemm_phase<EpiConvAct, pg8::StaticOrder, true, true>(ldsl, g, S, E); }
    if (IN(7)) { constexpr int NU = ((MALL + 1280) / 256) * (FH2 / 256), NFULL = NU % 256;
        if (G == 256 && (int)blockIdx.x >= NFULL) p0_transposes(a, lds, 1, ((int)blockIdx.x - NFULL) * NWAVES + wid, (256 - NFULL) * NWAVES);
        else if (G != 256) p0_transposes(a, lds, 1, gw, NGW); }
    SEAM(7);
    if (IN(8)) { { pg8::Gemm g{HID, (const bf16_t*)(ws + WS_WDN0), NLAT, DM, FH}; pg8::StaticOrder S; S.init(NLAT, DM, G, (int)blockIdx.x);
          EpiRes E{a.out, HC, a.out, HC, MOD + 5 * 1024}; pg8::gemm_phase<EpiRes, pg8::StaticOrder, true, true>(ldsl, g, S, E); }
#pragma unroll 1
        for (int kh = 0; kh < 2; ++kh) {
          pg8::Gemm g{HID + kh * (FH / 2), (const bf16_t*)(ws + WS_WDN0) + kh * (FH / 2), MALL, DM, FH / 2, FH, FH}; CtxOrder S{(int)blockIdx.x - 64 * kh};
          EpiCtxHalf E{HC, HC, CP, MOD + 5 * 1024, kh}; pg8::gemm_phase<EpiCtxHalf, CtxOrder, true, true>(ldsl, g, S, E); } }
    if (IN(8)) { const int bx = blockIdx.x; const bool busy = (bx < 32) || (bx >= 64 && bx < 96);
        if (G == 256) { if (!busy) { const int idx = bx < 64 ? bx - 32 : bx - 64; if (idx < 128) s5_pre_item(a.in, ws, lds, idx); else p0_mod_items(a, lds, 1, idx - 128, 64); } }
        else { for (int it = bx; it < 128; it += G) s5_pre_item(a.in, ws, lds, it); p0_mod_items(a, lds, 1, bx, G); } }
    SEAM(8);
    const float* MOD1 = MOD + 9 * 6144;
    if (IN(9)) REP(9) norm_phase(a.out, HC, a.in[6] + 2 * DM, MOD1, 0, 1, XN, MALL, -1, gw, NGW, lane, CP, nullptr);
    SEAM(9);
    if (IN(10)) REP(10) { pg8::Gemm g{XN, (const bf16_t*)(ws + WS_WIN1), MALL, OIN, DM}; pg8::StaticOrder S; S.init(MALL, OIN, G, (int)blockIdx.x);
        pg8::EpiBf16<0> E{PROJ, OIN, nullptr, 0, 0, 1.f}; pg8::gemm_phase<pg8::EpiBf16<0>, pg8::StaticOrder, true, true>(ldsl, g, S, E); }
    SEAM(10);
    if (IN(11)) { qknorm_phase(PROJ, OIN, 512, a.in[34], a.in[35], rope, gw, NGW, lane);
        for (int n = gw; n < 576; n += NGW) s5_repack_chunk(ws, n, lane);
        xcd_barrier(xbar);
        pg8::Gemm g{(const bf16_t*)(ws + WS_UG), (const bf16_t*)(ws + WS_S5E), 32 * 768, 32 * 256, 512, 768, 512}; S5Order S{G, (int)blockIdx.x, 1};
        EpiS5L E{(float*)(ws + WS_S5L)}; pg8::gemm_phase<EpiS5L, S5Order, true, true>(ldsl, g, S, E); }
    SEAM(11);
    if (IN(12)) REP(12) {
        { const int gt = blockIdx.x * NTHREADS + tid; if (gt < NB * 32 * 2 * 64) s5_scan_thread(ws, gt); }
        __syncthreads();
        const int nskip = (NB * 32 * 2 * 64) / NTHREADS;
        for (int it = (blockIdx.x + G - nskip) % G; it < 512; it += G) { const int qb = it & 7, head = (it >> 3) & 7, b = it >> 6;
            attn_unit<2, 1>(PROJ, OIN, 512, 1024, 1152, MIX, lds, b, head, qb * 256, a.in[36][head] * 1.4426950408889634f); }
    }
    SEAM(12);
    if (IN(13)) REP(13) { pg8::Gemm g{(const bf16_t*)(ws + WS_UG), (const bf16_t*)(ws + WS_S5MF), 32 * 768, 32 * 512, 768, 768, 768}; S5Order S{G, (int)blockIdx.x, 2};
        EpiS5Y E{(bf16_t*)(ws + WS_Z)}; pg8::gemm_phase<EpiS5Y, S5Order, true, true>(ldsl, g, S, E); }
    SEAM(13);
    if (IN(14)) REP(14) { pg8::Gemm g{(const bf16_t*)(ws + WS_Z), (const bf16_t*)(ws + WS_WGLU), NLAT, 512, 512}; pg8::StaticOrder S; S.init(NLAT, 512, G, (int)blockIdx.x);
        EpiGlu E{(const bf16_t*)(ws + WS_Z), MIX, a.in[33]}; pg8::gemm_phase<EpiGlu, pg8::StaticOrder, true, true>(ldsl, g, S, E); }
    SEAM(14);
    if (IN(15)) { pg8::Gemm g{MIX, (const bf16_t*)(ws + WS_WOUT1), NLAT, DM, DM}; pg8::StaticOrder S; S.init(NLAT, DM, G, (int)blockIdx.x);
        EpiRes E{a.out, HC, a.out, HC, MOD1 + 2 * 1024}; pg8::gemm_phase<EpiRes, pg8::StaticOrder, true, true>(ldsl, g, S, E); }
    SEAM(15);
    if (IN(16)) REP(16) norm_phase(a.out, HC, a.in[6] + 3 * DM, MOD1, 3, 4, XN, NLAT, XNE_ROW_L1, gw, NGW, lane);
    SEAM(16);
    if (IN(17)) REP(17) { constexpr int MT = NLAT + 1024; pg8::Gemm g{XN, (const bf16_t*)(ws + WS_WUP1), MT, FH2, DM}; pg8::StaticOrder S; S.init(MT, FH2, G, (int)blockIdx.x);
        EpiConvAct E{HID, a.in[8] + 3 * FH2, a.in[9] + FH2, NLAT / 256, NBND_LAT, NBND_LAT, lds + 131072}; pg8::gemm_phase<EpiConvAct, pg8::StaticOrder, true, true>(ldsl, g, S, E); }
    SEAM(17);
    if (IN(18)) { pg8::Gemm g{HID, (const bf16_t*)(ws + WS_WDN1), NLAT, DM, FH}; pg8::StaticOrder S; S.init(NLAT, DM, G, (int)blockIdx.x);
        EpiRes E{a.out, HC, a.out, HC, MOD1 + 5 * 1024}; pg8::gemm_phase<EpiRes, pg8::StaticOrder, true, true>(ldsl, g, S, E); }
#ifdef TIME_MASK
    xcd_barrier(xbar); TSTAMP(18);
    if (blockIdx.x == 0 && tid == 0) a.out[0] = 1e4f * ((float)tsum_ * 0.01f);
#endif
#undef IN
#undef SEAM
}

#ifndef N_LAUNCH_MODE
#define N_LAUNCH_MODE 1
#endif
extern "C" void kernel_launch(void* const* d_in, const int* in_sizes, int n_in, void* d_out, int out_size, void* d_ws, size_t ws_size, hipStream_t stream) {
    static int grid = 0;
    if (grid == 0) {
        if (n_in != 37 || out_size != NLAT * DM || ws_size < WS_END) { fprintf(stderr, "kernel_launch: unexpected problem (n_in %d out %d ws %zu)\n", n_in, out_size, ws_size); grid = -1; return; }
        int dev = 0, cus = 0, per_cu = 0;
        hipGetDevice(&dev); hipDeviceGetAttribute(&cus, hipDeviceAttributeMultiprocessorCount, dev);
        if (hipFuncSetAttribute((const void*)trunk_fwd, hipFuncAttributeMaxDynamicSharedMemorySize, LDS_BYTES) != hipSuccess) { fprintf(stderr, "kernel_launch: hipFuncSetAttribute failed\n"); grid = -1; return; }
        if (hipOccupancyMaxActiveBlocksPerMultiprocessor(&per_cu, (const void*)trunk_fwd, NTHREADS, LDS_BYTES) != hipSuccess || per_cu < 1) { fprintf(stderr, "kernel_launch: occupancy query says %d\n", per_cu); per_cu = 1; }
        (void)hipGetLastError();
        grid = cus;
        fprintf(stderr, "kernel_launch: grid %d (cus %d, per_cu %d)\n", grid, cus, per_cu);
    }
    if (grid < 0) return;
    (void)hipMemsetAsync((char*)d_ws + WS_CTL, 0, CTL_ZERO_BYTES, stream);
    Args a{};
    for (int i = 0; i < 37; ++i) a.in[i] = (const float*)d_in[i];
    a.out = (float*)d_out; a.ws = (unsigned char*)d_ws;
#if N_LAUNCH_MODE == 1
    a.ph_lo = 0; a.ph_hi = NPHASE;
    void* args[] = {&a};
    hipError_t e = hipLaunchCooperativeKernel((const void*)trunk_fwd, dim3(grid), dim3(NTHREADS), args, LDS_BYTES, stream);
    if (e != hipSuccess) fprintf(stderr, "cooperative launch failed: %s (grid %d)\n", hipGetErrorString(e), grid);
#else
    for (int p = 0; p < NPHASE; ++p) { a.ph_lo = p; a.ph_hi = p + 1; hipLaunchKernelGGL(trunk_fwd, dim3(grid), dim3(NTHREADS), LDS_BYTES, stream, a);
#ifdef DBG_CHECK
        Args d = a; d.ph_lo = 0; d.ph_hi = 0;
        static const int chk[NPHASE][2] = {{1,0},{0,0},{2,0},{3,0},{4,5},{6,0},{0,0},{7,8},{0,0},{0,0},{9,0},{10,0},{11,0},{12,0},{15,0},{0,0},{0,0},{14,0},{0,0}};
        for (int q = 0; q < 2; ++q) { const int st = chk[p][q]; if (!st) continue; const bool heavy = (st == 5 || st == 12); hipLaunchKernelGGL(dbg_check, dim3(heavy ? 1 : 4), dim3(heavy ? 64 : 256), 0, stream, d, st); }
        if (p == NPHASE - 1) hipLaunchKernelGGL(dbg_report, dim3(1), dim3(64), 0, stream, d);
#endif
    }
#endif
}
```

```cpp
#include <hip/hip_runtime.h>
#include <hip/hip_cooperative_groups.h>
#include <hip/hip_bf16.h>
#include <cstdio>
#include <cstdint>
#include <cmath>
namespace cg = cooperative_groups;
namespace pg8 {
#define PG8_LAS __attribute__((address_space(3)))
typedef unsigned short bf16_t;
typedef short bf16x8 __attribute__((ext_vector_type(8)));
typedef float f32x4 __attribute__((ext_vector_type(4)));
typedef unsigned u32x4 __attribute__((ext_vector_type(4)));
constexpr int BM = 256, BK = 64, HALF = 128, HTB = HALF * BK * 2  , STAGE_BYTES = 8 * HTB, NXCD = 8, WGM = 8;

__host__ __device__ __forceinline__ int lds_byte(int r, int c) { const int st = (r >> 4) * 2 + (c >> 5), rr = r & 15, cc = c & 31, ob = rr * 64 + cc * 2; return st * 1024 + (ob ^ (((ob >> 9) & 1) << 5)); }
__host__ __device__ __forceinline__ void stage_rc(int b, int& R, int& C) { const int st = b / 1024, sb = b % 1024, swz = sb ^ (((sb >> 9) & 1) << 5); R = (st >> 1) * 16 + swz / 64; C = (st & 1) * 32 + (swz % 64) / 2; }
__host__ __device__ __forceinline__ int perm32(int rho) { const int n = rho >> 4, i = rho & 15; return 8 * (i >> 2) + 4 * n + (i & 3); }

struct Unit { int pm, pn; };
struct Gemm { const bf16_t* A; const bf16_t* Bt; int M, N, K; int lda, ldb; };

struct StaticOrder {
    int nM, nN, nwg, G, c;
    __host__ __device__ void init(int M, int N, int G_, int c_) { nM = M / BM; nN = N / BM; nwg = nM * nN; G = G_; c = c_; }
    __host__ __device__ bool next(int i, Unit& u) const {
        const long L = (long)i * G + c; if (L >= nwg) return false;
        int wgid = (int)L; { const int q = nwg / NXCD, r = nwg % NXCD, xcd = wgid % NXCD, off = wgid / NXCD; wgid = (xcd < r ? xcd * (q + 1) : r * (q + 1) + (xcd - r) * q) + off; }
        const int nig = WGM * nN, gid = wgid / nig, fm = gid * WGM, gsz = (nM - fm) < WGM ? (nM - fm) : WGM;
        u.pm = fm + ((wgid % nig) % gsz); u.pn = (wgid % nig) / gsz; return true;
    }
    __device__ __forceinline__ void a_ready(const Unit&) const {}
    __device__ __forceinline__ void done(const Unit&) const {}
};

__device__ __forceinline__ unsigned cvt_pk_bf16(float lo, float hi) { unsigned r; asm volatile("v_cvt_pk_bf16_f32 %0, %1, %2" : "=v"(r) : "v"(lo), "v"(hi)); return r; }
typedef float f32x2 __attribute__((ext_vector_type(2)));
__device__ __forceinline__ f32x2 gelu_pk(f32x2 v) {
    const f32x2 av = __builtin_elementwise_abs(v), d = av * 0.2316418882f + 1.0f;
    f32x2 t; t.x = __builtin_amdgcn_rcpf(d.x); t.y = __builtin_amdgcn_rcpf(d.y);
    f32x2 q = t * 0.5307027145f + (-0.7265760135f); q = q * t + 0.7107068705f; q = q * t + (-0.142248368f); q = q * t + 0.127414796f; q = q * t;
    const f32x2 s = (v * v) * (-0.72134752044f);
    f32x2 e; e.x = __builtin_amdgcn_exp2f(s.x); e.y = __builtin_amdgcn_exp2f(s.y);
    const f32x2 m = v * (q * e), r = v - m;
    f32x2 o; o.x = v.x < 0.f ? m.x : r.x; o.y = v.y < 0.f ? m.y : r.y; return o;
}
template <int ACT  > struct EpiBf16 {
    static constexpr bool PERM = true, AFTER_DRAIN = false; static_assert(ACT == 0 || ACT == 1, "EpiBf16: ACT is 0 (none) or 1 (gelu_pk)");
    bf16_t* O; int ldc; const float* bias; int split_cols; size_t split_stride; float scale0;
    __device__ __forceinline__ void operator()(const f32x4 (&acc)[2][2][4][2], const Unit& u, int wr, int wc, int fr, int fq) const {
        const int row0 = u.pm * BM + wr * 64 + fr; int colt = u.pn * BM; bf16_t* base = O;
        float sc = 1.f; if (split_cols) { const int t = colt / split_cols; base += (size_t)t * split_stride; colt -= t * split_cols; if (t == 0) sc = scale0; }
        const int col0 = colt + wc * 32 + 8 * fq, bcol0 = u.pn * BM + wc * 32 + 8 * fq;
        f32x4 bv[2][2];
#pragma unroll
        for (int bj = 0; bj < 2; ++bj)
#pragma unroll
            for (int n = 0; n < 2; ++n) bv[bj][n] = bias ? *(const f32x4*)(bias + bcol0 + bj * HALF + 4 * n) : (f32x4){0.f, 0.f, 0.f, 0.f};
#pragma unroll
        for (int ai = 0; ai < 2; ++ai)
#pragma unroll
            for (int m = 0; m < 4; ++m) { bf16_t* rowp = base + (size_t)(row0 + ai * HALF + m * 16) * ldc + col0;
#pragma unroll
                for (int bj = 0; bj < 2; ++bj) { f32x4 v0 = acc[ai][bj][m][0] + bv[bj][0], v1 = acc[ai][bj][m][1] + bv[bj][1];
                    if (ACT == 1) { f32x2 a = gelu_pk((f32x2){v0[0], v0[1]}), b = gelu_pk((f32x2){v0[2], v0[3]}), c = gelu_pk((f32x2){v1[0], v1[1]}), d = gelu_pk((f32x2){v1[2], v1[3]});
                        v0 = (f32x4){a.x, a.y, b.x, b.y}; v1 = (f32x4){c.x, c.y, d.x, d.y}; }
                    v0 = v0 * sc; v1 = v1 * sc; u32x4 w; w.x = cvt_pk_bf16(v0[0], v0[1]); w.y = cvt_pk_bf16(v0[2], v0[3]); w.z = cvt_pk_bf16(v1[0], v1[1]); w.w = cvt_pk_bf16(v1[2], v1[3]);
                    *(u32x4*)(rowp + bj * HALF) = w; } }
    }
};
template <class Epi, class Sched, bool ALIGN_EPI = false, bool SP2 = false>
__device__ __forceinline__ void gemm_phase(PG8_LAS unsigned char* lds, const Gemm g, const Sched& S, const Epi& E) {
    const int tid = threadIdx.x, wid = __builtin_amdgcn_readfirstlane(tid >> 6), lane = tid & 63, wr = wid >> 2, wc = wid & 3, fr = lane & 15, fq = lane >> 4;
    const int K = g.K, nt = K / BK; const int lda = g.lda ? g.lda : K, ldb = g.ldb ? g.ldb : K;
    unsigned voffA[2], voffB[2];
#pragma unroll
    for (int i = 0; i < 2; ++i) { int R, C; stage_rc(tid * 16 + i * 8192, R, C); const int Rb = Epi::PERM ? ((R & ~31) + perm32(R & 31)) : R;
        voffA[i] = (unsigned)(R * lda + C) * 2u; voffB[i] = (unsigned)(Rb * ldb + C) * 2u; }
    const size_t kstep = (size_t)(BK * 2);
    const size_t hsA = (size_t)HALF * lda * 2, hsB = (size_t)HALF * ldb * 2;
    const size_t tsA = 2 * hsA, tsB = 2 * hsB;
    const unsigned ldsw = (unsigned)wid * 1024u;
    const int aoff = lds_byte(wr * 64 + fr, fq * 8), boff = lds_byte(wc * 32 + fr, fq * 8);
#define PG8_SA(b, h) (((b) * 2 + (h)) * HTB)
#define PG8_SB(b, h) ((4 + (b) * 2 + (h)) * HTB)
#define PG8_STAGE(bufoff, gbase, voff) do { _Pragma("unroll") for (int _i = 0; _i < 2; ++_i) \
        __builtin_amdgcn_global_load_lds((const unsigned*)((const char*)(gbase) + (voff)[_i]), (PG8_LAS unsigned*)(lds + (bufoff) + ldsw + _i * 8192), 16, 0, 0); } while (0)
#define PG8_LDA(dst, b, h) do { _Pragma("unroll") for (int m = 0; m < 4; ++m) _Pragma("unroll") for (int k = 0; k < 2; ++k) dst[m][k] = *(const PG8_LAS bf16x8*)(lds + PG8_SA(b, h) + aoff + m * 2048 + k * 1024); } while (0)
#define PG8_LDB(dst, b, h) do { _Pragma("unroll") for (int n = 0; n < 2; ++n) _Pragma("unroll") for (int k = 0; k < 2; ++k) dst[n][k] = *(const PG8_LAS bf16x8*)(lds + PG8_SB(b, h) + boff + n * 2048 + k * 1024); } while (0)
#define PG8_MMA(ai, bj, At, Bt) do { __builtin_amdgcn_s_setprio(1); _Pragma("unroll") for (int m = 0; m < 4; ++m) _Pragma("unroll") for (int n = 0; n < 2; ++n) _Pragma("unroll") for (int k = 0; k < 2; ++k) \
        acc[ai][bj][m][n] = __builtin_amdgcn_mfma_f32_16x16x32_bf16(Bt[n][k], At[m][k], acc[ai][bj][m][n], 0, 0, 0); __builtin_amdgcn_s_setprio(0); } while (0)
#define PG8_WAIT_V(n) asm volatile("s_waitcnt vmcnt(" #n ")" ::: "memory")
#define PG8_WAIT_L(n) asm volatile("s_waitcnt lgkmcnt(" #n ")" ::: "memory")
#define PG8_BAR __builtin_amdgcn_s_barrier()
#define PG8_SCHED __builtin_amdgcn_sched_barrier(0)
    Unit cur, nxt; int ui = 0;
    if (!S.next(0, cur)) return;
    f32x4 acc[2][2][4][2];
#pragma unroll
    for (int a = 0; a < 2; ++a)
#pragma unroll
        for (int b = 0; b < 2; ++b)
#pragma unroll
            for (int m = 0; m < 4; ++m)
#pragma unroll
                for (int n = 0; n < 2; ++n) acc[a][b][m][n] = (f32x4){0.f, 0.f, 0.f, 0.f};
    bf16x8 At[4][2], B0[2][2], B1[2][2];
    const char* cA = (const char*)g.A + (size_t)cur.pm * tsA; const char* cB = (const char*)g.Bt + (size_t)cur.pn * tsB;
    S.a_ready(cur);
    if constexpr (SP2) {
        PG8_STAGE(PG8_SB(0, 0), cB, voffB); PG8_STAGE(PG8_SB(0, 1), cB + hsB, voffB); PG8_STAGE(PG8_SA(0, 0), cA, voffA); PG8_STAGE(PG8_SA(0, 1), cA + hsA, voffA);
        if (wr == 1) PG8_BAR;
        PG8_WAIT_V(2); PG8_BAR;
        PG8_STAGE(PG8_SB(1, 0), cB + kstep, voffB); PG8_STAGE(PG8_SA(1, 0), cA + kstep, voffA); PG8_STAGE(PG8_SB(1, 1), cB + hsB + kstep, voffB);
        PG8_WAIT_V(6); PG8_BAR;
    } else {
        PG8_STAGE(PG8_SB(0, 0), cB, voffB); PG8_STAGE(PG8_SA(0, 0), cA, voffA); PG8_STAGE(PG8_SB(0, 1), cB + hsB, voffB); PG8_STAGE(PG8_SA(0, 1), cA + hsA, voffA);
        if (wr == 1) PG8_BAR;
        PG8_WAIT_V(4); PG8_BAR;
        PG8_STAGE(PG8_SB(1, 0), cB + kstep, voffB); PG8_STAGE(PG8_SA(1, 0), cA + kstep, voffA); PG8_STAGE(PG8_SB(1, 1), cB + hsB + kstep, voffB);
        PG8_WAIT_V(6); PG8_BAR;
    }
    for (;;) {
        const bool has_next = S.next(ui + 1, nxt);
        const char* nA = has_next ? (const char*)g.A + (size_t)nxt.pm * tsA : cA; const char* nB = has_next ? (const char*)g.Bt + (size_t)nxt.pn * tsB : cB;
        for (int t = 0; t < nt; t += 2) {
            const bool last = (t == nt - 2);
            const char* a1 = cA + (size_t)(t + 1) * kstep;
            const char* a2 = last ? nA : cA + (size_t)(t + 2) * kstep; const char* b2 = last ? nB : cB + (size_t)(t + 2) * kstep;
            const char* a3 = a2 + kstep; const char* b3 = b2 + kstep;
            if (last && has_next) S.a_ready(nxt);
            if constexpr (SP2) {
            PG8_LDB(B0, 0, 0); PG8_LDB(B1, 0, 1); PG8_SCHED; PG8_LDA(At, 0, 0); PG8_STAGE(PG8_SA(1, 1), a1 + hsA, voffA);
            PG8_WAIT_V(8); PG8_WAIT_L(0); PG8_BAR; PG8_MMA(0, 0, At, B0); PG8_MMA(0, 1, At, B1); PG8_BAR; PG8_SCHED;
            PG8_LDA(At, 0, 1); PG8_STAGE(PG8_SB(0, 0), b2, voffB); PG8_STAGE(PG8_SB(0, 1), b2 + hsB, voffB); PG8_STAGE(PG8_SA(0, 0), a2, voffA);
            PG8_WAIT_V(8); PG8_WAIT_L(0); PG8_BAR; PG8_MMA(1, 0, At, B0); PG8_MMA(1, 1, At, B1); PG8_BAR; PG8_SCHED;
            PG8_LDB(B0, 1, 0); PG8_LDB(B1, 1, 1); PG8_SCHED; PG8_LDA(At, 1, 0); PG8_STAGE(PG8_SA(0, 1), a2 + hsA, voffA);
            PG8_WAIT_V(8); PG8_WAIT_L(0); PG8_BAR; PG8_MMA(0, 0, At, B0); PG8_MMA(0, 1, At, B1); PG8_BAR; PG8_SCHED;
            PG8_LDA(At, 1, 1); PG8_STAGE(PG8_SB(1, 0), b3, voffB); PG8_STAGE(PG8_SB(1, 1), b3 + hsB, voffB); PG8_STAGE(PG8_SA(1, 0), a3, voffA);
            PG8_WAIT_V(8); PG8_WAIT_L(0); PG8_BAR; PG8_MMA(1, 0, At, B0); PG8_MMA(1, 1, At, B1); PG8_BAR; PG8_SCHED;
            } else {
            PG8_LDB(B0, 0, 0); PG8_SCHED; PG8_LDA(At, 0, 0); PG8_STAGE(PG8_SA(1, 1), a1 + hsA, voffA);
            PG8_WAIT_L(8); PG8_BAR; PG8_WAIT_L(0); PG8_MMA(0, 0, At, B0); PG8_BAR; PG8_SCHED;
            PG8_LDB(B1, 0, 1); PG8_STAGE(PG8_SB(0, 0), b2, voffB);
            PG8_BAR; PG8_WAIT_L(0); PG8_MMA(0, 1, At, B1); PG8_BAR;
            PG8_LDA(At, 0, 1); PG8_STAGE(PG8_SA(0, 0), a2, voffA);
            PG8_BAR; PG8_WAIT_L(0); PG8_MMA(1, 0, At, B0); PG8_BAR; PG8_SCHED;
            PG8_STAGE(PG8_SB(0, 1), b2 + hsB, voffB);
            PG8_WAIT_V(6); PG8_BAR; PG8_MMA(1, 1, At, B1); PG8_BAR;
            PG8_LDB(B0, 1, 0); PG8_SCHED; PG8_LDA(At, 1, 0); PG8_STAGE(PG8_SA(0, 1), a2 + hsA, voffA);
            PG8_WAIT_L(8); PG8_BAR; PG8_WAIT_L(0); PG8_MMA(0, 0, At, B0); PG8_BAR; PG8_SCHED;
            PG8_LDB(B1, 1, 1); PG8_STAGE(PG8_SB(1, 0), b3, voffB);
            PG8_BAR; PG8_WAIT_L(0); PG8_MMA(0, 1, At, B1); PG8_BAR;
            PG8_LDA(At, 1, 1); PG8_STAGE(PG8_SA(1, 0), a3, voffA);
            PG8_BAR; PG8_WAIT_L(0); PG8_MMA(1, 0, At, B0); PG8_BAR; PG8_SCHED;
            PG8_STAGE(PG8_SB(1, 1), b3 + hsB, voffB);
            PG8_WAIT_V(6); PG8_BAR; PG8_MMA(1, 1, At, B1); PG8_BAR;
            }
        }
        if constexpr (ALIGN_EPI) { if (wr == 0) PG8_BAR; }
        if constexpr (!Epi::AFTER_DRAIN) { E(acc, cur, wr, wc, fr, fq); S.done(cur); }
        if (!has_next) break;
#pragma unroll
        for (int a = 0; a < 2; ++a)
#pragma unroll
            for (int b = 0; b < 2; ++b)
#pragma unroll
                for (int m = 0; m < 4; ++m)
#pragma unroll
                    for (int n = 0; n < 2; ++n) acc[a][b][m][n] = (f32x4){0.f, 0.f, 0.f, 0.f};
        cur = nxt; cA = nA; cB = nB; ++ui;
        if constexpr (ALIGN_EPI) { if (wr == 1) PG8_BAR; }
    }
    PG8_WAIT_V(0);
    if constexpr (!ALIGN_EPI) { if (wr == 0) PG8_BAR; }
    PG8_BAR;
    if constexpr (Epi::AFTER_DRAIN) { E.fused(acc, cur, wr, wc, fr, fq, lds, wid, lane); S.done(cur); }
#undef PG8_SA
#undef PG8_SB
#undef PG8_STAGE
#undef PG8_LDA
#undef PG8_LDB
#undef PG8_MMA
#undef PG8_WAIT_V
#undef PG8_WAIT_L
#undef PG8_BAR
#undef PG8_SCHED
}
}

#define DI __device__ __forceinline__
typedef pg8::bf16_t bf16_t;
typedef short bf16x8 __attribute__((ext_vector_type(8)));
typedef short s16x4 __attribute__((ext_vector_type(4)));
typedef float f32x4 __attribute__((ext_vector_type(4)));
typedef float f32x16 __attribute__((ext_vector_type(16)));
typedef unsigned u32x4 __attribute__((ext_vector_type(4)));
typedef unsigned u32x2 __attribute__((ext_vector_type(2)));
#define LAS __attribute__((address_space(3)))
typedef float f32x2_t __attribute__((ext_vector_type(2)));

constexpr int DM = 1024, NB = 8, SEQ = 2048, CTXL = 256;
constexpr int NLAT = NB * SEQ, NCTX = NB * CTXL, MALL = NLAT + NCTX;
constexpr int FH = 2816, FH2 = 5632, EIN = 1792, OIN = 1280;
constexpr float NORM_EPS = 1e-6f;
constexpr float C2 = 0.125f * 1.4426950408889634f;
constexpr int NTHREADS = 512, NWAVES = 8;
constexpr int LDS_BYTES = 147456 + 8192 + 256, LDS_MISC = 147456 + 8192;
constexpr int NBND_LAT = NB * 31, NBND_CTX = NB * 3;
constexpr int XNE_ROW_L0 = MALL, XNE_ROW_L1 = NLAT;
constexpr int XN_ROWS = MALL + 1280;

constexpr size_t MiB = 1u << 20;
constexpr size_t WS_CTL = 0, CTL_ZERO_BYTES = 64 * 1024;
constexpr size_t WS_MOD = 1 * MiB;
constexpr size_t WS_ROPE = 2 * MiB;
constexpr size_t WS_RGW = 3 * MiB;
constexpr size_t WS_S5AT = 3 * MiB + 512 * 1024;
constexpr size_t WS_RGTOT = 4 * MiB;
constexpr size_t WS_S5E = 7 * MiB, WS_S5MF = 15 * MiB;
constexpr size_t WS_WIN0 = 39 * MiB, WS_WOUT0 = 43 * MiB, WS_WUP0 = 45 * MiB, WS_WDN0 = 56 * MiB;
constexpr size_t WS_WIN1 = 62 * MiB, WS_WOUT1 = 65 * MiB, WS_WUP1 = 67 * MiB, WS_WDN1 = 78 * MiB, WS_WGLU = 84 * MiB;
constexpr size_t WS_HC = 85 * MiB;
constexpr size_t WS_XN = 93 * MiB;
constexpr size_t WS_PROJ = 132 * MiB;
constexpr size_t WS_S5L = 177 * MiB;
constexpr size_t WS_MIX = 195 * MiB;
constexpr size_t WS_HID = 132 * MiB;
constexpr size_t WS_UG = WS_XN;
constexpr size_t WS_Z = 231 * MiB;
constexpr size_t WS_END = 250 * MiB;
static_assert(WS_XN + (size_t)XN_ROWS * DM * 2 <= WS_PROJ, "xn");
static_assert(WS_PROJ + (size_t)MALL * OIN * 2 <= WS_S5L && WS_S5L + (size_t)576 * 32 * 256 * 4 <= WS_MIX, "s5l");
static_assert((size_t)2 * MALL * 512 * 2 <= (size_t)XN_ROWS * DM * 2 && WS_Z + (size_t)MALL * 512 * 2 <= WS_END && WS_MIX + (size_t)MALL * DM * 2 <= WS_Z, "rg scratch");
static_assert(WS_HID + (size_t)MALL * FH * 2 <= WS_Z && WS_Z + (size_t)NLAT * 512 * 2 <= WS_END && (size_t)32 * 768 * 768 * 2 <= (size_t)XN_ROWS * DM * 2, "hid/z/ug");

DI float bf2f(bf16_t v) { return __uint_as_float((unsigned)v << 16); }
DI unsigned f2bf(float f) { unsigned u = __float_as_uint(f); return (u + 0x7fffu + ((u >> 16) & 1u)) >> 16; }
DI unsigned pk2(float lo, float hi) { return f2bf(lo) | (f2bf(hi) << 16); }
typedef __bf16 bf16x2v_t __attribute__((ext_vector_type(2)));
DI unsigned cvtpk_(float lo, float hi) { f32x2_t v = {lo, hi}; bf16x2v_t b = __builtin_convertvector(v, bf16x2v_t); return __builtin_bit_cast(unsigned, b); }
DI float wave_sum(float v) {
#pragma unroll
    for (int o = 1; o < 64; o <<= 1) v += __shfl_xor(v, o);
    return v;
}
DI float sigmoidf_(float x) { return __builtin_amdgcn_rcpf(1.f + __expf(-x)); }
DI float gelu_tanh(float x) { const float z = 1.5957691216057308f * (x + 0.044715f * x * x * x); return x * sigmoidf_(z); }
DI float siluf_(float x) { return x * sigmoidf_(x); }

struct EpiRes {
    static constexpr bool PERM = true, AFTER_DRAIN = false;
    const float* baseL; const float* baseC; float* outL; float* outC; const float* gate;
    __device__ __forceinline__ void operator()(const f32x4 (&acc)[2][2][4][2], const pg8::Unit& u, int wr, int wc, int fr, int fq) const {
        const bool isc = u.pm >= 64; const int bb = isc ? 8 : (u.pm >> 3);
        const float* base = isc ? baseC + (size_t)(u.pm - 64) * 256 * DM : baseL + (size_t)u.pm * 256 * DM;
        float* out = isc ? outC + (size_t)(u.pm - 64) * 256 * DM : outL + (size_t)u.pm * 256 * DM;
        const float* g = gate + (size_t)bb * 6144;
        const int col0 = u.pn * 256 + wc * 32 + 8 * fq;
#pragma unroll
        for (int bj = 0; bj < 2; ++bj) {
            const int c = col0 + bj * 128; const f32x4 g0 = *(const f32x4*)(g + c), g1 = *(const f32x4*)(g + c + 4);
#pragma unroll
            for (int ai = 0; ai < 2; ++ai) {
                f32x4 bs[4][2];
#pragma unroll
                for (int m = 0; m < 4; ++m) { const float* bp = base + (size_t)(ai * 128 + wr * 64 + m * 16 + fr) * DM + c; bs[m][0] = *(const f32x4*)bp; bs[m][1] = *(const f32x4*)(bp + 4); }
#pragma unroll
                for (int m = 0; m < 4; ++m) { float* op = out + (size_t)(ai * 128 + wr * 64 + m * 16 + fr) * DM + c; *(f32x4*)op = bs[m][0] + g0 * acc[ai][bj][m][0]; *(f32x4*)(op + 4) = bs[m][1] + g1 * acc[ai][bj][m][1]; }
            }
        }
    }
};

struct EpiCtxHalf {
    static constexpr bool PERM = true, AFTER_DRAIN = false;
    const float* baseC; float* outC; float* cp; const float* gate; int kh;
    __device__ __forceinline__ void operator()(const f32x4 (&acc)[2][2][4][2], const pg8::Unit& u, int wr, int wc, int fr, int fq) const {
        const size_t t0 = (size_t)(u.pm - 64) * 256 * DM; const float* g = gate + (size_t)8 * 6144;
        const int col0 = u.pn * 256 + wc * 32 + 8 * fq;
#pragma unroll
        for (int bj = 0; bj < 2; ++bj) {
            const int c = col0 + bj * 128; const f32x4 g0 = *(const f32x4*)(g + c), g1 = *(const f32x4*)(g + c + 4);
            float* o = kh == 0 ? outC : cp;
#pragma unroll
            for (int ai = 0; ai < 2; ++ai) {
                f32x4 bs[4][2];
#pragma unroll
                for (int m = 0; m < 4; ++m) { const float* bp = baseC + t0 + (size_t)(ai * 128 + wr * 64 + m * 16 + fr) * DM + c;
                    bs[m][0] = kh == 0 ? *(const f32x4*)bp : (f32x4){0.f, 0.f, 0.f, 0.f}; bs[m][1] = kh == 0 ? *(const f32x4*)(bp + 4) : (f32x4){0.f, 0.f, 0.f, 0.f}; }
#pragma unroll
                for (int m = 0; m < 4; ++m) { float* op = o + t0 + (size_t)(ai * 128 + wr * 64 + m * 16 + fr) * DM + c; *(f32x4*)op = bs[m][0] + g0 * acc[ai][bj][m][0]; *(f32x4*)(op + 4) = bs[m][1] + g1 * acc[ai][bj][m][1]; }
            }
        }
    }
};
struct CtxOrder {
    int c;
    __device__ bool next(int i, pg8::Unit& u) const { if (i != 0 || c < 0 || c >= 32) return false; u.pm = 64 + (c >> 2); u.pn = c & 3; return true; }
    __device__ __forceinline__ void a_ready(const pg8::Unit&) const {}
    __device__ __forceinline__ void done(const pg8::Unit&) const {}
};

struct EpiConvAct {
    static constexpr bool PERM = true, AFTER_DRAIN = false;
    bf16_t* H; const float* cw; const float* cb; int pm_edge; int nbnd_lat; int nbnd; char* xlds;
    __device__ __forceinline__ void operator()(const f32x4 (&acc)[2][2][4][2], const pg8::Unit& u, int wr_, int wc_, int fr_, int fq_) const {
        int tl = threadIdx.x; asm volatile("" : "+v"(tl));
        const int lane = tl & 63, wid_ = tl >> 6, fr = lane & 15, fq = lane >> 4, wr = wid_ >> 2, wc = wid_ & 3; (void)wr_; (void)wc_; (void)fr_; (void)fq_;
        const bool edge = u.pm >= pm_edge;
        const int hc0 = u.pn * 128 + wc * 32 + 8 * fq;
        u32x2* sc = (u32x2*)(xlds + wid_ * 2048);
        float* wl = (float*)(xlds + 16384 + wid_ * 1024);
        { const int p = lane >> 4, bjl = (lane >> 3) & 1, cg4 = lane & 7;
          const float* src = (p < 3 ? cw + p * FH2 : cb) + bjl * FH + u.pn * 128 + wc * 32 + 4 * cg4;
          *(f32x4*)(wl + (p * 2 + bjl) * 32 + 4 * cg4) = *(const f32x4*)src; }
        asm volatile("" ::: "memory");
#pragma unroll
        for (int ai = 0; ai < 2; ++ai) {
            u32x2 wd[2][4];
#pragma unroll
            for (int n = 0; n < 2; ++n) {
                float hvv[2][4][4];
#pragma unroll
                for (int bj = 0; bj < 2; ++bj) {
#pragma unroll
                    for (int m = 0; m < 4; ++m) { u32x2 w; w.x = cvtpk_(acc[ai][bj][m][n][0], acc[ai][bj][m][n][1]); w.y = cvtpk_(acc[ai][bj][m][n][2], acc[ai][bj][m][n][3]); sc[(16 * m + fr) * 4 + fq] = w; }
                    asm volatile("" ::: "memory");
                    const f32x4 w0 = *(const f32x4*)(wl + (0 * 2 + bj) * 32 + 8 * fq + 4 * n), w1 = *(const f32x4*)(wl + (1 * 2 + bj) * 32 + 8 * fq + 4 * n),
                                w2 = *(const f32x4*)(wl + (2 * 2 + bj) * 32 + 8 * fq + 4 * n), bb = *(const f32x4*)(wl + (3 * 2 + bj) * 32 + 8 * fq + 4 * n);
#pragma unroll
                    for (int m = 0; m < 4; ++m) {
                        const int row = 16 * m + fr; const int ru = row > 0 ? row - 1 : 0, rd = row < 63 ? row + 1 : 63;
                        u32x2 uu = sc[ru * 4 + fq], dd = sc[rd * 4 + fq];
                        if (row == 0) uu = (u32x2){0u, 0u}; if (row == 63) dd = (u32x2){0u, 0u};
                        const f32x4 up = (f32x4){__uint_as_float(uu.x << 16), __uint_as_float(uu.x & 0xffff0000u), __uint_as_float(uu.y << 16), __uint_as_float(uu.y & 0xffff0000u)};
                        const f32x4 dn = (f32x4){__uint_as_float(dd.x << 16), __uint_as_float(dd.x & 0xffff0000u), __uint_as_float(dd.y << 16), __uint_as_float(dd.y & 0xffff0000u)};
                        const f32x4 hv = bb + w0 * up + w1 * acc[ai][bj][m][n] + w2 * dn;
                        hvv[bj][m][0] = hv.x; hvv[bj][m][1] = hv.y; hvv[bj][m][2] = hv.z; hvv[bj][m][3] = hv.w;
                    }
                    asm volatile("" : "+v"(hvv[bj][0][0]), "+v"(hvv[bj][0][1]), "+v"(hvv[bj][0][2]), "+v"(hvv[bj][0][3]), "+v"(hvv[bj][1][0]), "+v"(hvv[bj][1][1]), "+v"(hvv[bj][1][2]), "+v"(hvv[bj][1][3]),
                                      "+v"(hvv[bj][2][0]), "+v"(hvv[bj][2][1]), "+v"(hvv[bj][2][2]), "+v"(hvv[bj][2][3]), "+v"(hvv[bj][3][0]), "+v"(hvv[bj][3][1]), "+v"(hvv[bj][3][2]), "+v"(hvv[bj][3][3]) :: "memory");
                }
#pragma unroll
                for (int m = 0; m < 4; ++m) { wd[n][m].x = cvtpk_(hvv[0][m][0] * siluf_(hvv[1][m][0]), hvv[0][m][1] * siluf_(hvv[1][m][1])); wd[n][m].y = cvtpk_(hvv[0][m][2] * siluf_(hvv[1][m][2]), hvv[0][m][3] * siluf_(hvv[1][m][3])); }
                asm volatile("" : "+v"(wd[n][0].x), "+v"(wd[n][0].y), "+v"(wd[n][1].x), "+v"(wd[n][1].y), "+v"(wd[n][2].x), "+v"(wd[n][2].y), "+v"(wd[n][3].x), "+v"(wd[n][3].y) :: "memory");
            }
#pragma unroll
            for (int m = 0; m < 4; ++m) {
                const int R = ai * 128 + wr * 64 + m * 16 + fr;
                long grow; bool st;
                if (!edge) {
                    grow = (long)u.pm * 256 + R; st = true;
                    const int r64 = R & 63;
                    if (r64 == 0) st = (R == 0) && (u.pm >= 64 || (u.pm & 7) == 0);
                    if (r64 == 63) st = (R == 255) && (u.pm >= 64 || (u.pm & 7) == 7);
                } else {
                    const int slot = (u.pm - pm_edge) * 256 + R, q = slot >> 2, pos = slot & 3;
                    st = (pos == 1 || pos == 2) && q < nbnd;
                    int row0;
                    if (q < nbnd_lat) { const int s = q / 31, k = q - s * 31 + 1; row0 = s * SEQ + 64 * k; }
                    else { const int q2 = q - nbnd_lat, s = q2 / 3, k = q2 - s * 3 + 1; row0 = NLAT + s * CTXL + 64 * k; }
                    grow = (long)row0 - 2 + pos;
                }
                if (st) { u32x4 w; w.x = wd[0][m].x; w.y = wd[0][m].y; w.z = wd[1][m].x; w.w = wd[1][m].y; *(u32x4*)(H + (size_t)grow * FH + hc0) = w; }
            }
            asm volatile("" ::: "memory"); __builtin_amdgcn_sched_barrier(0);
        }
    }
};

struct EpiGlu {
    static constexpr bool PERM = true, AFTER_DRAIN = false;
    const bf16_t* Z; bf16_t* O; const float* bias;
    __device__ __forceinline__ void operator()(const f32x4 (&acc)[2][2][4][2], const pg8::Unit& u, int wr, int wc, int fr, int fq) const {
        const int row0 = u.pm * 256 + wr * 64 + fr; const int col0 = u.pn * 256 + wc * 32 + 8 * fq;
#pragma unroll
        for (int bj = 0; bj < 2; ++bj) {
            const f32x4 b0 = *(const f32x4*)(bias + col0 + bj * 128), b1 = *(const f32x4*)(bias + col0 + bj * 128 + 4);
            u32x4 zq[2][4];
#pragma unroll
            for (int ai = 0; ai < 2; ++ai)
#pragma unroll
                for (int m = 0; m < 4; ++m) zq[ai][m] = *(const u32x4*)(Z + (size_t)(row0 + ai * 128 + m * 16) * 512 + col0 + bj * 128);
#pragma unroll
            for (int ai = 0; ai < 2; ++ai)
#pragma unroll
                for (int m = 0; m < 4; ++m) {
                    const size_t r = (size_t)(row0 + ai * 128 + m * 16);
                    const u32x4 zz = zq[ai][m];
                    const f32x4 v0 = acc[ai][bj][m][0] + b0, v1 = acc[ai][bj][m][1] + b1;
                    float o[8];
#pragma unroll
                    for (int j = 0; j < 4; ++j) {
                        const float z0 = __uint_as_float((j & 1) ? (zz[j >> 1] & 0xffff0000u) : (zz[j >> 1] << 16));
                        const float z1 = __uint_as_float((j & 1) ? (zz[2 + (j >> 1)] & 0xffff0000u) : (zz[2 + (j >> 1)] << 16));
                        o[j] = z0 * sigmoidf_(v0[j]); o[4 + j] = z1 * sigmoidf_(v1[j]);
                    }
                    u32x4 w; w.x = pk2(o[0], o[1]); w.y = pk2(o[2], o[3]); w.z = pk2(o[4], o[5]); w.w = pk2(o[6], o[7]);
                    *(u32x4*)(O + r * DM + col0 + bj * 128) = w;
                }
        }
    }
};
#define GAS __attribute__((address_space(1)))
typedef GAS unsigned gu32;
typedef GAS unsigned long long gu64;
#define RLX_AGENT __ATOMIC_RELAXED, __HIP_MEMORY_SCOPE_AGENT
#define LDS_WAIT() asm volatile("s_waitcnt lgkmcnt(0)" ::: "memory")
#define VM_WAIT() asm volatile("s_waitcnt vmcnt(0)" ::: "memory")
__device__ __forceinline__ unsigned long long rt() { return __builtin_amdgcn_s_memrealtime(); }
#define XB_TMO      128
#define XB_XCNT(j)  (256  + 64 * (j))
#define XB_XSUB(j)  (1280 + 64 * (j))
#define XB_XGEN(j)  (2304 + 64 * (j))
#define XB_TOP      3328
#define XB_TOPGEN   3392
#define XCD_BAR_WORDS 3456
#define XB_SPIN_CAP (1u << 18)

__device__ __forceinline__ unsigned xb_ld(unsigned* p)              { return __hip_atomic_load(p, __ATOMIC_RELAXED, __HIP_MEMORY_SCOPE_AGENT); }
__device__ __forceinline__ unsigned xb_add(unsigned* p, unsigned v) { return __hip_atomic_fetch_add(p, v, __ATOMIC_RELAXED, __HIP_MEMORY_SCOPE_AGENT); }
__device__ __forceinline__ unsigned xb_xcc_id() { return (unsigned)__builtin_amdgcn_s_getreg((3 << 11) | 20) & 0xFu; }
#define XB_SPIN(cond, bar) do { unsigned _sp = 0; while (cond) { __builtin_amdgcn_s_sleep(1); \
    if ((++_sp & 255u) == 0u) { if (xb_ld(&(bar)[XB_TMO])) break; if (_sp > XB_SPIN_CAP) { atomicAdd(&(bar)[XB_TMO], 1u); break; } } } } while (0)

struct XcdBarrier {
    unsigned* bar; unsigned x;
    volatile LAS unsigned* st;
};

__device__ __forceinline__ XcdBarrier xcd_barrier_post(unsigned* bar, volatile LAS unsigned* st) {
    XcdBarrier b; b.bar = bar; b.x = xb_xcc_id(); b.st = st;
    if (threadIdx.x == 0) (void)xb_add(&bar[XB_XCNT(b.x)], 1u);
    return b;
}
__device__ __forceinline__ void xcd_barrier_complete(unsigned* bar, unsigned x, unsigned& nloc, unsigned& nx) {
    const unsigned G = gridDim.x * gridDim.y * gridDim.z;
    unsigned sum, cnt, mine, sp = 0u;
    for (;;) {
        sum = 0u; cnt = 0u; mine = 0u;
#pragma unroll
        for (unsigned j = 0; j < 16; ++j) { const unsigned c = xb_ld(&bar[XB_XCNT(j)]); sum += c; cnt += (c > 0u) ? 1u : 0u; mine = (j == x) ? c : mine; }
        if (sum == G) break;
        __builtin_amdgcn_s_sleep(1);
        if ((++sp & 255u) == 0u) { if (xb_ld(&bar[XB_TMO])) break; if (sp > XB_SPIN_CAP) { atomicAdd(&bar[XB_TMO], 1u); break; } }
    }
    nloc = mine > 0u ? mine : 1u; nx = cnt > 0u ? cnt : 1u;
}

__device__ __forceinline__ void xcd_barrier(const XcdBarrier& b) {
    asm volatile("s_waitcnt vmcnt(0)" ::: "memory");
    __syncthreads();
    if (threadIdx.x == 0) {
        unsigned* bar = b.bar;
        __builtin_amdgcn_s_waitcnt(0);
        unsigned nloc = b.st[0], nx = b.st[1];
        if (nloc == 0u) { xcd_barrier_complete(bar, b.x, nloc, nx); b.st[0] = nloc; b.st[1] = nx; }
        const unsigned old = xb_add(&bar[XB_XSUB(b.x)], 1u);
        const unsigned gen = old / nloc;
        if (old + 1u == (gen + 1u) * nloc) {
            __builtin_amdgcn_fence(__ATOMIC_RELEASE, "agent");
            asm volatile("s_waitcnt vmcnt(0)" ::: "memory");
            const unsigned og = xb_add(&bar[XB_TOP], 1u);
            const unsigned tg = og / nx;
            if (og + 1u == (tg + 1u) * nx) xb_add(&bar[XB_TOPGEN], 1u);
            else XB_SPIN(xb_ld(&bar[XB_TOPGEN]) == tg, bar);
            __builtin_amdgcn_fence(__ATOMIC_ACQUIRE, "agent");
            xb_add(&bar[XB_XGEN(b.x)], 1u);
            asm volatile("s_waitcnt vmcnt(0)" ::: "memory");
        } else {
            XB_SPIN(xb_ld(&bar[XB_XGEN(b.x)]) == gen, bar);
            __builtin_amdgcn_fence(__ATOMIC_ACQUIRE, "agent");
            asm volatile("s_waitcnt vmcnt(0)" ::: "memory");
        }
    }
    __syncthreads();
}

DI s16x4 vtr(const char* p) { typedef short v4i16_t __attribute__((ext_vector_type(4))); return __builtin_bit_cast(s16x4, __builtin_amdgcn_ds_read_tr16_b64_v4i16((LAS v4i16_t*)p)); }
typedef __bf16 bf16x2_t __attribute__((ext_vector_type(2)));
DI unsigned cvtpk(float lo, float hi) { f32x2_t v = {lo, hi}; bf16x2_t b = __builtin_convertvector(v, bf16x2_t); return __builtin_bit_cast(unsigned, b); }
DI int crow(int r, int h) { return (r & 3) + 8 * (r >> 2) + 4 * h; }
#define MFMA32(a, b, c) __builtin_amdgcn_mfma_f32_32x32x16_bf16((a), (b), (c), 0, 0, 0)
constexpr int ATT_BUF = 17408, ATT_KB = 9216;

template <int MODE, int RB>
DI void attn_unit(const bf16_t* __restrict__ P, int ld, int qoff, int koff, int voff, bf16_t* __restrict__ O, char* lds, int b, int head, int q0, float sink_l2) {
    const int tid = threadIdx.x, lane = tid & 63, wid = tid >> 6, r32 = lane & 31, hi = lane >> 5;
    const int kvh = head >> 2;
    const int qrow0 = (MODE == 1) ? (NLAT + b * CTXL) : (b * SEQ + q0);
    int lat0 = 0, nlat = 0;
    if (MODE == 0) { lat0 = 0; nlat = SEQ / 64; }
    if (MODE == 2) { const int lo = q0 - 128 < 0 ? 0 : q0 - 128; const int hi_ = q0 + 256 * RB + 128 > SEQ ? SEQ : q0 + 256 * RB + 128; lat0 = lo; nlat = (hi_ - lo) / 64; }
    const int NT = 4 + nlat;
#define KROW(t) ((t) < 4 ? (NLAT + b * CTXL + 64 * (t)) : (b * SEQ + lat0 + 64 * ((t) - 4)))
    bf16x8 qr[RB][4];
#pragma unroll
    for (int rb = 0; rb < RB; ++rb) { const bf16_t* Qp = P + (size_t)(qrow0 + wid * 32 * RB + rb * 32 + r32) * ld + qoff + head * 64 + 8 * hi;
#pragma unroll
        for (int ks = 0; ks < 4; ++ks) qr[rb][ks] = *(const bf16x8*)(Qp + 16 * ks); }
    const int srow = tid >> 3, sch = tid & 7;
    const bf16_t* kg = P + koff + kvh * 64 + sch * 8; const bf16_t* vg = P + voff + kvh * 64 + sch * 8;
    const int kw = srow * 144 + sch * 16, vw = ATT_KB + (sch >> 2) * 4096 + srow * 64 + (sch & 3) * 16;
    const int kr_off = r32 * 144 + 16 * hi;
    const int vr_off = ATT_KB + ((lane >> 4) & 1) * 32 + (lane & 3) * 8 + (4 * hi + ((lane & 15) >> 2)) * 64;
    u32x4 kreg, vreg;
    { const size_t r = (size_t)(KROW(0) + srow) * ld; kreg = *(const u32x4*)(kg + r); vreg = *(const u32x4*)(vg + r); }
    *(u32x4*)(lds + kw) = kreg; *(u32x4*)(lds + vw) = vreg;
    if (NT > 1) { const size_t r = (size_t)(KROW(1) + srow) * ld; kreg = *(const u32x4*)(kg + r); vreg = *(const u32x4*)(vg + r); }
    float m[RB], l[RB]; f32x16 o0[RB], o1[RB];
#pragma unroll
    for (int rb = 0; rb < RB; ++rb) { m[rb] = 0.f; l[rb] = 0.f; o0[rb] = f32x16{}; o1[rb] = f32x16{}; }
    __syncthreads();
    for (int t = 0; t < NT; ++t) {
        const char* buf = lds + (t & 1) * ATT_BUF;
        bool need = true; int kpos0 = 0;
        if (MODE == 2 && t >= 4) { kpos0 = lat0 + 64 * (t - 4); const int ql = q0 + wid * 32 * RB; need = (kpos0 <= ql + 32 * RB - 1 + 128) && (kpos0 + 63 >= ql - 128); }
        if (need) {
#pragma unroll
            for (int kb = 0; kb < 2; ++kb) {
                f32x16 p[RB];
#pragma unroll
                for (int rb = 0; rb < RB; ++rb) p[rb] = f32x16{};
#pragma unroll
                for (int ks = 0; ks < 4; ++ks) {
                    const bf16x8 kf = *(const bf16x8*)(buf + kr_off + kb * 32 * 144 + ks * 32);
#pragma unroll
                    for (int rb = 0; rb < RB; ++rb) p[rb] = MFMA32(kf, qr[rb][ks], p[rb]);
                }
#pragma unroll
                for (int rb = 0; rb < RB; ++rb) {
                    if (__any(m[rb] != 0.f)) {
#pragma unroll
                        for (int i = 0; i < 16; ++i) p[rb][i] -= m[rb]; }
                    if (MODE == 2 && t >= 4) {
                        const int qpos = q0 + wid * 32 * RB + rb * 32 + r32;
#pragma unroll
                        for (int i = 0; i < 16; ++i) { const int kp = kpos0 + 32 * kb + crow(i, hi); int d0 = qpos - kp; d0 = d0 < 0 ? -d0 : d0; if (d0 > 128) p[rb][i] = -1e30f; }
                    }
                    float mx = fmaxf(fmaxf(p[rb][0], p[rb][1]), p[rb][2]), mx2 = fmaxf(fmaxf(p[rb][3], p[rb][4]), p[rb][5]);
#pragma unroll
                    for (int i = 6; i < 16; i += 4) { mx = fmaxf(fmaxf(mx, p[rb][i]), p[rb][i + 1]); mx2 = fmaxf(fmaxf(mx2, p[rb][i + 2 < 16 ? i + 2 : 15]), p[rb][i + 3 < 16 ? i + 3 : 15]); }
                    mx = fmaxf(mx, mx2); mx = fmaxf(mx, __shfl_xor(mx, 32));
                    if (__any(mx > 8.f)) {
                        const float dl = fmaxf(mx, 0.f); m[rb] += dl; const float f = __builtin_amdgcn_exp2f(-dl); l[rb] *= f;
#pragma unroll
                        for (int i = 0; i < 16; ++i) { p[rb][i] -= dl; o0[rb][i] *= f; o1[rb][i] *= f; }
                    }
                    float rs = 0.f, rs2 = 0.f;
#pragma unroll
                    for (int i = 0; i < 16; i += 2) { p[rb][i] = __builtin_amdgcn_exp2f(p[rb][i]); rs += p[rb][i]; p[rb][i + 1] = __builtin_amdgcn_exp2f(p[rb][i + 1]); rs2 += p[rb][i + 1]; }
                    l[rb] += rs + rs2;
                }
#pragma unroll
                for (int s2 = 0; s2 < 2; ++s2) {
                    const char* vb = buf + vr_off + (2 * kb + s2) * 1024;
                    const s16x4 a0 = vtr(vb), a1 = vtr(vb + 512), c0 = vtr(vb + 4096), c1 = vtr(vb + 4096 + 512);
                    const bf16x8 va0 = (bf16x8){a0[0], a0[1], a0[2], a0[3], a1[0], a1[1], a1[2], a1[3]};
                    const bf16x8 va1 = (bf16x8){c0[0], c0[1], c0[2], c0[3], c1[0], c1[1], c1[2], c1[3]};
#pragma unroll
                    for (int rb = 0; rb < RB; ++rb) {
                        u32x4 pw; pw[0] = cvtpk(p[rb][8 * s2], p[rb][8 * s2 + 1]); pw[1] = cvtpk(p[rb][8 * s2 + 2], p[rb][8 * s2 + 3]); pw[2] = cvtpk(p[rb][8 * s2 + 4], p[rb][8 * s2 + 5]); pw[3] = cvtpk(p[rb][8 * s2 + 6], p[rb][8 * s2 + 7]);
                        const bf16x8 pb = __builtin_bit_cast(bf16x8, pw);
                        o0[rb] = MFMA32(va0, pb, o0[rb]); o1[rb] = MFMA32(va1, pb, o1[rb]);
                    }
                }
            }
        }
        if (t + 1 < NT) {
            char* nb = lds + ((t + 1) & 1) * ATT_BUF;
            *(u32x4*)(nb + kw) = kreg; *(u32x4*)(nb + vw) = vreg;
            if (t + 2 < NT) { const size_t r = (size_t)(KROW(t + 2) + srow) * ld; kreg = *(const u32x4*)(kg + r); vreg = *(const u32x4*)(vg + r); }
        }
        __syncthreads();
    }
#undef KROW
    int tl_ = threadIdx.x; asm volatile("" : "+v"(tl_));
    const int lane2 = tl_ & 63, wid2 = tl_ >> 6, r32b = lane2 & 31, hib = lane2 >> 5;
#pragma unroll
    for (int rb = 0; rb < RB; ++rb) {
        float lt = l[rb] + __shfl_xor(l[rb], 32);
        if (MODE == 2) lt += __builtin_amdgcn_exp2f(sink_l2 - m[rb]);
        const float inv = 1.f / lt;
        bf16_t* Op = O + (size_t)(qrow0 + wid2 * 32 * RB + rb * 32 + r32b) * DM + 512 + head * 64 + 4 * hib;
#pragma unroll
        for (int k = 0; k < 4; ++k) {
            u32x2 w0, w1;
            w0.x = pk2(o0[rb][4 * k] * inv, o0[rb][4 * k + 1] * inv); w0.y = pk2(o0[rb][4 * k + 2] * inv, o0[rb][4 * k + 3] * inv);
            w1.x = pk2(o1[rb][4 * k] * inv, o1[rb][4 * k + 1] * inv); w1.y = pk2(o1[rb][4 * k + 2] * inv, o1[rb][4 * k + 3] * inv);
            *(u32x2*)(Op + 8 * k) = w0; *(u32x2*)(Op + 32 + 8 * k) = w1;
        }
    }
}

constexpr int RG_XA = 0, RG_XF = 9216, RG_GT = RG_XF + 64 * 65 * 4  , RG_SEG = RG_GT + 4 * 64 * 65 * 4  , RG_CAR = RG_SEG + 2 * 64 * 4 * 8  ;
DI bf16_t* rg_yl(unsigned char* ws) { return (bf16_t*)(ws + WS_XN); }
DI bf16_t* rg_pf(unsigned char* ws) { return (bf16_t*)(ws + WS_XN) + (size_t)MALL * 512; }
DI bf16_t* rg_pb(unsigned char* ws) { return (bf16_t*)(ws + WS_Z); }
DI void rg_item1(const float* const* in, unsigned char* ws, char* lds, int item) {
    const int tid = threadIdx.x, lane = tid & 63, wid = tid >> 6;
    const int ci = item % 36, bh = item / 36, head = bh & 7, b = bh >> 3;
    const bf16_t* PROJ = (const bf16_t*)(ws + WS_PROJ);
    const int seqbase = ci < 4 ? NLAT + b * CTXL : b * SEQ, t0 = ci < 4 ? ci * 64 : (ci - 4) * 64, slen = ci < 4 ? CTXL : SEQ;
    bf16_t* XA = (bf16_t*)(lds + RG_XA); float* XF = (float*)(lds + RG_XF); float* GT = (float*)(lds + RG_GT); float* SEGL = (float*)(lds + RG_SEG);
    float* TOT = (float*)(ws + WS_RGTOT);
    const int sdir = tid >> 8, sch = (tid >> 2) & 63, sseg = tid & 3;
    {
        const int tok = tid >> 3, cg8 = tid & 7, ch0 = head * 64 + cg8 * 8;
        const float* cw = in[13]; const float* cb = in[14];
        float x[8]; u32x4 uu4[4]; f32x4 wq[5][2];
#pragma unroll
        for (int j = 0; j < 4; ++j) { int tt = t0 + tok + j - 1; tt = tt < 0 ? 0 : (tt >= slen ? slen - 1 : tt); uu4[j] = *(const u32x4*)(PROJ + (size_t)(seqbase + tt) * EIN + ch0); }
#pragma unroll
        for (int j = 0; j < 4; ++j) { wq[j][0] = *(const f32x4*)(cw + j * 512 + ch0); wq[j][1] = *(const f32x4*)(cw + j * 512 + ch0 + 4); }
        wq[4][0] = *(const f32x4*)(cb + ch0); wq[4][1] = *(const f32x4*)(cb + ch0 + 4);
#pragma unroll
        for (int c = 0; c < 8; ++c) x[c] = wq[4][c >> 2][c & 3];
#pragma unroll
        for (int j = 0; j < 4; ++j) {
            const int tt = t0 + tok + j - 1; const float msk = (tt >= 0 && tt < slen) ? 1.f : 0.f;
#pragma unroll
            for (int c = 0; c < 8; ++c) { const float uv = __uint_as_float((c & 1) ? (uu4[j][c >> 1] & 0xffff0000u) : (uu4[j][c >> 1] << 16)); x[c] += (wq[j][c >> 2][c & 3] * msk) * uv; }
        }
        u32x4 w; w.x = pk2(x[0], x[1]); w.y = pk2(x[2], x[3]); w.z = pk2(x[4], x[5]); w.w = pk2(x[6], x[7]);
        *(u32x4*)(XA + tok * 72 + cg8 * 8) = w;
#pragma unroll
        for (int c = 0; c < 8; ++c) XF[tok * 65 + cg8 * 8 + c] = x[c];
    }
    __syncthreads();
    {
        const int mi = wid & 3, th = wid >> 2, r32 = lane & 31, hi = lane >> 5;
        const bf16_t* W = (const bf16_t*)(ws + WS_RGW) + (size_t)(mi * 8 + head) * 4096;
        const float* bias = (mi & 1) ? in[18] : in[16]; const int dirm = mi >> 1;
#pragma unroll
        for (int nt = 0; nt < 2; ++nt) {
            f32x16 acc = {};
#pragma unroll
            for (int ks = 0; ks < 4; ++ks) {
                const bf16x8 a = *(const bf16x8*)(XA + (32 * th + r32) * 72 + 16 * ks + 8 * hi);
                const bf16x8 bfr = *(const bf16x8*)(W + (32 * nt + r32) * 64 + 16 * ks + 8 * hi);
                acc = MFMA32(a, bfr, acc);
            }
            const float bv = bias[dirm * 512 + head * 64 + 32 * nt + r32];
#pragma unroll
            for (int i = 0; i < 16; ++i) GT[(mi * 64 + 32 * th + crow(i, hi)) * 65 + 32 * nt + r32] = sigmoidf_(acc[i] + bv);
        }
    }
    __syncthreads();
    float av[16], bvv[16];
    {
        const float lam = in[19][sdir * 512 + head * 64 + sch];
        const float nl = -lam; const float sp = nl > 20.f ? nl : log1pf(__expf(nl));
        float hh = 0.f, PP = 1.f;
#pragma unroll
        for (int s = 0; s < 16; ++s) {
            const int k = 16 * sseg + s, tok = sdir == 0 ? k : 63 - k;
            const float r = GT[((2 * sdir) * 64 + tok) * 65 + sch], ig = GT[((2 * sdir + 1) * 64 + tok) * 65 + sch], x = XF[tok * 65 + sch];
            const float la = -8.f * r * sp; const float a = __expf(la); const float bb = __builtin_amdgcn_sqrtf(fmaxf(1.f - a * a, 0.f)) * (ig * x);
            av[s] = a; bvv[s] = bb; hh = a * hh + bb; PP *= a;
        }
        __syncthreads();
        SEGL[((sdir * 64 + sch) * 4 + sseg) * 2] = PP; SEGL[((sdir * 64 + sch) * 4 + sseg) * 2 + 1] = hh;
    }
    __syncthreads();
    {
        float c = 0.f, Pbef = 1.f, Pt = 1.f;
#pragma unroll
        for (int s = 0; s < 4; ++s) { const float p = SEGL[((sdir * 64 + sch) * 4 + s) * 2], h = SEGL[((sdir * 64 + sch) * 4 + s) * 2 + 1];
            if (s < sseg) { c = p * c + h; Pbef *= p; } Pt *= p; }
        float h = c, P = Pbef;
#pragma unroll
        for (int s = 0; s < 16; ++s) { const int k = 16 * sseg + s, tok = sdir == 0 ? k : 63 - k; h = av[s] * h + bvv[s]; P *= av[s];
            GT[(sdir * 64 + tok) * 65 + sch] = h; GT[((2 + sdir) * 64 + tok) * 65 + sch] = P; }
        if (sseg == 3) { float* tp = TOT + ((size_t)((sdir * NB + b) * 36 + ci) * 2) * 512 + head * 64 + sch; tp[0] = Pt; tp[512] = h; }
    }
    __syncthreads();
    {
        const int tok = tid >> 3, cg8 = tid & 7, ch0 = head * 64 + cg8 * 8;
        const size_t off = (size_t)(seqbase + t0 + tok) * 512 + ch0;
        float y[8], pf[8], pb[8];
#pragma unroll
        for (int c = 0; c < 8; ++c) { y[c] = GT[tok * 65 + cg8 * 8 + c] + GT[(64 + tok) * 65 + cg8 * 8 + c]; pf[c] = GT[(128 + tok) * 65 + cg8 * 8 + c]; pb[c] = GT[(192 + tok) * 65 + cg8 * 8 + c]; }
        u32x4 w; w.x = pk2(y[0], y[1]); w.y = pk2(y[2], y[3]); w.z = pk2(y[4], y[5]); w.w = pk2(y[6], y[7]); *(u32x4*)(rg_yl(ws) + off) = w;
        w.x = pk2(pf[0], pf[1]); w.y = pk2(pf[2], pf[3]); w.z = pk2(pf[4], pf[5]); w.w = pk2(pf[6], pf[7]); *(u32x4*)(rg_pf(ws) + off) = w;
        w.x = pk2(pb[0], pb[1]); w.y = pk2(pb[2], pb[3]); w.z = pk2(pb[4], pb[5]); w.w = pk2(pb[6], pb[7]); *(u32x4*)(rg_pb(ws) + off) = w;
    }
    __syncthreads();
}
DI void rg_item2(const float* const* in, unsigned char* ws, char* lds, int item) {
    const int tid = threadIdx.x;
    const int ci = item % 36, bh = item / 36, head = bh & 7, b = bh >> 3;
    const bf16_t* PROJ = (const bf16_t*)(ws + WS_PROJ);
    const int seqbase = ci < 4 ? NLAT + b * CTXL : b * SEQ, t0 = ci < 4 ? ci * 64 : (ci - 4) * 64;
    float* SEGL = (float*)(lds + RG_SEG); float* CAR = (float*)(lds + RG_CAR);
    const float* TOT = (const float*)(ws + WS_RGTOT);
    const int sdir = tid >> 8, sch = (tid >> 2) & 63, sseg = tid & 3;
    const int tok = tid >> 3, cg8 = tid & 7, ch0 = head * 64 + cg8 * 8;
    const size_t row = (size_t)(seqbase + t0 + tok); const size_t off = row * 512 + ch0;
    const u32x4 yv = *(const u32x4*)(rg_yl(ws) + off), pfv = *(const u32x4*)(rg_pf(ws) + off), pbv = *(const u32x4*)(rg_pb(ws) + off), gg = *(const u32x4*)(PROJ + row * EIN + 512 + ch0);
    {
        const int pos = sdir == 0 ? ci : (ci < 4 ? 3 - ci : 4 + (35 - ci));
        float pp[9], hh[9];
#pragma unroll
        for (int i = 0; i < 9; ++i) { const int k0 = sseg * 9 + i; const int k = k0 < 35 ? k0 : 35; const int ck = sdir == 0 ? k : (k < 4 ? 3 - k : 35 - (k - 4));
            const float* tp = TOT + ((size_t)((sdir * NB + b) * 36 + ck) * 2) * 512 + head * 64 + sch; pp[i] = tp[0]; hh[i] = tp[512]; }
#pragma unroll
        for (int i = 0; i < 9; ++i) { if (sseg * 9 + i >= pos) { pp[i] = 1.f; hh[i] = 0.f; } }
        float Pc = 1.f, Hc = 0.f;
#pragma unroll
        for (int i = 0; i < 9; ++i) { Hc = pp[i] * Hc + hh[i]; Pc *= pp[i]; }
        SEGL[((sdir * 64 + sch) * 4 + sseg) * 2] = Pc; SEGL[((sdir * 64 + sch) * 4 + sseg) * 2 + 1] = Hc;
    }
    __syncthreads();
    if (tid < 128) { const int d = tid >> 6, ch = tid & 63; float Hc = 0.f;
#pragma unroll
        for (int s = 0; s < 4; ++s) { const float p = SEGL[((d * 64 + ch) * 4 + s) * 2], h = SEGL[((d * 64 + ch) * 4 + s) * 2 + 1]; Hc = p * Hc + h; }
        CAR[d * 64 + ch] = Hc; }
    __syncthreads();
    {
        float o[8];
#pragma unroll
        for (int c = 0; c < 8; ++c) {
            const float yl = __uint_as_float((c & 1) ? (yv[c >> 1] & 0xffff0000u) : (yv[c >> 1] << 16)), pf = __uint_as_float((c & 1) ? (pfv[c >> 1] & 0xffff0000u) : (pfv[c >> 1] << 16));
            const float pb = __uint_as_float((c & 1) ? (pbv[c >> 1] & 0xffff0000u) : (pbv[c >> 1] << 16)), gt = __uint_as_float((c & 1) ? (gg[c >> 1] & 0xffff0000u) : (gg[c >> 1] << 16));
            const float y = yl + pf * CAR[cg8 * 8 + c] + pb * CAR[64 + cg8 * 8 + c]; o[c] = y * gelu_tanh(gt); }
        u32x4 w; w.x = pk2(o[0], o[1]); w.y = pk2(o[2], o[3]); w.z = pk2(o[4], o[5]); w.w = pk2(o[6], o[7]);
        *(u32x4*)((bf16_t*)(ws + WS_MIX) + row * DM + ch0) = w;
    }
    __syncthreads();
}

DI void s5_pre_item(const float* const* in, unsigned char* ws, char* lds, int item) {
    const int tid = threadIdx.x; const int g = item >> 2, qq = item & 3;
    float* AP = (float*)lds;
    float* BB = AP + 2 * 33 * 64 * 2;
    float* CC = BB + 2 * 64 * 16 * 2;
    float* KT = CC + 2 * 16 * 64 * 2;
    const float* lam_re = in[24]; const float* lam_im = in[25]; const float* lstep = in[26];
    {
        const int p = tid & 63, d = (tid >> 6) & 1, j0 = tid >> 7;
        const float dt = __expf(lstep[d * 32 + g]); const float lr = lam_re[(d * 32 + g) * 64 + p], li = lam_im[(d * 32 + g) * 64 + p];
        for (int j = j0; j < 33; j += 4) { const float mag = __expf((float)j * lr * dt), ang = (float)j * li * dt; const int e = (d * 33 + j) * 64 + p; AP[e * 2] = mag * __cosf(ang); AP[e * 2 + 1] = mag * __sinf(ang); }
    }
    {
        float lr4[4], li4[4], br4[4], bi4[4], cr4[4], ci4[4], dt4[4];
#pragma unroll
        for (int i = 0; i < 4; ++i) { const int e = tid + i * NTHREADS; const int h = e & 15, p = (e >> 4) & 63, d = e >> 10;
            dt4[i] = lstep[d * 32 + g]; lr4[i] = lam_re[(d * 32 + g) * 64 + p]; li4[i] = lam_im[(d * 32 + g) * 64 + p];
            br4[i] = in[27][((size_t)(d * 32 + g) * 64 + p) * 16 + h]; bi4[i] = in[28][((size_t)(d * 32 + g) * 64 + p) * 16 + h];
            const int p2 = e & 63, h2 = (e >> 6) & 15; cr4[i] = in[29][((size_t)(d * 32 + g) * 16 + h2) * 64 + p2]; ci4[i] = in[30][((size_t)(d * 32 + g) * 16 + h2) * 64 + p2]; }
#pragma unroll
        for (int i = 0; i < 4; ++i) { const int e = tid + i * NTHREADS; const float dt = __expf(dt4[i]), lr = lr4[i], li = li4[i];
            const float mag = __expf(lr * dt), ang = li * dt; const float abr = mag * __cosf(ang), abi = mag * __sinf(ang);
            const float den = lr * lr + li * li, nr = abr - 1.f, ni = abi; const float kr = (nr * lr + ni * li) / den, ki = (ni * lr - nr * li) / den;
            BB[e * 2] = kr * br4[i] - ki * bi4[i]; BB[e * 2 + 1] = kr * bi4[i] + ki * br4[i]; CC[e * 2] = cr4[i]; CC[e * 2 + 1] = ci4[i]; }
    }
    __syncthreads();
    for (int task = tid; task < 64 * 16; task += NTHREADS) {
        const int dj = task >> 4, blk = task & 15, d = dj >> 5, j = dj & 31, ho0 = 4 * (blk >> 2), hi0 = 4 * (blk & 3);
        const int jmax = d == 0 ? 8 * qq + 7 : 31 - 8 * qq;
        if (j > jmax) continue;
        float acc4[4][4];
#pragma unroll
        for (int i = 0; i < 4; ++i)
#pragma unroll
            for (int k = 0; k < 4; ++k) acc4[i][k] = 0.f;
        const f32x2_t* ap = (const f32x2_t*)AP + (d * 33 + j) * 64; const f32x2_t* cp = (const f32x2_t*)CC + (d * 16 + ho0) * 64; const f32x4* bp = (const f32x4*)(BB + (size_t)(d * 64) * 16 * 2 + hi0 * 2);
#pragma unroll 2
        for (int p = 0; p < 64; ++p) {
            const f32x2_t av = ap[p]; const f32x4 b01 = bp[p * 8], b23 = bp[p * 8 + 1];
#pragma unroll
            for (int i = 0; i < 4; ++i) { const f32x2_t cv = cp[i * 64 + p]; const float xr = cv.x * av.x - cv.y * av.y, xi = cv.x * av.y + cv.y * av.x;
                acc4[i][0] += xr * b01.x - xi * b01.y; acc4[i][1] += xr * b01.z - xi * b01.w; acc4[i][2] += xr * b23.x - xi * b23.y; acc4[i][3] += xr * b23.z - xi * b23.w; }
        }
#pragma unroll
        for (int i = 0; i < 4; ++i) *(f32x4*)(KT + (d * 32 + j) * 256 + (ho0 + i) * 16 + hi0) = (f32x4){acc4[i][0], acc4[i][1], acc4[i][2], acc4[i][3]};
    }
    __syncthreads();
    bf16_t* Mg = (bf16_t*)(ws + WS_S5MF) + (size_t)g * 512 * 768; bf16_t* Eg = (bf16_t*)(ws + WS_S5E) + (size_t)g * 256 * 512; bf16_t* Fg = Mg + 512;
    const float dval = in[31][g * 16 + (tid & 15)];
    for (int e = tid; e < 128 * 512; e += NTHREADS) { const int k = e & 511, mr = e >> 9, m = qq * 128 + mr; const int t = m >> 4, ho = m & 15, tau = k >> 4, hi = k & 15;
        float v = 0.f; if (tau <= t) v += KT[(0 * 32 + (t - tau)) * 256 + ho * 16 + hi]; if (tau >= t) v += KT[(1 * 32 + (tau - t)) * 256 + ho * 16 + hi];
        if (tau == t && ho == hi) v += dval;
        Mg[(size_t)m * 768 + k] = (bf16_t)f2bf(v); }
    { const int d = qq >> 1, c = qq & 1;
      for (int e = tid; e < 64 * 512; e += NTHREADS) { const int k = e & 511, p = e >> 9, tau = k >> 4, hi = k & 15; const int j = d == 0 ? 31 - tau : tau;
          const float ar = AP[((d * 33 + j) * 64 + p) * 2], ai = AP[((d * 33 + j) * 64 + p) * 2 + 1]; const float br = BB[((d * 64 + p) * 16 + hi) * 2], bi = BB[((d * 64 + p) * 16 + hi) * 2 + 1];
          const float v = c ? (ar * bi + ai * br) : (ar * br - ai * bi);
          Eg[(size_t)(qq * 64 + p) * 512 + k] = (bf16_t)f2bf(v); } }
    for (int e = tid; e < 128 * 256; e += NTHREADS) { const int k = e & 255, mr = e >> 8, m = qq * 128 + mr, t = m >> 4, ho = m & 15; const int d = k >> 7, c = (k >> 6) & 1, p = k & 63;
        const int j = d == 0 ? t + 1 : 32 - t;
        const float ar = AP[((d * 33 + j) * 64 + p) * 2], ai = AP[((d * 33 + j) * 64 + p) * 2 + 1]; const float cr = CC[((d * 16 + ho) * 64 + p) * 2], ci = CC[((d * 16 + ho) * 64 + p) * 2 + 1];
        const float v = c ? -(cr * ai + ci * ar) : (cr * ar - ci * ai);
        Fg[(size_t)m * 768 + k] = (bf16_t)f2bf(v); }
    if (qq == 0) for (int e = tid; e < 2 * 64; e += NTHREADS) { const int p = e & 63, d = e >> 6; float* at = (float*)(ws + WS_S5AT) + ((size_t)(d * 32 + g) * 64 + p) * 2;
        at[0] = AP[((d * 33 + 32) * 64 + p) * 2]; at[1] = AP[((d * 33 + 32) * 64 + p) * 2 + 1]; }
    __syncthreads();
}
DI int s5_chunk_row(int n72) { const int b = n72 / 72, cc = n72 - b * 72; return cc < 8 ? NLAT + b * CTXL + 32 * cc : b * SEQ + 32 * (cc - 8); }
DI void s5_repack_chunk(unsigned char* ws, int n, int lane) {
    const bf16_t* src = (const bf16_t*)(ws + WS_PROJ) + (size_t)s5_chunk_row(n) * OIN + 8 * lane;
    bf16_t* dst = (bf16_t*)(ws + WS_UG) + ((size_t)(lane >> 1) * 768 + n) * 768 + (lane & 1) * 8;
    u32x4 v[8];
#pragma unroll
    for (int t0 = 0; t0 < 32; t0 += 8) {
#pragma unroll
        for (int i = 0; i < 8; ++i) v[i] = *(const u32x4*)(src + (size_t)(t0 + i) * OIN);
#pragma unroll
        for (int i = 0; i < 8; ++i) *(u32x4*)(dst + (t0 + i) * 16) = v[i];
    }
}
struct S5Order {
    int G, c, nb;
    __device__ bool next(int i, pg8::Unit& u) const { const int L = i * G + c; const int per = 3 * nb; if (L >= 32 * per) return false; const int g = L / per, r = L - g * per; u.pm = 3 * g + r / nb; u.pn = nb * g + r % nb; return true; }
    __device__ __forceinline__ void a_ready(const pg8::Unit&) const {}
    __device__ __forceinline__ void done(const pg8::Unit&) const {}
};
struct EpiS5L {
    static constexpr bool PERM = false, AFTER_DRAIN = false;
    float* L;
    __device__ __forceinline__ void operator()(const f32x4 (&acc)[2][2][4][2], const pg8::Unit& u, int wr, int wc, int fr, int fq) const {
        const int g = u.pn, mt = u.pm - 3 * g;
#pragma unroll
        for (int ai = 0; ai < 2; ++ai)
#pragma unroll
            for (int m = 0; m < 4; ++m) { const int n = mt * 256 + ai * 128 + wr * 64 + m * 16 + fr; if (n >= 576) continue;
                float* lp = L + ((size_t)n * 32 + g) * 256 + wc * 32 + 4 * fq;
#pragma unroll
                for (int bj = 0; bj < 2; ++bj)
#pragma unroll
                    for (int nn = 0; nn < 2; ++nn) *(f32x4*)(lp + bj * 128 + nn * 16) = acc[ai][bj][m][nn]; }
    }
};
struct EpiS5Y {
    static constexpr bool PERM = false, AFTER_DRAIN = false;
    bf16_t* Z;
    __device__ __forceinline__ void operator()(const f32x4 (&acc)[2][2][4][2], const pg8::Unit& u, int wr, int wc, int fr, int fq) const {
        const int g = u.pn >> 1, nh = u.pn & 1, mt = u.pm - 3 * g;
#pragma unroll
        for (int ai = 0; ai < 2; ++ai)
#pragma unroll
            for (int m = 0; m < 4; ++m) { const int n = mt * 256 + ai * 128 + wr * 64 + m * 16 + fr; const int b = n / 72, cc = n - b * 72; if (n >= 576 || cc < 8) continue;
                bf16_t* zp = Z + (size_t)(b * SEQ + 32 * (cc - 8)) * 512 + g * 16;
#pragma unroll
                for (int bj = 0; bj < 2; ++bj)
#pragma unroll
                    for (int nn = 0; nn < 2; ++nn) { const int mcol = nh * 256 + bj * 128 + wc * 32 + nn * 16 + 4 * fq, t = mcol >> 4, ho = mcol & 15; const f32x4 y = acc[ai][bj][m][nn];
                        u32x2 w; w.x = pk2(gelu_tanh(y.x), gelu_tanh(y.y)); w.y = pk2(gelu_tanh(y.z), gelu_tanh(y.w)); *(u32x2*)(zp + (size_t)t * 512 + ho) = w; } }
    }
};
DI void s5_scan_thread(unsigned char* ws, int gid) {
    const int p = gid & 63, d = (gid >> 6) & 1, g = (gid >> 7) & 31, b = gid >> 12;
    const float* at = (const float*)(ws + WS_S5AT) + ((size_t)(d * 32 + g) * 64 + p) * 2; const float ar = at[0], ai = at[1];
    const float* L = (const float*)(ws + WS_S5L); bf16_t* UG = (bf16_t*)(ws + WS_UG);
    float sr = 0.f, si = 0.f;
    for (int k0 = 0; k0 < 72; k0 += 8) {
        float lr8[8], li8[8];
#pragma unroll
        for (int i = 0; i < 8; ++i) { const int k = k0 + i; const int cc = d == 0 ? k : (k < 8 ? 7 - k : 71 - (k - 8)); const size_t lo = ((size_t)(b * 72 + cc) * 32 + g) * 256 + d * 128 + p; lr8[i] = L[lo]; li8[i] = L[lo + 64]; }
#pragma unroll
        for (int i = 0; i < 8; ++i) { const int k = k0 + i; const int cc = d == 0 ? k : (k < 8 ? 7 - k : 71 - (k - 8));
            if (cc >= 8) { bf16_t* so = UG + ((size_t)g * 768 + b * 72 + cc) * 768 + 512 + d * 128 + p; so[0] = (bf16_t)f2bf(sr); so[64] = (bf16_t)f2bf(si); }
            const float nr = ar * sr - ai * si + lr8[i], ni = ar * si + ai * sr + li8[i]; sr = nr; si = ni; }
    }
}

DI int up_row_map(int n) { return n < FH ? (n >> 7) * 256 + (n & 127) : ((n - FH) >> 7) * 256 + 128 + ((n - FH) & 127); }
DI void p0_transpose_item(const float* W, int K, int N, bf16_t* WT, bool upmap, float* scr, int item, int lane) {
    const int nblk = N / 32, kb = item / nblk, nb = item % nblk, k0 = 64 * kb, n0 = 32 * nb;
    float tv[32];
#pragma unroll
    for (int i = 0; i < 32; ++i) tv[i] = __builtin_nontemporal_load(W + (size_t)(k0 + 2 * i + (lane >> 5)) * N + n0 + (lane & 31));
#pragma unroll
    for (int i = 0; i < 32; ++i) scr[(2 * i + (lane >> 5)) * 33 + (lane & 31)] = tv[i];
    asm volatile("s_waitcnt lgkmcnt(0)" ::: "memory");
    const int c = lane & 7;
#pragma unroll
    for (int j = 0; j < 4; ++j) { const int n = (lane >> 3) + 8 * j; const float* s = scr + (8 * c) * 33 + n;
        u32x4 o; o.x = pk2(s[0 * 33], s[1 * 33]); o.y = pk2(s[2 * 33], s[3 * 33]); o.z = pk2(s[4 * 33], s[5 * 33]); o.w = pk2(s[6 * 33], s[7 * 33]);
        const int nr = upmap ? up_row_map(n0 + n) : n0 + n;
        *(u32x4*)(WT + (size_t)nr * K + k0 + 8 * c) = o; }
    asm volatile("s_waitcnt lgkmcnt(0)" ::: "memory");
}
DI void norm_row(const float* xrow, const float* g, const float* shift, const float* scale, bf16_t* o1, bf16_t* o2, int lane) {
    f32x4 v[4]; float s = 0.f;
#pragma unroll
    for (int j = 0; j < 4; ++j) { v[j] = *((const f32x4*)xrow + lane + 64 * j); s += (v[j].x * v[j].x + v[j].y * v[j].y) + (v[j].z * v[j].z + v[j].w * v[j].w); }
    const float rstd = rsqrtf(wave_sum(s) * (1.f / DM) + NORM_EPS);
#pragma unroll
    for (int j = 0; j < 4; ++j) {
        const f32x4 gg = *((const f32x4*)g + lane + 64 * j), sh = *((const f32x4*)shift + lane + 64 * j), sc = *((const f32x4*)scale + lane + 64 * j);
        const f32x4 y = (v[j] * rstd) * gg * (sc + 1.0f) + sh;
        u32x2 w; w.x = pk2(y.x, y.y); w.y = pk2(y.z, y.w);
        *((u32x2*)o1 + lane + 64 * j) = w; if (o2) *((u32x2*)o2 + lane + 64 * j) = w;
    }
}
DI bf16_t* norm_xne_ptr(bf16_t* XN, int r, int xne_row) {
    if (xne_row < 0) return nullptr;
    const bool isctx = r >= NLAT; const int t = isctx ? (r - NLAT) & 255 : r & 2047, slen = isctx ? CTXL : SEQ, s = isctx ? (r - NLAT) >> 8 : r >> 11;
    const int k = (t + 2) >> 6, pos = (t + 2) & 63;
    if (pos < 4 && k >= 1 && k <= slen / 64 - 1) { const int q = isctx ? NBND_LAT + s * 3 + (k - 1) : s * 31 + (k - 1); return XN + (size_t)(xne_row + 4 * q + pos) * DM; }
    return nullptr;
}
DI void norm_phase(const float* hL, const float* hC, const float* g, const float* mod, int ish, int isc, bf16_t* XN, int nrows, int xne_row, int gw, int NGW, int lane, const float* cadd = nullptr, float* cwb = nullptr) {
    for (int r0 = gw; r0 < nrows; r0 += 2 * NGW) {
        const int r1 = r0 + NGW; const bool has1 = r1 < nrows; const int r1c = has1 ? r1 : r0;
        const float* x0 = r0 >= NLAT ? hC + (size_t)(r0 - NLAT) * DM : hL + (size_t)r0 * DM;
        const float* x1 = r1c >= NLAT ? hC + (size_t)(r1c - NLAT) * DM : hL + (size_t)r1c * DM;
        f32x4 v0[4], v1[4];
#pragma unroll
        for (int j = 0; j < 4; ++j) { v0[j] = *((const f32x4*)x0 + lane + 64 * j); v1[j] = *((const f32x4*)x1 + lane + 64 * j); }
        if (cadd) {
#pragma unroll
            for (int j = 0; j < 4; ++j) {
                if (r0 >= NLAT) { v0[j] += *((const f32x4*)(cadd + (size_t)(r0 - NLAT) * DM) + lane + 64 * j); if (cwb) *((f32x4*)(cwb + (size_t)(r0 - NLAT) * DM) + lane + 64 * j) = v0[j]; }
                if (has1 && r1 >= NLAT) { v1[j] += *((const f32x4*)(cadd + (size_t)(r1 - NLAT) * DM) + lane + 64 * j); if (cwb) *((f32x4*)(cwb + (size_t)(r1 - NLAT) * DM) + lane + 64 * j) = v1[j]; } } }
        const int bb0 = r0 >= NLAT ? 8 : r0 >> 11, bb1 = r1c >= NLAT ? 8 : r1c >> 11;
        const float* sh0 = mod + (size_t)bb0 * 6144 + ish * 1024; const float* sc0 = mod + (size_t)bb0 * 6144 + isc * 1024;
        const float* sh1 = mod + (size_t)bb1 * 6144 + ish * 1024; const float* sc1 = mod + (size_t)bb1 * 6144 + isc * 1024;
        float s0 = 0.f, s1 = 0.f;
#pragma unroll
        for (int j = 0; j < 4; ++j) { s0 += (v0[j].x * v0[j].x + v0[j].y * v0[j].y) + (v0[j].z * v0[j].z + v0[j].w * v0[j].w); s1 += (v1[j].x * v1[j].x + v1[j].y * v1[j].y) + (v1[j].z * v1[j].z + v1[j].w * v1[j].w); }
#pragma unroll
        for (int o = 1; o < 64; o <<= 1) { s0 += __shfl_xor(s0, o); s1 += __shfl_xor(s1, o); }
        const float rs0 = rsqrtf(s0 * (1.f / DM) + NORM_EPS), rs1 = rsqrtf(s1 * (1.f / DM) + NORM_EPS);
        bf16_t* o0 = XN + (size_t)r0 * DM; bf16_t* o1 = XN + (size_t)r1c * DM; bf16_t* e0 = norm_xne_ptr(XN, r0, xne_row); bf16_t* e1 = norm_xne_ptr(XN, r1c, xne_row);
#pragma unroll
        for (int j = 0; j < 4; ++j) {
            const f32x4 gg = *((const f32x4*)g + lane + 64 * j);
            const f32x4 y0 = (v0[j] * rs0) * gg * (*((const f32x4*)sc0 + lane + 64 * j) + 1.0f) + *((const f32x4*)sh0 + lane + 64 * j);
            const f32x4 y1 = (v1[j] * rs1) * gg * (*((const f32x4*)sc1 + lane + 64 * j) + 1.0f) + *((const f32x4*)sh1 + lane + 64 * j);
            u32x2 w0, w1; w0.x = pk2(y0.x, y0.y); w0.y = pk2(y0.z, y0.w); w1.x = pk2(y1.x, y1.y); w1.y = pk2(y1.z, y1.w);
            *((u32x2*)o0 + lane + 64 * j) = w0; if (e0) *((u32x2*)e0 + lane + 64 * j) = w0;
            if (has1) { *((u32x2*)o1 + lane + 64 * j) = w1; if (e1) *((u32x2*)e1 + lane + 64 * j) = w1; }
        }
    }
}
DI void qknorm_phase(bf16_t* PROJ, int ld, int qoff, const float* qn, const float* kn, const float* rope, int gw, int NGW, int lane) {
    const int d0 = 2 * (lane & 31), hsel = lane >> 5;
    const f32x2_t gq = *(const f32x2_t*)(qn + d0), gk = *(const f32x2_t*)(kn + d0);
    const int ridx = (d0 >> 5) * 16 + (d0 & 15); const bool second = (d0 >> 4) & 1;
    for (int r = gw; r < MALL; r += NGW) {
        unsigned* p = (unsigned*)(PROJ + (size_t)r * ld + qoff) + lane;
        const bool lat = r < NLAT; f32x2_t cs = {1.f, 1.f}, sn = {0.f, 0.f};
        if (lat) { const int t = r & 2047; cs = *(const f32x2_t*)(rope + t * 32 + ridx); sn = *(const f32x2_t*)(rope + SEQ * 32 + t * 32 + ridx); }
        unsigned raw[5];
#pragma unroll
        for (int i = 0; i < 5; ++i) raw[i] = p[64 * i];
#pragma unroll
        for (int i = 0; i < 5; ++i) {
            const float a = __uint_as_float(raw[i] << 16), b = __uint_as_float(raw[i] & 0xffff0000u);
            float ss = a * a + b * b;
#pragma unroll
            for (int o = 1; o < 32; o <<= 1) ss += __shfl_xor(ss, o);
            const float rs = rsqrtf(ss * (1.f / 64.f) + NORM_EPS); const bool isq = (2 * i + hsel) < 8;
            float ya = a * rs * (isq ? gq.x : gk.x), yb = b * rs * (isq ? gq.y : gk.y);
            const float pa = __shfl_xor(ya, 8), pb = __shfl_xor(yb, 8);
            if (lat) { ya = second ? (ya * cs.x + pa * sn.x) : (ya * cs.x - pa * sn.x); yb = second ? (yb * cs.y + pb * sn.y) : (yb * cs.y - pb * sn.y); }
            if (isq) { ya *= C2; yb *= C2; }
            p[64 * i] = pk2(ya, yb);
        }
    }
}

struct Args { const float* in[37]; float* out; unsigned char* ws; int ph_lo, ph_hi; };
constexpr int NPHASE = 19;

DI void p0_mod_items(const Args& a, char* lds, int layer, int idx, int nwg) {
    const int tid = threadIdx.x, lane = tid & 63, wid = tid >> 6; unsigned char* ws = a.ws;
    float* cond = (float*)lds;
    float* red = (float*)(lds + 1024 * 12 * 4);
    if (idx < 96) for (int e = tid; e < 9 * 1024; e += NTHREADS) { const int k = e & 1023, bb = e >> 10; const float cv = bb < 8 ? a.in[1][bb * 1024 + k] : a.in[3][k]; cond[k * 12 + bb] = siluf_(cv); }
    __syncthreads();
    float* MOD = (float*)(ws + WS_MOD);
    for (int cb = idx; cb < 96; cb += nwg) {
        const int col = cb * 64 + lane;
        const float* w = a.in[4] + (size_t)layer * DM * 6144 + col;
        float acc[9];
#pragma unroll
        for (int bb = 0; bb < 9; ++bb) acc[bb] = 0.f;
        for (int kk0 = 0; kk0 < 128; kk0 += 16) {
            float wv16[16];
#pragma unroll
            for (int i = 0; i < 16; ++i) wv16[i] = __builtin_nontemporal_load(w + (size_t)(wid * 128 + kk0 + i) * 6144);
#pragma unroll
            for (int i = 0; i < 16; ++i) { const int k = wid * 128 + kk0 + i; const float wv = wv16[i];
                const f32x4 c0 = *(const f32x4*)(cond + k * 12), c1 = *(const f32x4*)(cond + k * 12 + 4); const float c8 = cond[k * 12 + 8];
                acc[0] += c0.x * wv; acc[1] += c0.y * wv; acc[2] += c0.z * wv; acc[3] += c0.w * wv; acc[4] += c1.x * wv; acc[5] += c1.y * wv; acc[6] += c1.z * wv; acc[7] += c1.w * wv; acc[8] += c8 * wv; }
        }
#pragma unroll
        for (int bb = 0; bb < 9; ++bb) red[(wid * 9 + bb) * 64 + lane] = acc[bb];
        __syncthreads();
        for (int e = tid; e < 9 * 64; e += NTHREADS) { const int bb = e >> 6, ln = e & 63; float sacc = a.in[5][layer * 6144 + cb * 64 + ln];
#pragma unroll
            for (int w8 = 0; w8 < 8; ++w8) sacc += red[(w8 * 9 + bb) * 64 + ln];
            MOD[((size_t)layer * 9 + bb) * 6144 + cb * 64 + ln] = sacc; }
        __syncthreads();
    }
}

DI void p0_transposes(const Args& a, char* lds, int layer, int w0, int nw) {
    const int lane = threadIdx.x & 63, wid = threadIdx.x >> 6; unsigned char* ws = a.ws;
    float* scr = (float*)(lds + wid * 16384);
    constexpr int I_IN0 = 16 * (EIN / 32), I_OUT = 16 * 32, I_UP = 16 * (FH2 / 32), I_DN = (FH / 64) * 32, I_IN1 = 16 * (OIN / 32), I_GLU = 8 * 16;
    if (layer == 0) {
        constexpr int NIT = I_IN0 + I_OUT;
        for (int it = w0; it < NIT; it += nw) { int r = it;
            if (r < I_IN0) { p0_transpose_item(a.in[11], DM, EIN, (bf16_t*)(ws + WS_WIN0), false, scr, r, lane); continue; } r -= I_IN0;
            p0_transpose_item(a.in[12], DM, DM, (bf16_t*)(ws + WS_WOUT0), false, scr, r, lane); }
    } else if (layer == 2) {
        constexpr int NIT = I_UP + I_DN;
        for (int it = w0; it < NIT; it += nw) { int r = it;
            if (r < I_UP) { p0_transpose_item(a.in[7], DM, FH2, (bf16_t*)(ws + WS_WUP0), true, scr, r, lane); continue; } r -= I_UP;
            p0_transpose_item(a.in[10], FH, DM, (bf16_t*)(ws + WS_WDN0), false, scr, r, lane); }
    } else {
        constexpr int NIT = I_UP + I_DN + I_IN1 + I_OUT + I_GLU;
        for (int it = w0; it < NIT; it += nw) { int r = it;
            if (r < I_UP) { p0_transpose_item(a.in[7] + (size_t)DM * FH2, DM, FH2, (bf16_t*)(ws + WS_WUP1), true, scr, r, lane); continue; } r -= I_UP;
            if (r < I_DN) { p0_transpose_item(a.in[10] + (size_t)FH * DM, FH, DM, (bf16_t*)(ws + WS_WDN1), false, scr, r, lane); continue; } r -= I_DN;
            if (r < I_IN1) { p0_transpose_item(a.in[22], DM, OIN, (bf16_t*)(ws + WS_WIN1), false, scr, r, lane); continue; } r -= I_IN1;
            if (r < I_OUT) { p0_transpose_item(a.in[23], DM, DM, (bf16_t*)(ws + WS_WOUT1), false, scr, r, lane); continue; } r -= I_OUT;
            p0_transpose_item(a.in[32], 512, 512, (bf16_t*)(ws + WS_WGLU), false, scr, r, lane); }
    }
}

DI void p0_prologue(const Args& a, char* lds, int G, int rep) {
#ifdef P0_REP_EMPTY
    if (rep == 1) return;
#endif
    const int tid = threadIdx.x, lane = tid & 63, wid = tid >> 6;
    unsigned char* ws = a.ws;
    const int gw = blockIdx.x * NWAVES + wid, NGW = G * NWAVES;
    {
        const int gt = blockIdx.x * NTHREADS + tid, NGT = G * NTHREADS;
        float* rope = (float*)(ws + WS_ROPE);
        for (int e = gt; e < SEQ * 32; e += NGT) { const int t = e >> 5, idx = e & 31, i = idx & 15; const float pos = (float)((idx < 16) ? (t >> 6) : (t & 63));
            const float invf = powf(10000.0f, -(float)i / 16.0f); const float ang = pos * invf; rope[e] = cosf(ang); rope[SEQ * 32 + e] = sinf(ang); }
        bf16_t* rgw = (bf16_t*)(ws + WS_RGW);
        for (int e = gt; e < 4 * 8 * 4096; e += NGT) { const int k = e & 63, n = (e >> 6) & 63, hd = (e >> 12) & 7, mi = e >> 15; const int d = mi >> 1;
            const float* w = (mi & 1) ? a.in[17] : a.in[15]; rgw[e] = (bf16_t)f2bf(w[((size_t)(d * 8 + hd) * 64 + k) * 64 + n]); }
    }
    __syncthreads();
    p0_mod_items(a, lds, 0, (int)blockIdx.x, G);
    __syncthreads();
    p0_transposes(a, lds, 0, gw, NGW);
}

__global__ void __launch_bounds__(NTHREADS, 2) trunk_fwd(Args a) {
    extern __shared__ __attribute__((aligned(16))) unsigned char lds_raw[];
    char* lds = (char*)lds_raw;
    PG8_LAS unsigned char* ldsl = (PG8_LAS unsigned char*)lds_raw;
    cg::grid_group grid = cg::this_grid();
    const int tid = threadIdx.x, lane = tid & 63, wid = tid >> 6, G = gridDim.x;
    const int gw = blockIdx.x * NWAVES + wid, NGW = G * NWAVES;
    unsigned char* ws = a.ws;
    const int lo = a.ph_lo, hi = a.ph_hi;
    float* MOD = (float*)(ws + WS_MOD); float* HC = (float*)(ws + WS_HC);
    bf16_t* XN = (bf16_t*)(ws + WS_XN); bf16_t* PROJ = (bf16_t*)(ws + WS_PROJ); bf16_t* MIX = (bf16_t*)(ws + WS_MIX); bf16_t* HID = (bf16_t*)(ws + WS_HID);
    const float* rope = (const float*)(ws + WS_ROPE);
    float* CP = (float*)(ws + WS_Z);
    volatile LAS unsigned* MISC = (volatile LAS unsigned*)((LAS unsigned char*)lds_raw + LDS_MISC);
    if (tid < 64) MISC[tid] = 0u;
    __syncthreads();
    XcdBarrier xbar; xbar.bar = (unsigned*)(ws + WS_CTL) + 4096; xbar.x = 0; xbar.st = nullptr;
    if (hi - lo > 1) xbar = xcd_barrier_post((unsigned*)(ws + WS_CTL) + 4096, MISC + 8);
#ifndef PHASE_MASK
#define PHASE_MASK 0x7ffff
#endif
#define IN(k) (((PHASE_MASK >> (k)) & 1) && lo <= (k) && (k) < hi)
#ifndef DUP_MASK
#define DUP_MASK 0
#endif
#define REP(k) for (int rep_ = 0; rep_ < (((DUP_MASK >> (k)) & 1) ? 2 : 1); ++rep_, (void)((((DUP_MASK >> (k)) & 1) && rep_ == 1) ? (xcd_barrier(xbar), 0) : 0))
#ifdef TIME_MASK
    unsigned long long tprev_ = __builtin_amdgcn_s_memrealtime(), tsum_ = 0ull;
#define TSTAMP(k) do { const unsigned long long tn_ = __builtin_amdgcn_s_memrealtime(); if (((TIME_MASK) >> (k)) & 1) tsum_ += tn_ - tprev_; tprev_ = tn_; } while (0)
#else
#define TSTAMP(k) do {} while (0)
#endif
#define SEAM(k) do { if (IN(k) && IN((k) + 1)) { xcd_barrier(xbar); TSTAMP(k); } } while (0)

    if (hi > 1000) grid.sync();
    if (IN(0)) REP(0) { p0_prologue(a, lds, G, rep_); } SEAM(0);
    if (IN(1)) REP(1) norm_phase(a.in[0], a.in[2], a.in[6], MOD, 0, 1, XN, MALL, -1, gw, NGW, lane);
    SEAM(1);
    if (IN(2)) REP(2) { pg8::Gemm g{XN, (const bf16_t*)(ws + WS_WIN0), MALL, EIN, DM}; pg8::StaticOrder S; S.init(MALL, EIN, G, (int)blockIdx.x);
        pg8::EpiBf16<0> E{PROJ, EIN, nullptr, 0, 0, 1.f}; pg8::gemm_phase<pg8::EpiBf16<0>, pg8::StaticOrder, true, true>(ldsl, g, S, E); }
    SEAM(2);
    if (IN(3)) { qknorm_phase(PROJ, EIN, 1024, a.in[20], a.in[21], rope, gw, NGW, lane); __syncthreads();
#ifdef DUP_RG1
        for (int rep2_ = 0; rep2_ < 2; ++rep2_)
#endif
        for (int it = blockIdx.x; it < NB * 8 * 36; it += G) rg_item1(a.in, ws, lds, it); }
    SEAM(3);
    if (IN(4)) REP(4) {
#ifndef P4_NO_ATTN
#ifdef DUP_ATT
        for (int rep2_ = 0; rep2_ < 2; ++rep2_)
#endif
        for (int it = blockIdx.x; it < 256; it += G) { const int qb = it & 3, head = (it >> 2) & 7, b = it >> 5; attn_unit<0, 2>(PROJ, EIN, 1024, 1536, 1664, MIX, lds, b, head, qb * 512, 0.f); }
        for (int it = blockIdx.x; it < 64; it += G) { const int head = it & 7, b = it >> 3; attn_unit<1, 1>(PROJ, EIN, 1024, 1536, 1664, MIX, lds, b, head, 0, 0.f); }
#endif
#ifndef P4_NO_RG
        for (int it = (blockIdx.x + G - 64) % G; it < NB * 8 * 36; it += G) rg_item2(a.in, ws, lds, it);
#endif
    }
    SEAM(4);
    if (IN(5)) REP(5) { { pg8::Gemm g{MIX, (const bf16_t*)(ws + WS_WOUT0), NLAT, DM, DM}; pg8::StaticOrder S; S.init(NLAT, DM, G, (int)blockIdx.x);
          EpiRes E{a.in[0], a.in[2], a.out, HC, MOD + 2 * 1024}; pg8::gemm_phase<EpiRes, pg8::StaticOrder, true, true>(ldsl, g, S, E); }
#pragma unroll 1
        for (int kh = 0; kh < 2; ++kh) {
          pg8::Gemm g{MIX + kh * 512, (const bf16_t*)(ws + WS_WOUT0) + kh * 512, MALL, DM, 512, DM, DM}; CtxOrder S{(int)blockIdx.x - 64 * kh};
          EpiCtxHalf E{a.in[2], HC, CP, MOD + 2 * 1024, kh}; pg8::gemm_phase<EpiCtxHalf, CtxOrder, true, true>(ldsl, g, S, E); } }
    if (IN(5)) { const int bx = blockIdx.x; const bool busy = (bx < 32) || (bx >= 64 && bx < 96);
        if (G == 256) { if (!busy) { const int idx = bx < 64 ? bx - 32 : bx - 64; p0_transposes(a, lds, 2, idx * NWAVES + wid, 192 * NWAVES); } }
        else p0_transposes(a, lds, 2, gw, NGW); }
    SEAM(5);
    if (IN(6)) REP(6) norm_phase(a.out, HC, a.in[6] + DM, MOD, 3, 4, XN, MALL, XNE_ROW_L0, gw, NGW, lane, CP, HC);
    SEAM(6);
    if (IN(7)) REP(7) { constexpr int MT = MALL + 1280; pg8::Gemm g{XN, (const bf16_t*)(ws + WS_WUP0), MT, FH2, DM}; pg8::StaticOrder S; S.init(MT, FH2, G, (int)blockIdx.x);
        EpiConvAct E{HID, a.in[8], a.in[9], MALL / 256, NBND_LAT, NBND_LAT + NBND_CTX, lds + 131072}; pg8::gemm_phase<EpiConvAct, pg8::StaticOrder, true, true>(ldsl, g, S, E); }
    if (IN(7)) { constexpr int NU = ((MALL + 1280) / 256) * (FH2 / 256), NFULL = NU % 256;
        if (G == 256 && (int)blockIdx.x >= NFULL) p0_transposes(a, lds, 1, ((int)blockIdx.x - NFULL) * NWAVES + wid, (256 - NFULL) * NWAVES);
        else if (G != 256) p0_transposes(a, lds, 1, gw, NGW); }
    SEAM(7);
    if (IN(8)) { { pg8::Gemm g{HID, (const bf16_t*)(ws + WS_WDN0), NLAT, DM, FH}; pg8::StaticOrder S; S.init(NLAT, DM, G, (int)blockIdx.x);
          EpiRes E{a.out, HC, a.out, HC, MOD + 5 * 1024}; pg8::gemm_phase<EpiRes, pg8::StaticOrder, true, true>(ldsl, g, S, E); }
#pragma unroll 1
        for (int kh = 0; kh < 2; ++kh) {
          pg8::Gemm g{HID + kh * (FH / 2), (const bf16_t*)(ws + WS_WDN0) + kh * (FH / 2), MALL, DM, FH / 2, FH, FH}; CtxOrder S{(int)blockIdx.x - 64 * kh};
          EpiCtxHalf E{HC, HC, CP, MOD + 5 * 1024, kh}; pg8::gemm_phase<EpiCtxHalf, CtxOrder, true, true>(ldsl, g, S, E); } }
    if (IN(8)) { const int bx = blockIdx.x; const bool busy = (bx < 32) || (bx >= 64 && bx < 96);
        if (G == 256) { if (!busy) { const int idx = bx < 64 ? bx - 32 : bx - 64; if (idx < 128) s5_pre_item(a.in, ws, lds, idx); else p0_mod_items(a, lds, 1, idx - 128, 64); } }
        else { for (int it = bx; it < 128; it += G) s5_pre_item(a.in, ws, lds, it); p0_mod_items(a, lds, 1, bx, G); } }
    SEAM(8);
    const float* MOD1 = MOD + 9 * 6144;
    if (IN(9)) REP(9) norm_phase(a.out, HC, a.in[6] + 2 * DM, MOD1, 0, 1, XN, MALL, -1, gw, NGW, lane, CP, nullptr);
    SEAM(9);
    if (IN(10)) REP(10) { pg8::Gemm g{XN, (const bf16_t*)(ws + WS_WIN1), MALL, OIN, DM}; pg8::StaticOrder S; S.init(MALL, OIN, G, (int)blockIdx.x);
        pg8::EpiBf16<0> E{PROJ, OIN, nullptr, 0, 0, 1.f}; pg8::gemm_phase<pg8::EpiBf16<0>, pg8::StaticOrder, true, true>(ldsl, g, S, E); }
    SEAM(10);
#define WATT(it_) do { const int it__ = (it_); const int qb = it__ & 7, head = (it__ >> 3) & 7, b = it__ >> 6; \
        attn_unit<2, 1>(PROJ, OIN, 512, 1024, 1152, MIX, lds, b, head, qb * 256, a.in[36][head] * 1.4426950408889634f); } while (0)
    const bool spread = (G == 256); const int bx = blockIdx.x;
    if (IN(11)) { qknorm_phase(PROJ, OIN, 512, a.in[34], a.in[35], rope, gw, NGW, lane);
        for (int n = gw; n < 576; n += NGW) s5_repack_chunk(ws, n, lane);
        xcd_barrier(xbar);
        pg8::Gemm g{(const bf16_t*)(ws + WS_UG), (const bf16_t*)(ws + WS_S5E), 32 * 768, 32 * 256, 512, 768, 512}; S5Order S{G, (int)blockIdx.x, 1};
        EpiS5L E{(float*)(ws + WS_S5L)}; pg8::gemm_phase<EpiS5L, S5Order, true, true>(ldsl, g, S, E);
        if (spread && bx >= 96) WATT(bx - 96); }
    SEAM(11);
    if (IN(12)) REP(12) {
        { const int gt = blockIdx.x * NTHREADS + tid; if (gt < NB * 32 * 2 * 64) s5_scan_thread(ws, gt); }
        __syncthreads();
        if (spread) { if (bx >= 64) WATT(160 + bx - 64); }
        else { const int nskip = (NB * 32 * 2 * 64) / NTHREADS; for (int it = (bx + G - nskip) % G; it < 512; it += G) WATT(it); }
    }
    SEAM(12);
    if (IN(13)) REP(13) { pg8::Gemm g{(const bf16_t*)(ws + WS_UG), (const bf16_t*)(ws + WS_S5MF), 32 * 768, 32 * 512, 768, 768, 768}; S5Order S{G, (int)blockIdx.x, 2};
        EpiS5Y E{(bf16_t*)(ws + WS_Z)}; pg8::gemm_phase<EpiS5Y, S5Order, true, true>(ldsl, g, S, E);
        if (spread && bx >= 192) WATT(352 + bx - 192); }
    SEAM(13);
    if (IN(14)) REP(14) { pg8::Gemm g{(const bf16_t*)(ws + WS_Z), (const bf16_t*)(ws + WS_WGLU), NLAT, 512, 512}; pg8::StaticOrder S; S.init(NLAT, 512, G, (int)blockIdx.x);
        EpiGlu E{(const bf16_t*)(ws + WS_Z), MIX, a.in[33]}; pg8::gemm_phase<EpiGlu, pg8::StaticOrder, true, true>(ldsl, g, S, E);
        if (spread && bx >= 128 && bx < 224) WATT(416 + bx - 128); }
#undef WATT
    SEAM(14);
    if (IN(15)) { pg8::Gemm g{MIX, (const bf16_t*)(ws + WS_WOUT1), NLAT, DM, DM}; pg8::StaticOrder S; S.init(NLAT, DM, G, (int)blockIdx.x);
        EpiRes E{a.out, HC, a.out, HC, MOD1 + 2 * 1024}; pg8::gemm_phase<EpiRes, pg8::StaticOrder, true, true>(ldsl, g, S, E); }
    SEAM(15);
    if (IN(16)) REP(16) norm_phase(a.out, HC, a.in[6] + 3 * DM, MOD1, 3, 4, XN, NLAT, XNE_ROW_L1, gw, NGW, lane);
    SEAM(16);
    if (IN(17)) REP(17) { constexpr int MT = NLAT + 1024; pg8::Gemm g{XN, (const bf16_t*)(ws + WS_WUP1), MT, FH2, DM}; pg8::StaticOrder S; S.init(MT, FH2, G, (int)blockIdx.x);
        EpiConvAct E{HID, a.in[8] + 3 * FH2, a.in[9] + FH2, NLAT / 256, NBND_LAT, NBND_LAT, lds + 131072}; pg8::gemm_phase<EpiConvAct, pg8::StaticOrder, true, true>(ldsl, g, S, E); }
    SEAM(17);
    if (IN(18)) { pg8::Gemm g{HID, (const bf16_t*)(ws + WS_WDN1), NLAT, DM, FH}; pg8::StaticOrder S; S.init(NLAT, DM, G, (int)blockIdx.x);
        EpiRes E{a.out, HC, a.out, HC, MOD1 + 5 * 1024}; pg8::gemm_phase<EpiRes, pg8::StaticOrder, true, true>(ldsl, g, S, E); }
#ifdef TIME_MASK
    xcd_barrier(xbar); TSTAMP(18);
    if (blockIdx.x == 0 && tid == 0) a.out[0] = 1e4f * ((float)tsum_ * 0.01f);
#endif
#undef IN
#undef SEAM
}

#ifndef N_LAUNCH_MODE
#define N_LAUNCH_MODE 1
#endif
extern "C" void kernel_launch(void* const* d_in, const int* in_sizes, int n_in, void* d_out, int out_size, void* d_ws, size_t ws_size, hipStream_t stream) {
    static int grid = 0;
    if (grid == 0) {
        if (n_in != 37 || out_size != NLAT * DM || ws_size < WS_END) { fprintf(stderr, "kernel_launch: unexpected problem (n_in %d out %d ws %zu)\n", n_in, out_size, ws_size); grid = -1; return; }
        int dev = 0, cus = 0, per_cu = 0;
        hipGetDevice(&dev); hipDeviceGetAttribute(&cus, hipDeviceAttributeMultiprocessorCount, dev);
        if (hipFuncSetAttribute((const void*)trunk_fwd, hipFuncAttributeMaxDynamicSharedMemorySize, LDS_BYTES) != hipSuccess) { fprintf(stderr, "kernel_launch: hipFuncSetAttribute failed\n"); grid = -1; return; }
        if (hipOccupancyMaxActiveBlocksPerMultiprocessor(&per_cu, (const void*)trunk_fwd, NTHREADS, LDS_BYTES) != hipSuccess || per_cu < 1) { fprintf(stderr, "kernel_launch: occupancy query says %d\n", per_cu); per_cu = 1; }
        (void)hipGetLastError();
        grid = cus;
        fprintf(stderr, "kernel_launch: grid %d (cus %d, per_cu %d)\n", grid, cus, per_cu);
    }
    if (grid < 0) return;
    (void)hipMemsetAsync((char*)d_ws + WS_CTL, 0, CTL_ZERO_BYTES, stream);
    Args a{};
    for (int i = 0; i < 37; ++i) a.in[i] = (const float*)d_in[i];
    a.out = (float*)d_out; a.ws = (unsigned char*)d_ws;
#if N_LAUNCH_MODE == 1
    a.ph_lo = 0; a.ph_hi = NPHASE;
    void* args[] = {&a};
    hipError_t e = hipLaunchCooperativeKernel((const void*)trunk_fwd, dim3(grid), dim3(NTHREADS), args, LDS_BYTES, stream);
    if (e != hipSuccess) fprintf(stderr, "cooperative launch failed: %s (grid %d)\n", hipGetErrorString(e), grid);
#else
    for (int p = 0; p < NPHASE; ++p) { a.ph_lo = p; a.ph_hi = p + 1; hipLaunchKernelGGL(trunk_fwd, dim3(grid), dim3(NTHREADS), LDS_BYTES, stream, a);
#ifdef DBG_CHECK
        Args d = a; d.ph_lo = 0; d.ph_hi = 0;
        static const int chk[NPHASE][2] = {{1,0},{0,0},{2,0},{3,0},{4,5},{6,0},{0,0},{7,8},{0,0},{0,0},{9,0},{10,0},{11,0},{12,0},{15,0},{0,0},{0,0},{14,0},{0,0}};
        for (int q = 0; q < 2; ++q) { const int st = chk[p][q]; if (!st) continue; const bool heavy = (st == 5 || st == 12); hipLaunchKernelGGL(dbg_check, dim3(heavy ? 1 : 4), dim3(heavy ? 64 : 256), 0, stream, d, st); }
        if (p == NPHASE - 1) hipLaunchKernelGGL(dbg_report, dim3(1), dim3(64), 0, stream, d);
#endif
    }
#endif
}
```
